# Optimizing an MI355X kernel written in HIP

```python
import jax, jax.numpy as jnp
from jax import lax
import numpy as np

D_MODEL = 1024
BATCH = 8
SEQ = 2048
DEPTH = 1

ATTN_GROUPS = ((128, 1), (512, 4), (2048, 16))
N_ATTN_GROUPS = len(ATTN_GROUPS)
ATTN_HEADS_PER_GROUP = 4
ATTN_HEAD_DIM = 128
ATTN_WIDTH = N_ATTN_GROUPS * ATTN_HEADS_PER_GROUP * ATTN_HEAD_DIM
ATTN_OUT_WIDTH = ATTN_HEADS_PER_GROUP * ATTN_HEAD_DIM
ROPE_THETA = 500000.0
ROPE_DIM = ATTN_HEAD_DIM // 4
MLSTM_HEADS = 4
MLSTM_WIDTH = D_MODEL
MLSTM_HEAD_DIM = MLSTM_WIDTH // MLSTM_HEADS
MLSTM_CHUNK = 64
CONV_WIDTH = 4
N_EXPERTS = 32
TOP_K = 4
D_FF = D_MODEL
SWIGLU_LIMIT = 7.0
SWIGLU_ALPHA = 1.702
MOE_BLOCK = 128
RMS_EPS = 1e-5
LN_EPS = 1e-5

IN_SPLIT_SIZES = (ATTN_WIDTH, ATTN_WIDTH, ATTN_WIDTH,
                  MLSTM_WIDTH, MLSTM_WIDTH, MLSTM_WIDTH,
                  MLSTM_WIDTH,
                  MLSTM_HEADS, MLSTM_HEADS,
                  D_MODEL, D_MODEL)
D_IN = sum(IN_SPLIT_SIZES)

kernel_name = 'hybrid_dilated_attn_mlstm_moe_block'


def rms_norm(x, g):
    x32 = x.astype(jnp.float32)
    y = x32 * lax.rsqrt(jnp.mean(x32 * x32, axis=-1, keepdims=True) + RMS_EPS)
    return (y * g.astype(jnp.float32)).astype(x.dtype)


def partial_rotary(x, positions):
    half = ROPE_DIM // 2
    inv_freq = ROPE_THETA ** (-jnp.arange(half, dtype=jnp.float32) / half)
    ang = positions.astype(jnp.float32)[..., None] * inv_freq
    ang = ang.reshape(ang.shape[:2] + (1,) * (x.ndim - 3) + (half,))
    cos, sin = jnp.cos(ang), jnp.sin(ang)
    x32 = x.astype(jnp.float32)
    x1, x2 = x32[..., :half], x32[..., half:ROPE_DIM]
    out = jnp.concatenate([x1 * cos - x2 * sin, x2 * cos + x1 * sin, x32[..., ROPE_DIM:]], axis=-1)
    return out.astype(x.dtype)


def dilated_window_attention(q, k, v, window, dilation):
    B_, S_, H, Dh = q.shape
    sub = window // dilation
    L = S_ // dilation
    nblk = -(-L // sub)
    Lp = nblk * sub

    def to_sub(t):
        t = t.reshape(B_, L, dilation, H, Dh).transpose(0, 2, 3, 1, 4)
        t = jnp.pad(t, ((0, 0), (0, 0), (0, 0), (0, Lp - L), (0, 0)))
        return t.reshape(B_, dilation, H, nblk, sub, Dh)

    def with_prev(t):
        prev = jnp.pad(t, ((0, 0), (0, 0), (0, 0), (1, 0), (0, 0), (0, 0)))[:, :, :, :-1]
        return jnp.concatenate([prev, t], axis=-2)

    qb = to_sub(q)
    kk = with_prev(to_sub(k))
    vv = with_prev(to_sub(v))
    s = jnp.einsum('bdhnqe,bdhnke->bdhnqk', qb, kk, preferred_element_type=jnp.float32) * (Dh ** -0.5)
    blk = jnp.arange(nblk)[:, None, None] * sub
    q_pos = blk + jnp.arange(sub)[None, :, None]
    k_pos = blk - sub + jnp.arange(2 * sub)[None, None, :]
    rel = q_pos - k_pos
    valid = (rel >= 0) & (rel <= sub) & (k_pos >= 0)
    s = jnp.where(valid, s, -jnp.inf)
    m = jnp.max(s, axis=-1, keepdims=True)
    p = jnp.exp(s - m)
    den = jnp.sum(p, axis=-1)
    out = jnp.einsum('bdhnqk,bdhnke->bdhnqe', p, vv.astype(jnp.float32)) / den[..., None]
    lse = m[..., 0] + jnp.log(den)
    out = out.reshape(B_, dilation, H, Lp, Dh)[:, :, :, :L].transpose(0, 3, 1, 2, 4).reshape(B_, S_, H, Dh)
    lse = lse.reshape(B_, dilation, H, Lp)[..., :L].transpose(0, 3, 1, 2).reshape(B_, S_, H)
    return out, lse


def dilated_attention_mixer(aq, ak, av, positions):
    B_, S_, _ = aq.shape
    shp = (B_, S_, N_ATTN_GROUPS, ATTN_HEADS_PER_GROUP, ATTN_HEAD_DIM)
    q = partial_rotary(aq.reshape(shp), positions)
    k = partial_rotary(ak.reshape(shp), positions)
    v = av.reshape(shp)
    outs, lses = [], []
    for g, (window, dilation) in enumerate(ATTN_GROUPS):
        o, lse = dilated_window_attention(q[:, :, g], k[:, :, g], v[:, :, g], window, dilation)
        outs.append(o)
        lses.append(lse)
    w = jax.nn.softmax(jnp.stack(lses), axis=0)
    out = jnp.sum(w[..., None] * jnp.stack(outs), axis=0)
    return out.reshape(B_, S_, ATTN_OUT_WIDTH).astype(aq.dtype)


def causal_depthwise_conv(x, w):
    K, C = w.shape
    return lax.conv_general_dilated(x, w[:, None, :].astype(x.dtype), window_strides=(1,),
                                    padding=[(K - 1, 0)], dimension_numbers=('NWC', 'WIO', 'NWC'),
                                    feature_group_count=C)


def mlstm_chunkwise(q, k, v, i_raw, f_raw):
    B_, S_, H, Dk = q.shape
    Dv = v.shape[-1]
    LC = MLSTM_CHUNK
    nC = S_ // LC

    def chunks(t):
        t = t.astype(jnp.float32)
        if t.ndim == 4:
            return t.reshape(B_, nC, LC, H, t.shape[-1]).transpose(1, 0, 3, 2, 4)
        return t.reshape(B_, nC, LC, H).transpose(1, 0, 3, 2)

    logf = jax.nn.log_sigmoid(f_raw.astype(jnp.float32))
    xs = (chunks(q), chunks(k), chunks(v), chunks(i_raw), chunks(logf))
    causal = jnp.tril(jnp.ones((LC, LC), dtype=bool))

    def step(carry, inp):
        C, n, m = carry
        qc, kc, vc, ic, fc = inp
        b = jnp.cumsum(fc, axis=-1)
        Dm = jnp.where(causal, b[..., :, None] - b[..., None, :] + ic[..., None, :], -jnp.inf)
        inter = b + m[..., None]
        m_t = jnp.maximum(inter, jnp.max(Dm, axis=-1))
        w_intra = jnp.exp(Dm - m_t[..., None])
        w_inter = jnp.exp(inter - m_t)
        A = jnp.einsum('bhtd,bhsd->bhts', qc, kc) * w_intra
        num = jnp.einsum('bhts,bhsv->bhtv', A, vc) + w_inter[..., None] * jnp.einsum('bhtd,bhdv->bhtv', qc, C)
        den = jnp.sum(A, axis=-1) + w_inter * jnp.einsum('bhtd,bhd->bht', qc, n)
        h = num / jnp.maximum(jnp.abs(den), jnp.exp(-m_t))[..., None]
        bL = b[..., -1]
        g = bL[..., None] - b + ic
        m_new = jnp.maximum(bL + m, jnp.max(g, axis=-1))
        decay = jnp.exp(bL + m - m_new)
        wk = jnp.exp(g - m_new[..., None])
        kw = kc * wk[..., None]
        C_new = decay[..., None, None] * C + jnp.einsum('bhsd,bhsv->bhdv', kw, vc)
        n_new = decay[..., None] * n + jnp.sum(kw, axis=-2)
        return (C_new, n_new, m_new), h

    init = (jnp.zeros((B_, H, Dk, Dv), jnp.float32), jnp.zeros((B_, H, Dk), jnp.float32),
            jnp.zeros((B_, H), jnp.float32))
    _, hs = lax.scan(step, init, xs)
    return hs.transpose(1, 0, 3, 2, 4).reshape(B_, S_, H, Dv)


def mlstm_mixer(mq, mk, mv, mo, mi, mf, conv_w, b_if, g_norm):
    B_, S_, _ = mq.shape
    H, Dh = MLSTM_HEADS, MLSTM_HEAD_DIM
    qk = jax.nn.silu(causal_depthwise_conv(jnp.concatenate([mq, mk], axis=-1), conv_w))
    q = qk[..., :MLSTM_WIDTH].reshape(B_, S_, H, Dh)
    k = qk[..., MLSTM_WIDTH:].reshape(B_, S_, H, Dh) * (Dh ** -0.5)
    v = mv.reshape(B_, S_, H, Dh)
    i_raw = mi.astype(jnp.float32) + b_if[:H].astype(jnp.float32)
    f_raw = mf.astype(jnp.float32) + b_if[H:].astype(jnp.float32)
    h = mlstm_chunkwise(q, k, v, i_raw, f_raw)
    mu = jnp.mean(h, axis=-1, keepdims=True)
    var = jnp.mean(jnp.square(h - mu), axis=-1, keepdims=True)
    hn = (h - mu) * lax.rsqrt(var + LN_EPS) * g_norm.astype(jnp.float32).reshape(H, Dh)
    out = jax.nn.sigmoid(mo.astype(jnp.float32)) * hn.reshape(B_, S_, MLSTM_WIDTH)
    return out.astype(mq.dtype)


def moe_ffn(xn, w_router, b_router, w_gate_up, b_gate_up, w_down, b_down):
    B_, S_, D = xn.shape
    T = B_ * S_
    A = T * TOP_K
    xf = xn.reshape(T, D)
    logits = (xf @ w_router + b_router).astype(jnp.float32)
    top_logits, top_idx = lax.top_k(logits, TOP_K)
    gates = jax.nn.softmax(top_logits, axis=-1)
    flat_e = top_idx.reshape(A)
    flat_tok = jnp.repeat(jnp.arange(T, dtype=jnp.int32), TOP_K)
    flat_w = gates.reshape(A)
    order = jnp.argsort(flat_e)
    sorted_e = flat_e[order]
    counts = jnp.bincount(flat_e, length=N_EXPERTS)
    starts = jnp.cumsum(counts) - counts
    padded = (counts + MOE_BLOCK - 1) // MOE_BLOCK * MOE_BLOCK
    padded_ends = jnp.cumsum(padded)
    padded_starts = padded_ends - padded
    rank = jnp.arange(A, dtype=jnp.int32) - starts[sorted_e]
    dest = padded_starts[sorted_e] + rank
    n_blocks = -(-A // MOE_BLOCK) + N_EXPERTS
    n_rows = n_blocks * MOE_BLOCK
    row_tok = jnp.zeros((n_rows,), jnp.int32).at[dest].set(flat_tok[order])
    row_w = jnp.zeros((n_rows,), jnp.float32).at[dest].set(flat_w[order])
    block_e = jnp.minimum(jnp.searchsorted(padded_ends, jnp.arange(n_blocks, dtype=jnp.int32) * MOE_BLOCK,
                                           side='right'), N_EXPERTS - 1)
    xs = xf[row_tok].reshape(n_blocks, MOE_BLOCK, D)

    def expert_block(args):
        xb, e = args
        hg = xb @ w_gate_up[e] + b_gate_up[e]
        gate = jnp.minimum(hg[:, 0::2], SWIGLU_LIMIT)
        up = jnp.clip(hg[:, 1::2], -SWIGLU_LIMIT, SWIGLU_LIMIT)
        act = (up + 1.0) * (gate * jax.nn.sigmoid(SWIGLU_ALPHA * gate))
        return act @ w_down[e] + b_down[e]

    ys = lax.map(expert_block, (xs, block_e)).reshape(n_rows, D).astype(jnp.float32) * row_w[:, None]
    out = jnp.zeros((T, D), jnp.float32).at[row_tok].add(ys)
    return out.reshape(B_, S_, D).astype(xn.dtype)


def setup_inputs(seed: int = 0) -> dict:
    key = jax.random.key(seed)
    ks = jax.random.split(key, 20)
    f32 = jnp.float32
    nrm = lambda k, shp: jax.random.normal(k, shp, f32)
    H = MLSTM_HEADS
    b_i = 0.1 * nrm(ks[5], (DEPTH, H))
    b_f = jnp.linspace(3.0, 6.0, H, dtype=f32)[None, :] + 0.1 * nrm(ks[6], (DEPTH, H))
    return {
        'x': nrm(ks[0], (BATCH, SEQ, D_MODEL)),
        'positions': (jnp.arange(SEQ, dtype=jnp.int32)[None, :]
                      + jax.random.randint(ks[1], (BATCH, 1), 0, 4096, dtype=jnp.int32)),
        'g_mix': 1.0 + 0.05 * nrm(ks[2], (DEPTH, D_MODEL)),
        'w_in': nrm(ks[3], (DEPTH, D_MODEL, D_IN)) * D_MODEL ** -0.5,
        'conv_qk': nrm(ks[4], (DEPTH, CONV_WIDTH, 2 * MLSTM_WIDTH)) * CONV_WIDTH ** -0.5,
        'b_if': jnp.concatenate([b_i, b_f], axis=-1),
        'g_mlstm_norm': 1.0 + 0.05 * nrm(ks[7], (DEPTH, MLSTM_WIDTH)),
        'w_attn_out': nrm(ks[8], (DEPTH, ATTN_OUT_WIDTH, D_MODEL)) * ATTN_OUT_WIDTH ** -0.5,
        'w_mlstm_out': nrm(ks[9], (DEPTH, MLSTM_WIDTH, D_MODEL)) * MLSTM_WIDTH ** -0.5,
        'w_mix_out': nrm(ks[10], (DEPTH, D_MODEL, D_MODEL)) * D_MODEL ** -0.5,
        'g_ffn': 1.0 + 0.05 * nrm(ks[11], (DEPTH, D_MODEL)),
        'w_router': nrm(ks[12], (DEPTH, D_MODEL, N_EXPERTS)) * D_MODEL ** -0.5,
        'b_router': 0.01 * nrm(ks[13], (DEPTH, N_EXPERTS)),
        'w_gate_up': nrm(ks[14], (DEPTH, N_EXPERTS, D_MODEL, 2 * D_FF)) * D_MODEL ** -0.5,
        'b_gate_up': 0.02 * nrm(ks[15], (DEPTH, N_EXPERTS, 2 * D_FF)),
        'w_down': nrm(ks[16], (DEPTH, N_EXPERTS, D_FF, D_MODEL)) * D_FF ** -0.5,
        'b_down': 0.02 * nrm(ks[17], (DEPTH, N_EXPERTS, D_MODEL)),
        'g_final': 1.0 + 0.05 * nrm(ks[18], (D_MODEL,)),
    }


def reference(x, positions, g_mix, w_in, conv_qk, b_if, g_mlstm_norm, w_attn_out, w_mlstm_out,
              w_mix_out, g_ffn, w_router, b_router, w_gate_up, b_gate_up, w_down, b_down, g_final):
    offsets = [int(o) for o in np.cumsum(IN_SPLIT_SIZES)[:-1]]
    h = x
    for l in range(DEPTH):
        xn = rms_norm(h, g_mix[l])
        proj = xn @ w_in[l]
        aq, ak, av, mq, mk, mv, mo, mi, mf, ga, gm = jnp.split(proj, offsets, axis=-1)
        attn = dilated_attention_mixer(aq, ak, av, positions)
        mem = mlstm_mixer(mq, mk, mv, mo, mi, mf, conv_qk[l], b_if[l], g_mlstm_norm[l])
        merged = (jax.nn.sigmoid(ga) * (attn @ w_attn_out[l])
                  + jax.nn.sigmoid(gm) * (mem @ w_mlstm_out[l]))
        h = h + merged @ w_mix_out[l]
        h = h + moe_ffn(rms_norm(h, g_ffn[l]), w_router[l], b_router[l], w_gate_up[l],
                        b_gate_up[l], w_down[l], b_down[l])
    return rms_norm(h, g_final)
```

```cpp
#include <hip/hip_runtime.h>
#include <cstdio>
#include <cstdint>

#define LAS __attribute__((address_space(3)))
#define GAS __attribute__((address_space(1)))
typedef unsigned short bf16;
typedef float f32x4 __attribute__((ext_vector_type(4)));
typedef float f32x2 __attribute__((ext_vector_type(2)));
typedef unsigned u32x4 __attribute__((ext_vector_type(4)));
typedef unsigned u32x2 __attribute__((ext_vector_type(2)));
typedef short bf16x8 __attribute__((ext_vector_type(8)));

#ifndef FAST_P1
#define FAST_P1 1
#endif
#ifndef FAST_P4
#define FAST_P4 1
#endif
#ifndef FAST_P5
#define FAST_P5 1
#endif
#ifndef FAST_MOE
#define FAST_MOE 1
#endif
#ifndef FAST_ATTN
#define FAST_ATTN 0
#endif
#ifndef FAST_MLSTM
#define FAST_MLSTM 0
#endif

constexpr int T = 16384, D = 1024, SEQ = 2048, NB = 8;
constexpr int DIN = 10760, NP = 10752;
constexpr int C_AQ = 0, C_AK = 1536, C_AV = 3072, C_MQ = 4608, C_MK = 5632, C_MV = 6656, C_MO = 7680, C_GA = 8704, C_GM = 9728;
constexpr int NE = 32, TOPK = 4, NA = T * TOPK, MAXTILES = NA / 256 + NE, XS_ROWS = MAXTILES * 256;
constexpr float QSCALE = 0.08838834764831845f * 1.4426950408889634f;
constexpr float RMS_EPS = 1e-5f, LN_EPS = 1e-5f;

constexpr size_t MiB = 1u << 20;
constexpr size_t WS_CTL = 0, CTL_ZERO_BYTES = 1 * MiB;
constexpr size_t WS_WIN = 2 * MiB, WS_WAM = 23 * MiB, WS_WO = 26 * MiB, WS_WGU = 28 * MiB, WS_WDN = 156 * MiB;
constexpr size_t WS_XN = 220 * MiB, WS_GATES = 252 * MiB, WS_ROPE = 253 * MiB, WS_ROUTE = 255 * MiB;
constexpr size_t WS_H = 256 * MiB, WS_MERGED = 320 * MiB;
constexpr size_t WS_OG = 352 * MiB, WS_LSE = 400 * MiB, WS_HT = 401 * MiB, WS_AM = 465 * MiB;
constexpr size_t WS_YBUF = 352 * MiB;
constexpr size_t WS_PROJ = 513 * MiB;
constexpr size_t WS_XS = 513 * MiB, WS_ACT = 657 * MiB;
constexpr size_t WS_ROWMETA = 801 * MiB;
constexpr size_t WS_QC = 849 * MiB, WS_KC = 913 * MiB, WS_END = 977 * MiB;
constexpr int CW_TMO = 0, CW_BAR = 4096, CW_CNT = 8192, CW_NTILES = 8256, CW_TILEE = 8320;

constexpr int RING_BYTES = 131072, LDSCTL_OFF = RING_BYTES, MISC_OFF = LDSCTL_OFF + 320, LDS_BYTES = 147456;
constexpr int NWAVES = 8, NTHREADS = 512;

__device__ __forceinline__ unsigned f2bf(float f) { unsigned u = __builtin_bit_cast(unsigned, f); return (u + 0x7fffu + ((u >> 16) & 1u)) >> 16; }
__device__ __forceinline__ unsigned pk2(float lo, float hi) { return f2bf(lo) | (f2bf(hi) << 16); }
__device__ __forceinline__ float bf2f(unsigned b) { return __builtin_bit_cast(float, b << 16); }
__device__ __forceinline__ float bflo(unsigned w) { return __builtin_bit_cast(float, w << 16); }
__device__ __forceinline__ float bfhi(unsigned w) { return __builtin_bit_cast(float, w & 0xffff0000u); }
__device__ __forceinline__ float wave_sum(float v) {
#pragma unroll
    for (int o = 1; o < 64; o <<= 1) v += __shfl_xor(v, o);
    return v;
}
__device__ __forceinline__ float wave_max(float v) {
#pragma unroll
    for (int o = 1; o < 64; o <<= 1) v = fmaxf(v, __shfl_xor(v, o));
    return v;
}
__device__ __forceinline__ float sigmoidf_(float x) { return 1.0f / (1.0f + __expf(-x)); }

__host__ __device__ __forceinline__ int win_logical_col(int c) {
    if (c < C_AV) { const int p = c & 127; if (p < 32) { const int a = p >> 3, n = (p >> 2) & 1, j = p & 3; return (c - p) + 16 * n + 4 * a + j; } return c; }
    return c < C_GA ? c : c + 8;
}
__host__ __device__ __forceinline__ int wgu_logical_col(int c) { const int pn = c >> 8, bj = (c >> 7) & 1, jl = c & 127; return 2 * (128 * pn + jl) + bj; }
namespace pg8 {
#define PG8_LAS __attribute__((address_space(3)))
typedef unsigned short bf16_t;
typedef short bf16x8 __attribute__((ext_vector_type(8)));
typedef float f32x4 __attribute__((ext_vector_type(4)));
typedef unsigned u32x4 __attribute__((ext_vector_type(4)));
constexpr int BM = 256, BK = 64, HALF = 128, HTB = HALF * BK * 2  , STAGE_BYTES = 8 * HTB, NXCD = 8, WGM = 8;

__host__ __device__ __forceinline__ int lds_byte(int r, int c) { const int st = (r >> 4) * 2 + (c >> 5), rr = r & 15, cc = c & 31, ob = rr * 64 + cc * 2; return st * 1024 + (ob ^ (((ob >> 9) & 1) << 5)); }
__host__ __device__ __forceinline__ void stage_rc(int b, int& R, int& C) { const int st = b / 1024, sb = b % 1024, swz = sb ^ (((sb >> 9) & 1) << 5); R = (st >> 1) * 16 + swz / 64; C = (st & 1) * 32 + (swz % 64) / 2; }
__host__ __device__ __forceinline__ int perm32(int rho) { const int n = rho >> 4, i = rho & 15; return 8 * (i >> 2) + 4 * n + (i & 3); }

struct Unit { int pm, pn, part; };
struct Gemm { const bf16_t* A; const bf16_t* Bt; int M, N, K; };

struct StaticOrder {
    int nM, nN, nwg, G, c;
    __host__ __device__ void init(int M, int N, int G_, int c_) { nM = M / BM; nN = N / BM; nwg = nM * nN; G = G_; c = c_; }
    __host__ __device__ bool next(int i, Unit& u) const {
        const long L = (long)i * G + c; if (L >= nwg) return false;
        int wgid = (int)L; { const int q = nwg / NXCD, r = nwg % NXCD, xcd = wgid % NXCD, off = wgid / NXCD; wgid = (xcd < r ? xcd * (q + 1) : r * (q + 1) + (xcd - r) * q) + off; }
        const int nig = WGM * nN, gid = wgid / nig, fm = gid * WGM, gsz = (nM - fm) < WGM ? (nM - fm) : WGM;
        u.pm = fm + ((wgid % nig) % gsz); u.pn = (wgid % nig) / gsz; u.part = 0; return true;
    }
    __device__ __forceinline__ int kt0(const Unit&) const { return 0; }
    __device__ __forceinline__ int nkt(const Unit&, int full) const { return full; }
    __device__ __forceinline__ void a_ready(const Unit&) const {}
    __device__ __forceinline__ void done(const Unit&) const {}
};


__device__ __forceinline__ unsigned cvt_pk_bf16(float lo, float hi) { unsigned r; asm volatile("v_cvt_pk_bf16_f32 %0, %1, %2" : "=v"(r) : "v"(lo), "v"(hi)); return r; }
__device__ __forceinline__ u32x4 pack8(const f32x4 v0, const f32x4 v1) { u32x4 w; w.x = cvt_pk_bf16(v0[0], v0[1]); w.y = cvt_pk_bf16(v0[2], v0[3]); w.z = cvt_pk_bf16(v1[0], v1[1]); w.w = cvt_pk_bf16(v1[2], v1[3]); return w; }
__device__ __forceinline__ void unpack8(const u32x4 w, f32x4& v0, f32x4& v1) {
    v0[0] = __builtin_bit_cast(float, w.x << 16); v0[1] = __builtin_bit_cast(float, w.x & 0xffff0000u); v0[2] = __builtin_bit_cast(float, w.y << 16); v0[3] = __builtin_bit_cast(float, w.y & 0xffff0000u);
    v1[0] = __builtin_bit_cast(float, w.z << 16); v1[1] = __builtin_bit_cast(float, w.z & 0xffff0000u); v1[2] = __builtin_bit_cast(float, w.w << 16); v1[3] = __builtin_bit_cast(float, w.w & 0xffff0000u);
}
__device__ __forceinline__ f32x4 sig4(const f32x4 x) { f32x4 r; r[0] = 1.0f / (1.0f + __expf(-x[0])); r[1] = 1.0f / (1.0f + __expf(-x[1])); r[2] = 1.0f / (1.0f + __expf(-x[2])); r[3] = 1.0f / (1.0f + __expf(-x[3])); return r; }

struct GroupedOrder {
    const unsigned* tile_e; int ntiles, nN, G, c;
    __device__ __forceinline__ int kt0(const Unit&) const { return 0; }
    __device__ __forceinline__ int nkt(const Unit&, int full) const { return full; }
    __device__ bool next(int i, Unit& u) const {
        const long L = (long)i * G + c; if (L >= (long)ntiles * nN) return false;
        u.pm = (int)(L / nN); const int e = (int)tile_e[u.pm]; u.pn = e * nN + (int)(L % nN); u.part = 0; return true;
    }
    __device__ __forceinline__ void a_ready(const Unit&) const {}
    __device__ __forceinline__ void done(const Unit&) const {}
};

struct EpiProj {
    static constexpr bool PERM = true, AFTER_DRAIN = false, HAS_MID = false;
    bf16_t* O; const float* rope;
    __device__ __forceinline__ bool keep(const Unit&) const { return false; }
    __device__ __forceinline__ void operator()(f32x4 (&acc)[2][2][4][2], const Unit& u, int wr, int wc, int fr, int fq) const {
        const int row0 = u.pm * BM + wr * 64 + fr, col0 = u.pn * BM + wc * 32 + 8 * fq;
        const float sc = (u.pn < 6) ? QSCALE : 1.0f;
        const bool dorope = (u.pn < 12) && (wc == 0);
#pragma unroll
        for (int ai = 0; ai < 2; ++ai)
#pragma unroll
            for (int m = 0; m < 4; ++m) {
                const int row = row0 + ai * HALF + m * 16; bf16_t* rowp = O + (size_t)row * NP + col0;
                f32x4 cs = (f32x4){1.f, 1.f, 1.f, 1.f}, sn = (f32x4){0.f, 0.f, 0.f, 0.f};
                if (dorope) { cs = *(const f32x4*)(rope + (size_t)row * 32 + 4 * fq); sn = *(const f32x4*)(rope + (size_t)row * 32 + 16 + 4 * fq); }
#pragma unroll
                for (int bj = 0; bj < 2; ++bj) {
                    f32x4 v0 = acc[ai][bj][m][0], v1 = acc[ai][bj][m][1];
                    if (dorope) { const f32x4 t0 = v0 * cs - v1 * sn, t1 = v1 * cs + v0 * sn; v0 = t0; v1 = t1; }
                    v0 = v0 * sc; v1 = v1 * sc;
                    *(u32x4*)(rowp + bj * HALF) = pack8(v0, v1);
                }
            }
    }
};

struct MergedOrder {
    StaticOrder base;
    __device__ bool next(int i, Unit& u) const { if (!base.next(i >> 1, u)) return false; u.part = i & 1; return true; }
    __device__ __forceinline__ int kt0(const Unit& u) const { return u.part ? 8 : 0; }
    __device__ __forceinline__ int nkt(const Unit& u, int) const { return u.part ? 16 : 8; }
    __device__ __forceinline__ void a_ready(const Unit&) const {}
    __device__ __forceinline__ void done(const Unit&) const {}
};
struct EpiMerged {
    static constexpr bool PERM = true, AFTER_DRAIN = false, HAS_MID = false;
    bf16_t* O; const bf16_t* proj;
    __device__ __forceinline__ bool keep(const Unit& u) const { return u.part == 0; }
    __device__ __forceinline__ void operator()(f32x4 (&acc)[2][2][4][2], const Unit& u, int wr, int wc, int fr, int fq) const {
        const int row0 = u.pm * BM + wr * 64 + fr, col0 = u.pn * BM + wc * 32 + 8 * fq;
        if (u.part == 0) {
#pragma unroll
            for (int ai = 0; ai < 2; ++ai)
#pragma unroll
                for (int m = 0; m < 4; ++m) {
                    const bf16_t* rowp = proj + (size_t)(row0 + ai * HALF + m * 16) * NP + col0;
#pragma unroll
                    for (int bj = 0; bj < 2; ++bj) {
                        const u32x4 ga = *(const u32x4*)(rowp + C_GA + bj * HALF), gm = *(const u32x4*)(rowp + C_GM + bj * HALF);
                        f32x4 a0, a1, m0, m1; unpack8(ga, a0, a1); unpack8(gm, m0, m1);
                        f32x4 r0, r1;
#pragma unroll
                        for (int j = 0; j < 4; ++j) { r0[j] = (1.0f + __expf(-m0[j])) / (1.0f + __expf(-a0[j])); r1[j] = (1.0f + __expf(-m1[j])) / (1.0f + __expf(-a1[j])); }
                        acc[ai][bj][m][0] *= r0; acc[ai][bj][m][1] *= r1;
                    }
                    if (m & 1) asm volatile("" ::: "memory");
                }
        } else {
#pragma unroll
            for (int ai = 0; ai < 2; ++ai)
#pragma unroll
                for (int m = 0; m < 4; ++m) {
                    const int row = row0 + ai * HALF + m * 16;
#pragma unroll
                    for (int bj = 0; bj < 2; ++bj) {
                        const u32x4 gm = *(const u32x4*)(proj + (size_t)row * NP + C_GM + col0 + bj * HALF);
                        f32x4 m0, m1; unpack8(gm, m0, m1);
                        const f32x4 v0 = acc[ai][bj][m][0] * sig4(m0), v1 = acc[ai][bj][m][1] * sig4(m1);
                        *(u32x4*)(O + (size_t)row * D + col0 + bj * HALF) = pack8(v0, v1);
                    }
                }
        }
    }
};

struct EpiResid {
    static constexpr bool PERM = false, AFTER_DRAIN = false, HAS_MID = false;
    const float* x; float* h;
    __device__ __forceinline__ bool keep(const Unit&) const { return false; }
    __device__ __forceinline__ void operator()(f32x4 (&acc)[2][2][4][2], const Unit& u, int wr, int wc, int fr, int fq) const {
        const int row0 = u.pm * BM + wr * 64 + fr, col0 = u.pn * BM + wc * 32 + 4 * fq;
#pragma unroll
        for (int ai = 0; ai < 2; ++ai)
#pragma unroll
            for (int m = 0; m < 4; ++m) {
                const size_t off = (size_t)(row0 + ai * HALF + m * 16) * D + col0;
#pragma unroll
                for (int bj = 0; bj < 2; ++bj)
#pragma unroll
                    for (int n = 0; n < 2; ++n) *(f32x4*)(h + off + bj * HALF + n * 16) = *(const f32x4*)(x + off + bj * HALF + n * 16) + acc[ai][bj][m][n];
            }
    }
};

struct EpiSwiGLU {
    static constexpr bool PERM = true, AFTER_DRAIN = false, HAS_MID = false;
    bf16_t* act; const float* bgu;
    __device__ __forceinline__ bool keep(const Unit&) const { return false; }
    __device__ __forceinline__ void operator()(f32x4 (&acc)[2][2][4][2], const Unit& u, int wr, int wc, int fr, int fq) const {
        const int e = u.pn >> 3, pnl = u.pn & 7, row0 = u.pm * BM + wr * 64 + fr, j0 = 128 * pnl + 32 * wc + 8 * fq;
        const float* bp = bgu + (size_t)e * 2048 + 2 * j0;
        const f32x4 b0 = *(const f32x4*)(bp), b1 = *(const f32x4*)(bp + 4), b2 = *(const f32x4*)(bp + 8), b3 = *(const f32x4*)(bp + 12);
        const f32x4 bg0 = (f32x4){b0[0], b0[2], b1[0], b1[2]}, bu0 = (f32x4){b0[1], b0[3], b1[1], b1[3]}, bg1 = (f32x4){b2[0], b2[2], b3[0], b3[2]}, bu1 = (f32x4){b2[1], b2[3], b3[1], b3[3]};
#pragma unroll
        for (int ai = 0; ai < 2; ++ai)
#pragma unroll
            for (int m = 0; m < 4; ++m) {
                const int row = row0 + ai * HALF + m * 16;
                f32x4 o[2];
#pragma unroll
                for (int n = 0; n < 2; ++n) {
                    const f32x4 g = acc[ai][0][m][n] + (n ? bg1 : bg0), up = acc[ai][1][m][n] + (n ? bu1 : bu0);
#pragma unroll
                    for (int j = 0; j < 4; ++j) { const float gg = fminf(g[j], 7.0f), uu = fminf(fmaxf(up[j], -7.0f), 7.0f); o[n][j] = (uu + 1.0f) * gg / (1.0f + __expf(-1.702f * gg)); }
                }
                *(u32x4*)(act + (size_t)row * D + j0) = pack8(o[0], o[1]);
            }
    }
};

struct EpiDown {
    static constexpr bool PERM = true, AFTER_DRAIN = false, HAS_MID = false;
    bf16_t* ybuf; const float* bdn; const int* row_tok; const float* row_w;
    __device__ __forceinline__ bool keep(const Unit&) const { return false; }
    __device__ __forceinline__ void operator()(f32x4 (&acc)[2][2][4][2], const Unit& u, int wr, int wc, int fr, int fq) const {
        const int e = u.pn >> 2, pnl = u.pn & 3, row0 = u.pm * BM + wr * 64 + fr, col0 = 256 * pnl + 32 * wc + 8 * fq;
        f32x4 bv[2][2];
#pragma unroll
        for (int bj = 0; bj < 2; ++bj)
#pragma unroll
            for (int n = 0; n < 2; ++n) bv[bj][n] = *(const f32x4*)(bdn + (size_t)e * D + col0 + bj * HALF + 4 * n);
#pragma unroll
        for (int ai = 0; ai < 2; ++ai)
#pragma unroll
            for (int m = 0; m < 4; ++m) {
                const int row = row0 + ai * HALF + m * 16; const int tk = row_tok[row]; const float w = row_w[row];
                if (tk >= 0) {
#pragma unroll
                    for (int bj = 0; bj < 2; ++bj) {
                        const f32x4 v0 = (acc[ai][bj][m][0] + bv[bj][0]) * w, v1 = (acc[ai][bj][m][1] + bv[bj][1]) * w;
                        *(u32x4*)(ybuf + (size_t)tk * D + col0 + bj * HALF) = pack8(v0, v1);
                    }
                }
            }
    }
};
template <class Epi, class Sched, bool ALIGN_EPI = false, bool SP2 = false>
__device__ __forceinline__ void gemm_phase(PG8_LAS unsigned char* lds, const Gemm g, const Sched& S, const Epi& E) {
    const int tid = threadIdx.x, wid = __builtin_amdgcn_readfirstlane(tid >> 6), lane = tid & 63, wr = wid >> 2, wc = wid & 3, fr = lane & 15, fq = lane >> 4;
    const int K = g.K, ntfull = K / BK;
    unsigned voffA[2], voffB[2];
#pragma unroll
    for (int i = 0; i < 2; ++i) { int R, C; stage_rc(tid * 16 + i * 8192, R, C); const int Rb = Epi::PERM ? ((R & ~31) + perm32(R & 31)) : R;
        voffA[i] = (unsigned)(R * K + C) * 2u; voffB[i] = (unsigned)(Rb * K + C) * 2u; }
    const size_t kstep = (size_t)(BK * 2);
    const size_t hstep = (size_t)HALF * K * 2;
    const size_t tstep = 2 * hstep;
    const unsigned ldsw = (unsigned)wid * 1024u;
    const int aoff = lds_byte(wr * 64 + fr, fq * 8), boff = lds_byte(wc * 32 + fr, fq * 8);
#define PG8_SA(b, h) (((b) * 2 + (h)) * HTB)
#define PG8_SB(b, h) ((4 + (b) * 2 + (h)) * HTB)
#define PG8_STAGE(bufoff, gbase, voff) do { _Pragma("unroll") for (int _i = 0; _i < 2; ++_i) \
        __builtin_amdgcn_global_load_lds((const unsigned*)((const char*)(gbase) + (voff)[_i]), (PG8_LAS unsigned*)(lds + (bufoff) + ldsw + _i * 8192), 16, 0, 0); } while (0)
#define PG8_LDA(dst, b, h) do { _Pragma("unroll") for (int m = 0; m < 4; ++m) _Pragma("unroll") for (int k = 0; k < 2; ++k) dst[m][k] = *(const PG8_LAS bf16x8*)(lds + PG8_SA(b, h) + aoff + m * 2048 + k * 1024); } while (0)
#define PG8_LDB(dst, b, h) do { _Pragma("unroll") for (int n = 0; n < 2; ++n) _Pragma("unroll") for (int k = 0; k < 2; ++k) dst[n][k] = *(const PG8_LAS bf16x8*)(lds + PG8_SB(b, h) + boff + n * 2048 + k * 1024); } while (0)
#define PG8_MMA(ai, bj, At, Bt) do { __builtin_amdgcn_s_setprio(1); _Pragma("unroll") for (int m = 0; m < 4; ++m) _Pragma("unroll") for (int n = 0; n < 2; ++n) _Pragma("unroll") for (int k = 0; k < 2; ++k) \
        acc[ai][bj][m][n] = __builtin_amdgcn_mfma_f32_16x16x32_bf16(Bt[n][k], At[m][k], acc[ai][bj][m][n], 0, 0, 0); __builtin_amdgcn_s_setprio(0); } while (0)
#define PG8_WAIT_V(n) asm volatile("s_waitcnt vmcnt(" #n ")" ::: "memory")
#define PG8_WAIT_L(n) asm volatile("s_waitcnt lgkmcnt(" #n ")" ::: "memory")
#define PG8_BAR __builtin_amdgcn_s_barrier()
#define PG8_SCHED __builtin_amdgcn_sched_barrier(0)
    Unit cur, nxt; int ui = 0;
    if (!S.next(0, cur)) return;
    f32x4 acc[2][2][4][2];
#pragma unroll
    for (int a = 0; a < 2; ++a)
#pragma unroll
        for (int b = 0; b < 2; ++b)
#pragma unroll
            for (int m = 0; m < 4; ++m)
#pragma unroll
                for (int n = 0; n < 2; ++n) acc[a][b][m][n] = (f32x4){0.f, 0.f, 0.f, 0.f};
    bf16x8 At[4][2], B0[2][2], B1[2][2];
    const char* cA = (const char*)g.A + (size_t)cur.pm * tstep + (size_t)S.kt0(cur) * kstep; const char* cB = (const char*)g.Bt + (size_t)cur.pn * tstep + (size_t)S.kt0(cur) * kstep;
    S.a_ready(cur);
    if constexpr (SP2) {
        PG8_STAGE(PG8_SB(0, 0), cB, voffB); PG8_STAGE(PG8_SB(0, 1), cB + hstep, voffB); PG8_STAGE(PG8_SA(0, 0), cA, voffA); PG8_STAGE(PG8_SA(0, 1), cA + hstep, voffA);
        if (wr == 1) PG8_BAR;
        PG8_WAIT_V(2); PG8_BAR;
        PG8_STAGE(PG8_SB(1, 0), cB + kstep, voffB); PG8_STAGE(PG8_SA(1, 0), cA + kstep, voffA); PG8_STAGE(PG8_SB(1, 1), cB + hstep + kstep, voffB);
        PG8_WAIT_V(6); PG8_BAR;
    } else {
        PG8_STAGE(PG8_SB(0, 0), cB, voffB); PG8_STAGE(PG8_SA(0, 0), cA, voffA); PG8_STAGE(PG8_SB(0, 1), cB + hstep, voffB); PG8_STAGE(PG8_SA(0, 1), cA + hstep, voffA);
        if (wr == 1) PG8_BAR;
        PG8_WAIT_V(4); PG8_BAR;
        PG8_STAGE(PG8_SB(1, 0), cB + kstep, voffB); PG8_STAGE(PG8_SA(1, 0), cA + kstep, voffA); PG8_STAGE(PG8_SB(1, 1), cB + hstep + kstep, voffB);
        PG8_WAIT_V(6); PG8_BAR;
    }
    for (;;) {
        const bool has_next = S.next(ui + 1, nxt);
        const char* nA = has_next ? (const char*)g.A + (size_t)nxt.pm * tstep + (size_t)S.kt0(nxt) * kstep : cA; const char* nB = has_next ? (const char*)g.Bt + (size_t)nxt.pn * tstep + (size_t)S.kt0(nxt) * kstep : cB;
        const int nt = S.nkt(cur, ntfull);
        for (int t = 0; t < nt; t += 2) {
            const bool last = (t == nt - 2);
            const char* a1 = cA + (size_t)(t + 1) * kstep;
            const char* a2 = last ? nA : cA + (size_t)(t + 2) * kstep; const char* b2 = last ? nB : cB + (size_t)(t + 2) * kstep;
            const char* a3 = a2 + kstep; const char* b3 = b2 + kstep;
            if (last && has_next) S.a_ready(nxt);
            if constexpr (SP2) {
            PG8_LDB(B0, 0, 0); PG8_LDB(B1, 0, 1); PG8_SCHED; PG8_LDA(At, 0, 0); PG8_STAGE(PG8_SA(1, 1), a1 + hstep, voffA);
            PG8_WAIT_V(8); PG8_WAIT_L(0); PG8_BAR; PG8_MMA(0, 0, At, B0); PG8_MMA(0, 1, At, B1); PG8_BAR; PG8_SCHED;
            PG8_LDA(At, 0, 1); PG8_STAGE(PG8_SB(0, 0), b2, voffB); PG8_STAGE(PG8_SB(0, 1), b2 + hstep, voffB); PG8_STAGE(PG8_SA(0, 0), a2, voffA);
            PG8_WAIT_V(8); PG8_WAIT_L(0); PG8_BAR; PG8_MMA(1, 0, At, B0); PG8_MMA(1, 1, At, B1); PG8_BAR; PG8_SCHED;
            PG8_LDB(B0, 1, 0); PG8_LDB(B1, 1, 1); PG8_SCHED; PG8_LDA(At, 1, 0); PG8_STAGE(PG8_SA(0, 1), a2 + hstep, voffA);
            PG8_WAIT_V(8); PG8_WAIT_L(0); PG8_BAR; PG8_MMA(0, 0, At, B0); PG8_MMA(0, 1, At, B1); PG8_BAR; PG8_SCHED;
            PG8_LDA(At, 1, 1); PG8_STAGE(PG8_SB(1, 0), b3, voffB); PG8_STAGE(PG8_SB(1, 1), b3 + hstep, voffB); PG8_STAGE(PG8_SA(1, 0), a3, voffA);
            PG8_WAIT_V(8); PG8_WAIT_L(0); PG8_BAR; PG8_MMA(1, 0, At, B0); PG8_MMA(1, 1, At, B1); PG8_BAR; PG8_SCHED;
            } else {
            PG8_LDB(B0, 0, 0); PG8_SCHED; PG8_LDA(At, 0, 0); PG8_STAGE(PG8_SA(1, 1), a1 + hstep, voffA);
            PG8_WAIT_L(8); PG8_BAR; PG8_WAIT_L(0); PG8_MMA(0, 0, At, B0); PG8_BAR; PG8_SCHED;
            PG8_LDB(B1, 0, 1); PG8_STAGE(PG8_SB(0, 0), b2, voffB);
            PG8_BAR; PG8_WAIT_L(0); PG8_MMA(0, 1, At, B1); PG8_BAR;
            PG8_LDA(At, 0, 1); PG8_STAGE(PG8_SA(0, 0), a2, voffA);
            PG8_BAR; PG8_WAIT_L(0); PG8_MMA(1, 0, At, B0); PG8_BAR; PG8_SCHED;
            PG8_STAGE(PG8_SB(0, 1), b2 + hstep, voffB);
            PG8_WAIT_V(6); PG8_BAR; PG8_MMA(1, 1, At, B1); PG8_BAR;
            PG8_LDB(B0, 1, 0); PG8_SCHED; PG8_LDA(At, 1, 0); PG8_STAGE(PG8_SA(0, 1), a2 + hstep, voffA);
            PG8_WAIT_L(8); PG8_BAR; PG8_WAIT_L(0); PG8_MMA(0, 0, At, B0); PG8_BAR; PG8_SCHED;
            PG8_LDB(B1, 1, 1); PG8_STAGE(PG8_SB(1, 0), b3, voffB);
            PG8_BAR; PG8_WAIT_L(0); PG8_MMA(0, 1, At, B1); PG8_BAR;
            PG8_LDA(At, 1, 1); PG8_STAGE(PG8_SA(1, 0), a3, voffA);
            PG8_BAR; PG8_WAIT_L(0); PG8_MMA(1, 0, At, B0); PG8_BAR; PG8_SCHED;
            PG8_STAGE(PG8_SB(1, 1), b3 + hstep, voffB);
            PG8_WAIT_V(6); PG8_BAR; PG8_MMA(1, 1, At, B1); PG8_BAR;
            }
        }
        if constexpr (ALIGN_EPI) { if (wr == 0) PG8_BAR; }
        if constexpr (!Epi::AFTER_DRAIN) { E(acc, cur, wr, wc, fr, fq); S.done(cur); }
        if (!has_next) break;
        if (!E.keep(cur)) {
#pragma unroll
        for (int a = 0; a < 2; ++a)
#pragma unroll
            for (int b = 0; b < 2; ++b)
#pragma unroll
                for (int m = 0; m < 4; ++m)
#pragma unroll
                    for (int n = 0; n < 2; ++n) acc[a][b][m][n] = (f32x4){0.f, 0.f, 0.f, 0.f};
        }
        cur = nxt; cA = nA; cB = nB; ++ui;
        if constexpr (ALIGN_EPI) { if (wr == 1) PG8_BAR; }
    }
    PG8_WAIT_V(0);
    if constexpr (!ALIGN_EPI) { if (wr == 0) PG8_BAR; }
    PG8_BAR;
    if constexpr (Epi::AFTER_DRAIN) { E.fused(acc, cur, wr, wc, fr, fq, lds, wid, lane); S.done(cur); }
#undef PG8_SA
#undef PG8_SB
#undef PG8_STAGE
#undef PG8_LDA
#undef PG8_LDB
#undef PG8_MMA
#undef PG8_WAIT_V
#undef PG8_WAIT_L
#undef PG8_BAR
#undef PG8_SCHED
}
}

struct Frame {
    LAS unsigned char* lds;
    unsigned* ctl;
    int tid, lane, wave, vcu, G, gw, NGW;
    const float *x, *g_mix, *w_in, *conv_qk, *b_if, *g_mnorm, *w_attn_out, *w_mlstm_out, *w_mix_out, *g_ffn, *w_router, *b_router, *w_gate_up, *b_gate_up, *w_down, *b_down, *g_final;
    const int* positions;
    float* out;
    bf16 *WinT, *WamT, *WoT, *WguT, *WdnT, *XN, *PROJ, *OG, *AM, *MERGED, *XS, *ACT, *YBUF;
    float *GATES, *ROPE, *LSE, *HT, *H, *QC, *KC, *ROW_W, *TOK_W;
    int *TOK_E, *TOK_SLOT, *ROW_TOK;
};

__constant__ double ROPE_REV[16] = {
    1.59154943091895346e-01, 7.00865215877985032e-02, 3.08637634047012298e-02, 1.35913706361939050e-02, 5.98518571271370540e-03, 2.63567589866741401e-03, 1.16066364124006098e-03, 5.11117504537543857e-04,
    2.25079079039276525e-04, 9.91173093690193548e-05, 4.36479527928028909e-05, 1.92211006849448627e-05, 8.46433080824140138e-06, 3.72740860191535193e-06, 1.64142626279503449e-06, 7.22829306883286479e-07};

template <int MAP>
__device__ __forceinline__ void transpose_item(const float* W, int Nsrc, bf16* WT, int ldk, int kofs, int nblk, LAS float* scr, int item, int lane) {
    const int kb = item / nblk, nb = item % nblk, k0 = 64 * kb, n0 = 32 * nb;
    const int np = n0 + (lane & 31);
    const int sc = (MAP == 1) ? win_logical_col(np) : (MAP == 2) ? wgu_logical_col(np) : np;
#pragma unroll 8
    for (int i = 0; i < 32; ++i) { const int kk = 2 * i + (lane >> 5); scr[kk * 33 + (lane & 31)] = W[(size_t)(k0 + kk) * Nsrc + sc]; }
    asm volatile("s_waitcnt lgkmcnt(0)" ::: "memory");
    const int c = lane & 7;
#pragma unroll
    for (int j = 0; j < 4; ++j) { const int n = (lane >> 3) + 8 * j; const LAS float* s = scr + (8 * c) * 33 + n;
        u32x4 o; o.x = pk2(s[0 * 33], s[1 * 33]); o.y = pk2(s[2 * 33], s[3 * 33]); o.z = pk2(s[4 * 33], s[5 * 33]); o.w = pk2(s[6 * 33], s[7 * 33]);
        *(u32x4*)(WT + (size_t)(n0 + n) * ldk + kofs + k0 + 8 * c) = o; }
    asm volatile("s_waitcnt lgkmcnt(0)" ::: "memory");
}

__device__ __forceinline__ void p0_weights(Frame& F) {
    LAS float* scr = (LAS float*)(F.lds + F.wave * 16384);
    constexpr int I_IN = (D / 64) * (NP / 32), I_A = (512 / 64) * (D / 32), I_M = (D / 64) * (D / 32), I_O = I_M;
    constexpr int I_GU1 = (D / 64) * (2048 / 32), I_DN1 = (D / 64) * (D / 32);
    constexpr int NITEMS = I_IN + I_A + I_M + I_O + NE * I_GU1 + NE * I_DN1;
    for (int it = F.gw; it < NITEMS; it += F.NGW) {
        int r = it;
        if (r < I_IN) { transpose_item<1>(F.w_in, DIN, F.WinT, D, 0, NP / 32, scr, r, F.lane); continue; } r -= I_IN;
        if (r < I_A) { transpose_item<0>(F.w_attn_out, D, F.WamT, 1536, 0, D / 32, scr, r, F.lane); continue; } r -= I_A;
        if (r < I_M) { transpose_item<0>(F.w_mlstm_out, D, F.WamT, 1536, 512, D / 32, scr, r, F.lane); continue; } r -= I_M;
        if (r < I_O) { transpose_item<0>(F.w_mix_out, D, F.WoT, D, 0, D / 32, scr, r, F.lane); continue; } r -= I_O;
        if (r < NE * I_GU1) { const int e = r / I_GU1; transpose_item<2>(F.w_gate_up + (size_t)e * D * 2048, 2048, F.WguT + (size_t)e * 2048 * D, D, 0, 2048 / 32, scr, r % I_GU1, F.lane); continue; } r -= NE * I_GU1;
        { const int e = r / I_DN1; transpose_item<0>(F.w_down + (size_t)e * D * D, D, F.WdnT + (size_t)e * D * D, D, 0, D / 32, scr, r % I_DN1, F.lane); }
    }
}

__device__ __forceinline__ void p0_rows(Frame& F) {
    LAS float* w8t = (LAS float*)(F.lds);
    __syncthreads();
    for (int i = F.tid; i < 8192; i += NTHREADS) { const int k = i >> 3, o = i & 7; w8t[o * 1024 + k] = F.w_in[(size_t)k * DIN + 8704 + o]; }
    __syncthreads();
    for (int row = F.gw; row < T; row += F.NGW) {
        const f32x4* xr = (const f32x4*)(F.x + (size_t)row * D) + F.lane;
        f32x4 v[4]; float s = 0.f;
#pragma unroll
        for (int j = 0; j < 4; ++j) { v[j] = xr[64 * j]; s += (v[j].x * v[j].x + v[j].y * v[j].y) + (v[j].z * v[j].z + v[j].w * v[j].w); }
        const float rstd = 1.0f / sqrtf(wave_sum(s) * (1.0f / D) + RMS_EPS);
        float ga[8];
#pragma unroll
        for (int o = 0; o < 8; ++o) ga[o] = 0.f;
        unsigned long long* o8 = (unsigned long long*)(F.XN + (size_t)row * D) + F.lane;
#pragma unroll
        for (int j = 0; j < 4; ++j) {
            const f32x4 g = *((const f32x4*)F.g_mix + F.lane + 64 * j);
            v[j] = v[j] * rstd * g;
            o8[64 * j] = (unsigned long long)pk2(v[j].x, v[j].y) | ((unsigned long long)pk2(v[j].z, v[j].w) << 32);
#pragma unroll
            for (int o = 0; o < 8; ++o) { const f32x4 w = *((const LAS f32x4*)(w8t + o * 1024) + F.lane + 64 * j); ga[o] += (v[j].x * w.x + v[j].y * w.y) + (v[j].z * w.z + v[j].w * w.w); }
        }
#pragma unroll
        for (int o = 0; o < 8; ++o) ga[o] = wave_sum(ga[o]);
        if (F.lane < 8) { float gv = ga[0];
#pragma unroll
            for (int o = 1; o < 8; ++o) gv = (F.lane == o) ? ga[o] : gv;
            F.GATES[(size_t)row * 8 + F.lane] = gv + F.b_if[F.lane]; }
        if (F.lane < 16) {
            const int pos = F.positions[row];
            double rev = (double)pos * ROPE_REV[F.lane]; rev -= floor(rev);
            const float fr = (float)rev;
            F.ROPE[(size_t)row * 32 + F.lane] = __builtin_amdgcn_cosf(fr);
            F.ROPE[(size_t)row * 32 + 16 + F.lane] = __builtin_amdgcn_sinf(fr);
        }
    }
}

template <int RT, class AF, class BF, class EP>
__device__ __forceinline__ void naive_gemm(Frame& F, int M, int N, int K, AF af, BF bf, EP ep) {
    const long gthreads = (long)F.G * NTHREADS, gtid = (long)blockIdx.x * NTHREADS + F.tid;
    for (long it = gtid; it < (long)(M / RT) * N; it += gthreads) {
        const int col = (int)(it % N), r0 = (int)(it / N) * RT;
        float acc[RT];
#pragma unroll
        for (int r = 0; r < RT; ++r) acc[r] = 0.f;
        for (int k = 0; k < K; ++k) { const float b = bf(k, col);
#pragma unroll
            for (int r = 0; r < RT; ++r) acc[r] += af(r0 + r, k) * b; }
#pragma unroll
        for (int r = 0; r < RT; ++r) ep(r0 + r, col, acc[r]);
    }
}

__device__ __forceinline__ void naive_p1(Frame& F) {
    const bf16* XN = F.XN; const float* W = F.w_in; bf16* P = F.PROJ;
    naive_gemm<8>(F, T, NP, D,
        [=](int r, int k) { return bf2f(XN[(size_t)r * D + k]); },
        [=](int k, int c) { return bf2f(f2bf(W[(size_t)k * DIN + win_logical_col(c)])); },
        [=](int r, int c, float a) { P[(size_t)r * NP + c] = (bf16)f2bf(a * (c < C_AK ? QSCALE : 1.0f)); });
}
__device__ __forceinline__ void naive_p1_rope(Frame& F) {
    const long gthreads = (long)F.G * NTHREADS, gtid = (long)blockIdx.x * NTHREADS + F.tid;
    for (long it = gtid; it < (long)T * 24 * 16; it += gthreads) {
        const int i = (int)(it & 15), hh = (int)((it >> 4) % 24), row = (int)(it / (24 * 16));
        const int a = i >> 2, j = i & 3; bf16* p = F.PROJ + (size_t)row * NP + hh * 128;
        const float x1 = bf2f(p[8 * a + j]), x2 = bf2f(p[8 * a + 4 + j]), cs = F.ROPE[(size_t)row * 32 + i], sn = F.ROPE[(size_t)row * 32 + 16 + i];
        p[8 * a + j] = (bf16)f2bf(x1 * cs - x2 * sn); p[8 * a + 4 + j] = (bf16)f2bf(x2 * cs + x1 * sn);
    }
}
__device__ __forceinline__ void naive_attn(Frame& F) {
    for (int it = F.gw; it < T * 12; it += F.NGW) {
        const int row = it / 12, gh = it % 12, g = gh >> 2, h = gh & 3, b = row / SEQ, t = row % SEQ, d = (g == 0) ? 1 : (g == 1) ? 4 : 16, i = t / d, r = t % d;
        const int hc = g * 512 + h * 128 + 2 * F.lane;
        const unsigned qw = *(const unsigned*)(F.PROJ + (size_t)row * NP + C_AQ + hc); const float q0 = bflo(qw), q1 = bfhi(qw);
        float m = -INFINITY, l = 0.f, o0 = 0.f, o1 = 0.f;
        for (int ii = (i > 128 ? i - 128 : 0); ii <= i; ++ii) {
            const size_t kr = (size_t)(b * SEQ + r + d * ii) * NP;
            const unsigned kw = *(const unsigned*)(F.PROJ + kr + C_AK + hc), vw = *(const unsigned*)(F.PROJ + kr + C_AV + hc);
            const float s = wave_sum(q0 * bflo(kw) + q1 * bfhi(kw));
            const float mn = fmaxf(m, s), al = exp2f(m - mn), p = exp2f(s - mn);
            l = l * al + p; o0 = o0 * al + p * bflo(vw); o1 = o1 * al + p * bfhi(vw); m = mn;
        }
        const float il = 1.0f / l;
        *(unsigned*)(F.OG + ((size_t)g * T + row) * 512 + h * 128 + 2 * F.lane) = pk2(o0 * il, o1 * il);
        if (F.lane == 0) F.LSE[((size_t)g * T + row) * 4 + h] = m + log2f(l);
    }
}
__device__ __forceinline__ void naive_conv(Frame& F) {
    const long gthreads = (long)F.G * NTHREADS, gtid = (long)blockIdx.x * NTHREADS + F.tid;
    for (long it = gtid; it < (long)T * 2048; it += gthreads) {
        const int c = (int)(it & 2047), row = (int)(it >> 11), t = row % SEQ;
        float a = 0.f;
#pragma unroll
        for (int j = 0; j < 4; ++j) if (t - 3 + j >= 0) a += F.conv_qk[j * 2048 + c] * bf2f(F.PROJ[(size_t)(row - 3 + j) * NP + C_MQ + c]);
        const float y = a / (1.0f + __expf(-a));
        if (c < 1024) F.QC[(size_t)row * 1024 + c] = y; else F.KC[(size_t)row * 1024 + c - 1024] = y * 0.0625f;
    }
}
__device__ __forceinline__ void naive_mlstm(Frame& F) {
    LAS float* sq = (LAS float*)F.lds; LAS float* sk = sq + 256; LAS float* red = sk + 256; LAS float* redn = red + 512;
    for (int item = blockIdx.x; item < NB * 4 * 8; item += F.G) {
        const int sl = item & 7, h = (item >> 3) & 3, b = item >> 5, dvl = F.tid & 31, dkp = F.tid >> 5;
        float c[16], n[16];
#pragma unroll
        for (int j = 0; j < 16; ++j) { c[j] = 0.f; n[j] = 0.f; }
        float m = 0.f;
        for (int t = 0; t < SEQ; ++t) {
            const size_t row = (size_t)b * SEQ + t;
            __syncthreads();
            if (F.tid < 256) sq[F.tid] = F.QC[row * 1024 + h * 256 + F.tid]; else sk[F.tid - 256] = F.KC[row * 1024 + h * 256 + F.tid - 256];
            const float v = bf2f(F.PROJ[row * NP + C_MV + h * 256 + sl * 32 + dvl]);
            const float ir = F.GATES[row * 8 + h], fr = F.GATES[row * 8 + 4 + h];
            const float logf = fminf(fr, 0.f) - log1pf(__expf(-fabsf(fr)));
            const float mn = fmaxf(logf + m, ir), fa = __expf(logf + m - mn), ia = __expf(ir - mn);
            m = mn;
            __syncthreads();
            float pn = 0.f, pd = 0.f;
#pragma unroll
            for (int j = 0; j < 16; ++j) { const float kk = sk[dkp * 16 + j], qq = sq[dkp * 16 + j]; c[j] = fa * c[j] + ia * kk * v; n[j] = fa * n[j] + ia * kk; pn += qq * c[j]; pd += qq * n[j]; }
            red[dkp * 32 + dvl] = pn; redn[dkp * 32 + dvl] = pd;
            __syncthreads();
            if (F.tid < 32) { float num = 0.f, den = 0.f;
#pragma unroll
                for (int p = 0; p < 16; ++p) { num += red[p * 32 + F.tid]; den += redn[p * 32 + F.tid]; }
                F.HT[row * 1024 + h * 256 + sl * 32 + F.tid] = num / fmaxf(fabsf(den), __expf(-mn)); }
        }
    }
}
__device__ __forceinline__ void naive_p4(Frame& F) {
    const bf16 *AM = F.AM, *PJ = F.PROJ; const float *WA = F.w_attn_out, *WM = F.w_mlstm_out; bf16* O = F.MERGED;
    float* tmp = F.QC;
    naive_gemm<8>(F, T, D, 512, [=](int r, int k) { return bf2f(AM[(size_t)r * 1536 + k]); }, [=](int k, int c) { return bf2f(f2bf(WA[(size_t)k * D + c])); },
        [=](int r, int c, float a) { tmp[(size_t)r * D + c] = a * sigmoidf_(bf2f(PJ[(size_t)r * NP + C_GA + c])); });
    __threadfence();
    naive_gemm<8>(F, T, D, D, [=](int r, int k) { return bf2f(AM[(size_t)r * 1536 + 512 + k]); }, [=](int k, int c) { return bf2f(f2bf(WM[(size_t)k * D + c])); },
        [=](int r, int c, float a) { O[(size_t)r * D + c] = (bf16)f2bf(tmp[(size_t)r * D + c] + a * sigmoidf_(bf2f(PJ[(size_t)r * NP + C_GM + c]))); });
}
__device__ __forceinline__ void naive_p5(Frame& F) {
    const bf16* MG = F.MERGED; const float *WO = F.w_mix_out, *X = F.x; float* H = F.H;
    naive_gemm<8>(F, T, D, D, [=](int r, int k) { return bf2f(MG[(size_t)r * D + k]); }, [=](int k, int c) { return bf2f(f2bf(WO[(size_t)k * D + c])); },
        [=](int r, int c, float a) { H[(size_t)r * D + c] = X[(size_t)r * D + c] + a; });
}
__device__ __forceinline__ void naive_p8(Frame& F, int ntiles) {
    const long gthreads = (long)F.G * NTHREADS, gtid = (long)blockIdx.x * NTHREADS + F.tid;
    const unsigned* tile_e = F.ctl + CW_TILEE;
    for (long it = gtid; it < (long)ntiles * 256 * D; it += gthreads) {
        const int j = (int)(it & 1023), row = (int)(it >> 10), e = (int)tile_e[row >> 8];
        if (F.ROW_TOK[row] < 0) { F.ACT[(size_t)row * D + j] = 0; continue; }
        const float* W = F.w_gate_up + (size_t)e * D * 2048; float g = 0.f, u = 0.f;
        for (int k = 0; k < D; ++k) { const float a = bf2f(F.XS[(size_t)row * D + k]); g += a * bf2f(f2bf(W[(size_t)k * 2048 + 2 * j])); u += a * bf2f(f2bf(W[(size_t)k * 2048 + 2 * j + 1])); }
        g += F.b_gate_up[e * 2048 + 2 * j]; u += F.b_gate_up[e * 2048 + 2 * j + 1];
        const float gg = fminf(g, 7.0f), uu = fminf(fmaxf(u, -7.0f), 7.0f);
        F.ACT[(size_t)row * D + j] = (bf16)f2bf((uu + 1.0f) * gg / (1.0f + __expf(-1.702f * gg)));
    }
}
__device__ __forceinline__ void naive_p9(Frame& F, int ntiles) {
    const long gthreads = (long)F.G * NTHREADS, gtid = (long)blockIdx.x * NTHREADS + F.tid;
    const unsigned* tile_e = F.ctl + CW_TILEE;
    for (long it = gtid; it < (long)ntiles * 256 * D; it += gthreads) {
        const int c = (int)(it & 1023), row = (int)(it >> 10), e = (int)tile_e[row >> 8], tk = F.ROW_TOK[row];
        if (tk < 0) continue;
        const float* W = F.w_down + (size_t)e * D * D; float y = 0.f;
        for (int k = 0; k < D; ++k) y += bf2f(F.ACT[(size_t)row * D + k]) * bf2f(f2bf(W[(size_t)k * D + c]));
        F.YBUF[(size_t)tk * D + c] = (bf16)f2bf((y + F.b_down[e * D + c]) * F.ROW_W[row]);
    }
}

__device__ __forceinline__ void p3_post_mixer(Frame& F) {
    for (int row = F.gw; row < T; row += F.NGW) {
        { const int h = F.lane >> 4; float l0 = F.LSE[((size_t)0 * T + row) * 4 + h], l1 = F.LSE[((size_t)1 * T + row) * 4 + h], l2 = F.LSE[((size_t)2 * T + row) * 4 + h];
          const float mx = fmaxf(l0, fmaxf(l1, l2)); float w0 = exp2f(l0 - mx), w1 = exp2f(l1 - mx), w2 = exp2f(l2 - mx); const float inv = 1.0f / (w0 + w1 + w2); w0 *= inv; w1 *= inv; w2 *= inv;
          const u32x4 a = *(const u32x4*)(F.OG + ((size_t)0 * T + row) * 512 + 8 * F.lane), b = *(const u32x4*)(F.OG + ((size_t)1 * T + row) * 512 + 8 * F.lane), c = *(const u32x4*)(F.OG + ((size_t)2 * T + row) * 512 + 8 * F.lane);
          f32x4 a0, a1, b0, b1, c0, c1; pg8::unpack8(a, a0, a1); pg8::unpack8(b, b0, b1); pg8::unpack8(c, c0, c1);
          const f32x4 o0 = a0 * w0 + b0 * w1 + c0 * w2, o1 = a1 * w0 + b1 * w1 + c1 * w2;
          u32x4 w; w.x = pk2(o0[0], o0[1]); w.y = pk2(o0[2], o0[3]); w.z = pk2(o1[0], o1[1]); w.w = pk2(o1[2], o1[3]);
          *(u32x4*)(F.AM + (size_t)row * 1536 + 8 * F.lane) = w; }
        { const float* hp = F.HT + (size_t)row * D + 16 * F.lane; f32x4 v[4]; float s = 0.f;
#pragma unroll
          for (int j = 0; j < 4; ++j) { v[j] = *(const f32x4*)(hp + 4 * j); s += (v[j].x + v[j].y) + (v[j].z + v[j].w); }
          s += __shfl_xor(s, 1); s += __shfl_xor(s, 2); s += __shfl_xor(s, 4); s += __shfl_xor(s, 8);
          const float mu = s * (1.0f / 256.0f); float q = 0.f;
#pragma unroll
          for (int j = 0; j < 4; ++j) { v[j] = v[j] - mu; q += (v[j].x * v[j].x + v[j].y * v[j].y) + (v[j].z * v[j].z + v[j].w * v[j].w); }
          q += __shfl_xor(q, 1); q += __shfl_xor(q, 2); q += __shfl_xor(q, 4); q += __shfl_xor(q, 8);
          const float rstd = 1.0f / sqrtf(q * (1.0f / 256.0f) + LN_EPS);
          const bf16* mo = F.PROJ + (size_t)row * NP + C_MO + 16 * F.lane; bf16* op = F.AM + (size_t)row * 1536 + 512 + 16 * F.lane;
#pragma unroll
          for (int jj = 0; jj < 2; ++jj) { const u32x4 mw = *(const u32x4*)(mo + 8 * jj); f32x4 m0, m1; pg8::unpack8(mw, m0, m1);
              const f32x4 g0 = *(const f32x4*)(F.g_mnorm + 16 * F.lane + 8 * jj), g1 = *(const f32x4*)(F.g_mnorm + 16 * F.lane + 8 * jj + 4);
              const f32x4 o0 = v[2 * jj] * rstd * g0 * pg8::sig4(m0), o1 = v[2 * jj + 1] * rstd * g1 * pg8::sig4(m1);
              u32x4 w; w.x = pk2(o0[0], o0[1]); w.y = pk2(o0[2], o0[3]); w.z = pk2(o1[0], o1[1]); w.w = pk2(o1[2], o1[3]);
              *(u32x4*)(op + 8 * jj) = w; } }
    }
}

__device__ __forceinline__ void p6_router(Frame& F) {
    LAS float* xs = (LAS float*)(F.lds) + F.wave * 1024;
    for (int row = F.gw; row < T; row += F.NGW) {
        const f32x4* hr = (const f32x4*)(F.H + (size_t)row * D) + F.lane;
        f32x4 v[4]; float s = 0.f;
#pragma unroll
        for (int j = 0; j < 4; ++j) { v[j] = hr[64 * j]; s += (v[j].x * v[j].x + v[j].y * v[j].y) + (v[j].z * v[j].z + v[j].w * v[j].w); }
        const float rstd = 1.0f / sqrtf(wave_sum(s) * (1.0f / D) + RMS_EPS);
        unsigned long long* o8 = (unsigned long long*)(F.XN + (size_t)row * D) + F.lane;
#pragma unroll
        for (int j = 0; j < 4; ++j) { const f32x4 g = *((const f32x4*)F.g_ffn + F.lane + 64 * j); v[j] = v[j] * rstd * g;
            o8[64 * j] = (unsigned long long)pk2(v[j].x, v[j].y) | ((unsigned long long)pk2(v[j].z, v[j].w) << 32);
            *((LAS f32x4*)xs + F.lane + 64 * j) = v[j]; }
        asm volatile("s_waitcnt lgkmcnt(0)" ::: "memory");
        const int e = F.lane & 31, kh = F.lane >> 5; float lg = 0.f;
        const float* wr = F.w_router + (size_t)(kh * 512) * NE + e;
#pragma unroll 8
        for (int k = 0; k < 512; ++k) lg += xs[kh * 512 + k] * wr[(size_t)k * NE];
        lg += __shfl_xor(lg, 32); lg += F.b_router[e];
        float tv[4]; int ti[4]; float cur = lg;
#pragma unroll
        for (int r = 0; r < 4; ++r) { float bv = cur; int bi = e;
#pragma unroll
            for (int o = 1; o < 32; o <<= 1) { const float ov = __shfl_xor(bv, o); const int oi = __shfl_xor(bi, o); if (ov > bv || (ov == bv && oi < bi)) { bv = ov; bi = oi; } }
            tv[r] = bv; ti[r] = bi; if (e == bi) cur = -INFINITY; }
        const float e1 = __expf(tv[1] - tv[0]), e2 = __expf(tv[2] - tv[0]), e3 = __expf(tv[3] - tv[0]), inv = 1.0f / (1.0f + e1 + e2 + e3);
        if (F.lane < 4) {
            const int ee = (F.lane == 0) ? ti[0] : (F.lane == 1) ? ti[1] : (F.lane == 2) ? ti[2] : ti[3];
            const float ww = ((F.lane == 0) ? 1.0f : (F.lane == 1) ? e1 : (F.lane == 2) ? e2 : e3) * inv;
            const unsigned slot = atomicAdd(F.ctl + CW_CNT + ee, 1u);
            F.TOK_E[row * 4 + F.lane] = ee; F.TOK_SLOT[row * 4 + F.lane] = (int)slot; F.TOK_W[row * 4 + F.lane] = ww;
        }
        asm volatile("s_waitcnt lgkmcnt(0)" ::: "memory");
    }
}

__device__ __forceinline__ void p7_gather(Frame& F) {
    LAS int* pst = (LAS int*)F.lds;
    __syncthreads();
    if (F.tid == 0) { int acc = 0; for (int e = 0; e < NE; ++e) { pst[e] = acc; const int c = (int)F.ctl[CW_CNT + e]; acc += (c + 255) & ~255; } pst[NE] = acc;
        if (blockIdx.x == 0) { F.ctl[CW_NTILES] = (unsigned)(acc >> 8); int tix = 0; for (int e = 0; e < NE; ++e) { const int c = (int)F.ctl[CW_CNT + e]; for (int k = 0; k < ((c + 255) >> 8); ++k) F.ctl[CW_TILEE + tix++] = (unsigned)e; } } }
    __syncthreads();
    for (int a = F.gw; a < NA; a += F.NGW) {
        const int e = F.TOK_E[a], dest = pst[e] + F.TOK_SLOT[a];
        const u32x4* src = (const u32x4*)(F.XN + (size_t)(a >> 2) * D) + F.lane; u32x4* dst = (u32x4*)(F.XS + (size_t)dest * D) + F.lane;
        const u32x4 v0 = src[0], v1 = src[64]; dst[0] = v0; dst[64] = v1;
        if (F.lane == 0) { F.ROW_TOK[dest] = a; F.ROW_W[dest] = F.TOK_W[a]; }
    }
    for (int e = 0; e < NE; ++e) { const int c = (int)F.ctl[CW_CNT + e], pe = (c + 255) & ~255;
        for (int r = c + F.gw; r < pe; r += F.NGW) { const int dest = pst[e] + r; u32x4* dst = (u32x4*)(F.XS + (size_t)dest * D) + F.lane; const u32x4 z = (u32x4){0u, 0u, 0u, 0u}; dst[0] = z; dst[64] = z;
            if (F.lane == 0) { F.ROW_TOK[dest] = -1; F.ROW_W[dest] = 0.f; } } }
}

__device__ __forceinline__ void p10_final(Frame& F) {
    for (int row = F.gw; row < T; row += F.NGW) {
        const f32x4* hr = (const f32x4*)(F.H + (size_t)row * D) + F.lane;
        f32x4 v[4]; float s = 0.f;
#pragma unroll
        for (int j = 0; j < 4; ++j) { v[j] = hr[64 * j];
#pragma unroll
            for (int k = 0; k < 4; ++k) { const u32x2 w = *((const u32x2*)(F.YBUF + ((size_t)row * 4 + k) * D) + F.lane + 64 * j); v[j].x += bflo(w.x); v[j].y += bfhi(w.x); v[j].z += bflo(w.y); v[j].w += bfhi(w.y); }
            s += (v[j].x * v[j].x + v[j].y * v[j].y) + (v[j].z * v[j].z + v[j].w * v[j].w); }
        const float rstd = 1.0f / sqrtf(wave_sum(s) * (1.0f / D) + RMS_EPS);
        f32x4* orow = (f32x4*)(F.out + (size_t)row * D) + F.lane;
#pragma unroll
        for (int j = 0; j < 4; ++j) { const f32x4 g = *((const f32x4*)F.g_final + F.lane + 64 * j); orow[64 * j] = v[j] * rstd * g; }
    }
}

constexpr int N_PHASES = 13;
struct Args { const void* in[18]; float* out; unsigned char* ws; int ph_lo, ph_hi; };

__global__ void __launch_bounds__(NTHREADS, 2) mega_fwd(Args args) {
    extern __shared__ __attribute__((aligned(16))) unsigned char lds[];
    Frame F;
    F.lds = (LAS unsigned char*)lds;
    F.tid = threadIdx.x; F.lane = F.tid & 63; F.wave = __builtin_amdgcn_readfirstlane(F.tid >> 6);
    F.G = gridDim.x; { const int bx = blockIdx.x; F.vcu = (F.G % 8 == 0) ? (bx % 8) * (F.G / 8) + bx / 8 : bx; }
    F.gw = F.vcu * NWAVES + F.wave; F.NGW = F.G * NWAVES;
    unsigned char* ws = args.ws;
    F.ctl = (unsigned*)(ws + WS_CTL);
    F.x = (const float*)args.in[0]; F.positions = (const int*)args.in[1]; F.g_mix = (const float*)args.in[2]; F.w_in = (const float*)args.in[3]; F.conv_qk = (const float*)args.in[4];
    F.b_if = (const float*)args.in[5]; F.g_mnorm = (const float*)args.in[6]; F.w_attn_out = (const float*)args.in[7]; F.w_mlstm_out = (const float*)args.in[8]; F.w_mix_out = (const float*)args.in[9];
    F.g_ffn = (const float*)args.in[10]; F.w_router = (const float*)args.in[11]; F.b_router = (const float*)args.in[12]; F.w_gate_up = (const float*)args.in[13]; F.b_gate_up = (const float*)args.in[14];
    F.w_down = (const float*)args.in[15]; F.b_down = (const float*)args.in[16]; F.g_final = (const float*)args.in[17]; F.out = args.out;
    F.WinT = (bf16*)(ws + WS_WIN); F.WamT = (bf16*)(ws + WS_WAM); F.WoT = (bf16*)(ws + WS_WO); F.WguT = (bf16*)(ws + WS_WGU); F.WdnT = (bf16*)(ws + WS_WDN);
    F.XN = (bf16*)(ws + WS_XN); F.PROJ = (bf16*)(ws + WS_PROJ); F.OG = (bf16*)(ws + WS_OG); F.AM = (bf16*)(ws + WS_AM); F.MERGED = (bf16*)(ws + WS_MERGED);
    F.XS = (bf16*)(ws + WS_XS); F.ACT = (bf16*)(ws + WS_ACT); F.YBUF = (bf16*)(ws + WS_YBUF);
    F.GATES = (float*)(ws + WS_GATES); F.ROPE = (float*)(ws + WS_ROPE); F.LSE = (float*)(ws + WS_LSE); F.HT = (float*)(ws + WS_HT); F.H = (float*)(ws + WS_H);
    F.QC = (float*)(ws + WS_QC); F.KC = (float*)(ws + WS_KC);
    F.TOK_E = (int*)(ws + WS_ROUTE); F.TOK_SLOT = F.TOK_E + NA; F.TOK_W = (float*)(F.TOK_SLOT + NA);
    F.ROW_TOK = (int*)(ws + WS_ROWMETA); F.ROW_W = (float*)(F.ROW_TOK + XS_ROWS);

    const int lo = args.ph_lo, hi = args.ph_hi;
#ifndef PH_MASK
#define PH_MASK 0xffffffffu
#endif
#define IN(k) (((PH_MASK >> (k)) & 1u) && lo <= (k) && (k) < hi)
#define SEAM(k) do { if (IN(k) && IN((k) + 1)) { GRID_BAR(); } } while (0)
#define GRID_BAR() do { } while (0)

    if (IN(0)) { p0_weights(F); p0_rows(F); }
    SEAM(0);
    if (IN(1)) {
#if FAST_P1
        pg8::Gemm g{F.XN, F.WinT, T, NP, D}; pg8::StaticOrder S; S.init(T, NP, F.G, (int)blockIdx.x);
        pg8::EpiProj E{F.PROJ, F.ROPE};
        pg8::gemm_phase<pg8::EpiProj, pg8::StaticOrder, true, true>(F.lds, g, S, E);
#else
        naive_p1(F);
#endif
    }
    SEAM(1);
    if (IN(2)) {
#if !FAST_P1
        naive_p1_rope(F);
#endif
    }
    SEAM(2);
    if (IN(3)) {
#if !FAST_MLSTM
        naive_conv(F);
#endif
#if !FAST_ATTN
        naive_attn(F);
#endif
    }
    SEAM(3);
    if (IN(4)) {
#if !FAST_MLSTM
        naive_mlstm(F);
#endif
    }
    SEAM(4);
    if (IN(5)) p3_post_mixer(F);
    SEAM(5);
    if (IN(6)) {
#if FAST_P4
        pg8::Gemm g{F.AM, F.WamT, T, D, 1536}; pg8::MergedOrder S; S.base.init(T, D, F.G, (int)blockIdx.x);
        pg8::EpiMerged E{F.MERGED, F.PROJ};
        pg8::gemm_phase<pg8::EpiMerged, pg8::MergedOrder, false, true>(F.lds, g, S, E);
#else
        naive_p4(F);
#endif
    }
    SEAM(6);
    if (IN(7)) {
#if FAST_P5
        pg8::Gemm g{F.MERGED, F.WoT, T, D, D}; pg8::StaticOrder S; S.init(T, D, F.G, (int)blockIdx.x);
        pg8::EpiResid E{F.x, F.H};
        pg8::gemm_phase<pg8::EpiResid, pg8::StaticOrder, false, true>(F.lds, g, S, E);
#else
        naive_p5(F);
#endif
    }
    SEAM(7);
    if (IN(8)) p6_router(F);
    SEAM(8);
    if (IN(9)) p7_gather(F);
    SEAM(9);
    if (IN(10)) {
        const int ntiles = (int)F.ctl[CW_NTILES];
#if FAST_MOE
        pg8::Gemm g{F.XS, F.WguT, ntiles * 256, NE * 2048, D}; pg8::GroupedOrder S{F.ctl + CW_TILEE, ntiles, 8, F.G, (int)blockIdx.x};
        pg8::EpiSwiGLU E{F.ACT, F.b_gate_up};
        pg8::gemm_phase<pg8::EpiSwiGLU, pg8::GroupedOrder, true, true>(F.lds, g, S, E);
#else
        naive_p8(F, ntiles);
#endif
    }
    SEAM(10);
    if (IN(11)) {
        const int ntiles = (int)F.ctl[CW_NTILES];
#if FAST_MOE
        pg8::Gemm g{F.ACT, F.WdnT, ntiles * 256, NE * D, D}; pg8::GroupedOrder S{F.ctl + CW_TILEE, ntiles, 4, F.G, (int)blockIdx.x};
        pg8::EpiDown E{F.YBUF, F.b_down, F.ROW_TOK, F.ROW_W};
        pg8::gemm_phase<pg8::EpiDown, pg8::GroupedOrder, true, true>(F.lds, g, S, E);
#else
        naive_p9(F, ntiles);
#endif
    }
    SEAM(11);
    if (IN(12)) p10_final(F);
#undef IN
#undef SEAM
}

extern "C" void kernel_launch(void* const* d_in, const int* in_sizes, int n_in, void* d_out, int out_size, void* d_ws, size_t ws_size, hipStream_t stream) {
    static int grid = 0;
    if (grid == 0) {
        if (n_in != 18 || out_size != T * D || ws_size < WS_END) { fprintf(stderr, "kernel_launch: unexpected shapes (n_in %d, out %d, ws %zu)\n", n_in, out_size, ws_size); grid = -1; return; }
        int dev = 0, cus = 0;
        if (hipGetDevice(&dev) != hipSuccess || hipDeviceGetAttribute(&cus, hipDeviceAttributeMultiprocessorCount, dev) != hipSuccess) { grid = -1; return; }
        if (hipFuncSetAttribute((const void*)mega_fwd, hipFuncAttributeMaxDynamicSharedMemorySize, LDS_BYTES) != hipSuccess) { fprintf(stderr, "kernel_launch: hipFuncSetAttribute failed\n"); grid = -1; return; }
        grid = cus;
    }
    if (grid < 0) return;
    (void)hipMemsetAsync((char*)d_ws + WS_CTL, 0, CTL_ZERO_BYTES, stream);
    Args a{};
    for (int i = 0; i < 18; ++i) a.in[i] = d_in[i];
    a.out = (float*)d_out; a.ws = (unsigned char*)d_ws;
    for (int p = 0; p < N_PHASES; ++p) {
        a.ph_lo = p; a.ph_hi = p + 1;
        hipLaunchKernelGGL(mega_fwd, dim3(grid), dim3(NTHREADS), LDS_BYTES, stream, a);
    }
}
```

```cpp
#include <hip/hip_runtime.h>
#include <cstdio>
#include <cstdint>

#define LAS __attribute__((address_space(3)))
#define GAS __attribute__((address_space(1)))
typedef unsigned short bf16;
typedef float f32x4 __attribute__((ext_vector_type(4)));
typedef float f32x2 __attribute__((ext_vector_type(2)));
typedef unsigned u32x4 __attribute__((ext_vector_type(4)));
typedef unsigned u32x2 __attribute__((ext_vector_type(2)));
typedef short bf16x8 __attribute__((ext_vector_type(8)));

#ifndef FAST_P1
#define FAST_P1 1
#endif
#ifndef FAST_P4
#define FAST_P4 1
#endif
#ifndef FAST_P5
#define FAST_P5 1
#endif
#ifndef FAST_MOE
#define FAST_MOE 1
#endif
#ifndef MOE_FP8
#define MOE_FP8 1
#endif
#ifndef P1_FP8
#define P1_FP8 1
#endif
#ifndef STEAL
#define STEAL 1
#endif
#ifndef ROUTER_MFMA
#define ROUTER_MFMA 1
#endif
#ifndef P1_HI
#define P1_HI 30
#endif
#ifndef MOE_STREAM
#define MOE_STREAM 1
#endif
#ifndef FAST_ATTN
#define FAST_ATTN 1
#endif
#ifndef FAST_MLSTM
#define FAST_MLSTM 1
#endif

constexpr int T = 16384, D = 1024, SEQ = 2048, NB = 8;
constexpr int DIN = 10760, NP = 10752;
constexpr int C_AQ = 0, C_AK = 1536, C_AV = 3072, C_MQ = 4608, C_MK = 5632, C_MV = 6656, C_MO = 7680, C_GA = 8704, C_GM = 9728;
constexpr int NE = 32, TOPK = 4, NA = T * TOPK, MAXTILES = NA / 256 + NE, XS_ROWS = MAXTILES * 256;
constexpr float QSCALE = 0.08838834764831845f * 1.4426950408889634f;
constexpr float RMS_EPS = 1e-5f, LN_EPS = 1e-5f;

constexpr size_t MiB = 1u << 20;
constexpr size_t WS_CTL = 0, CTL_ZERO_BYTES = 1 * MiB;
constexpr size_t WS_WIN = 2 * MiB, WS_WAM = 23 * MiB, WS_WO = 26 * MiB, WS_WGU = 28 * MiB, WS_WDN = 156 * MiB;
constexpr size_t WS_XN = 220 * MiB, WS_GATES = 252 * MiB, WS_ROPE = 253 * MiB, WS_ROUTE = 255 * MiB;
constexpr size_t WS_H = 256 * MiB, WS_MERGED = 320 * MiB;
constexpr size_t WS_OG = 352 * MiB, WS_LSE = 400 * MiB, WS_HT = 401 * MiB, WS_AM = 433 * MiB;
constexpr int AMLD = 2560;
#ifndef MIX_STREAM
#define MIX_STREAM 1
#endif
constexpr size_t WS_YBUF = 352 * MiB;
constexpr size_t WS_PROJ = 513 * MiB;
constexpr size_t WS_XS = 513 * MiB, WS_ACT = 657 * MiB;
constexpr size_t WS_ROWMETA = 801 * MiB;
constexpr size_t WS_QC = 849 * MiB, WS_KC = 913 * MiB, WS_XN8 = 916 * MiB, WS_END = 977 * MiB;
constexpr int CW_TMO = 0, CW_BAR = 4096, CW_CNT = 8192  , CW_NTILES = 12288, CW_TSTART = 12289  , CW_TILEE = 12352, CW_QCTR = 16384, CW_READY = 32768  , CW_READY2 = 65536  ;

constexpr int RING_BYTES = 131072, LDS_BYTES = 147456, LDSCTL_OFF = LDS_BYTES - 256, MISC_OFF = LDSCTL_OFF;
constexpr int NWAVES = 8, NTHREADS = 512;

__device__ __forceinline__ unsigned f2bf(float f) { unsigned u = __builtin_bit_cast(unsigned, f); return (u + 0x7fffu + ((u >> 16) & 1u)) >> 16; }
__device__ __forceinline__ unsigned pk2(float lo, float hi) { unsigned r; asm("v_cvt_pk_bf16_f32 %0, %1, %2" : "=v"(r) : "v"(lo), "v"(hi)); return r; }
__device__ __forceinline__ unsigned pk4_fp8(float a, float b, float c, float d) { int w = __builtin_amdgcn_cvt_pk_fp8_f32(a, b, 0, false); w = __builtin_amdgcn_cvt_pk_fp8_f32(c, d, w, true); return (unsigned)w; }
__device__ __forceinline__ float frcp(float x) { return __builtin_amdgcn_rcpf(x); }
__device__ __forceinline__ float bf2f(unsigned b) { return __builtin_bit_cast(float, b << 16); }
__device__ __forceinline__ float bflo(unsigned w) { return __builtin_bit_cast(float, w << 16); }
__device__ __forceinline__ float bfhi(unsigned w) { return __builtin_bit_cast(float, w & 0xffff0000u); }
__device__ __forceinline__ float wave_sum(float v) {
#pragma unroll
    for (int o = 1; o < 64; o <<= 1) v += __shfl_xor(v, o);
    return v;
}
__device__ __forceinline__ float wave_max(float v) {
#pragma unroll
    for (int o = 1; o < 64; o <<= 1) v = fmaxf(v, __shfl_xor(v, o));
    return v;
}
__device__ __forceinline__ float sigmoidf_(float x) { return frcp(1.0f + __expf(-x)); }

__host__ __device__ __forceinline__ int win_logical_col(int c) {
    if (c < C_AV) { const int p = c & 127; if (p < 32) { const int a = p >> 3, n = (p >> 2) & 1, j = p & 3; return (c - p) + 16 * n + 4 * a + j; } return c; }
    return c < C_GA ? c : c + 8;
}
__host__ __device__ __forceinline__ int wgu_logical_col(int c) { const int pn = c >> 8, bj = (c >> 7) & 1, jl = c & 127; return 2 * (128 * pn + jl) + bj; }
namespace pg8 {
#define PG8_LAS __attribute__((address_space(3)))
typedef unsigned short bf16_t;
typedef short bf16x8 __attribute__((ext_vector_type(8)));
typedef float f32x4 __attribute__((ext_vector_type(4)));
typedef unsigned u32x4 __attribute__((ext_vector_type(4)));
constexpr int BM = 256, BK = 64, HALF = 128, HTB = HALF * BK * 2  , STAGE_BYTES = 8 * HTB, NXCD = 8, WGM = 8;

__host__ __device__ __forceinline__ int lds_byte(int r, int c) { const int st = (r >> 4) * 2 + (c >> 5), rr = r & 15, cc = c & 31, ob = rr * 64 + cc * 2; return st * 1024 + (ob ^ (((ob >> 9) & 1) << 5)); }
__host__ __device__ __forceinline__ void stage_rc(int b, int& R, int& C) { const int st = b / 1024, sb = b % 1024, swz = sb ^ (((sb >> 9) & 1) << 5); R = (st >> 1) * 16 + swz / 64; C = (st & 1) * 32 + (swz % 64) / 2; }
__host__ __device__ __forceinline__ int perm32(int rho) { const int n = rho >> 4, i = rho & 15; return 8 * (i >> 2) + 4 * n + (i & 3); }

typedef int i32x4 __attribute__((ext_vector_type(4)));
typedef int i32x8 __attribute__((ext_vector_type(8)));
template <bool FP8> struct FragT { typedef bf16x8 type; };
template <> struct FragT<true> { typedef i32x8 type; };
__device__ __forceinline__ f32x4 mma16(bf16x8 a, bf16x8 b, f32x4 c) { return __builtin_amdgcn_mfma_f32_16x16x32_bf16(a, b, c, 0, 0, 0); }
__device__ __forceinline__ f32x4 mma16(i32x8, i32x8, f32x4 c) { return c; }
__device__ __forceinline__ f32x4 mma8(i32x8 a, i32x8 b, f32x4 c) { const int one = 0x7F7F7F7F;
    asm volatile("v_mfma_scale_f32_16x16x128_f8f6f4 %0, %1, %2, %0, %3, %3 op_sel_hi:[0,0,0]" : "+v"(c) : "v"(a), "v"(b), "v"(one)); return c; }
__device__ __forceinline__ f32x4 mma8(bf16x8, bf16x8, f32x4 c) { return c; }
struct Unit { int pm, pn, part; };
struct Gemm { const bf16_t* A; const bf16_t* Bt; int M, N, K; };

struct StaticOrder {
    int nM, nN, nwg, G, c;
    __host__ __device__ void init(int M, int N, int G_, int c_) { nM = M / BM; nN = N / BM; nwg = nM * nN; G = G_; c = c_; }
    __host__ __device__ bool next(int i, Unit& u) const { return at((long)i * G + c, u); }
    __host__ __device__ bool at(long L, Unit& u) const {
        if (L >= nwg) return false;
        int wgid = (int)L; { const int q = nwg / NXCD, r = nwg % NXCD, xcd = wgid % NXCD, off = wgid / NXCD; wgid = (xcd < r ? xcd * (q + 1) : r * (q + 1) + (xcd - r) * q) + off; }
        const int nig = WGM * nN, gid = wgid / nig, fm = gid * WGM, gsz = (nM - fm) < WGM ? (nM - fm) : WGM;
        u.pm = fm + ((wgid % nig) % gsz); u.pn = (wgid % nig) / gsz; u.part = 0; return true;
    }
    __device__ __forceinline__ int kt0(const Unit&) const { return 0; }
    __device__ __forceinline__ int nkt(const Unit&, int full) const { return full; }
    __device__ __forceinline__ int rowsel(const Unit&, int r) const { return r; }
    __device__ __forceinline__ const void* abase(const Unit&) const { return nullptr; }
    __device__ __forceinline__ const void* bbase(const Unit&) const { return nullptr; }
    __device__ __forceinline__ void a_ready(const Unit&) const {}
    __device__ __forceinline__ void done(const Unit&) const {}
};


__device__ __forceinline__ unsigned cvt_pk_bf16(float lo, float hi) { unsigned r; asm volatile("v_cvt_pk_bf16_f32 %0, %1, %2" : "=v"(r) : "v"(lo), "v"(hi)); return r; }
__device__ __forceinline__ u32x4 pack8(const f32x4 v0, const f32x4 v1) { u32x4 w; w.x = cvt_pk_bf16(v0[0], v0[1]); w.y = cvt_pk_bf16(v0[2], v0[3]); w.z = cvt_pk_bf16(v1[0], v1[1]); w.w = cvt_pk_bf16(v1[2], v1[3]); return w; }
__device__ __forceinline__ void unpack8(const u32x4 w, f32x4& v0, f32x4& v1) {
    v0[0] = __builtin_bit_cast(float, w.x << 16); v0[1] = __builtin_bit_cast(float, w.x & 0xffff0000u); v0[2] = __builtin_bit_cast(float, w.y << 16); v0[3] = __builtin_bit_cast(float, w.y & 0xffff0000u);
    v1[0] = __builtin_bit_cast(float, w.z << 16); v1[1] = __builtin_bit_cast(float, w.z & 0xffff0000u); v1[2] = __builtin_bit_cast(float, w.w << 16); v1[3] = __builtin_bit_cast(float, w.w & 0xffff0000u);
}
__device__ __forceinline__ f32x4 sig4(const f32x4 x) { f32x4 r; r[0] = frcp(1.0f + __expf(-x[0])); r[1] = frcp(1.0f + __expf(-x[1])); r[2] = frcp(1.0f + __expf(-x[2])); r[3] = frcp(1.0f + __expf(-x[3])); return r; }

struct GroupedOrder {
    const unsigned* tile_e; int ntiles, nN, G, c; const int* rowidx;
    __device__ __forceinline__ int kt0(const Unit&) const { return 0; }
    __device__ __forceinline__ int nkt(const Unit&, int full) const { return full; }
    __device__ __forceinline__ int rowsel(const Unit&, int r) const { const int v = rowidx[r]; return (v < 0 ? 0 : v) >> 2; }
    __device__ __forceinline__ const void* abase(const Unit&) const { return nullptr; }
    __device__ __forceinline__ const void* bbase(const Unit&) const { return nullptr; }
    __device__ bool next(int i, Unit& u) const {
        const long L = (long)i * G + c; if (L >= (long)ntiles * nN) return false;
        u.pm = (int)(L / nN); const int e = (int)tile_e[u.pm]; u.pn = e * nN + (int)(L % nN); u.part = 0; return true;
    }
    __device__ __forceinline__ void a_ready(const Unit&) const {}
    __device__ __forceinline__ void done(const Unit&) const {}
};

template <int MODE> struct EpiProj {
    static constexpr bool PERM = true, AFTER_DRAIN = false, HAS_MID = false;
    bf16_t* O; const float* rope;
    __device__ __forceinline__ bool keep(const Unit&) const { return false; }
    __device__ __forceinline__ void operator()(f32x4 (&acc)[2][2][4][2], const Unit& u, int wr, int wc, int fr, int fq) const {
        const int pnp = (MODE == 0) ? u.pn : (MODE == 1) ? (u.pn < 18 ? u.pn : u.pn + (P1_HI - 18)) : u.pn + 18;
        const int row0 = u.pm * BM + wr * 64 + fr, col0 = pnp * BM + wc * 32 + 8 * fq;
        const float sc = ((pnp < 6) ? QSCALE : 1.0f) * ((MODE == 1) ? (1.0f / 32.0f) : 1.0f);
        const bool dorope = (pnp < 12) && (wc == 0);
#pragma unroll
        for (int ai = 0; ai < 2; ++ai)
#pragma unroll
            for (int m = 0; m < 4; ++m) {
                const int row = row0 + ai * HALF + m * 16; bf16_t* rowp = O + (size_t)row * NP + col0;
                f32x4 cs = (f32x4){1.f, 1.f, 1.f, 1.f}, sn = (f32x4){0.f, 0.f, 0.f, 0.f};
                if (dorope) { cs = *(const f32x4*)(rope + (size_t)row * 32 + 4 * fq); sn = *(const f32x4*)(rope + (size_t)row * 32 + 16 + 4 * fq); }
#pragma unroll
                for (int bj = 0; bj < 2; ++bj) {
                    f32x4 v0 = acc[ai][bj][m][0], v1 = acc[ai][bj][m][1];
                    if (dorope) { const f32x4 t0 = v0 * cs - v1 * sn, t1 = v1 * cs + v0 * sn; v0 = t0; v1 = t1; }
                    v0 = v0 * sc; v1 = v1 * sc;
                    *(u32x4*)(rowp + bj * HALF) = pack8(v0, v1);
                }
            }
    }
};

struct SplitOrder {
    StaticOrder base; int nA, nB;
    __device__ bool next(int i, Unit& u) const {
        const int c = base.c;
        if (base.G != 256 || nA < 0) return base.next(i, u);
        if (c < 128) { if (i >= nA) return false; return base.at((long)i * 128 + c, u); }
        if (i >= nB) return false; return base.at((long)128 * nA + (long)i * 128 + (c - 128), u);
    }
    __device__ __forceinline__ int kt0(const Unit&) const { return 0; }
    __device__ __forceinline__ int nkt(const Unit&, int full) const { return full; }
    __device__ __forceinline__ int rowsel(const Unit&, int r) const { return r; }
    __device__ __forceinline__ const void* abase(const Unit&) const { return nullptr; }
    __device__ __forceinline__ const void* bbase(const Unit&) const { return nullptr; }
    __device__ __forceinline__ void a_ready(const Unit&) const {}
    __device__ __forceinline__ void done(const Unit&) const {}
};
struct MergedOrder {
    StaticOrder base; int nparts; unsigned* ready; unsigned* tmo;
    bool pub;
    __device__ bool next(int i, Unit& u) const { if (!base.next(i / nparts, u)) return false; u.part = (nparts == 1) ? 2 : (i % nparts); return true; }
    __device__ __forceinline__ int kt0(const Unit& u) const { return u.part == 0 ? 0 : (u.part == 1 ? 8 : 24); }
    __device__ __forceinline__ int nkt(const Unit& u, int) const { return u.part == 0 ? 8 : 16; }
    __device__ __forceinline__ int rowsel(const Unit&, int r) const { return r; }
    __device__ __forceinline__ const void* abase(const Unit&) const { return nullptr; }
    __device__ __forceinline__ const void* bbase(const Unit&) const { return nullptr; }
    __device__ __forceinline__ void a_ready(const Unit& u) const {
        if (u.part != 2 || !pub) return;
        if (threadIdx.x < 64) {
            unsigned spins = 0;
            while ((unsigned)__builtin_amdgcn_readfirstlane(__hip_atomic_load(ready + 64 * u.pm, __ATOMIC_RELAXED, __HIP_MEMORY_SCOPE_AGENT)) < 32u) {
                __builtin_amdgcn_s_sleep(2);
                if (++spins > (1u << 22)) { if (threadIdx.x == 0) __hip_atomic_store(tmo, 1u, __ATOMIC_RELAXED, __HIP_MEMORY_SCOPE_AGENT); break; } }
            __builtin_amdgcn_fence(__ATOMIC_ACQUIRE, "agent");
            asm volatile("s_waitcnt vmcnt(0)" ::: "memory");
        }
        asm volatile("" ::: "memory"); __builtin_amdgcn_s_barrier(); asm volatile("" ::: "memory");
    }
    __device__ __forceinline__ void done(const Unit& u) const {
        if (!pub || u.part != 1) return;
        asm volatile("s_waitcnt vmcnt(0)" ::: "memory");
        if ((threadIdx.x & 63) == 0) __hip_atomic_fetch_add(ready + 64 * u.pm, 1u, __ATOMIC_RELAXED, __HIP_MEMORY_SCOPE_AGENT);
    }
};
struct EpiMerged {
    static constexpr bool PERM = true, AFTER_DRAIN = false, HAS_MID = false;
    bf16_t* O; const bf16_t* proj; const float* x; float* h; bool wt;
    __device__ __forceinline__ bool keep(const Unit& u) const { return u.part == 0; }
    __device__ __forceinline__ void operator()(f32x4 (&acc)[2][2][4][2], const Unit& u, int wr, int wc, int fr, int fq) const {
        const int row0 = u.pm * BM + wr * 64 + fr, col0 = u.pn * BM + wc * 32 + 8 * fq;
        if (u.part == 0) {
#pragma unroll
            for (int ai = 0; ai < 2; ++ai)
#pragma unroll
                for (int m = 0; m < 4; ++m) {
                    const bf16_t* rowp = proj + (size_t)(row0 + ai * HALF + m * 16) * NP + col0;
#pragma unroll
                    for (int bj = 0; bj < 2; ++bj) {
                        const u32x4 ga = *(const u32x4*)(rowp + C_GA + bj * HALF), gm = *(const u32x4*)(rowp + C_GM + bj * HALF);
                        f32x4 a0, a1, m0, m1; unpack8(ga, a0, a1); unpack8(gm, m0, m1);
                        f32x4 r0, r1;
#pragma unroll
                        for (int j = 0; j < 4; ++j) { r0[j] = (1.0f + __expf(-m0[j])) * frcp(1.0f + __expf(-a0[j])); r1[j] = (1.0f + __expf(-m1[j])) * frcp(1.0f + __expf(-a1[j])); }
                        acc[ai][bj][m][0] *= r0; acc[ai][bj][m][1] *= r1;
                    }
                    if (m & 1) asm volatile("" ::: "memory");
                }
        } else if (u.part == 1) {
#pragma unroll
            for (int ai = 0; ai < 2; ++ai)
#pragma unroll
                for (int m = 0; m < 4; ++m) {
                    const int row = row0 + ai * HALF + m * 16;
#pragma unroll
                    for (int bj = 0; bj < 2; ++bj) {
                        const u32x4 gm = *(const u32x4*)(proj + (size_t)row * NP + C_GM + col0 + bj * HALF);
                        f32x4 m0, m1; unpack8(gm, m0, m1);
                        const f32x4 v0 = acc[ai][bj][m][0] * sig4(m0), v1 = acc[ai][bj][m][1] * sig4(m1);
                        const u32x4 pw = pack8(v0, v1); bf16_t* dst = O + (size_t)row * AMLD + col0 + bj * HALF;
                        if (wt) { __hip_atomic_store((unsigned long long*)dst, (unsigned long long)pw.x | ((unsigned long long)pw.y << 32), __ATOMIC_RELAXED, __HIP_MEMORY_SCOPE_AGENT);
                                  __hip_atomic_store((unsigned long long*)dst + 1, (unsigned long long)pw.z | ((unsigned long long)pw.w << 32), __ATOMIC_RELAXED, __HIP_MEMORY_SCOPE_AGENT); }
                        else *(u32x4*)dst = pw;
                    }
                }
        } else {
#pragma unroll
            for (int ai = 0; ai < 2; ++ai)
#pragma unroll
                for (int m = 0; m < 4; ++m) {
                    const size_t off = (size_t)(row0 + ai * HALF + m * 16) * D + col0;
#pragma unroll
                    for (int bj = 0; bj < 2; ++bj)
#pragma unroll
                        for (int n = 0; n < 2; ++n) *(f32x4*)(h + off + bj * HALF + 4 * n) = *(const f32x4*)(x + off + bj * HALF + 4 * n) + acc[ai][bj][m][n];
                }
        }
    }
};

struct EpiResid {
    static constexpr bool PERM = false, AFTER_DRAIN = false, HAS_MID = false;
    const float* x; float* h;
    __device__ __forceinline__ bool keep(const Unit&) const { return false; }
    __device__ __forceinline__ void operator()(f32x4 (&acc)[2][2][4][2], const Unit& u, int wr, int wc, int fr, int fq) const {
        const int row0 = u.pm * BM + wr * 64 + fr, col0 = u.pn * BM + wc * 32 + 4 * fq;
#pragma unroll
        for (int ai = 0; ai < 2; ++ai)
#pragma unroll
            for (int m = 0; m < 4; ++m) {
                const size_t off = (size_t)(row0 + ai * HALF + m * 16) * D + col0;
#pragma unroll
                for (int bj = 0; bj < 2; ++bj)
#pragma unroll
                    for (int n = 0; n < 2; ++n) *(f32x4*)(h + off + bj * HALF + n * 16) = *(const f32x4*)(x + off + bj * HALF + n * 16) + acc[ai][bj][m][n];
            }
    }
};

template <bool OUT8> struct EpiSwiGLU {
    static constexpr bool PERM = true, AFTER_DRAIN = false, HAS_MID = false;
    bf16_t* act; const float* bgu; float sc;
    __device__ __forceinline__ bool keep(const Unit&) const { return false; }
    __device__ __forceinline__ void operator()(f32x4 (&acc)[2][2][4][2], const Unit& u, int wr, int wc, int fr, int fq) const {
        const int e = u.pn >> 3, pnl = u.pn & 7, row0 = u.pm * BM + wr * 64 + fr, j0 = 128 * pnl + 32 * wc + 8 * fq;
        const float* bp = bgu + (size_t)e * 2048 + 2 * j0;
        const f32x4 b0 = *(const f32x4*)(bp), b1 = *(const f32x4*)(bp + 4), b2 = *(const f32x4*)(bp + 8), b3 = *(const f32x4*)(bp + 12);
        const f32x4 bg0 = (f32x4){b0[0], b0[2], b1[0], b1[2]}, bu0 = (f32x4){b0[1], b0[3], b1[1], b1[3]}, bg1 = (f32x4){b2[0], b2[2], b3[0], b3[2]}, bu1 = (f32x4){b2[1], b2[3], b3[1], b3[3]};
#pragma unroll
        for (int ai = 0; ai < 2; ++ai)
#pragma unroll
            for (int m = 0; m < 4; ++m) {
                const int row = row0 + ai * HALF + m * 16;
                f32x4 o[2]; const float lim = 7.0f, nlim = -7.0f;
#pragma unroll
                for (int n = 0; n < 2; ++n) {
                    const f32x4 g = acc[ai][0][m][n] * sc + (n ? bg1 : bg0), up = acc[ai][1][m][n] * sc + (n ? bu1 : bu0);
#pragma unroll
                    for (int j = 0; j < 4; ++j) { float gg, uu;
                        asm("v_min_f32 %0, %2, %1" : "=v"(gg) : "v"(g[j]), "v"(lim)); asm("v_med3_f32 %0, %1, %2, %3" : "=v"(uu) : "v"(up[j]), "v"(nlim), "v"(lim));
                        const float sg = frcp(1.0f + __builtin_amdgcn_exp2f(gg * (-1.702f * 1.4426950408889634f)));
                        o[n][j] = __builtin_fmaf(uu, gg, gg) * sg; }
                }
                if constexpr (OUT8) { u32x2 w8; w8.x = pk4_fp8(o[0][0], o[0][1], o[0][2], o[0][3]); w8.y = pk4_fp8(o[1][0], o[1][1], o[1][2], o[1][3]); __hip_atomic_store((unsigned long long*)((unsigned char*)act + (size_t)row * D + j0), (unsigned long long)w8.x | ((unsigned long long)w8.y << 32), __ATOMIC_RELAXED, __HIP_MEMORY_SCOPE_AGENT); }
                else *(u32x4*)(act + (size_t)row * D + j0) = pack8(o[0], o[1]);
            }
    }
};

struct EpiDown {
    static constexpr bool PERM = true, AFTER_DRAIN = false, HAS_MID = false;
    bf16_t* ybuf; const float* bdn; const int* row_tok; const float* row_w; float sc;
    __device__ __forceinline__ bool keep(const Unit&) const { return false; }
    __device__ __forceinline__ void operator()(f32x4 (&acc)[2][2][4][2], const Unit& u, int wr, int wc, int fr, int fq) const {
        const int e = u.pn >> 2, pnl = u.pn & 3, row0 = u.pm * BM + wr * 64 + fr, col0 = 256 * pnl + 32 * wc + 8 * fq;
        f32x4 bv[2][2];
#pragma unroll
        for (int bj = 0; bj < 2; ++bj)
#pragma unroll
            for (int n = 0; n < 2; ++n) bv[bj][n] = *(const f32x4*)(bdn + (size_t)e * D + col0 + bj * HALF + 4 * n);
        int tks[8]; float ws[8];
#pragma unroll
        for (int i = 0; i < 8; ++i) { const int row = row0 + (i >> 2) * HALF + (i & 3) * 16; tks[i] = row_tok[row]; ws[i] = row_w[row]; }
#pragma unroll
        for (int ai = 0; ai < 2; ++ai)
#pragma unroll
            for (int m = 0; m < 4; ++m) {
                const int tk = tks[ai * 4 + m]; const float w = ws[ai * 4 + m];
                if (tk >= 0) {
#pragma unroll
                    for (int bj = 0; bj < 2; ++bj) {
                        const f32x4 v0 = (acc[ai][bj][m][0] * sc + bv[bj][0]) * w, v1 = (acc[ai][bj][m][1] * sc + bv[bj][1]) * w;
                        *(u32x4*)(ybuf + (size_t)tk * D + col0 + bj * HALF) = pack8(v0, v1);
                    }
                }
            }
    }
};

struct MoeOrder {
    const unsigned* tile_e; int ntiles, G, c; const int* rowidx; const void *a0, *a1, *b0, *b1; unsigned* ready; unsigned* tmo;
    __device__ __forceinline__ int kt0(const Unit&) const { return 0; }
    __device__ __forceinline__ int nkt(const Unit&, int full) const { return full; }
    __device__ __forceinline__ int rowsel(const Unit& u, int r) const { if (u.part) return r; const int v = rowidx[r]; return (v < 0 ? 0 : v) >> 2; }
    __device__ __forceinline__ const void* abase(const Unit& u) const { return u.part ? a1 : a0; }
    __device__ __forceinline__ const void* bbase(const Unit& u) const { return u.part ? b1 : b0; }
    __device__ bool next(int i, Unit& u) const {
        long L = (long)i * G + c; const long n1 = (long)ntiles * 8;
        if (L < n1) { u.pm = (int)(L >> 3); u.pn = (int)tile_e[u.pm] * 8 + (int)(L & 7); u.part = 0; return true; }
        L -= n1; if (L >= (long)ntiles * 4) return false;
        u.pm = (int)(L >> 2); u.pn = (int)tile_e[u.pm] * 4 + (int)(L & 3); u.part = 1; return true;
    }
    __device__ __forceinline__ void a_ready(const Unit& u) const {
        if (u.part == 0) return;
        if (threadIdx.x < 64) {
            unsigned spins = 0;
            while ((unsigned)__builtin_amdgcn_readfirstlane(__hip_atomic_load(ready + 64 * u.pm, __ATOMIC_RELAXED, __HIP_MEMORY_SCOPE_AGENT)) < 64u) {
                __builtin_amdgcn_s_sleep(2);
                if (++spins > (1u << 22)) { if (threadIdx.x == 0) __hip_atomic_store(tmo, 1u, __ATOMIC_RELAXED, __HIP_MEMORY_SCOPE_AGENT); break; } }
            __builtin_amdgcn_fence(__ATOMIC_ACQUIRE, "agent");
            asm volatile("s_waitcnt vmcnt(0)" ::: "memory");
        }
        asm volatile("" ::: "memory"); __builtin_amdgcn_s_barrier(); asm volatile("" ::: "memory");
    }
    __device__ __forceinline__ void done(const Unit& u) const {
        if (u.part != 0) return;
        asm volatile("s_waitcnt vmcnt(0)" ::: "memory");
        if ((threadIdx.x & 63) == 0) __hip_atomic_fetch_add(ready + 64 * u.pm, 1u, __ATOMIC_RELAXED, __HIP_MEMORY_SCOPE_AGENT);
    }
};
struct EpiMoe {
    static constexpr bool PERM = true, AFTER_DRAIN = false, HAS_MID = false;
    EpiSwiGLU<true> e0; EpiDown e1;
    __device__ __forceinline__ bool keep(const Unit&) const { return false; }
    __device__ __forceinline__ void operator()(f32x4 (&acc)[2][2][4][2], const Unit& u, int wr, int wc, int fr, int fq) const {
        if (u.part == 0) e0(acc, u, wr, wc, fr, fq); else e1(acc, u, wr, wc, fr, fq);
    }
};
template <class Epi, class Sched, bool ALIGN_EPI = false, bool SP2 = false, bool FP8 = false, bool GATHER = false, bool MULTI = false>
__device__ __forceinline__ void gemm_phase(PG8_LAS unsigned char* lds, const Gemm g, const Sched& S, const Epi& E) {
    typedef typename FragT<FP8>::type frag_t;
    const int tid = threadIdx.x, wid = __builtin_amdgcn_readfirstlane(tid >> 6), lane = tid & 63, wr = wid >> 2, wc = wid & 3, fr = lane & 15, fq = lane >> 4;
    int K_ = g.K; asm volatile("" : "+s"(K_));
    const int K = K_, ntfull = K / BK;
    unsigned voffA[2], voffB[2];
#pragma unroll
    for (int i = 0; i < 2; ++i) { int R, C; stage_rc(tid * 16 + i * 8192, R, C); const int Rb = Epi::PERM ? ((R & ~31) + perm32(R & 31)) : R;
        voffA[i] = (unsigned)(R * K + C) * 2u; voffB[i] = (unsigned)(Rb * K + C) * 2u; }
    const size_t kstep = (size_t)(BK * 2);
    const size_t hstep = (size_t)HALF * K * 2;
    const size_t tstep = 2 * hstep;
    const unsigned ldsw = (unsigned)wid * 1024u;
    const int aoff = lds_byte(wr * 64 + fr, fq * (FP8 ? 16 : 8)), boff = lds_byte(wc * 32 + fr, fq * (FP8 ? 16 : 8));
    constexpr int NKF = FP8 ? 1 : 2;
#define PG8_SA(b, h) (((b) * 2 + (h)) * HTB)
#define PG8_SB(b, h) ((4 + (b) * 2 + (h)) * HTB)
#define PG8_STAGE(bufoff, gbase, voff) do { _Pragma("unroll") for (int _i = 0; _i < 2; ++_i) \
        __builtin_amdgcn_global_load_lds((const unsigned*)((const char*)(gbase) + (voff)[_i]), (PG8_LAS unsigned*)(lds + (bufoff) + ldsw + _i * 8192), 16, 0, 0); } while (0)
#define PG8_STAGEA(bufoff, gbase, half, isnext) do { if constexpr (GATHER) { unsigned vs_[2]; vs_[0] = (isnext) ? voffAn[half][0] : voffAc[half][0]; vs_[1] = (isnext) ? voffAn[half][1] : voffAc[half][1]; PG8_STAGE(bufoff, gbase, vs_); } \
        else { PG8_STAGE(bufoff, (gbase) + (half) * hstep, voffA); } } while (0)
#define PG8_LDA(dst, b, h) do { _Pragma("unroll") for (int m = 0; m < 4; ++m) _Pragma("unroll") for (int k = 0; k < NKF; ++k) dst[m][k] = *(const PG8_LAS frag_t*)(lds + PG8_SA(b, h) + aoff + m * 2048 + k * 1024); } while (0)
#define PG8_LDB(dst, b, h) do { _Pragma("unroll") for (int n = 0; n < 2; ++n) _Pragma("unroll") for (int k = 0; k < NKF; ++k) dst[n][k] = *(const PG8_LAS frag_t*)(lds + PG8_SB(b, h) + boff + n * 2048 + k * 1024); } while (0)
#define PG8_MMA(ai, bj, At, Bt) do { __builtin_amdgcn_s_setprio(1); \
        if constexpr (FP8) { _Pragma("unroll") for (int m = 0; m < 4; ++m) _Pragma("unroll") for (int n = 0; n < 2; ++n) \
            acc[ai][bj][m][n] = mma8(Bt[n][0], At[m][0], acc[ai][bj][m][n]); } \
        else { _Pragma("unroll") for (int m = 0; m < 4; ++m) _Pragma("unroll") for (int n = 0; n < 2; ++n) _Pragma("unroll") for (int k = 0; k < 2; ++k) \
            acc[ai][bj][m][n] = mma16(Bt[n][k], At[m][k], acc[ai][bj][m][n]); } \
        __builtin_amdgcn_s_setprio(0); } while (0)
#define PG8_WAIT_V(n) asm volatile("s_waitcnt vmcnt(" #n ")" ::: "memory")
#define PG8_WAIT_L(n) asm volatile("s_waitcnt lgkmcnt(" #n ")" ::: "memory")
#define PG8_BAR __builtin_amdgcn_s_barrier()
#define PG8_SCHED __builtin_amdgcn_sched_barrier(0)
    Unit cur, nxt; int ui = 0;
    if (!S.next(0, cur)) return;
    unsigned voffAc[2][2], voffAn[2][2];
#define PG8_GROWS(dst, u_) do { if constexpr (GATHER) { _Pragma("unroll") for (int h_ = 0; h_ < 2; ++h_) _Pragma("unroll") for (int i_ = 0; i_ < 2; ++i_) { int R_, C_; stage_rc(tid * 16 + i_ * 8192, R_, C_); \
        const int ri_ = S.rowsel((u_), (u_).pm * BM + h_ * HALF + R_); dst[h_][i_] = (unsigned)ri_ * (unsigned)(K * 2) + (unsigned)(C_ * 2); } } } while (0)
    PG8_GROWS(voffAc, cur);
    f32x4 acc[2][2][4][2];
#pragma unroll
    for (int a = 0; a < 2; ++a)
#pragma unroll
        for (int b = 0; b < 2; ++b)
#pragma unroll
            for (int m = 0; m < 4; ++m)
#pragma unroll
                for (int n = 0; n < 2; ++n) acc[a][b][m][n] = (f32x4){0.f, 0.f, 0.f, 0.f};
    frag_t At[4][NKF], B0[2][NKF], B1[2][NKF];
    const char* cA = (MULTI ? (const char*)S.abase(cur) : (const char*)g.A) + (GATHER ? (size_t)0 : (size_t)cur.pm * tstep) + (size_t)S.kt0(cur) * kstep; const char* cB = (MULTI ? (const char*)S.bbase(cur) : (const char*)g.Bt) + (size_t)cur.pn * tstep + (size_t)S.kt0(cur) * kstep;
    S.a_ready(cur);
    if constexpr (SP2) {
        PG8_STAGE(PG8_SB(0, 0), cB, voffB); PG8_STAGE(PG8_SB(0, 1), cB + hstep, voffB); PG8_STAGEA(PG8_SA(0, 0), cA, 0, false); PG8_STAGEA(PG8_SA(0, 1), cA, 1, false);
        if (wr == 1) PG8_BAR;
        PG8_WAIT_V(2); PG8_BAR;
        PG8_STAGE(PG8_SB(1, 0), cB + kstep, voffB); PG8_STAGEA(PG8_SA(1, 0), cA + kstep, 0, false); PG8_STAGE(PG8_SB(1, 1), cB + hstep + kstep, voffB);
        PG8_WAIT_V(6); PG8_BAR;
    } else {
        PG8_STAGE(PG8_SB(0, 0), cB, voffB); PG8_STAGEA(PG8_SA(0, 0), cA, 0, false); PG8_STAGE(PG8_SB(0, 1), cB + hstep, voffB); PG8_STAGEA(PG8_SA(0, 1), cA, 1, false);
        if (wr == 1) PG8_BAR;
        PG8_WAIT_V(4); PG8_BAR;
        PG8_STAGE(PG8_SB(1, 0), cB + kstep, voffB); PG8_STAGEA(PG8_SA(1, 0), cA + kstep, 0, false); PG8_STAGE(PG8_SB(1, 1), cB + hstep + kstep, voffB);
        PG8_WAIT_V(6); PG8_BAR;
    }
    for (;;) {
        const bool has_next = S.next(ui + 1, nxt);
        if (has_next) PG8_GROWS(voffAn, nxt);
        else if constexpr (GATHER) { _Pragma("unroll") for (int h_ = 0; h_ < 2; ++h_) _Pragma("unroll") for (int i_ = 0; i_ < 2; ++i_) voffAn[h_][i_] = voffAc[h_][i_]; }
        const char* nA = has_next ? (MULTI ? (const char*)S.abase(nxt) : (const char*)g.A) + (GATHER ? (size_t)0 : (size_t)nxt.pm * tstep) + (size_t)S.kt0(nxt) * kstep : cA; const char* nB = has_next ? (MULTI ? (const char*)S.bbase(nxt) : (const char*)g.Bt) + (size_t)nxt.pn * tstep + (size_t)S.kt0(nxt) * kstep : cB;
        const int nt = S.nkt(cur, ntfull);
        for (int t = 0; t < nt; t += 2) {
            const bool last = (t == nt - 2);
            const char* a1 = cA + (size_t)(t + 1) * kstep;
            const char* a2 = last ? nA : cA + (size_t)(t + 2) * kstep; const char* b2 = last ? nB : cB + (size_t)(t + 2) * kstep;
            const char* a3 = a2 + kstep; const char* b3 = b2 + kstep;
            if (last && has_next) S.a_ready(nxt);
            if constexpr (SP2) {
            PG8_LDB(B0, 0, 0); PG8_LDB(B1, 0, 1); PG8_SCHED; PG8_LDA(At, 0, 0); PG8_STAGEA(PG8_SA(1, 1), a1, 1, false);
            PG8_WAIT_V(8); PG8_WAIT_L(0); PG8_BAR; PG8_MMA(0, 0, At, B0); PG8_MMA(0, 1, At, B1); PG8_BAR; PG8_SCHED;
            PG8_LDA(At, 0, 1); PG8_STAGE(PG8_SB(0, 0), b2, voffB); PG8_STAGE(PG8_SB(0, 1), b2 + hstep, voffB); PG8_STAGEA(PG8_SA(0, 0), a2, 0, last);
            PG8_WAIT_V(8); PG8_WAIT_L(0); PG8_BAR; PG8_MMA(1, 0, At, B0); PG8_MMA(1, 1, At, B1); PG8_BAR; PG8_SCHED;
            PG8_LDB(B0, 1, 0); PG8_LDB(B1, 1, 1); PG8_SCHED; PG8_LDA(At, 1, 0); PG8_STAGEA(PG8_SA(0, 1), a2, 1, last);
            PG8_WAIT_V(8); PG8_WAIT_L(0); PG8_BAR; PG8_MMA(0, 0, At, B0); PG8_MMA(0, 1, At, B1); PG8_BAR; PG8_SCHED;
            PG8_LDA(At, 1, 1); PG8_STAGE(PG8_SB(1, 0), b3, voffB); PG8_STAGE(PG8_SB(1, 1), b3 + hstep, voffB); PG8_STAGEA(PG8_SA(1, 0), a3, 0, last);
            PG8_WAIT_V(8); PG8_WAIT_L(0); PG8_BAR; PG8_MMA(1, 0, At, B0); PG8_MMA(1, 1, At, B1); PG8_BAR; PG8_SCHED;
            } else {
            PG8_LDB(B0, 0, 0); PG8_SCHED; PG8_LDA(At, 0, 0); PG8_STAGEA(PG8_SA(1, 1), a1, 1, false);
            PG8_WAIT_L(8); PG8_BAR; PG8_WAIT_L(0); PG8_MMA(0, 0, At, B0); PG8_BAR; PG8_SCHED;
            PG8_LDB(B1, 0, 1); PG8_STAGE(PG8_SB(0, 0), b2, voffB);
            PG8_BAR; PG8_WAIT_L(0); PG8_MMA(0, 1, At, B1); PG8_BAR;
            PG8_LDA(At, 0, 1); PG8_STAGEA(PG8_SA(0, 0), a2, 0, last);
            PG8_BAR; PG8_WAIT_L(0); PG8_MMA(1, 0, At, B0); PG8_BAR; PG8_SCHED;
            PG8_STAGE(PG8_SB(0, 1), b2 + hstep, voffB);
            PG8_WAIT_V(6); PG8_BAR; PG8_MMA(1, 1, At, B1); PG8_BAR;
            PG8_LDB(B0, 1, 0); PG8_SCHED; PG8_LDA(At, 1, 0); PG8_STAGEA(PG8_SA(0, 1), a2, 1, last);
            PG8_WAIT_L(8); PG8_BAR; PG8_WAIT_L(0); PG8_MMA(0, 0, At, B0); PG8_BAR; PG8_SCHED;
            PG8_LDB(B1, 1, 1); PG8_STAGE(PG8_SB(1, 0), b3, voffB);
            PG8_BAR; PG8_WAIT_L(0); PG8_MMA(0, 1, At, B1); PG8_BAR;
            PG8_LDA(At, 1, 1); PG8_STAGEA(PG8_SA(1, 0), a3, 0, last);
            PG8_BAR; PG8_WAIT_L(0); PG8_MMA(1, 0, At, B0); PG8_BAR; PG8_SCHED;
            PG8_STAGE(PG8_SB(1, 1), b3 + hstep, voffB);
            PG8_WAIT_V(6); PG8_BAR; PG8_MMA(1, 1, At, B1); PG8_BAR;
            }
        }
        if constexpr (FP8) asm volatile("s_nop 15\n\ts_nop 15" ::: "memory");
        if constexpr (ALIGN_EPI) { if (wr == 0) PG8_BAR; }
        if constexpr (!Epi::AFTER_DRAIN) { E(acc, cur, wr, wc, fr, fq); S.done(cur); }
        if (!has_next) break;
        if (!E.keep(cur)) {
#pragma unroll
        for (int a = 0; a < 2; ++a)
#pragma unroll
            for (int b = 0; b < 2; ++b)
#pragma unroll
                for (int m = 0; m < 4; ++m)
#pragma unroll
                    for (int n = 0; n < 2; ++n) acc[a][b][m][n] = (f32x4){0.f, 0.f, 0.f, 0.f};
        }
        cur = nxt; cA = nA; cB = nB; ++ui;
        if constexpr (GATHER) { _Pragma("unroll") for (int h_ = 0; h_ < 2; ++h_) _Pragma("unroll") for (int i_ = 0; i_ < 2; ++i_) voffAc[h_][i_] = voffAn[h_][i_]; }
        if constexpr (ALIGN_EPI) { if (wr == 1) PG8_BAR; }
    }
    PG8_WAIT_V(0);
    if constexpr (!ALIGN_EPI) { if (wr == 0) PG8_BAR; }
    PG8_BAR;
    if constexpr (Epi::AFTER_DRAIN) { E.fused(acc, cur, wr, wc, fr, fq, lds, wid, lane); S.done(cur); }
#undef PG8_SA
#undef PG8_SB
#undef PG8_STAGE
#undef PG8_LDA
#undef PG8_STAGEA
#undef PG8_GROWS
#undef PG8_LDB
#undef PG8_MMA
#undef PG8_WAIT_V
#undef PG8_WAIT_L
#undef PG8_BAR
#undef PG8_SCHED
}
}
#define XB_TMO      128
#define XB_XCNT(j)  (256  + 64 * (j))
#define XB_XSUB(j)  (1280 + 64 * (j))
#define XB_XGEN(j)  (2304 + 64 * (j))
#define XB_TOP      3328
#define XB_TOPGEN   3392
#define XCD_BAR_WORDS 3456
#define XB_SPIN_CAP (1u << 24)

__device__ __forceinline__ unsigned xb_ld(unsigned* p)              { return __hip_atomic_load(p, __ATOMIC_RELAXED, __HIP_MEMORY_SCOPE_AGENT); }
__device__ __forceinline__ unsigned xb_add(unsigned* p, unsigned v) { return __hip_atomic_fetch_add(p, v, __ATOMIC_RELAXED, __HIP_MEMORY_SCOPE_AGENT); }
__device__ __forceinline__ unsigned xb_xcc_id() { return (unsigned)__builtin_amdgcn_s_getreg((3 << 11) | 20) & 0xFu; }
#define XB_SPIN(cond, bar) do { unsigned _sp = 0; while (cond) { __builtin_amdgcn_s_sleep(1); \
    if ((++_sp & 255u) == 0u) { if (xb_ld(&(bar)[XB_TMO])) break; if (_sp > XB_SPIN_CAP) { atomicAdd(&(bar)[XB_TMO], 1u); break; } } } } while (0)

struct XcdBarrier {
    unsigned* bar; unsigned x;
    volatile LAS unsigned* st;
};

__device__ __forceinline__ XcdBarrier xcd_barrier_post(unsigned* bar, volatile LAS unsigned* st) {
    XcdBarrier b; b.bar = bar; b.x = xb_xcc_id(); b.st = st;
    if (threadIdx.x == 0) (void)xb_add(&bar[XB_XCNT(b.x)], 1u);
    return b;
}
__device__ __forceinline__ void xcd_barrier_complete(unsigned* bar, unsigned x, unsigned& nloc, unsigned& nx) {
    const unsigned G = gridDim.x * gridDim.y * gridDim.z;
    unsigned sum, cnt, mine, sp = 0u;
    for (;;) {
        sum = 0u; cnt = 0u; mine = 0u;
#pragma unroll
        for (unsigned j = 0; j < 16; ++j) { const unsigned c = xb_ld(&bar[XB_XCNT(j)]); sum += c; cnt += (c > 0u) ? 1u : 0u; mine = (j == x) ? c : mine; }
        if (sum == G) break;
        __builtin_amdgcn_s_sleep(1);
        if ((++sp & 255u) == 0u) { if (xb_ld(&bar[XB_TMO])) break; if (sp > XB_SPIN_CAP) { atomicAdd(&bar[XB_TMO], 1u); break; } }
    }
    nloc = mine > 0u ? mine : 1u; nx = cnt > 0u ? cnt : 1u;
}

__device__ __forceinline__ void xcd_barrier(const XcdBarrier& b) {
    asm volatile("s_waitcnt vmcnt(0)" ::: "memory");
    __syncthreads();
    if (threadIdx.x == 0) {
        unsigned* bar = b.bar;
        __builtin_amdgcn_s_waitcnt(0);
        unsigned nloc = b.st[0], nx = b.st[1];
        if (nloc == 0u) { xcd_barrier_complete(bar, b.x, nloc, nx); b.st[0] = nloc; b.st[1] = nx; }
        const unsigned old = xb_add(&bar[XB_XSUB(b.x)], 1u);
        const unsigned gen = old / nloc;
        if (old + 1u == (gen + 1u) * nloc) {
            __builtin_amdgcn_fence(__ATOMIC_RELEASE, "agent");
            asm volatile("s_waitcnt vmcnt(0)" ::: "memory");
            const unsigned og = xb_add(&bar[XB_TOP], 1u);
            const unsigned tg = og / nx;
            if (og + 1u == (tg + 1u) * nx) xb_add(&bar[XB_TOPGEN], 1u);
            else XB_SPIN(xb_ld(&bar[XB_TOPGEN]) == tg, bar);
            __builtin_amdgcn_fence(__ATOMIC_ACQUIRE, "agent");
            xb_add(&bar[XB_XGEN(b.x)], 1u);
            asm volatile("s_waitcnt vmcnt(0)" ::: "memory");
        } else {
            XB_SPIN(xb_ld(&bar[XB_XGEN(b.x)]) == gen, bar);
            __builtin_amdgcn_fence(__ATOMIC_ACQUIRE, "agent");
            asm volatile("s_waitcnt vmcnt(0)" ::: "memory");
        }
    }
    __syncthreads();
}

struct Frame {
    LAS unsigned char* lds;
    unsigned* ctl;
    int tid, lane, wave, vcu, G, gw, NGW;
    const float *x, *g_mix, *w_in, *conv_qk, *b_if, *g_mnorm, *w_attn_out, *w_mlstm_out, *w_mix_out, *g_ffn, *w_router, *b_router, *w_gate_up, *b_gate_up, *w_down, *b_down, *g_final;
    const int* positions;
    float* out;
    bf16 *WinT, *WamT, *WoT, *WguT, *WdnT, *XN, *PROJ, *OG, *AM, *MERGED, *XS, *ACT, *YBUF;
    float *GATES, *ROPE, *LSE, *HT, *H, *QC, *KC, *ROW_W, *TOK_W;
    int *TOK_E, *TOK_SLOT, *ROW_TOK;
};

__constant__ double ROPE_REV[16] = {
    1.59154943091895346e-01, 7.00865215877985032e-02, 3.08637634047012298e-02, 1.35913706361939050e-02, 5.98518571271370540e-03, 2.63567589866741401e-03, 1.16066364124006098e-03, 5.11117504537543857e-04,
    2.25079079039276525e-04, 9.91173093690193548e-05, 4.36479527928028909e-05, 1.92211006849448627e-05, 8.46433080824140138e-06, 3.72740860191535193e-06, 1.64142626279503449e-06, 7.22829306883286479e-07};

template <int MAP>
__device__ __forceinline__ void transpose_item(const float* W, int Nsrc, bf16* WT, int ldk, int kofs, int nblk, LAS float* scr, int item, int lane) {
    const int kb = item / nblk, nb = item % nblk, k0 = 64 * kb, n0 = 32 * nb;
    const int np = n0 + (lane & 31);
    const int sc = (MAP == 1) ? win_logical_col(np) : (MAP == 2) ? wgu_logical_col(np) : np;
    float tv[32];
#pragma unroll
    for (int i = 0; i < 32; ++i) tv[i] = W[(size_t)(k0 + 2 * i + (lane >> 5)) * Nsrc + sc];
#pragma unroll
    for (int i = 0; i < 32; ++i) scr[(2 * i + (lane >> 5)) * 33 + (lane & 31)] = tv[i];
    asm volatile("s_waitcnt lgkmcnt(0)" ::: "memory");
    const int c = lane & 7;
#pragma unroll
    for (int j = 0; j < 4; ++j) { const int n = (lane >> 3) + 8 * j; const LAS float* s = scr + (8 * c) * 33 + n;
        u32x4 o; o.x = pk2(s[0 * 33], s[1 * 33]); o.y = pk2(s[2 * 33], s[3 * 33]); o.z = pk2(s[4 * 33], s[5 * 33]); o.w = pk2(s[6 * 33], s[7 * 33]);
        *(u32x4*)(WT + (size_t)(n0 + n) * ldk + kofs + k0 + 8 * c) = o; }
    asm volatile("s_waitcnt lgkmcnt(0)" ::: "memory");
}

template <int MAP>
__device__ __forceinline__ void transpose_item_fp8(const float* W, int Nsrc, unsigned char* WT, int ldk, int nblk, LAS float* scr, int item, int lane, float scale) {
    const int kb = item / nblk, nb = item % nblk, k0 = 64 * kb, n0 = 32 * nb;
    const int np = n0 + (lane & 31);
    const int sc = (MAP == 1) ? win_logical_col(np) : (MAP == 2) ? wgu_logical_col(np) : np;
    float tv[32];
#pragma unroll
    for (int i = 0; i < 32; ++i) tv[i] = W[(size_t)(k0 + 2 * i + (lane >> 5)) * Nsrc + sc];
#pragma unroll
    for (int i = 0; i < 32; ++i) scr[(2 * i + (lane >> 5)) * 33 + (lane & 31)] = tv[i] * scale;
    asm volatile("s_waitcnt lgkmcnt(0)" ::: "memory");
    const int n = lane >> 1, c = lane & 1;
#pragma unroll
    for (int q = 0; q < 2; ++q) { const LAS float* s = scr + (32 * c + 16 * q) * 33 + n;
        u32x4 o; o.x = pk4_fp8(s[0 * 33], s[1 * 33], s[2 * 33], s[3 * 33]); o.y = pk4_fp8(s[4 * 33], s[5 * 33], s[6 * 33], s[7 * 33]);
        o.z = pk4_fp8(s[8 * 33], s[9 * 33], s[10 * 33], s[11 * 33]); o.w = pk4_fp8(s[12 * 33], s[13 * 33], s[14 * 33], s[15 * 33]);
        *(u32x4*)(WT + (size_t)(n0 + n) * ldk + k0 + 32 * c + 16 * q) = o; }
    asm volatile("s_waitcnt lgkmcnt(0)" ::: "memory");
}

template <int MAP>
__device__ __forceinline__ void tr8_load(const float* W, int Nsrc, int nblk, int item, int lane, float (&tv)[32]) {
    const int kb = item / nblk, nb = item % nblk, k0 = 64 * kb, np = 32 * nb + (lane & 31);
    const int sc = (MAP == 1) ? win_logical_col(np) : (MAP == 2) ? wgu_logical_col(np) : np;
#pragma unroll
    for (int i = 0; i < 32; ++i) tv[i] = W[(size_t)(k0 + 2 * i + (lane >> 5)) * Nsrc + sc];
}
__device__ __forceinline__ void tr8_store(const float (&tv)[32], unsigned char* WT, int ldk, int nblk, LAS float* scr, int item, int lane, float scale) {
    const int kb = item / nblk, nb = item % nblk, k0 = 64 * kb, n0 = 32 * nb;
#pragma unroll
    for (int i = 0; i < 32; ++i) scr[(2 * i + (lane >> 5)) * 33 + (lane & 31)] = tv[i] * scale;
    asm volatile("s_waitcnt lgkmcnt(0)" ::: "memory");
    const int n = lane >> 1, c = lane & 1;
#pragma unroll
    for (int q = 0; q < 2; ++q) { const LAS float* s = scr + (32 * c + 16 * q) * 33 + n;
        u32x4 o; o.x = pk4_fp8(s[0 * 33], s[1 * 33], s[2 * 33], s[3 * 33]); o.y = pk4_fp8(s[4 * 33], s[5 * 33], s[6 * 33], s[7 * 33]);
        o.z = pk4_fp8(s[8 * 33], s[9 * 33], s[10 * 33], s[11 * 33]); o.w = pk4_fp8(s[12 * 33], s[13 * 33], s[14 * 33], s[15 * 33]);
        *(u32x4*)(WT + (size_t)(n0 + n) * ldk + k0 + 32 * c + 16 * q) = o; }
    asm volatile("s_waitcnt lgkmcnt(0)" ::: "memory");
}

__device__ __forceinline__ void p0_weights(Frame& F) {
    LAS float* scr = (LAS float*)(F.lds + F.wave * 16384);
    constexpr int I_IN = (D / 64) * (NP / 32), I_A = (512 / 64) * (D / 32), I_M = (D / 64) * (D / 32), I_O = I_M;
    constexpr int I_GU1 = (D / 64) * (2048 / 32), I_DN1 = (D / 64) * (D / 32);
    constexpr int NITEMS = I_IN + I_A + I_M + I_O + ((MOE_FP8 && STEAL) ? 0 : NE * I_GU1 + NE * I_DN1);
    for (int it = F.gw; it < NITEMS; it += F.NGW) {
        int r = it;
#if P1_FP8
        if (r < I_IN) { const int pn = (r % (NP / 32)) >> 3;
            if (pn < 18 || pn >= P1_HI) transpose_item_fp8<1>(F.w_in, DIN, (unsigned char*)F.WinT - (pn >= P1_HI ? (size_t)(P1_HI - 18) * 256 * D : (size_t)0), D, NP / 32, scr, r, F.lane, 32.0f);
            else transpose_item<1>(F.w_in, DIN, F.WinT, D, 0, NP / 32, scr, r, F.lane);
            continue; } r -= I_IN;
#else
        if (r < I_IN) { transpose_item<1>(F.w_in, DIN, F.WinT, D, 0, NP / 32, scr, r, F.lane); continue; } r -= I_IN;
#endif
        if (r < I_A) { transpose_item<0>(F.w_attn_out, D, F.WamT, AMLD, 0, D / 32, scr, r, F.lane); continue; } r -= I_A;
        if (r < I_M) { transpose_item<0>(F.w_mlstm_out, D, F.WamT, AMLD, 512, D / 32, scr, r, F.lane); continue; } r -= I_M;
        if (r < I_O) { transpose_item<0>(F.w_mix_out, D, F.WamT, AMLD, 1536, D / 32, scr, r, F.lane); continue; } r -= I_O;
#if MOE_FP8 && STEAL
        (void)r;
#elif MOE_FP8
        if (r < NE * I_GU1) { const int e = r / I_GU1; transpose_item_fp8<2>(F.w_gate_up + (size_t)e * D * 2048, 2048, (unsigned char*)F.WguT + (size_t)e * 2048 * D, D, 2048 / 32, scr, r % I_GU1, F.lane, 32.0f); continue; } r -= NE * I_GU1;
        { const int e = r / I_DN1; transpose_item_fp8<0>(F.w_down + (size_t)e * D * D, D, (unsigned char*)F.WdnT + (size_t)e * D * D, D, D / 32, scr, r % I_DN1, F.lane, 32.0f); }
#else
        if (r < NE * I_GU1) { const int e = r / I_GU1; transpose_item<2>(F.w_gate_up + (size_t)e * D * 2048, 2048, F.WguT + (size_t)e * 2048 * D, D, 0, 2048 / 32, scr, r % I_GU1, F.lane); continue; } r -= NE * I_GU1;
        { const int e = r / I_DN1; transpose_item<0>(F.w_down + (size_t)e * D * D, D, F.WdnT + (size_t)e * D * D, D, 0, D / 32, scr, r % I_DN1, F.lane); }
#endif
    }
}

__device__ __forceinline__ void p0_rows(Frame& F) {
    LAS float* w8t = (LAS float*)(F.lds);
    __syncthreads();
    { float w8v[16];
#pragma unroll
      for (int j = 0; j < 16; ++j) { const int i = F.tid + j * NTHREADS; w8v[j] = F.w_in[(size_t)(i >> 3) * DIN + 8704 + (i & 7)]; }
#pragma unroll
      for (int j = 0; j < 16; ++j) { const int i = F.tid + j * NTHREADS; w8t[(i & 7) * 1024 + (i >> 3)] = w8v[j]; } }
    __syncthreads();
    f32x4 vnx[4];
    if (F.gw < T) { const f32x4* xr = (const f32x4*)(F.x + (size_t)F.gw * D) + F.lane;
#pragma unroll
        for (int j = 0; j < 4; ++j) vnx[j] = xr[64 * j]; }
    for (int row = F.gw; row < T; row += F.NGW) {
        f32x4 v[4]; float s = 0.f;
#pragma unroll
        for (int j = 0; j < 4; ++j) { v[j] = vnx[j]; s += (v[j].x * v[j].x + v[j].y * v[j].y) + (v[j].z * v[j].z + v[j].w * v[j].w); }
        if (row + F.NGW < T) { const f32x4* xr = (const f32x4*)(F.x + (size_t)(row + F.NGW) * D) + F.lane;
#pragma unroll
            for (int j = 0; j < 4; ++j) vnx[j] = xr[64 * j]; }
        const float rstd = 1.0f / sqrtf(wave_sum(s) * (1.0f / D) + RMS_EPS);
        float ga[8];
#pragma unroll
        for (int o = 0; o < 8; ++o) ga[o] = 0.f;
        unsigned long long* o8 = (unsigned long long*)(F.XN + (size_t)row * D) + F.lane;
#pragma unroll
        for (int j = 0; j < 4; ++j) {
            const f32x4 g = *((const f32x4*)F.g_mix + F.lane + 64 * j);
            v[j] = v[j] * rstd * g;
            o8[64 * j] = (unsigned long long)pk2(v[j].x, v[j].y) | ((unsigned long long)pk2(v[j].z, v[j].w) << 32);
#if P1_FP8
            ((unsigned*)((unsigned char*)F.ctl + WS_XN8 + (size_t)row * D))[F.lane + 64 * j] = pk4_fp8(v[j].x, v[j].y, v[j].z, v[j].w);
#endif
#pragma unroll
            for (int o = 0; o < 8; ++o) { const f32x4 w = *((const LAS f32x4*)(w8t + o * 1024) + F.lane + 64 * j); ga[o] += (v[j].x * w.x + v[j].y * w.y) + (v[j].z * w.z + v[j].w * w.w); }
        }
#pragma unroll
        for (int o = 0; o < 8; ++o) ga[o] = wave_sum(ga[o]);
        if (F.lane < 8) { float gv = ga[0];
#pragma unroll
            for (int o = 1; o < 8; ++o) gv = (F.lane == o) ? ga[o] : gv;
            F.GATES[(size_t)row * 8 + F.lane] = gv + F.b_if[F.lane]; }
        if (F.lane < 16) {
            const int pos = F.positions[row];
            double rev = (double)pos * ROPE_REV[F.lane]; rev -= floor(rev);
            const float fr = (float)rev;
            F.ROPE[(size_t)row * 32 + F.lane] = __builtin_amdgcn_cosf(fr);
            F.ROPE[(size_t)row * 32 + 16 + F.lane] = __builtin_amdgcn_sinf(fr);
        }
    }
}

template <int RT, class AF, class BF, class EP>
__device__ __forceinline__ void naive_gemm(Frame& F, int M, int N, int K, AF af, BF bf, EP ep) {
    const long gthreads = (long)F.G * NTHREADS, gtid = (long)blockIdx.x * NTHREADS + F.tid;
    for (long it = gtid; it < (long)(M / RT) * N; it += gthreads) {
        const int col = (int)(it % N), r0 = (int)(it / N) * RT;
        float acc[RT];
#pragma unroll
        for (int r = 0; r < RT; ++r) acc[r] = 0.f;
        for (int k = 0; k < K; ++k) { const float b = bf(k, col);
#pragma unroll
            for (int r = 0; r < RT; ++r) acc[r] += af(r0 + r, k) * b; }
#pragma unroll
        for (int r = 0; r < RT; ++r) ep(r0 + r, col, acc[r]);
    }
}

__device__ __forceinline__ void naive_p1(Frame& F) {
    const bf16* XN = F.XN; const float* W = F.w_in; bf16* P = F.PROJ;
    naive_gemm<8>(F, T, NP, D,
        [=](int r, int k) { return bf2f(XN[(size_t)r * D + k]); },
        [=](int k, int c) { return bf2f(f2bf(W[(size_t)k * DIN + win_logical_col(c)])); },
        [=](int r, int c, float a) { P[(size_t)r * NP + c] = (bf16)f2bf(a * (c < C_AK ? QSCALE : 1.0f)); });
}
__device__ __forceinline__ void naive_p1_rope(Frame& F) {
    const long gthreads = (long)F.G * NTHREADS, gtid = (long)blockIdx.x * NTHREADS + F.tid;
    for (long it = gtid; it < (long)T * 24 * 16; it += gthreads) {
        const int i = (int)(it & 15), hh = (int)((it >> 4) % 24), row = (int)(it / (24 * 16));
        const int a = i >> 2, j = i & 3; bf16* p = F.PROJ + (size_t)row * NP + hh * 128;
        const float x1 = bf2f(p[8 * a + j]), x2 = bf2f(p[8 * a + 4 + j]), cs = F.ROPE[(size_t)row * 32 + i], sn = F.ROPE[(size_t)row * 32 + 16 + i];
        p[8 * a + j] = (bf16)f2bf(x1 * cs - x2 * sn); p[8 * a + 4 + j] = (bf16)f2bf(x2 * cs + x1 * sn);
    }
}
__device__ __forceinline__ void naive_attn(Frame& F) {
    for (int it = F.gw; it < T * 12; it += F.NGW) {
        const int row = it / 12, gh = it % 12, g = gh >> 2, h = gh & 3, b = row / SEQ, t = row % SEQ, d = (g == 0) ? 1 : (g == 1) ? 4 : 16, i = t / d, r = t % d;
        const int hc = g * 512 + h * 128 + 2 * F.lane;
        const unsigned qw = *(const unsigned*)(F.PROJ + (size_t)row * NP + C_AQ + hc); const float q0 = bflo(qw), q1 = bfhi(qw);
        float m = -INFINITY, l = 0.f, o0 = 0.f, o1 = 0.f;
        for (int ii = (i > 128 ? i - 128 : 0); ii <= i; ++ii) {
            const size_t kr = (size_t)(b * SEQ + r + d * ii) * NP;
            const unsigned kw = *(const unsigned*)(F.PROJ + kr + C_AK + hc), vw = *(const unsigned*)(F.PROJ + kr + C_AV + hc);
            const float s = wave_sum(q0 * bflo(kw) + q1 * bfhi(kw));
            const float mn = fmaxf(m, s), al = exp2f(m - mn), p = exp2f(s - mn);
            l = l * al + p; o0 = o0 * al + p * bflo(vw); o1 = o1 * al + p * bfhi(vw); m = mn;
        }
        const float il = 1.0f / l;
        *(unsigned*)(F.OG + ((size_t)g * T + row) * 512 + h * 128 + 2 * F.lane) = pk2(o0 * il, o1 * il);
        if (F.lane == 0) F.LSE[((size_t)g * T + row) * 4 + h] = m + log2f(l);
    }
}
__device__ __forceinline__ void naive_conv(Frame& F) {
    const long gthreads = (long)F.G * NTHREADS, gtid = (long)blockIdx.x * NTHREADS + F.tid;
    for (long it = gtid; it < (long)T * 2048; it += gthreads) {
        const int c = (int)(it & 2047), row = (int)(it >> 11), t = row % SEQ;
        float a = 0.f;
#pragma unroll
        for (int j = 0; j < 4; ++j) if (t - 3 + j >= 0) a += F.conv_qk[j * 2048 + c] * bf2f(F.PROJ[(size_t)(row - 3 + j) * NP + C_MQ + c]);
        const float y = a / (1.0f + __expf(-a));
        if (c < 1024) F.QC[(size_t)row * 1024 + c] = y; else F.KC[(size_t)row * 1024 + c - 1024] = y * 0.0625f;
    }
}
__device__ __forceinline__ void naive_mlstm(Frame& F) {
    LAS float* sq = (LAS float*)F.lds; LAS float* sk = sq + 256; LAS float* red = sk + 256; LAS float* redn = red + 512;
    for (int item = blockIdx.x; item < NB * 4 * 8; item += F.G) {
        const int sl = item & 7, h = (item >> 3) & 3, b = item >> 5, dvl = F.tid & 31, dkp = F.tid >> 5;
        float c[16], n[16];
#pragma unroll
        for (int j = 0; j < 16; ++j) { c[j] = 0.f; n[j] = 0.f; }
        float m = 0.f;
        for (int t = 0; t < SEQ; ++t) {
            const size_t row = (size_t)b * SEQ + t;
            __syncthreads();
            if (F.tid < 256) sq[F.tid] = F.QC[row * 1024 + h * 256 + F.tid]; else sk[F.tid - 256] = F.KC[row * 1024 + h * 256 + F.tid - 256];
            const float v = bf2f(F.PROJ[row * NP + C_MV + h * 256 + sl * 32 + dvl]);
            const float ir = F.GATES[row * 8 + h], fr = F.GATES[row * 8 + 4 + h];
            const float logf = fminf(fr, 0.f) - log1pf(__expf(-fabsf(fr)));
            const float mn = fmaxf(logf + m, ir), fa = __expf(logf + m - mn), ia = __expf(ir - mn);
            m = mn;
            __syncthreads();
            float pn = 0.f, pd = 0.f;
#pragma unroll
            for (int j = 0; j < 16; ++j) { const float kk = sk[dkp * 16 + j], qq = sq[dkp * 16 + j]; c[j] = fa * c[j] + ia * kk * v; n[j] = fa * n[j] + ia * kk; pn += qq * c[j]; pd += qq * n[j]; }
            red[dkp * 32 + dvl] = pn; redn[dkp * 32 + dvl] = pd;
            __syncthreads();
            if (F.tid < 32) { float num = 0.f, den = 0.f;
#pragma unroll
                for (int p = 0; p < 16; ++p) { num += red[p * 32 + F.tid]; den += redn[p * 32 + F.tid]; }
                F.HT[row * 1024 + h * 256 + sl * 32 + F.tid] = num / fmaxf(fabsf(den), __expf(-mn)); }
        }
    }
}
__device__ __forceinline__ void naive_p4(Frame& F) {
    const bf16 *AM = F.AM, *PJ = F.PROJ; const float *WA = F.w_attn_out, *WM = F.w_mlstm_out; bf16* O = F.AM + 1536;
    float* tmp = F.QC;
    naive_gemm<8>(F, T, D, 512, [=](int r, int k) { return bf2f(AM[(size_t)r * AMLD + k]); }, [=](int k, int c) { return bf2f(f2bf(WA[(size_t)k * D + c])); },
        [=](int r, int c, float a) { tmp[(size_t)r * D + c] = a * sigmoidf_(bf2f(PJ[(size_t)r * NP + C_GA + c])); });
    __threadfence();
    naive_gemm<8>(F, T, D, D, [=](int r, int k) { return bf2f(AM[(size_t)r * AMLD + 512 + k]); }, [=](int k, int c) { return bf2f(f2bf(WM[(size_t)k * D + c])); },
        [=](int r, int c, float a) { O[(size_t)r * AMLD + c] = (bf16)f2bf(tmp[(size_t)r * D + c] + a * sigmoidf_(bf2f(PJ[(size_t)r * NP + C_GM + c]))); });
}
__device__ __forceinline__ void naive_p5(Frame& F) {
    const bf16* MG = F.AM + 1536; const float *WO = F.w_mix_out, *X = F.x; float* H = F.H;
    naive_gemm<8>(F, T, D, D, [=](int r, int k) { return bf2f(MG[(size_t)r * AMLD + k]); }, [=](int k, int c) { return bf2f(f2bf(WO[(size_t)k * D + c])); },
        [=](int r, int c, float a) { H[(size_t)r * D + c] = X[(size_t)r * D + c] + a; });
}
__device__ __forceinline__ void naive_p8(Frame& F, int ntiles) {
    const long gthreads = (long)F.G * NTHREADS, gtid = (long)blockIdx.x * NTHREADS + F.tid;
    const unsigned* tile_e = F.ctl + CW_TILEE;
    for (long it = gtid; it < (long)ntiles * 256 * D; it += gthreads) {
        const int j = (int)(it & 1023), row = (int)(it >> 10), e = (int)tile_e[row >> 8];
        if (F.ROW_TOK[row] < 0) { F.ACT[(size_t)row * D + j] = 0; continue; }
        const float* W = F.w_gate_up + (size_t)e * D * 2048; float g = 0.f, u = 0.f;
        for (int k = 0; k < D; ++k) { const float a = bf2f(F.XS[(size_t)row * D + k]); g += a * bf2f(f2bf(W[(size_t)k * 2048 + 2 * j])); u += a * bf2f(f2bf(W[(size_t)k * 2048 + 2 * j + 1])); }
        g += F.b_gate_up[e * 2048 + 2 * j]; u += F.b_gate_up[e * 2048 + 2 * j + 1];
        const float gg = fminf(g, 7.0f), uu = fminf(fmaxf(u, -7.0f), 7.0f);
        F.ACT[(size_t)row * D + j] = (bf16)f2bf((uu + 1.0f) * gg / (1.0f + __expf(-1.702f * gg)));
    }
}
__device__ __forceinline__ void naive_p9(Frame& F, int ntiles) {
    const long gthreads = (long)F.G * NTHREADS, gtid = (long)blockIdx.x * NTHREADS + F.tid;
    const unsigned* tile_e = F.ctl + CW_TILEE;
    for (long it = gtid; it < (long)ntiles * 256 * D; it += gthreads) {
        const int c = (int)(it & 1023), row = (int)(it >> 10), e = (int)tile_e[row >> 8], tk = F.ROW_TOK[row];
        if (tk < 0) continue;
        const float* W = F.w_down + (size_t)e * D * D; float y = 0.f;
        for (int k = 0; k < D; ++k) y += bf2f(F.ACT[(size_t)row * D + k]) * bf2f(f2bf(W[(size_t)k * D + c]));
        F.YBUF[(size_t)tk * D + c] = (bf16)f2bf((y + F.b_down[e * D + c]) * F.ROW_W[row]);
    }
}

__device__ __forceinline__ void p3_post_mixer(Frame& F) {
    for (int row = F.gw; row < T; row += F.NGW) {
        { const int h = F.lane >> 4; float l0 = F.LSE[((size_t)0 * T + row) * 4 + h], l1 = F.LSE[((size_t)1 * T + row) * 4 + h], l2 = F.LSE[((size_t)2 * T + row) * 4 + h];
          const float mx = fmaxf(l0, fmaxf(l1, l2)); float w0 = exp2f(l0 - mx), w1 = exp2f(l1 - mx), w2 = exp2f(l2 - mx); const float inv = 1.0f / (w0 + w1 + w2); w0 *= inv; w1 *= inv; w2 *= inv;
          const u32x4 a = *(const u32x4*)(F.OG + ((size_t)0 * T + row) * 512 + 8 * F.lane), b = *(const u32x4*)(F.OG + ((size_t)1 * T + row) * 512 + 8 * F.lane), c = *(const u32x4*)(F.OG + ((size_t)2 * T + row) * 512 + 8 * F.lane);
          f32x4 a0, a1, b0, b1, c0, c1; pg8::unpack8(a, a0, a1); pg8::unpack8(b, b0, b1); pg8::unpack8(c, c0, c1);
          const f32x4 o0 = a0 * w0 + b0 * w1 + c0 * w2, o1 = a1 * w0 + b1 * w1 + c1 * w2;
          u32x4 w; w.x = pk2(o0[0], o0[1]); w.y = pk2(o0[2], o0[3]); w.z = pk2(o1[0], o1[1]); w.w = pk2(o1[2], o1[3]);
          *(u32x4*)(F.AM + (size_t)row * AMLD + 8 * F.lane) = w; }
        { f32x4 v[4]; float s = 0.f;
#if FAST_MLSTM
          { const bf16* hp = (const bf16*)F.HT + (size_t)row * D + 16 * F.lane; const u32x4 w0 = *(const u32x4*)hp, w1 = *(const u32x4*)(hp + 8); pg8::unpack8(w0, v[0], v[1]); pg8::unpack8(w1, v[2], v[3]); }
#else
          { const float* hp = F.HT + (size_t)row * D + 16 * F.lane;
#pragma unroll
            for (int j = 0; j < 4; ++j) v[j] = *(const f32x4*)(hp + 4 * j); }
#endif
#pragma unroll
          for (int j = 0; j < 4; ++j) s += (v[j].x + v[j].y) + (v[j].z + v[j].w);
          s += __shfl_xor(s, 1); s += __shfl_xor(s, 2); s += __shfl_xor(s, 4); s += __shfl_xor(s, 8);
          const float mu = s * (1.0f / 256.0f); float q = 0.f;
#pragma unroll
          for (int j = 0; j < 4; ++j) { v[j] = v[j] - mu; q += (v[j].x * v[j].x + v[j].y * v[j].y) + (v[j].z * v[j].z + v[j].w * v[j].w); }
          q += __shfl_xor(q, 1); q += __shfl_xor(q, 2); q += __shfl_xor(q, 4); q += __shfl_xor(q, 8);
          const float rstd = 1.0f / sqrtf(q * (1.0f / 256.0f) + LN_EPS);
          const bf16* mo = F.PROJ + (size_t)row * NP + C_MO + 16 * F.lane; bf16* op = F.AM + (size_t)row * AMLD + 512 + 16 * F.lane;
#pragma unroll
          for (int jj = 0; jj < 2; ++jj) { const u32x4 mw = *(const u32x4*)(mo + 8 * jj); f32x4 m0, m1; pg8::unpack8(mw, m0, m1);
              const f32x4 g0 = *(const f32x4*)(F.g_mnorm + 16 * F.lane + 8 * jj), g1 = *(const f32x4*)(F.g_mnorm + 16 * F.lane + 8 * jj + 4);
              const f32x4 o0 = v[2 * jj] * rstd * g0 * pg8::sig4(m0), o1 = v[2 * jj + 1] * rstd * g1 * pg8::sig4(m1);
              u32x4 w; w.x = pk2(o0[0], o0[1]); w.y = pk2(o0[2], o0[3]); w.z = pk2(o1[0], o1[1]); w.w = pk2(o1[2], o1[3]);
              *(u32x4*)(op + 8 * jj) = w; } }
    }
}

constexpr int RT_WS = 1028;
constexpr int RT_TAB = NE * RT_WS * 4, RT_CNT = RT_TAB + 64 * 4 * 12;
static_assert(RT_CNT + 256 <= LDSCTL_OFF, "router LDS map");
__device__ __forceinline__ void p6_router(Frame& F) {
    LAS float* wt = (LAS float*)F.lds;
    LAS int* tab = (LAS int*)(F.lds + RT_TAB); LAS int* cntl = (LAS int*)(F.lds + RT_CNT); LAS int* basel = cntl + 32;
    const int lane = F.lane;
    for (int r0 = 0; r0 < T; r0 += F.NGW * 8) {
        __syncthreads();
        if (r0 == 0) for (int i = F.tid; i < D * NE; i += NTHREADS) wt[(i & 31) * RT_WS + (i >> 5)] = F.w_router[i];
        if (F.tid < 32) cntl[F.tid] = 0;
        __syncthreads();
        f32x4 vn[4];
        { const int row = r0 + F.gw; if (row < T) { const f32x4* hr = (const f32x4*)(F.H + (size_t)row * D) + lane;
#pragma unroll
            for (int j = 0; j < 4; ++j) vn[j] = hr[64 * j]; } }
        for (int ri = 0; ri < 8; ++ri) {
            const int row = r0 + ri * F.NGW + F.gw; if (row >= T) break;
            f32x4 v[4]; float s = 0.f;
#pragma unroll
            for (int j = 0; j < 4; ++j) { v[j] = vn[j]; s += (v[j].x * v[j].x + v[j].y * v[j].y) + (v[j].z * v[j].z + v[j].w * v[j].w); }
            { const int rown = row + F.NGW; if (ri + 1 < 8 && rown < T) { const f32x4* hr = (const f32x4*)(F.H + (size_t)rown * D) + lane;
#pragma unroll
                for (int j = 0; j < 4; ++j) vn[j] = hr[64 * j]; } }
            const float rstd = 1.0f / sqrtf(wave_sum(s) * (1.0f / D) + RMS_EPS);
            unsigned long long* o8 = (unsigned long long*)(F.XN + (size_t)row * D) + lane;
#pragma unroll
            for (int j = 0; j < 4; ++j) { const f32x4 g = *((const f32x4*)F.g_ffn + lane + 64 * j); v[j] = v[j] * rstd * g;
#if MOE_FP8
                ((unsigned*)((unsigned char*)F.XN + (size_t)row * D))[lane + 64 * j] = pk4_fp8(v[j].x, v[j].y, v[j].z, v[j].w); }
#else
                o8[64 * j] = (unsigned long long)pk2(v[j].x, v[j].y) | ((unsigned long long)pk2(v[j].z, v[j].w) << 32); }
#endif
            float lg[32];
#pragma unroll
            for (int e = 0; e < 32; ++e) { float a = 0.f;
#pragma unroll
                for (int j = 0; j < 4; ++j) { const f32x4 w = *((const LAS f32x4*)(wt + e * RT_WS) + lane + 64 * j); a += (v[j].x * w.x + v[j].y * w.y) + (v[j].z * w.z + v[j].w * w.w); }
                lg[e] = a; if ((e & 3) == 3) asm volatile("" ::: "memory"); }
#define RT_BF(N_, O_) do { const bool up = (lane & (O_)) != 0; _Pragma("unroll") for (int i = 0; i < (N_); ++i) { const float send = up ? lg[i] : lg[i + (N_)]; const float keep = up ? lg[i + (N_)] : lg[i]; lg[i] = keep + __shfl_xor(send, (O_)); } } while (0)
            RT_BF(16, 32); RT_BF(8, 16); RT_BF(4, 8); RT_BF(2, 4); RT_BF(1, 2);
#undef RT_BF
            float lgt = lg[0] + __shfl_xor(lg[0], 1);
            const int e = (lane >> 1) & 31;
            lgt += F.b_router[e];
            float tv[4]; int ti[4]; float cur = lgt;
#pragma unroll
            for (int r = 0; r < 4; ++r) { float bv = cur; int bi = e;
#pragma unroll
                for (int o = 2; o < 64; o <<= 1) { const float ov = __shfl_xor(bv, o); const int oi = __shfl_xor(bi, o); if (ov > bv || (ov == bv && oi < bi)) { bv = ov; bi = oi; } }
                tv[r] = bv; ti[r] = bi; if (e == bi) cur = -INFINITY; }
            const float e1 = __expf(tv[1] - tv[0]), e2 = __expf(tv[2] - tv[0]), e3 = __expf(tv[3] - tv[0]), inv = 1.0f / (1.0f + e1 + e2 + e3);
            if (lane < 4) {
                const int ee = (lane == 0) ? ti[0] : (lane == 1) ? ti[1] : (lane == 2) ? ti[2] : ti[3];
                const float ww = ((lane == 0) ? 1.0f : (lane == 1) ? e1 : (lane == 2) ? e2 : e3) * inv;
                const int loc = __hip_atomic_fetch_add(cntl + ee, 1, __ATOMIC_RELAXED, __HIP_MEMORY_SCOPE_WORKGROUP);
                LAS int* tp = tab + ((ri * 8 + F.wave) * 4 + lane) * 3; tp[0] = ee; tp[1] = loc; tp[2] = __float_as_int(ww);
            }
        }
        __syncthreads();
        if (F.tid < 32) basel[F.tid] = (int)atomicAdd(F.ctl + CW_CNT + 64 * F.tid, (unsigned)cntl[F.tid]);
        __syncthreads();
        if (lane < 4) for (int ri = 0; ri < 8; ++ri) {
            const int row = r0 + ri * F.NGW + F.gw; if (row >= T) break;
            const LAS int* tp = tab + ((ri * 8 + F.wave) * 4 + lane) * 3; const int ee = tp[0];
            F.TOK_E[row * 4 + lane] = ee; F.TOK_SLOT[row * 4 + lane] = basel[ee] + tp[1]; F.TOK_W[row * 4 + lane] = __int_as_float(tp[2]);
        }
    }
}

constexpr int RM_WS = 2064;
constexpr int RM_HI = 0, RM_LO = NE * RM_WS, RM_RSTD = 2 * NE * RM_WS, RM_TAB = RM_RSTD + 256, RM_CNT = RM_TAB + 64 * 4 * 12;
static_assert(RM_CNT + 256 <= LDSCTL_OFF, "router LDS map");
__device__ __forceinline__ void p6_router_mfma(Frame& F) {
    LAS unsigned char* L = F.lds;
    LAS float* rstdl = (LAS float*)(L + RM_RSTD); LAS int* tab = (LAS int*)(L + RM_TAB); LAS int* cntl = (LAS int*)(L + RM_CNT); LAS int* basel = cntl + 32;
    const int lane = F.lane, fr = lane & 15, fq = lane >> 4, w = F.wave;
    __syncthreads();
    for (int i0 = F.tid; i0 < D * NE; i0 += 16 * NTHREADS) {
        float wv[16], gv[16];
#pragma unroll
        for (int j = 0; j < 16; ++j) { const int i = i0 + j * NTHREADS; wv[j] = F.w_router[i]; gv[j] = F.g_ffn[i >> 5]; }
#pragma unroll
        for (int j = 0; j < 16; ++j) { const int i = i0 + j * NTHREADS, k = i >> 5, e = i & 31; const float w = wv[j] * gv[j];
            const unsigned hi = f2bf(w), lo = f2bf(w - bf2f(hi));
            *(LAS bf16*)(L + RM_HI + e * RM_WS + 2 * k) = (bf16)hi; *(LAS bf16*)(L + RM_LO + e * RM_WS + 2 * k) = (bf16)lo; } }
    const float br0 = F.b_router[fr], br1 = F.b_router[16 + fr];
    for (int rg = F.vcu; rg < T / 64; rg += F.G) {
        __syncthreads();
        if (F.tid < 32) cntl[F.tid] = 0;
        __syncthreads();
        if (w < 4) {
            const int row0 = rg * 64 + 16 * w;
            const float* hp = F.H + (size_t)(row0 + fr) * D + 8 * fq;
            const LAS unsigned char* bh = L + RM_HI + fr * RM_WS + 16 * fq; const LAS unsigned char* bl = L + RM_LO + fr * RM_WS + 16 * fq;
            f32x4 acc[2] = {(f32x4){0.f, 0.f, 0.f, 0.f}, (f32x4){0.f, 0.f, 0.f, 0.f}}; float ss = 0.f;
#pragma unroll 4
            for (int ks = 0; ks < 32; ++ks) {
                const f32x4 a0 = *(const f32x4*)(hp + 32 * ks), a1 = *(const f32x4*)(hp + 32 * ks + 4);
                ss += (a0.x * a0.x + a0.y * a0.y) + (a0.z * a0.z + a0.w * a0.w) + (a1.x * a1.x + a1.y * a1.y) + (a1.z * a1.z + a1.w * a1.w);
                u32x4 hw; hw.x = pk2(a0.x, a0.y); hw.y = pk2(a0.z, a0.w); hw.z = pk2(a1.x, a1.y); hw.w = pk2(a1.z, a1.w);
                u32x4 lw; lw.x = pk2(a0.x - bflo(hw.x), a0.y - bfhi(hw.x)); lw.y = pk2(a0.z - bflo(hw.y), a0.w - bfhi(hw.y));
                lw.z = pk2(a1.x - bflo(hw.z), a1.y - bfhi(hw.z)); lw.w = pk2(a1.z - bflo(hw.w), a1.w - bfhi(hw.w));
                const bf16x8 ahi = __builtin_bit_cast(bf16x8, hw), alo = __builtin_bit_cast(bf16x8, lw);
#pragma unroll
                for (int nt = 0; nt < 2; ++nt) { const bf16x8 bhi = *(const LAS bf16x8*)(bh + 16 * nt * RM_WS + 64 * ks), blo = *(const LAS bf16x8*)(bl + 16 * nt * RM_WS + 64 * ks);
                    acc[nt] = __builtin_amdgcn_mfma_f32_16x16x32_bf16(ahi, bhi, acc[nt], 0, 0, 0);
                    acc[nt] = __builtin_amdgcn_mfma_f32_16x16x32_bf16(ahi, blo, acc[nt], 0, 0, 0);
                    acc[nt] = __builtin_amdgcn_mfma_f32_16x16x32_bf16(alo, bhi, acc[nt], 0, 0, 0); }
            }
            ss += __shfl_xor(ss, 16); ss += __shfl_xor(ss, 32);
            const float rstd = 1.0f / sqrtf(ss * (1.0f / D) + RMS_EPS);
            if (fq == 0) rstdl[16 * w + fr] = rstd;
#pragma unroll
            for (int reg = 0; reg < 4; ++reg) {
                const float rs = __shfl(rstd, 4 * fq + reg);
                float c0 = acc[0][reg] * rs + br0, c1 = acc[1][reg] * rs + br1;
                float tv[4]; int ti[4];
#pragma unroll
                for (int r = 0; r < 4; ++r) { float bv = (c0 >= c1) ? c0 : c1; int bi = (c0 >= c1) ? fr : 16 + fr;
#pragma unroll
                    for (int o = 1; o < 16; o <<= 1) { const float ov = __shfl_xor(bv, o); const int oi = __shfl_xor(bi, o); if (ov > bv || (ov == bv && oi < bi)) { bv = ov; bi = oi; } }
                    tv[r] = bv; ti[r] = bi; if (bi == fr) c0 = -INFINITY; if (bi == 16 + fr) c1 = -INFINITY; }
                const float e1 = __expf(tv[1] - tv[0]), e2 = __expf(tv[2] - tv[0]), e3 = __expf(tv[3] - tv[0]), inv = 1.0f / (1.0f + e1 + e2 + e3);
                if (fr < 4) {
                    const int ee = (fr == 0) ? ti[0] : (fr == 1) ? ti[1] : (fr == 2) ? ti[2] : ti[3];
                    const float ww = ((fr == 0) ? 1.0f : (fr == 1) ? e1 : (fr == 2) ? e2 : e3) * inv;
                    const int loc = __hip_atomic_fetch_add(cntl + ee, 1, __ATOMIC_RELAXED, __HIP_MEMORY_SCOPE_WORKGROUP);
                    LAS int* tp = tab + ((16 * w + 4 * fq + reg) * 4 + fr) * 3; tp[0] = ee; tp[1] = loc; tp[2] = __float_as_int(ww);
                }
            }
        }
        __syncthreads();
        if (F.tid < 32) basel[F.tid] = (int)atomicAdd(F.ctl + CW_CNT + 64 * F.tid, (unsigned)cntl[F.tid]);
#pragma unroll 2
        for (int i = 0; i < 8; ++i) { const int rl = 8 * w + i, row = rg * 64 + rl; const float rs = rstdl[rl];
            const f32x4* hr = (const f32x4*)(F.H + (size_t)row * D) + lane;
#pragma unroll
            for (int j = 0; j < 4; ++j) { const f32x4 g = *((const f32x4*)F.g_ffn + lane + 64 * j); const f32x4 v = hr[64 * j] * rs * g;
                ((unsigned*)((unsigned char*)F.XN + (size_t)row * D))[lane + 64 * j] = pk4_fp8(v.x, v.y, v.z, v.w); } }
        __syncthreads();
        if (F.tid < 256) { const int rl = F.tid >> 2, k = F.tid & 3, row = rg * 64 + rl; const LAS int* tp = tab + (rl * 4 + k) * 3; const int ee = tp[0];
            F.TOK_E[row * 4 + k] = ee; F.TOK_SLOT[row * 4 + k] = basel[ee] + tp[1]; F.TOK_W[row * 4 + k] = __int_as_float(tp[2]); }
    }
}

__device__ __forceinline__ void p7_gather(Frame& F) {
    LAS int* pst = (LAS int*)F.lds;
    LAS int* cntl = pst + 64;
    __syncthreads();
    if (F.tid < NE) cntl[F.tid] = (int)F.ctl[CW_CNT + 64 * F.tid];
    __syncthreads();
    if (F.tid == 0) { int acc = 0; for (int e = 0; e < NE; ++e) { pst[e] = acc; acc += (cntl[e] + 255) & ~255; } pst[NE] = acc; }
    __syncthreads();
    if (blockIdx.x == 0) {
        if (F.tid == 0) F.ctl[CW_NTILES] = (unsigned)(pst[NE] >> 8);
        if (F.tid < NE) { const int t0 = pst[F.tid] >> 8, t1 = pst[F.tid + 1] >> 8; for (int k = t0; k < t1; ++k) F.ctl[CW_TILEE + k] = (unsigned)F.tid; }
        if (F.tid <= NE) F.ctl[CW_TSTART + F.tid] = (unsigned)(pst[F.tid] >> 8);
    }
#if MOE_FP8
    { const int gthreads = F.G * NTHREADS, gtid = F.vcu * NTHREADS + F.tid;
      for (int a = gtid; a < NA; a += gthreads) { const int e = F.TOK_E[a], dest = pst[e] + F.TOK_SLOT[a]; F.ROW_TOK[dest] = a; F.ROW_W[dest] = F.TOK_W[a]; }
      for (int e = 0; e < NE; ++e) { const int c = cntl[e], pe = (c + 255) & ~255;
          for (int r = c + gtid; r < pe; r += gthreads) { F.ROW_TOK[pst[e] + r] = -1; F.ROW_W[pst[e] + r] = 0.f; } } }
#else
    for (int a = F.gw; a < NA; a += F.NGW) {
        const int e = F.TOK_E[a], dest = pst[e] + F.TOK_SLOT[a];
        { const u32x4* src = (const u32x4*)(F.XN + (size_t)(a >> 2) * D) + F.lane; u32x4* dst = (u32x4*)(F.XS + (size_t)dest * D) + F.lane;
        const u32x4 v0 = src[0], v1 = src[64]; dst[0] = v0; dst[64] = v1; }
        if (F.lane == 0) { F.ROW_TOK[dest] = a; F.ROW_W[dest] = F.TOK_W[a]; }
    }
    for (int e = 0; e < NE; ++e) { const int c = cntl[e], pe = (c + 255) & ~255;
        for (int r = c + F.gw; r < pe; r += F.NGW) { const int dest = pst[e] + r; const u32x4 z = (u32x4){0u, 0u, 0u, 0u};
            { u32x4* dst = (u32x4*)(F.XS + (size_t)dest * D) + F.lane; dst[0] = z; dst[64] = z; }
            if (F.lane == 0) { F.ROW_TOK[dest] = -1; F.ROW_W[dest] = 0.f; } } }
#endif
}

__device__ __forceinline__ void p10_final(Frame& F) {
    f32x4 hn[4]; u32x2 yn[4][4];
#define P10_LOAD(r_) do { const f32x4* hr_ = (const f32x4*)(F.H + (size_t)(r_) * D) + F.lane; \
        _Pragma("unroll") for (int j = 0; j < 4; ++j) { hn[j] = hr_[64 * j]; _Pragma("unroll") for (int k = 0; k < 4; ++k) yn[j][k] = *((const u32x2*)(F.YBUF + ((size_t)(r_) * 4 + k) * D) + F.lane + 64 * j); } } while (0)
    if (F.gw < T) P10_LOAD(F.gw);
    for (int row = F.gw; row < T; row += F.NGW) {
        f32x4 v[4]; float s = 0.f;
#pragma unroll
        for (int j = 0; j < 4; ++j) { v[j] = hn[j];
#pragma unroll
            for (int k = 0; k < 4; ++k) { const u32x2 w = yn[j][k]; v[j].x += bflo(w.x); v[j].y += bfhi(w.x); v[j].z += bflo(w.y); v[j].w += bfhi(w.y); }
            s += (v[j].x * v[j].x + v[j].y * v[j].y) + (v[j].z * v[j].z + v[j].w * v[j].w); }
        if (row + F.NGW < T) P10_LOAD(row + F.NGW);
        const float rstd = 1.0f / sqrtf(wave_sum(s) * (1.0f / D) + RMS_EPS);
        f32x4* orow = (f32x4*)(F.out + (size_t)row * D) + F.lane;
#pragma unroll
        for (int j = 0; j < 4; ++j) { const f32x4 g = *((const f32x4*)F.g_final + F.lane + 64 * j); orow[64 * j] = v[j] * rstd * g; }
    }
#undef P10_LOAD
}

typedef float f32x16 __attribute__((ext_vector_type(16)));
typedef short s16x4 __attribute__((ext_vector_type(4)));
constexpr int ATT_SCR_OFF = RING_BYTES;
__device__ __forceinline__ int crow16(int r, int hi) { return (r & 3) + 8 * (r >> 2) + 4 * hi; }
__device__ __forceinline__ s16x4 lds_tr16(const LAS unsigned char* p) { return __builtin_bit_cast(s16x4, __builtin_amdgcn_ds_read_tr16_b64_v4i16((LAS s16x4*)p)); }

struct AttItem { int b, g, hd, r, n, d; };
__device__ __forceinline__ AttItem att_decode(int it) {
    AttItem a; const int i = it >> 8, c = it & 255; a.g = i % 3; const int idx = (i / 3) * 256 + c, rn = idx & 15; a.b = idx >> 6; a.hd = (idx >> 4) & 3;
    a.r = (a.g == 0) ? 0 : (a.g == 1) ? (rn >> 2) : rn; a.n = (a.g == 0) ? rn : (a.g == 1) ? (rn & 3) : 0; a.d = (a.g == 0) ? 1 : (a.g == 1) ? 4 : 16; return a;
}
__device__ __forceinline__ const bf16* att_base(Frame& F, const AttItem& a) { return F.PROJ + (size_t)(a.b * SEQ + a.r) * NP + a.g * 512 + a.hd * 128; }
#define ATT_LOADKV(dst, a_, coff_) do { const bf16* base_ = att_base(F, a_) + (coff_) + 8 * (F.tid & 15); const size_t rs_ = (size_t)(a_).d * NP; const int i0_ = 128 * ((a_).n - 1) + (F.tid >> 4); \
        _Pragma("unroll") for (int p_ = 0; p_ < 8; ++p_) { if ((a_).n == 0 && p_ < 4) continue; dst[p_] = *(const u32x4*)(base_ + (size_t)(i0_ + 32 * p_) * rs_); } } while (0)

__device__ __forceinline__ void attn_phase(Frame& F) {
    const int lane = F.lane, w = F.wave, fr = lane & 15, fq = lane >> 4;
    LAS unsigned char* Ks = F.lds; LAS unsigned char* Vs = F.lds + 65536;
    const int kc = F.tid & 15, kk0 = F.tid >> 4;
    u32x4 kreg[8], vreg[8]; bf16x8 qn[4];
#define ATT_LOADQ(dst, a_) do { const bf16* qrow_ = att_base(F, a_) + (size_t)(128 * (a_).n + 16 * w + fr) * ((size_t)(a_).d * NP) + C_AQ + 8 * fq; \
        _Pragma("unroll") for (int s_ = 0; s_ < 4; ++s_) dst[s_] = *(const bf16x8*)(qrow_ + 32 * s_); } while (0)
    int it = F.vcu;
    if (it < 1536) { const AttItem a0 = att_decode(it); ATT_LOADKV(kreg, a0, C_AK); ATT_LOADKV(vreg, a0, C_AV); ATT_LOADQ(qn, a0); }
    for (; it < 1536; it += F.G) {
        const AttItem a = att_decode(it); const int n = a.n, d = a.d;
        __syncthreads();
#pragma unroll
        for (int pass = 0; pass < 8; ++pass) { if (n == 0 && pass < 4) continue; const int key = pass * 32 + kk0;
            *(LAS u32x4*)(Ks + key * 256 + ((kc ^ (key & 15)) << 4)) = kreg[pass];
            *(LAS u32x4*)(Vs + key * 256 + ((((kc >> 2) ^ (key & 3)) << 6) | ((kc & 3) << 4))) = vreg[pass]; }
        bf16x8 qf[4];
#pragma unroll
        for (int s = 0; s < 4; ++s) qf[s] = qn[s];
        __syncthreads();
        f32x4 S[10];
#pragma unroll
        for (int i = 0; i < 9; ++i) {
            const int kt = w + i; const bool act = !(n == 0 && kt < 8);
            f32x4 acc = (f32x4){0.f, 0.f, 0.f, 0.f};
            if (act) {
                const LAS unsigned char* kp = Ks + (kt * 16 + fr) * 256;
#pragma unroll
                for (int s = 0; s < 4; ++s) { const bf16x8 kf = *(const LAS bf16x8*)(kp + (((4 * s + fq) ^ fr) << 4)); acc = __builtin_amdgcn_mfma_f32_16x16x32_bf16(kf, qf[s], acc, 0, 0, 0); }
                if (i == 0) {
#pragma unroll
                    for (int r = 0; r < 4; ++r) if (4 * fq + r < fr) acc[r] = -INFINITY; }
                if (i == 8) {
#pragma unroll
                    for (int r = 0; r < 4; ++r) if (4 * fq + r > fr) acc[r] = -INFINITY; }
            } else acc = (f32x4){-INFINITY, -INFINITY, -INFINITY, -INFINITY};
            S[i] = acc;
        }
        float m = -INFINITY;
#pragma unroll
        for (int i = 0; i < 9; ++i)
#pragma unroll
            for (int r = 0; r < 4; ++r) m = fmaxf(m, S[i][r]);
        m = fmaxf(m, __shfl_xor(m, 16)); m = fmaxf(m, __shfl_xor(m, 32));
        float l = 0.f;
#pragma unroll
        for (int i = 0; i < 9; ++i)
#pragma unroll
            for (int r = 0; r < 4; ++r) { const float p = __builtin_amdgcn_exp2f(S[i][r] - m); S[i][r] = p; l += p; }
        l += __shfl_xor(l, 16); l += __shfl_xor(l, 32);
        S[9] = (f32x4){0.f, 0.f, 0.f, 0.f};
        if (it + F.G < 1536) { const AttItem an = att_decode(it + F.G); ATT_LOADKV(kreg, an, C_AK); ATT_LOADKV(vreg, an, C_AV); ATT_LOADQ(qn, an); }
        f32x4 O[8];
#pragma unroll
        for (int t = 0; t < 8; ++t) O[t] = (f32x4){0.f, 0.f, 0.f, 0.f};
        const int q4 = fr >> 2, p4 = lane & 3;
#pragma unroll
        for (int p = 0; p < 5; ++p) {
            const int kt0 = w + 2 * p, kt1 = kt0 + 1;
            const bool act0 = !(n == 0 && kt0 < 8), act1 = (2 * p + 1 < 9) && !(n == 0 && kt1 < 8);
            if (act0 || act1) {
                u32x4 pw; pw.x = pg8::cvt_pk_bf16(S[2 * p][0], S[2 * p][1]); pw.y = pg8::cvt_pk_bf16(S[2 * p][2], S[2 * p][3]);
                pw.z = pg8::cvt_pk_bf16(S[2 * p + 1][0], S[2 * p + 1][1]); pw.w = pg8::cvt_pk_bf16(S[2 * p + 1][2], S[2 * p + 1][3]);
                const bf16x8 pa = __builtin_bit_cast(bf16x8, pw);
                const int key0 = kt0 * 16 + 4 * fq + q4, key1 = kt1 * 16 + 4 * fq + q4;
#pragma unroll
                for (int t = 0; t < 8; ++t) {
                    const int col = 16 * t + 4 * p4;
                    const int coff = ((((col >> 5) ^ q4) << 6) | ((col & 31) << 1));
                    s16x4 lo = (s16x4){0, 0, 0, 0}, hi = (s16x4){0, 0, 0, 0};
                    if (act0) lo = lds_tr16(Vs + key0 * 256 + coff);
                    if (act1) hi = lds_tr16(Vs + key1 * 256 + coff);
                    const bf16x8 vb = (bf16x8){lo[0], lo[1], lo[2], lo[3], hi[0], hi[1], hi[2], hi[3]};
                    O[t] = __builtin_amdgcn_mfma_f32_16x16x32_bf16(pa, vb, O[t], 0, 0, 0);
                }
            }
        }
        const float linv = frcp(l);
        const size_t tok0 = (size_t)a.b * SEQ + a.r + (size_t)d * (128 * n + 16 * w);
        if (fq == 0) F.LSE[((size_t)a.g * T + tok0 + (size_t)d * fr) * 4 + a.hd] = m + __log2f(l);
#pragma unroll
        for (int r = 0; r < 4; ++r) {
            const int q = 4 * fq + r; const float rl = __shfl(linv, q);
            bf16* op = F.OG + ((size_t)a.g * T + tok0 + (size_t)d * q) * 512 + a.hd * 128 + fr;
#pragma unroll
            for (int t = 0; t < 8; ++t) op[16 * t] = (bf16)f2bf(O[t][r] * rl);
        }
    }
    __syncthreads();
}
#undef ATT_LOADKV
#undef ATT_LOADQ

constexpr int ML_QS = 528, ML_AS = 144;
constexpr int ML_Q = 0, ML_K = 33792;
constexpr int SC_U = 0, SC_MX = 64, SC_EBD = 128, SC_WI = 192, SC_WK = 256, SC_DEC = 320;
__device__ __forceinline__ f32x4 mfma16(bf16x8 a, bf16x8 b, f32x4 c) { return __builtin_amdgcn_mfma_f32_16x16x32_bf16(a, b, c, 0, 0, 0); }


constexpr size_t WS_QK = WS_QC, WS_SCAL = WS_KC;
__device__ __forceinline__ void mlstm_prepass(Frame& F) {
    const int tid = F.tid, lane = F.lane;
    float* SCAL = (float*)((unsigned char*)F.ctl + WS_SCAL);
    bf16* QK = (bf16*)((unsigned char*)F.ctl + WS_QK);
    if (F.vcu < 32) {
        const int b = F.vcu >> 2, h = F.vcu & 3; const float* gbase = F.GATES + (size_t)(b * SEQ) * 8;
        LAS float* lu = (LAS float*)F.lds; LAS float* lpm = lu + 2048; LAS float* lbc = lpm + 2048; LAS float* lm = lbc + 2048;
        __syncthreads();
#pragma unroll
        for (int i = 0; i < 4; ++i) { const int c = 4 * F.wave + i;
            const float gi = gbase[(size_t)(64 * c + lane) * 8 + h], gf = gbase[(size_t)(64 * c + lane) * 8 + 4 + h];
            const float logf = fminf(gf, 0.f) - __logf(1.0f + __expf(-fabsf(gf)));
            float bc = logf;
#pragma unroll
            for (int o = 1; o < 64; o <<= 1) { const float v = __shfl_up(bc, o); if (lane >= o) bc += v; }
            const float u = gi - bc; float pm = u;
#pragma unroll
            for (int o = 1; o < 64; o <<= 1) { const float v = __shfl_up(pm, o); if (lane >= o) pm = fmaxf(pm, v); }
            lu[64 * c + lane] = u; lpm[64 * c + lane] = pm; lbc[64 * c + lane] = bc; }
        __syncthreads();
        if (tid == 0) { float m = 0.f; for (int c = 0; c < 32; ++c) { const float M63 = fmaxf(m, lpm[64 * c + 63]); lm[c] = m; lm[32 + c] = M63; m = lbc[64 * c + 63] + M63; } }
        __syncthreads();
#pragma unroll
        for (int i = 0; i < 4; ++i) { const int c = 4 * F.wave + i; const float m_carry = lm[c], M63 = lm[32 + c];
            const float u = lu[64 * c + lane], bc = lbc[64 * c + lane], Mx = fmaxf(m_carry, lpm[64 * c + lane]);
            float* sp = SCAL + ((size_t)F.vcu * 32 + c) * 384;
            sp[SC_U + lane] = u; sp[SC_MX + lane] = Mx; sp[SC_EBD + lane] = __expf(-(bc + Mx)); sp[SC_WI + lane] = __expf(m_carry - Mx); sp[SC_WK + lane] = __expf(u - M63);
            sp[SC_DEC + lane] = __expf(m_carry - M63); }
        __syncthreads();
    }
    const int rb = tid >> 8, half = (tid >> 7) & 1, cg = tid & 127;
    float cw[4][8];
#pragma unroll
    for (int j = 0; j < 4; ++j) { const float* p = F.conv_qk + j * 2048 + half * 1024 + 8 * cg; const f32x4 a = *(const f32x4*)p, c = *(const f32x4*)(p + 4);
        cw[j][0] = a[0]; cw[j][1] = a[1]; cw[j][2] = a[2]; cw[j][3] = a[3]; cw[j][4] = c[0]; cw[j][5] = c[1]; cw[j][6] = c[2]; cw[j][7] = c[3]; }
    const float oscale = half ? 0.0625f : 1.0f;
    for (int step = F.vcu; step < T / 16; step += F.G) {
        const int row0 = step * 16 + rb * 8, ts0 = row0 & (SEQ - 1);
        const bf16* src = F.PROJ + (size_t)row0 * NP + (half ? C_MK : C_MQ) + 8 * cg;
        u32x4 raw[11];
#pragma unroll
        for (int r = 0; r < 11; ++r) raw[r] = (ts0 - 3 + r >= 0) ? *(const u32x4*)(src + (ptrdiff_t)(r - 3) * NP) : (u32x4){0u, 0u, 0u, 0u};
        bf16* dst = QK + (size_t)row0 * 2048 + half * 1024 + 8 * cg;
        float xf[11][8];
#pragma unroll
        for (int r = 0; r < 11; ++r) { const u32x4 rw = raw[r]; xf[r][0] = bflo(rw.x); xf[r][1] = bfhi(rw.x); xf[r][2] = bflo(rw.y); xf[r][3] = bfhi(rw.y); xf[r][4] = bflo(rw.z); xf[r][5] = bfhi(rw.z); xf[r][6] = bflo(rw.w); xf[r][7] = bfhi(rw.w); }
#pragma unroll
        for (int o = 0; o < 8; ++o) {
            float y[8];
#pragma unroll
            for (int i = 0; i < 8; ++i) y[i] = (cw[0][i] * xf[o][i] + cw[1][i] * xf[o + 1][i]) + (cw[2][i] * xf[o + 2][i] + cw[3][i] * xf[o + 3][i]);
#pragma unroll
            for (int i = 0; i < 8; ++i) y[i] = y[i] * oscale * frcp(1.0f + __expf(-y[i]));
            u32x4 pw; pw.x = pk2(y[0], y[1]); pw.y = pk2(y[2], y[3]); pw.z = pk2(y[4], y[5]); pw.w = pk2(y[6], y[7]);
            *(u32x4*)(dst + (size_t)o * 2048) = pw; }
    }
}

template <int NDT> struct MLMap {
    static constexpr int VROWS = 16 * (NDT + 1), CT = ML_K + 64 * ML_QS, A = CT + VROWS * ML_QS, VT = A + 64 * ML_AS, VWT = VT + VROWS * ML_AS, SC = VWT + VROWS * ML_AS, END = SC + 4 * 384;
    static_assert(END <= LDSCTL_OFF, "mLSTM LDS map");
};
template <int NDT>
__device__ __forceinline__ void mlstm_item(Frame& F, int b, int h, int sl) {
    typedef MLMap<NDT> MP; constexpr int VROWS = MP::VROWS, PARTS = 2 * NDT, NT2 = NDT / 2, NB5 = NDT + 1;
    const int tid = F.tid, lane = F.lane, w = F.wave, fr = lane & 15, fq = lane >> 4;
    LAS unsigned char* L = F.lds; LAS float* SC = (LAS float*)(L + MP::SC);
    const bf16* qkbase = (const bf16*)((const unsigned char*)F.ctl + WS_QK) + (size_t)(b * SEQ) * 2048 + h * 256 + 8 * (tid & 31);
#ifndef VMAP
#define VMAP 1
#endif
    const bool vact = tid < 64 * PARTS; const int vs = VMAP ? (tid & 63) : (tid / PARTS), vpart = VMAP ? (tid >> 6) : (tid % PARTS);
    const bf16* vbase = F.PROJ + (size_t)(b * SEQ) * NP + C_MV + h * 256 + sl * (16 * NDT) + 8 * vpart;
    const float* scbase = (const float*)((const unsigned char*)F.ctl + WS_SCAL) + (size_t)((b * 4 + h) * 32) * 384 + (tid < 384 ? tid : 0);
    const float* wkbase = (const float*)((const unsigned char*)F.ctl + WS_SCAL) + (size_t)((b * 4 + h) * 32) * 384 + SC_WK + vs;
    __syncthreads();
    for (int i = tid; i < (MP::A - MP::CT) / 4; i += NTHREADS) ((LAS unsigned*)(L + MP::CT))[i] = 0u;
    for (int i = tid; i < (MP::SC - MP::VT) / 4; i += NTHREADS) ((LAS unsigned*)(L + MP::VT))[i] = 0u;
    __syncthreads();
    if (tid < 32) ((LAS unsigned*)(L + MP::VT + (16 * NDT) * ML_AS))[tid] = 0x3F803F80u;
    f32x4 C[2][NB5];
#pragma unroll
    for (int a = 0; a < 2; ++a)
#pragma unroll
        for (int bb = 0; bb < NB5; ++bb) C[a][bb] = (f32x4){0.f, 0.f, 0.f, 0.f};
    u32x4 qk[8]; u32x4 vraw = (u32x4){0u, 0u, 0u, 0u}; float scv = 0.f, wkv = 0.f;
    unsigned hpk[NT2][2];
#define ML_ISSUE(c_) do { const int t0_ = 64 * (c_); \
        _Pragma("unroll") for (int i_ = 0; i_ < 4; ++i_) { const bf16* p_ = qkbase + (size_t)(t0_ + (tid >> 5) + 16 * i_) * 2048; qk[i_] = *(const u32x4*)p_; qk[4 + i_] = *(const u32x4*)(p_ + 1024); } \
        if (vact) { vraw = *(const u32x4*)(vbase + (size_t)(t0_ + vs) * NP); wkv = wkbase[(size_t)(c_) * 384]; } \
        if (tid < 384) scv = scbase[(size_t)(c_) * 384]; } while (0)
    ML_ISSUE(0);
    for (int c = 0; c < 32; ++c) {
        { LAS unsigned char* dq = L + ML_Q + (tid >> 5) * ML_QS + 16 * (tid & 31);
#pragma unroll
          for (int i = 0; i < 4; ++i) { *(LAS u32x4*)(dq + 16 * i * ML_QS) = qk[i]; *(LAS u32x4*)(dq + (ML_K - ML_Q) + 16 * i * ML_QS) = qk[4 + i]; } }
        if (vact) { LAS bf16* vt = (LAS bf16*)(L + MP::VT) + vs; LAS bf16* vw = (LAS bf16*)(L + MP::VWT) + vs;
            const float vf[8] = {bflo(vraw.x), bfhi(vraw.x), bflo(vraw.y), bfhi(vraw.y), bflo(vraw.z), bfhi(vraw.z), bflo(vraw.w), bfhi(vraw.w)};
            const unsigned vr[4] = {vraw.x, vraw.y, vraw.z, vraw.w};
#pragma unroll
            for (int i = 0; i < 4; ++i) { const unsigned pw = pk2(vf[2 * i] * wkv, vf[2 * i + 1] * wkv);
                vt[(8 * vpart + 2 * i) * (ML_AS / 2)] = (bf16)(vr[i] & 0xffffu); vt[(8 * vpart + 2 * i + 1) * (ML_AS / 2)] = (bf16)(vr[i] >> 16);
                vw[(8 * vpart + 2 * i) * (ML_AS / 2)] = (bf16)(pw & 0xffffu); vw[(8 * vpart + 2 * i + 1) * (ML_AS / 2)] = (bf16)(pw >> 16); } }
        if (tid >= 256 && tid < 320) ((LAS bf16*)(L + MP::VWT))[(16 * NDT) * (ML_AS / 2) + tid - 256] = (bf16)f2bf(scv);
        if (tid < 384) SC[tid] = scv;
        __syncthreads();
        if (c > 0) { bf16* hpp = (bf16*)F.HT + (size_t)(b * SEQ + 64 * (c - 1) + 16 * (w & 3) + 4 * fq) * D + h * 256 + sl * (16 * NDT) + 16 * ((w >> 2) * NT2) + fr;
#pragma unroll
            for (int j = 0; j < NT2; ++j) { hpp[16 * j] = (bf16)(hpk[j][0] & 0xffffu); hpp[(size_t)D + 16 * j] = (bf16)(hpk[j][0] >> 16); hpp[(size_t)2 * D + 16 * j] = (bf16)(hpk[j][1] & 0xffffu); hpp[(size_t)3 * D + 16 * j] = (bf16)(hpk[j][1] >> 16); } }
        if (c + 1 < 32) ML_ISSUE(c + 1);
        const int ti = w & 3;
#ifndef DUP_B
#define DUP_B 1
#endif
        for (int dupb = 0; dupb < DUP_B; ++dupb)
        { const int si0 = (w >> 2) * 2;
          const LAS unsigned char* qp = L + ML_Q + (16 * ti + fr) * ML_QS + 16 * fq;
          const LAS unsigned char* kp = L + ML_K + (16 * si0 + fr) * ML_QS + 16 * fq;
          f32x4 sacc[2] = {(f32x4){0.f, 0.f, 0.f, 0.f}, (f32x4){0.f, 0.f, 0.f, 0.f}};
#pragma unroll
          for (int hb = 0; hb < 2; ++hb) {
              bf16x8 qa[4], k0[4], k1[4];
#pragma unroll
              for (int kk = 0; kk < 4; ++kk) { qa[kk] = *(const LAS bf16x8*)(qp + 64 * (4 * hb + kk)); k0[kk] = *(const LAS bf16x8*)(kp + 64 * (4 * hb + kk)); k1[kk] = *(const LAS bf16x8*)(kp + 16 * ML_QS + 64 * (4 * hb + kk)); }
              __builtin_amdgcn_sched_barrier(0);
#pragma unroll
              for (int kk = 0; kk < 4; ++kk) { sacc[0] = mfma16(k0[kk], qa[kk], sacc[0]); sacc[1] = mfma16(k1[kk], qa[kk], sacc[1]); }
          }
          { const int t = 16 * ti + fr; const float mxt = SC[SC_MX + t];
#pragma unroll
            for (int si = 0; si < 2; ++si) { const int s0 = 16 * (si0 + si) + 4 * fq; const f32x4 us = *(const LAS f32x4*)(SC + SC_U + s0); float val[4];
#pragma unroll
                for (int r = 0; r < 4; ++r) val[r] = (s0 + r <= t) ? sacc[si][r] * __expf(us[r] - mxt) : 0.f;
                u32x2 pw; pw.x = pk2(val[0], val[1]); pw.y = pk2(val[2], val[3]);
                *(LAS u32x2*)(L + MP::A + t * ML_AS + 2 * s0) = pw; } } }
        __syncthreads();
        { const int dj0 = (w >> 2) * NT2;
          const LAS unsigned char* ap = L + MP::A + (16 * ti + fr) * ML_AS + 16 * fq;
          const LAS unsigned char* vp = L + MP::VT + (16 * dj0 + fr) * ML_AS + 16 * fq; const LAS unsigned char* ep = L + MP::VT + (16 * NDT + fr) * ML_AS + 16 * fq;
          const LAS unsigned char* cp = L + MP::CT + (16 * dj0 + fr) * ML_QS + 16 * fq; const LAS unsigned char* cep = L + MP::CT + (16 * NDT + fr) * ML_QS + 16 * fq;
          bf16x8 aa[2], vv[NT2][2], ee[2], afr[2][2], bw[2][NB5];
#pragma unroll
          for (int ks = 0; ks < 2; ++ks) { aa[ks] = *(const LAS bf16x8*)(ap + 64 * ks); ee[ks] = *(const LAS bf16x8*)(ep + 64 * ks);
#pragma unroll
              for (int j = 0; j < NT2; ++j) vv[j][ks] = *(const LAS bf16x8*)(vp + 16 * j * ML_AS + 64 * ks); }
          const int q4 = fr >> 2, p4 = lane & 3;
#pragma unroll
          for (int ks = 0; ks < 2; ++ks) {
#pragma unroll
              for (int a = 0; a < 2; ++a) { const LAS unsigned char* kp = L + ML_K + (32 * ks + 8 * fq + q4) * ML_QS + (16 * (2 * w + a) + 4 * p4) * 2;
                  const s16x4 lo = lds_tr16(kp), hi = lds_tr16(kp + 4 * ML_QS); afr[ks][a] = (bf16x8){lo[0], lo[1], lo[2], lo[3], hi[0], hi[1], hi[2], hi[3]}; }
#pragma unroll
              for (int bb = 0; bb < NB5; ++bb) bw[ks][bb] = *(const LAS bf16x8*)(L + MP::VWT + (16 * bb + fr) * ML_AS + 16 * fq + 64 * ks); }
          const float dec = SC[SC_DEC];
          f32x4 wi4, eb4;
#pragma unroll
          for (int r = 0; r < 4; ++r) { wi4[r] = SC[SC_WI + 16 * ti + 4 * fq + r]; eb4[r] = SC[SC_EBD + 16 * ti + 4 * fq + r]; }
          __builtin_amdgcn_sched_barrier(0);
          f32x4 av[NT2], av2[NT2], ae = (f32x4){0.f, 0.f, 0.f, 0.f}, ae2 = ae;
#pragma unroll
          for (int j = 0; j < NT2; ++j) { av[j] = (f32x4){0.f, 0.f, 0.f, 0.f}; av2[j] = av[j]; }
#pragma unroll
          for (int a = 0; a < 2; ++a)
#pragma unroll
              for (int bb = 0; bb < NB5; ++bb) C[a][bb] *= dec;
#pragma unroll
          for (int ks = 0; ks < 2; ++ks) { ae = mfma16(aa[ks], ee[ks], ae);
#pragma unroll
              for (int j = 0; j < NT2; ++j) av[j] = mfma16(aa[ks], vv[j][ks], av[j]); }
#pragma unroll
          for (int ks = 0; ks < 2; ++ks)
#pragma unroll
              for (int bb = 0; bb < NB5; ++bb) { C[0][bb] = mfma16(afr[ks][0], bw[ks][bb], C[0][bb]); C[1][bb] = mfma16(afr[ks][1], bw[ks][bb], C[1][bb]); }
          __builtin_amdgcn_sched_barrier(0);
          { const LAS unsigned char* qp = L + ML_Q + (16 * ti + fr) * ML_QS + 16 * fq;
#pragma unroll
            for (int hb = 0; hb < 2; ++hb) {
                bf16x8 qa[4], cc[NT2][4], ce[4];
#pragma unroll
                for (int kk = 0; kk < 4; ++kk) { qa[kk] = *(const LAS bf16x8*)(qp + 64 * (4 * hb + kk)); ce[kk] = *(const LAS bf16x8*)(cep + 64 * (4 * hb + kk));
#pragma unroll
                    for (int j = 0; j < NT2; ++j) cc[j][kk] = *(const LAS bf16x8*)(cp + 16 * j * ML_QS + 64 * (4 * hb + kk)); }
                __builtin_amdgcn_sched_barrier(0);
#pragma unroll
                for (int kk = 0; kk < 4; ++kk) { ae2 = mfma16(qa[kk], ce[kk], ae2);
#pragma unroll
                    for (int j = 0; j < NT2; ++j) av2[j] = mfma16(qa[kk], cc[j][kk], av2[j]); }
            } }
          float rd[4];
#pragma unroll
          for (int r = 0; r < 4; ++r) { float dn = ae[r] + wi4[r] * ae2[r]; dn = __shfl(dn, lane & 48); rd[r] = frcp(fmaxf(fabsf(dn), eb4[r])); }
#pragma unroll
          for (int j = 0; j < NT2; ++j) { hpk[j][0] = pk2((av[j][0] + wi4[0] * av2[j][0]) * rd[0], (av[j][1] + wi4[1] * av2[j][1]) * rd[1]);
              hpk[j][1] = pk2((av[j][2] + wi4[2] * av2[j][2]) * rd[2], (av[j][3] + wi4[3] * av2[j][3]) * rd[3]); } }
        __syncthreads();
#pragma unroll
        for (int a = 0; a < 2; ++a)
#pragma unroll
            for (int bb = 0; bb < NB5; ++bb) { u32x2 pw; pw.x = pk2(C[a][bb][0], C[a][bb][1]); pw.y = pk2(C[a][bb][2], C[a][bb][3]);
                *(LAS u32x2*)(L + MP::CT + (16 * bb + fr) * ML_QS + (16 * (2 * w + a) + 4 * fq) * 2) = pw; }
    }
#undef ML_ISSUE
    { bf16* hpp = (bf16*)F.HT + (size_t)(b * SEQ + 64 * 31 + 16 * (w & 3) + 4 * fq) * D + h * 256 + sl * (16 * NDT) + 16 * ((w >> 2) * NT2) + fr;
#pragma unroll
      for (int j = 0; j < NT2; ++j) { hpp[16 * j] = (bf16)(hpk[j][0] & 0xffffu); hpp[(size_t)D + 16 * j] = (bf16)(hpk[j][0] >> 16); hpp[(size_t)2 * D + 16 * j] = (bf16)(hpk[j][1] & 0xffffu); hpp[(size_t)3 * D + 16 * j] = (bf16)(hpk[j][1] >> 16); } }
    __syncthreads();
}

constexpr int CQ_TS = 144, CQ_SCR = 2 * 32 * CQ_TS;
struct CqItem { const float* W; unsigned char* WT; int Nsrc, c0, k0, row0, row1, rstep; };
__device__ __forceinline__ CqItem cq_decode(Frame& F, int r) {
    constexpr int I_GU1 = (D / 128) * (2048 / 64), I_DN1 = (D / 128) * (D / 64);
    CqItem it;
    if (r < NE * I_GU1) { const int e = r / I_GU1, q = r % I_GU1, kb = q / 32, cb = q % 32, j0 = 32 * cb;
        it.W = F.w_gate_up + (size_t)e * D * 2048; it.WT = (unsigned char*)F.WguT + (size_t)e * 2048 * D; it.Nsrc = 2048; it.c0 = 2 * j0; it.k0 = 128 * kb;
        it.row0 = (j0 >> 7) * 256 + (j0 & 127); it.row1 = it.row0 + 128; it.rstep = 1; }
    else { r -= NE * I_GU1; const int e = r / I_DN1, q = r % I_DN1, kb = q / 16, cb = q % 16;
        it.W = F.w_down + (size_t)e * D * D; it.WT = (unsigned char*)F.WdnT + (size_t)e * D * D; it.Nsrc = D; it.c0 = 64 * cb; it.k0 = 128 * kb;
        it.row0 = 64 * cb; it.row1 = 64 * cb + 1; it.rstep = 2; }
    return it;
}
__device__ __forceinline__ void cq_load(const CqItem& it, int half, int lane, f32x2 (&v)[32]) {
    const float* p = it.W + (size_t)(it.k0 + 64 * half + 4 * (lane >> 5)) * it.Nsrc + it.c0 + 2 * (lane & 31);
#pragma unroll
    for (int pp = 0; pp < 8; ++pp)
#pragma unroll
        for (int i = 0; i < 4; ++i) v[4 * pp + i] = *(const f32x2*)(p + (size_t)(8 * pp + i) * it.Nsrc);
}
__device__ __forceinline__ void cq_pack(const f32x2 (&v)[32], int half, int lane, LAS unsigned char* scr, float sc) {
    LAS unsigned char* t0 = scr + (lane & 31) * CQ_TS + 4 * (16 * half + (lane >> 5));
#pragma unroll
    for (int pp = 0; pp < 8; ++pp) {
        *(LAS unsigned*)(t0 + 8 * pp) = pk4_fp8(v[4 * pp].x * sc, v[4 * pp + 1].x * sc, v[4 * pp + 2].x * sc, v[4 * pp + 3].x * sc);
        *(LAS unsigned*)(t0 + 32 * CQ_TS + 8 * pp) = pk4_fp8(v[4 * pp].y * sc, v[4 * pp + 1].y * sc, v[4 * pp + 2].y * sc, v[4 * pp + 3].y * sc); }
}
__device__ __forceinline__ void cq_store(const CqItem& it, int lane, LAS unsigned char* scr) {
    asm volatile("s_waitcnt lgkmcnt(0)" ::: "memory");
    const int r = lane >> 1, hf = lane & 1;
#pragma unroll
    for (int t = 0; t < 2; ++t) { const LAS unsigned char* s = scr + t * 32 * CQ_TS + r * CQ_TS + 64 * hf;
        unsigned char* d = it.WT + (size_t)((t ? it.row1 : it.row0) + r * it.rstep) * D + it.k0 + 64 * hf;
#pragma unroll
        for (int j = 0; j < 4; ++j) *(u32x4*)(d + 16 * j) = *(const LAS u32x4*)(s + 16 * j); }
    asm volatile("s_waitcnt lgkmcnt(0)" ::: "memory");
}
constexpr int CS_GRAB = 8;
__device__ __forceinline__ void convert_steal(Frame& F) {
    constexpr int I_GU1 = (D / 128) * (2048 / 64), I_DN1 = (D / 128) * (D / 64), NIT = NE * (I_GU1 + I_DN1);
    static_assert(NIT % CS_GRAB == 0, "conversion items per grab");
    LAS unsigned char* scr = F.lds + F.wave * CQ_SCR; LAS int* slot = (LAS int*)(F.lds + 8 * CQ_SCR);
    int nxt = 0;
    __syncthreads();
    if (F.tid == 0) nxt = (int)atomicAdd(F.ctl + CW_QCTR, (unsigned)CS_GRAB);
    for (;;) {
        if (F.tid == 0) slot[0] = nxt;
        __syncthreads();
        const int base = slot[0]; if (base >= NIT) break;
        if (F.tid == 0) nxt = (int)atomicAdd(F.ctl + CW_QCTR, (unsigned)CS_GRAB);
        const CqItem it = cq_decode(F, base + F.wave);
        f32x2 va[32], vb[32];
        cq_load(it, 0, F.lane, va);
        cq_load(it, 1, F.lane, vb);
        cq_pack(va, 0, F.lane, scr, 32.0f);
        cq_pack(vb, 1, F.lane, scr, 32.0f);
        cq_store(it, F.lane, scr);
        __syncthreads();
    }
}

#ifndef ML_NDT
#define ML_NDT 4
#endif
__device__ __forceinline__ void mlstm_phase(Frame& F) {
    constexpr int SLICES = 16 / ML_NDT, NITEMS = NB * 4 * SLICES;
    for (int item = F.vcu; item < NITEMS; item += F.G) mlstm_item<ML_NDT>(F, item / (4 * SLICES), (item / SLICES) & 3, item % SLICES);
#if MOE_FP8 && STEAL
    convert_steal(F);
#endif
}

constexpr int N_PHASES = 13;
struct Args { const void* in[18]; float* out; unsigned char* ws; int ph_lo, ph_hi; };

__global__ void __launch_bounds__(NTHREADS, 2) mega_fwd(Args args) {
    extern __shared__ __attribute__((aligned(16))) unsigned char lds[];
    Frame F;
    F.lds = (LAS unsigned char*)lds;
    F.tid = threadIdx.x; F.lane = F.tid & 63; F.wave = __builtin_amdgcn_readfirstlane(F.tid >> 6);
    F.G = gridDim.x; { const int bx = blockIdx.x; F.vcu = (F.G % 8 == 0) ? (bx % 8) * (F.G / 8) + bx / 8 : bx; }
    F.gw = F.vcu * NWAVES + F.wave; F.NGW = F.G * NWAVES;
    unsigned char* ws = args.ws;
    F.ctl = (unsigned*)(ws + WS_CTL);
    F.x = (const float*)args.in[0]; F.positions = (const int*)args.in[1]; F.g_mix = (const float*)args.in[2]; F.w_in = (const float*)args.in[3]; F.conv_qk = (const float*)args.in[4];
    F.b_if = (const float*)args.in[5]; F.g_mnorm = (const float*)args.in[6]; F.w_attn_out = (const float*)args.in[7]; F.w_mlstm_out = (const float*)args.in[8]; F.w_mix_out = (const float*)args.in[9];
    F.g_ffn = (const float*)args.in[10]; F.w_router = (const float*)args.in[11]; F.b_router = (const float*)args.in[12]; F.w_gate_up = (const float*)args.in[13]; F.b_gate_up = (const float*)args.in[14];
    F.w_down = (const float*)args.in[15]; F.b_down = (const float*)args.in[16]; F.g_final = (const float*)args.in[17]; F.out = args.out;
    F.WinT = (bf16*)(ws + WS_WIN); F.WamT = (bf16*)(ws + WS_WAM); F.WoT = (bf16*)(ws + WS_WO); F.WguT = (bf16*)(ws + WS_WGU); F.WdnT = (bf16*)(ws + WS_WDN);
    F.XN = (bf16*)(ws + WS_XN); F.PROJ = (bf16*)(ws + WS_PROJ); F.OG = (bf16*)(ws + WS_OG); F.AM = (bf16*)(ws + WS_AM); F.MERGED = (bf16*)(ws + WS_MERGED);
    F.XS = (bf16*)(ws + WS_XS); F.ACT = (bf16*)(ws + WS_ACT); F.YBUF = (bf16*)(ws + WS_YBUF);
    F.GATES = (float*)(ws + WS_GATES); F.ROPE = (float*)(ws + WS_ROPE); F.LSE = (float*)(ws + WS_LSE); F.HT = (float*)(ws + WS_HT); F.H = (float*)(ws + WS_H);
    F.QC = (float*)(ws + WS_QC); F.KC = (float*)(ws + WS_KC);
    F.TOK_E = (int*)(ws + WS_ROUTE); F.TOK_SLOT = F.TOK_E + NA; F.TOK_W = (float*)(F.TOK_SLOT + NA);
    F.ROW_TOK = (int*)(ws + WS_ROWMETA); F.ROW_W = (float*)(F.ROW_TOK + XS_ROWS);

    const int lo = args.ph_lo, hi = args.ph_hi;
    for (int u = F.tid; u < (LDS_BYTES - LDSCTL_OFF) / 4; u += NTHREADS) ((LAS unsigned*)(F.lds + LDSCTL_OFF))[u] = 0u;
    __syncthreads();
    XcdBarrier bar; bar.bar = F.ctl + CW_BAR; bar.x = 0; bar.st = nullptr;
    if (hi - lo > 1) bar = xcd_barrier_post(F.ctl + CW_BAR, (volatile LAS unsigned*)(F.lds + MISC_OFF) + 8);
#ifndef PH_MASK
#define PH_MASK 0xffffffffu
#endif
#ifndef REP_MASK
#define REP_MASK 0u
#endif
#define IN(k) (((PH_MASK >> (k)) & 1u) && lo <= (k) && (k) < hi)
#define REPS(k) for (int rep_ = 0; rep_ < 1 + (int)((REP_MASK >> (k)) & 1u); ++rep_)
#define SEAM(k) do { if (IN(k) && IN((k) + 1)) { GRID_BAR(); } } while (0)
#define GRID_BAR() xcd_barrier(bar)

    if (IN(0)) REPS(0) { p0_weights(F); p0_rows(F); }
    SEAM(0);
    if (IN(1)) REPS(1) {
#if FAST_P1
#if P1_FP8
        constexpr int NF8 = 64 * (18 + 42 - P1_HI), NBF = 64 * (P1_HI - 18);
        constexpr bool SPLIT = (NF8 == 128 * 15 && NBF == 128 * 6);
        { pg8::Gemm g{(const bf16*)((const unsigned char*)F.ctl + WS_XN8), F.WinT, T, (18 + 42 - P1_HI) * 256, D / 2}; pg8::SplitOrder S; S.base.init(T, (18 + 42 - P1_HI) * 256, F.G, (int)blockIdx.x);
          S.nA = SPLIT ? 9 : -1; S.nB = SPLIT ? 6 : -1;
          pg8::EpiProj<1> E{F.PROJ, F.ROPE};
          pg8::gemm_phase<pg8::EpiProj<1>, pg8::SplitOrder, true, true, true>(F.lds, g, S, E); }
        { pg8::Gemm g{F.XN, F.WinT + (size_t)18 * 256 * D, T, (P1_HI - 18) * 256, D}; pg8::SplitOrder S; S.base.init(T, (P1_HI - 18) * 256, F.G, (int)blockIdx.x);
          S.nA = SPLIT ? 2 : -1; S.nB = SPLIT ? 4 : -1;
          pg8::EpiProj<2> E{F.PROJ, F.ROPE};
          pg8::gemm_phase<pg8::EpiProj<2>, pg8::SplitOrder, true, true>(F.lds, g, S, E); }
#else
        pg8::Gemm g{F.XN, F.WinT, T, NP, D}; pg8::StaticOrder S; S.init(T, NP, F.G, (int)blockIdx.x);
        pg8::EpiProj<0> E{F.PROJ, F.ROPE};
        pg8::gemm_phase<pg8::EpiProj<0>, pg8::StaticOrder, true, true>(F.lds, g, S, E);
#endif
#else
        naive_p1(F);
#endif
    }
    SEAM(1);
    if (IN(2)) REPS(2) {
#if !FAST_P1
        naive_p1_rope(F);
#endif
    }
#if !FAST_P1
    SEAM(2);
#endif
    if (IN(3)) REPS(3) {
#if !FAST_MLSTM
        naive_conv(F);
#endif
#if FAST_MLSTM
        mlstm_prepass(F);
#endif
#if FAST_ATTN
        attn_phase(F);
#else
        naive_attn(F);
#endif
    }
    SEAM(3);
    if (IN(4)) REPS(4) {
#if FAST_MLSTM
        mlstm_phase(F);
#else
        naive_mlstm(F);
#endif
    }
    SEAM(4);
    if (IN(5)) REPS(5) p3_post_mixer(F);
    SEAM(5);
    if (IN(6)) REPS(6) {
#if FAST_P4
        constexpr bool STREAM = (MIX_STREAM && FAST_P5);
        pg8::Gemm g{F.AM, F.WamT, T, D, AMLD};
        { pg8::MergedOrder S; S.base.init(T, D, F.G, (int)blockIdx.x); S.nparts = 2; S.pub = STREAM; S.ready = F.ctl + CW_READY2; S.tmo = F.ctl + CW_TMO;
          pg8::EpiMerged E{F.AM + 1536, F.PROJ, F.x, F.H, STREAM};
          pg8::gemm_phase<pg8::EpiMerged, pg8::MergedOrder, false, true>(F.lds, g, S, E); }
        if (STREAM) {
          pg8::MergedOrder S; S.base.init(T, D, F.G, (int)blockIdx.x); S.nparts = 1; S.pub = true; S.ready = F.ctl + CW_READY2; S.tmo = F.ctl + CW_TMO;
          pg8::EpiMerged E{F.AM + 1536, F.PROJ, F.x, F.H, false};
          pg8::gemm_phase<pg8::EpiMerged, pg8::MergedOrder, false, true>(F.lds, g, S, E); }
#else
        naive_p4(F);
#endif
    }
#if !(MIX_STREAM && FAST_P4 && FAST_P5)
    SEAM(6);
#endif
    if (IN(7)) REPS(7) {
#if FAST_P5
#if !(MIX_STREAM && FAST_P4)
        { pg8::Gemm g{F.AM, F.WamT, T, D, AMLD}; pg8::MergedOrder S; S.base.init(T, D, F.G, (int)blockIdx.x); S.nparts = 1; S.pub = false; S.ready = F.ctl + CW_READY2; S.tmo = F.ctl + CW_TMO;
          pg8::EpiMerged E{F.AM + 1536, F.PROJ, F.x, F.H, false};
          pg8::gemm_phase<pg8::EpiMerged, pg8::MergedOrder, false, true>(F.lds, g, S, E); }
#endif
#else
        naive_p5(F);
#endif
    }
    SEAM(7);
#if MOE_FP8 && ROUTER_MFMA
    if (IN(8)) REPS(8) p6_router_mfma(F);
#else
    if (IN(8)) REPS(8) p6_router(F);
#endif
    SEAM(8);
    if (IN(9)) REPS(9) p7_gather(F);
    SEAM(9);
#if MOE_FP8 && MOE_STREAM && FAST_MOE
    if (IN(10)) REPS(10) {
        const int ntiles = (int)F.ctl[CW_NTILES];
        pg8::MoeOrder S{F.ctl + CW_TILEE, ntiles, F.G, (int)blockIdx.x, F.ROW_TOK, F.XN, F.ACT, F.WguT, F.WdnT, F.ctl + CW_READY, F.ctl + CW_TMO};
        pg8::Gemm g{F.XN, F.WguT, ntiles * 256, NE * 2048, D / 2};
        pg8::EpiMoe E{{F.ACT, F.b_gate_up, 1.0f / 32.0f}, {F.YBUF, F.b_down, F.ROW_TOK, F.ROW_W, 1.0f / 32.0f}};
        pg8::gemm_phase<pg8::EpiMoe, pg8::MoeOrder, true, true, true, true, true>(F.lds, g, S, E);
    }
#else
    if (IN(10)) REPS(10) {
        const int ntiles = (int)F.ctl[CW_NTILES];
#if FAST_MOE
        pg8::GroupedOrder S{F.ctl + CW_TILEE, ntiles, 8, F.G, (int)blockIdx.x, F.ROW_TOK};
#if MOE_FP8
        pg8::Gemm g{F.XN, F.WguT, ntiles * 256, NE * 2048, D / 2}; pg8::EpiSwiGLU<true> E{F.ACT, F.b_gate_up, 1.0f / 32.0f};
        pg8::gemm_phase<pg8::EpiSwiGLU<true>, pg8::GroupedOrder, true, true, true, true>(F.lds, g, S, E);
#else
        pg8::Gemm g{F.XS, F.WguT, ntiles * 256, NE * 2048, D}; pg8::EpiSwiGLU<false> E{F.ACT, F.b_gate_up, 1.0f};
        pg8::gemm_phase<pg8::EpiSwiGLU<false>, pg8::GroupedOrder, true, true, false>(F.lds, g, S, E);
#endif
#else
        naive_p8(F, ntiles);
#endif
    }
    SEAM(10);
    if (IN(11)) REPS(11) {
        const int ntiles = (int)F.ctl[CW_NTILES];
#if FAST_MOE
        pg8::GroupedOrder S{F.ctl + CW_TILEE, ntiles, 4, F.G, (int)blockIdx.x, F.ROW_TOK};
#if MOE_FP8
        pg8::Gemm g{F.ACT, F.WdnT, ntiles * 256, NE * D, D / 2}; pg8::EpiDown E{F.YBUF, F.b_down, F.ROW_TOK, F.ROW_W, 1.0f / 32.0f};
        pg8::gemm_phase<pg8::EpiDown, pg8::GroupedOrder, true, true, true>(F.lds, g, S, E);
#else
        pg8::Gemm g{F.ACT, F.WdnT, ntiles * 256, NE * D, D}; pg8::EpiDown E{F.YBUF, F.b_down, F.ROW_TOK, F.ROW_W, 1.0f};
        pg8::gemm_phase<pg8::EpiDown, pg8::GroupedOrder, true, true, false>(F.lds, g, S, E);
#endif
#else
        naive_p9(F, ntiles);
#endif
    }
#endif
    SEAM(11);
    if (IN(12)) REPS(12) p10_final(F);
#undef IN
#undef SEAM
}

extern "C" void kernel_launch(void* const* d_in, const int* in_sizes, int n_in, void* d_out, int out_size, void* d_ws, size_t ws_size, hipStream_t stream) {
    static int grid = 0;
    if (grid == 0) {
        if (n_in != 18 || out_size != T * D || ws_size < WS_END) { fprintf(stderr, "kernel_launch: unexpected shapes (n_in %d, out %d, ws %zu)\n", n_in, out_size, ws_size); grid = -1; return; }
        int dev = 0, cus = 0;
        if (hipGetDevice(&dev) != hipSuccess || hipDeviceGetAttribute(&cus, hipDeviceAttributeMultiprocessorCount, dev) != hipSuccess) { grid = -1; return; }
        if (hipFuncSetAttribute((const void*)mega_fwd, hipFuncAttributeMaxDynamicSharedMemorySize, LDS_BYTES) != hipSuccess) { fprintf(stderr, "kernel_launch: hipFuncSetAttribute failed\n"); grid = -1; return; }
        int per_cu = 0;
        if (hipOccupancyMaxActiveBlocksPerMultiprocessor(&per_cu, (const void*)mega_fwd, NTHREADS, LDS_BYTES) != hipSuccess || per_cu < 1) { fprintf(stderr, "kernel_launch: occupancy query says %d blocks per CU\n", per_cu); (void)hipGetLastError(); grid = -1; return; }
        grid = cus;
    }
    if (grid < 0) return;
    (void)hipMemsetAsync((char*)d_ws + WS_CTL, 0, CTL_ZERO_BYTES, stream);
    Args a{};
    for (int i = 0; i < 18; ++i) a.in[i] = d_in[i];
    a.out = (float*)d_out; a.ws = (unsigned char*)d_ws;
#if defined(MK_MULTI)
    for (int p = 0; p < N_PHASES; ++p) {
        a.ph_lo = p; a.ph_hi = p + 1;
        hipLaunchKernelGGL(mega_fwd, dim3(grid), dim3(NTHREADS), LDS_BYTES, stream, a);
    }
#else
#if defined(PROBE_HI)
    a.ph_lo = 0; a.ph_hi = PROBE_HI;
    hipLaunchKernelGGL(mega_fwd, dim3(grid), dim3(NTHREADS), LDS_BYTES, stream, a);
    (void)hipMemsetAsync((char*)d_ws + WS_CTL, 0, CTL_ZERO_BYTES, stream);
#endif
    a.ph_lo = 0; a.ph_hi = N_PHASES;
    hipLaunchKernelGGL(mega_fwd, dim3(grid), dim3(NTHREADS), LDS_BYTES, stream, a);
#endif
}
```

```cpp
#include <hip/hip_runtime.h>
#include <cstdio>
#include <cstdint>

#define LAS __attribute__((address_space(3)))
#define GAS __attribute__((address_space(1)))
typedef unsigned short bf16;
typedef float f32x4 __attribute__((ext_vector_type(4)));
typedef float f32x2 __attribute__((ext_vector_type(2)));
typedef unsigned u32x4 __attribute__((ext_vector_type(4)));
typedef unsigned u32x2 __attribute__((ext_vector_type(2)));
typedef short bf16x8 __attribute__((ext_vector_type(8)));

#ifndef FAST_P1
#define FAST_P1 1
#endif
#ifndef FAST_P4
#define FAST_P4 1
#endif
#ifndef FAST_P5
#define FAST_P5 1
#endif
#ifndef FAST_MOE
#define FAST_MOE 1
#endif
#ifndef MOE_FP8
#define MOE_FP8 1
#endif
#ifndef P1_FP8
#define P1_FP8 1
#endif
#ifndef STEAL
#define STEAL 1
#endif
#ifndef ROUTER_MFMA
#define ROUTER_MFMA 1
#endif
#ifndef P1_HI
#define P1_HI 30
#endif
#ifndef MOE_STREAM
#define MOE_STREAM 1
#endif
#ifndef ATT_QUEUE
#define ATT_QUEUE 1
#endif
#ifndef FAST_ATTN
#define FAST_ATTN 1
#endif
#ifndef FAST_MLSTM
#define FAST_MLSTM 1
#endif

constexpr int T = 16384, D = 1024, SEQ = 2048, NB = 8;
constexpr int DIN = 10760, NP = 10752;
constexpr int C_AQ = 0, C_AK = 1536, C_AV = 3072, C_MQ = 4608, C_MK = 5632, C_MV = 6656, C_MO = 7680, C_GA = 8704, C_GM = 9728;
constexpr int NE = 32, TOPK = 4, NA = T * TOPK, MAXTILES = NA / 256 + NE, XS_ROWS = MAXTILES * 256;
constexpr float QSCALE = 0.08838834764831845f * 1.4426950408889634f;
constexpr float RMS_EPS = 1e-5f, LN_EPS = 1e-5f;

constexpr size_t MiB = 1u << 20;
constexpr size_t WS_CTL = 0, CTL_ZERO_BYTES = 1 * MiB;
constexpr size_t WS_WIN = 2 * MiB, WS_WAM = 23 * MiB, WS_WO = 26 * MiB, WS_WGU = 28 * MiB, WS_WDN = 156 * MiB;
constexpr size_t WS_XN = 220 * MiB, WS_GATES = 252 * MiB, WS_ROPE = 253 * MiB, WS_ROUTE = 255 * MiB;
constexpr size_t WS_H = 256 * MiB, WS_MERGED = 320 * MiB;
constexpr size_t WS_OG = 352 * MiB, WS_LSE = 400 * MiB, WS_HT = 401 * MiB, WS_AM = 433 * MiB;
constexpr int AMLD = 2560;
#ifndef MIX_STREAM
#define MIX_STREAM 0
#endif
constexpr size_t WS_YBUF = 352 * MiB;
constexpr size_t WS_PROJ = 513 * MiB;
constexpr size_t WS_XS = 513 * MiB, WS_ACT = 657 * MiB;
constexpr size_t WS_ROWMETA = 801 * MiB;
constexpr size_t WS_QC = 849 * MiB, WS_KC = 913 * MiB, WS_XN8 = 916 * MiB, WS_END = 977 * MiB;
constexpr int CW_TMO = 0, CW_BAR = 4096, CW_CNT = 8192  , CW_NTILES = 12288, CW_TILEE = 12352, CW_QCTR = 16384, CW_ACTR = 16448  , CW_READY = 32768  , CW_READY2 = 65536  ;

constexpr int RING_BYTES = 131072, LDS_BYTES = 147456, LDSCTL_OFF = LDS_BYTES - 256, MISC_OFF = LDSCTL_OFF;
constexpr int NWAVES = 8, NTHREADS = 512;

__device__ __forceinline__ unsigned f2bf(float f) { unsigned u = __builtin_bit_cast(unsigned, f); return (u + 0x7fffu + ((u >> 16) & 1u)) >> 16; }
__device__ __forceinline__ unsigned pk2(float lo, float hi) { unsigned r; asm("v_cvt_pk_bf16_f32 %0, %1, %2" : "=v"(r) : "v"(lo), "v"(hi)); return r; }
__device__ __forceinline__ unsigned pk4_fp8(float a, float b, float c, float d) { int w = __builtin_amdgcn_cvt_pk_fp8_f32(a, b, 0, false); w = __builtin_amdgcn_cvt_pk_fp8_f32(c, d, w, true); return (unsigned)w; }
__device__ __forceinline__ float frcp(float x) { return __builtin_amdgcn_rcpf(x); }
__device__ __forceinline__ float bf2f(unsigned b) { return __builtin_bit_cast(float, b << 16); }
__device__ __forceinline__ float bflo(unsigned w) { return __builtin_bit_cast(float, w << 16); }
__device__ __forceinline__ float bfhi(unsigned w) { return __builtin_bit_cast(float, w & 0xffff0000u); }
__device__ __forceinline__ float wave_sum(float v) {
#pragma unroll
    for (int o = 1; o < 64; o <<= 1) v += __shfl_xor(v, o);
    return v;
}
__device__ __forceinline__ float wave_max(float v) {
#pragma unroll
    for (int o = 1; o < 64; o <<= 1) v = fmaxf(v, __shfl_xor(v, o));
    return v;
}
__device__ __forceinline__ float sigmoidf_(float x) { return frcp(1.0f + __expf(-x)); }

__host__ __device__ __forceinline__ int win_logical_col(int c) {
    if (c < C_AV) { const int p = c & 127; if (p < 32) { const int a = p >> 3, n = (p >> 2) & 1, j = p & 3; return (c - p) + 16 * n + 4 * a + j; } return c; }
    return c < C_GA ? c : c + 8;
}
__host__ __device__ __forceinline__ int wgu_logical_col(int c) { const int pn = c >> 8, bj = (c >> 7) & 1, jl = c & 127; return 2 * (128 * pn + jl) + bj; }
namespace pg8 {
#define PG8_LAS __attribute__((address_space(3)))
typedef unsigned short bf16_t;
typedef short bf16x8 __attribute__((ext_vector_type(8)));
typedef float f32x4 __attribute__((ext_vector_type(4)));
typedef unsigned u32x4 __attribute__((ext_vector_type(4)));
constexpr int BM = 256, BK = 64, HALF = 128, HTB = HALF * BK * 2  , STAGE_BYTES = 8 * HTB, NXCD = 8, WGM = 8;

__host__ __device__ __forceinline__ int lds_byte(int r, int c) { const int st = (r >> 4) * 2 + (c >> 5), rr = r & 15, cc = c & 31, ob = rr * 64 + cc * 2; return st * 1024 + (ob ^ (((ob >> 9) & 1) << 5)); }
__host__ __device__ __forceinline__ void stage_rc(int b, int& R, int& C) { const int st = b / 1024, sb = b % 1024, swz = sb ^ (((sb >> 9) & 1) << 5); R = (st >> 1) * 16 + swz / 64; C = (st & 1) * 32 + (swz % 64) / 2; }
__host__ __device__ __forceinline__ int perm32(int rho) { const int n = rho >> 4, i = rho & 15; return 8 * (i >> 2) + 4 * n + (i & 3); }

typedef int i32x4 __attribute__((ext_vector_type(4)));
typedef int i32x8 __attribute__((ext_vector_type(8)));
template <bool FP8> struct FragT { typedef bf16x8 type; };
template <> struct FragT<true> { typedef i32x8 type; };
__device__ __forceinline__ f32x4 mma16(bf16x8 a, bf16x8 b, f32x4 c) { return __builtin_amdgcn_mfma_f32_16x16x32_bf16(a, b, c, 0, 0, 0); }
__device__ __forceinline__ f32x4 mma16(i32x8, i32x8, f32x4 c) { return c; }
__device__ __forceinline__ f32x4 mma8(i32x8 a, i32x8 b, f32x4 c) { const int one = 0x7F7F7F7F;
    asm volatile("v_mfma_scale_f32_16x16x128_f8f6f4 %0, %1, %2, %0, %3, %3 op_sel_hi:[0,0,0]" : "+v"(c) : "v"(a), "v"(b), "v"(one)); return c; }
__device__ __forceinline__ f32x4 mma8(bf16x8, bf16x8, f32x4 c) { return c; }
struct Unit { int pm, pn, part; };
struct Gemm { const bf16_t* A; const bf16_t* Bt; int M, N, K; };

struct StaticOrder {
    int nM, nN, nwg, G, c;
    __host__ __device__ void init(int M, int N, int G_, int c_) { nM = M / BM; nN = N / BM; nwg = nM * nN; G = G_; c = c_; }
    __host__ __device__ bool next(int i, Unit& u) const { return at((long)i * G + c, u); }
    __host__ __device__ bool at(long L, Unit& u) const {
        if (L >= nwg) return false;
        int wgid = (int)L; { const int q = nwg / NXCD, r = nwg % NXCD, xcd = wgid % NXCD, off = wgid / NXCD; wgid = (xcd < r ? xcd * (q + 1) : r * (q + 1) + (xcd - r) * q) + off; }
        const int nig = WGM * nN, gid = wgid / nig, fm = gid * WGM, gsz = (nM - fm) < WGM ? (nM - fm) : WGM;
        u.pm = fm + ((wgid % nig) % gsz); u.pn = (wgid % nig) / gsz; u.part = 0; return true;
    }
    __device__ __forceinline__ int kt0(const Unit&) const { return 0; }
    __device__ __forceinline__ int nkt(const Unit&, int full) const { return full; }
    __device__ __forceinline__ int rowsel(const Unit&, int r) const { return r; }
    __device__ __forceinline__ const void* abase(const Unit&) const { return nullptr; }
    __device__ __forceinline__ const void* bbase(const Unit&) const { return nullptr; }
    __device__ __forceinline__ void a_ready(const Unit&) const {}
    __device__ __forceinline__ void done(const Unit&) const {}
};


__device__ __forceinline__ unsigned cvt_pk_bf16(float lo, float hi) { unsigned r; asm volatile("v_cvt_pk_bf16_f32 %0, %1, %2" : "=v"(r) : "v"(lo), "v"(hi)); return r; }
__device__ __forceinline__ u32x4 pack8(const f32x4 v0, const f32x4 v1) { u32x4 w; w.x = cvt_pk_bf16(v0[0], v0[1]); w.y = cvt_pk_bf16(v0[2], v0[3]); w.z = cvt_pk_bf16(v1[0], v1[1]); w.w = cvt_pk_bf16(v1[2], v1[3]); return w; }
__device__ __forceinline__ void unpack8(const u32x4 w, f32x4& v0, f32x4& v1) {
    v0[0] = __builtin_bit_cast(float, w.x << 16); v0[1] = __builtin_bit_cast(float, w.x & 0xffff0000u); v0[2] = __builtin_bit_cast(float, w.y << 16); v0[3] = __builtin_bit_cast(float, w.y & 0xffff0000u);
    v1[0] = __builtin_bit_cast(float, w.z << 16); v1[1] = __builtin_bit_cast(float, w.z & 0xffff0000u); v1[2] = __builtin_bit_cast(float, w.w << 16); v1[3] = __builtin_bit_cast(float, w.w & 0xffff0000u);
}
__device__ __forceinline__ f32x4 sig4(const f32x4 x) { f32x4 r; r[0] = frcp(1.0f + __expf(-x[0])); r[1] = frcp(1.0f + __expf(-x[1])); r[2] = frcp(1.0f + __expf(-x[2])); r[3] = frcp(1.0f + __expf(-x[3])); return r; }

struct GroupedOrder {
    const unsigned* tile_e; int ntiles, nN, G, c; const int* rowidx;
    __device__ __forceinline__ int kt0(const Unit&) const { return 0; }
    __device__ __forceinline__ int nkt(const Unit&, int full) const { return full; }
    __device__ __forceinline__ int rowsel(const Unit&, int r) const { const int v = rowidx[r]; return (v < 0 ? 0 : v) >> 2; }
    __device__ __forceinline__ const void* abase(const Unit&) const { return nullptr; }
    __device__ __forceinline__ const void* bbase(const Unit&) const { return nullptr; }
    __device__ bool next(int i, Unit& u) const {
        const long L = (long)i * G + c; if (L >= (long)ntiles * nN) return false;
        u.pm = (int)(L / nN); const int e = (int)tile_e[u.pm]; u.pn = e * nN + (int)(L % nN); u.part = 0; return true;
    }
    __device__ __forceinline__ void a_ready(const Unit&) const {}
    __device__ __forceinline__ void done(const Unit&) const {}
};

template <int MODE> struct EpiProj {
    static constexpr bool PERM = true, AFTER_DRAIN = false, HAS_MID = false;
    bf16_t* O; const float* rope;
    __device__ __forceinline__ bool keep(const Unit&) const { return false; }
    __device__ __forceinline__ void operator()(f32x4 (&acc)[2][2][4][2], const Unit& u, int wr, int wc, int fr, int fq) const {
        const int pnp = (MODE == 0) ? u.pn : (MODE == 1) ? (u.pn < 18 ? u.pn : u.pn + (P1_HI - 18)) : u.pn + 18;
        const int row0 = u.pm * BM + wr * 64 + fr, col0 = pnp * BM + wc * 32 + 8 * fq;
        const float sc = ((pnp < 6) ? QSCALE : 1.0f) * ((MODE == 1) ? (1.0f / 32.0f) : 1.0f);
        const bool dorope = (pnp < 12) && (wc == 0);
#pragma unroll
        for (int ai = 0; ai < 2; ++ai)
#pragma unroll
            for (int m = 0; m < 4; ++m) {
                const int row = row0 + ai * HALF + m * 16; bf16_t* rowp = O + (size_t)row * NP + col0;
                f32x4 cs = (f32x4){1.f, 1.f, 1.f, 1.f}, sn = (f32x4){0.f, 0.f, 0.f, 0.f};
                if (dorope) { cs = *(const f32x4*)(rope + (size_t)row * 32 + 4 * fq); sn = *(const f32x4*)(rope + (size_t)row * 32 + 16 + 4 * fq); }
#pragma unroll
                for (int bj = 0; bj < 2; ++bj) {
                    f32x4 v0 = acc[ai][bj][m][0], v1 = acc[ai][bj][m][1];
                    if (dorope) { const f32x4 t0 = v0 * cs - v1 * sn, t1 = v1 * cs + v0 * sn; v0 = t0; v1 = t1; }
                    v0 = v0 * sc; v1 = v1 * sc;
                    *(u32x4*)(rowp + bj * HALF) = pack8(v0, v1);
                }
            }
    }
};

struct SplitOrder {
    StaticOrder base; int nA, nB;
    __device__ bool next(int i, Unit& u) const {
        const int c = base.c;
        if (base.G != 256 || nA < 0) return base.next(i, u);
        if (c < 128) { if (i >= nA) return false; return base.at((long)i * 128 + c, u); }
        if (i >= nB) return false; return base.at((long)128 * nA + (long)i * 128 + (c - 128), u);
    }
    __device__ __forceinline__ int kt0(const Unit&) const { return 0; }
    __device__ __forceinline__ int nkt(const Unit&, int full) const { return full; }
    __device__ __forceinline__ int rowsel(const Unit&, int r) const { return r; }
    __device__ __forceinline__ const void* abase(const Unit&) const { return nullptr; }
    __device__ __forceinline__ const void* bbase(const Unit&) const { return nullptr; }
    __device__ __forceinline__ void a_ready(const Unit&) const {}
    __device__ __forceinline__ void done(const Unit&) const {}
};
struct MergedOrder {
    StaticOrder base; int nparts; unsigned* ready; unsigned* tmo;
    bool pub;
    __device__ bool next(int i, Unit& u) const { if (!base.next(i / nparts, u)) return false; u.part = (nparts == 1) ? 2 : (i % nparts); return true; }
    __device__ __forceinline__ int kt0(const Unit& u) const { return u.part == 0 ? 0 : (u.part == 1 ? 8 : 24); }
    __device__ __forceinline__ int nkt(const Unit& u, int) const { return u.part == 0 ? 8 : 16; }
    __device__ __forceinline__ int rowsel(const Unit&, int r) const { return r; }
    __device__ __forceinline__ const void* abase(const Unit&) const { return nullptr; }
    __device__ __forceinline__ const void* bbase(const Unit&) const { return nullptr; }
    __device__ __forceinline__ void a_ready(const Unit& u) const {
        if (u.part != 2 || !pub) return;
        if (threadIdx.x < 64) {
            unsigned spins = 0;
            while ((unsigned)__builtin_amdgcn_readfirstlane(__hip_atomic_load(ready + 64 * u.pm, __ATOMIC_RELAXED, __HIP_MEMORY_SCOPE_AGENT)) < 32u) {
                __builtin_amdgcn_s_sleep(2);
                if (++spins > (1u << 22)) { if (threadIdx.x == 0) __hip_atomic_store(tmo, 1u, __ATOMIC_RELAXED, __HIP_MEMORY_SCOPE_AGENT); break; } }
            __builtin_amdgcn_fence(__ATOMIC_ACQUIRE, "agent");
            asm volatile("s_waitcnt vmcnt(0)" ::: "memory");
        }
        asm volatile("" ::: "memory"); __builtin_amdgcn_s_barrier(); asm volatile("" ::: "memory");
    }
    __device__ __forceinline__ void done(const Unit& u) const {
        if (!pub || u.part != 1) return;
        asm volatile("s_waitcnt vmcnt(0)" ::: "memory");
        __builtin_amdgcn_s_barrier(); asm volatile("" ::: "memory");
        if (threadIdx.x == 0) { __builtin_amdgcn_fence(__ATOMIC_RELEASE, "agent"); asm volatile("s_waitcnt vmcnt(0)" ::: "memory");
                                __hip_atomic_fetch_add(ready + 64 * u.pm, 8u, __ATOMIC_RELAXED, __HIP_MEMORY_SCOPE_AGENT); }
    }
};
struct EpiMerged {
    static constexpr bool PERM = true, AFTER_DRAIN = false, HAS_MID = false;
    bf16_t* O; const bf16_t* proj; const float* x; float* h; bool wt;
    __device__ __forceinline__ bool keep(const Unit& u) const { return u.part == 0; }
    __device__ __forceinline__ void operator()(f32x4 (&acc)[2][2][4][2], const Unit& u, int wr, int wc, int fr, int fq) const {
        const int row0 = u.pm * BM + wr * 64 + fr, col0 = u.pn * BM + wc * 32 + 8 * fq;
        if (u.part == 0) {
#pragma unroll
            for (int ai = 0; ai < 2; ++ai)
#pragma unroll
                for (int m = 0; m < 4; ++m) {
                    const bf16_t* rowp = proj + (size_t)(row0 + ai * HALF + m * 16) * NP + col0;
#pragma unroll
                    for (int bj = 0; bj < 2; ++bj) {
                        const u32x4 ga = *(const u32x4*)(rowp + C_GA + bj * HALF), gm = *(const u32x4*)(rowp + C_GM + bj * HALF);
                        f32x4 a0, a1, m0, m1; unpack8(ga, a0, a1); unpack8(gm, m0, m1);
                        f32x4 r0, r1;
#pragma unroll
                        for (int j = 0; j < 4; ++j) { r0[j] = (1.0f + __expf(-m0[j])) * frcp(1.0f + __expf(-a0[j])); r1[j] = (1.0f + __expf(-m1[j])) * frcp(1.0f + __expf(-a1[j])); }
                        acc[ai][bj][m][0] *= r0; acc[ai][bj][m][1] *= r1;
                    }
                    if (m & 1) asm volatile("" ::: "memory");
                }
        } else if (u.part == 1) {
#pragma unroll
            for (int ai = 0; ai < 2; ++ai)
#pragma unroll
                for (int m = 0; m < 4; ++m) {
                    const int row = row0 + ai * HALF + m * 16;
#pragma unroll
                    for (int bj = 0; bj < 2; ++bj) {
                        const u32x4 gm = *(const u32x4*)(proj + (size_t)row * NP + C_GM + col0 + bj * HALF);
                        f32x4 m0, m1; unpack8(gm, m0, m1);
                        const f32x4 v0 = acc[ai][bj][m][0] * sig4(m0), v1 = acc[ai][bj][m][1] * sig4(m1);
                        const u32x4 pw = pack8(v0, v1); bf16_t* dst = O + (size_t)row * AMLD + col0 + bj * HALF;
                        if (wt) { __hip_atomic_store((unsigned long long*)dst, (unsigned long long)pw.x | ((unsigned long long)pw.y << 32), __ATOMIC_RELAXED, __HIP_MEMORY_SCOPE_AGENT);
                                  __hip_atomic_store((unsigned long long*)dst + 1, (unsigned long long)pw.z | ((unsigned long long)pw.w << 32), __ATOMIC_RELAXED, __HIP_MEMORY_SCOPE_AGENT); }
                        else *(u32x4*)dst = pw;
                    }
                }
        } else {
#pragma unroll
            for (int ai = 0; ai < 2; ++ai)
#pragma unroll
                for (int m = 0; m < 4; ++m) {
                    const size_t off = (size_t)(row0 + ai * HALF + m * 16) * D + col0;
#pragma unroll
                    for (int bj = 0; bj < 2; ++bj)
#pragma unroll
                        for (int n = 0; n < 2; ++n) *(f32x4*)(h + off + bj * HALF + 4 * n) = *(const f32x4*)(x + off + bj * HALF + 4 * n) + acc[ai][bj][m][n];
                }
        }
    }
};

struct EpiResid {
    static constexpr bool PERM = false, AFTER_DRAIN = false, HAS_MID = false;
    const float* x; float* h;
    __device__ __forceinline__ bool keep(const Unit&) const { return false; }
    __device__ __forceinline__ void operator()(f32x4 (&acc)[2][2][4][2], const Unit& u, int wr, int wc, int fr, int fq) const {
        const int row0 = u.pm * BM + wr * 64 + fr, col0 = u.pn * BM + wc * 32 + 4 * fq;
#pragma unroll
        for (int ai = 0; ai < 2; ++ai)
#pragma unroll
            for (int m = 0; m < 4; ++m) {
                const size_t off = (size_t)(row0 + ai * HALF + m * 16) * D + col0;
#pragma unroll
                for (int bj = 0; bj < 2; ++bj)
#pragma unroll
                    for (int n = 0; n < 2; ++n) *(f32x4*)(h + off + bj * HALF + n * 16) = *(const f32x4*)(x + off + bj * HALF + n * 16) + acc[ai][bj][m][n];
            }
    }
};

template <bool OUT8> struct EpiSwiGLU {
    static constexpr bool PERM = true, AFTER_DRAIN = false, HAS_MID = false;
    bf16_t* act; const float* bgu; float sc;
    __device__ __forceinline__ bool keep(const Unit&) const { return false; }
    __device__ __forceinline__ void operator()(f32x4 (&acc)[2][2][4][2], const Unit& u, int wr, int wc, int fr, int fq) const {
        const int e = u.pn >> 3, pnl = u.pn & 7, row0 = u.pm * BM + wr * 64 + fr, j0 = 128 * pnl + 32 * wc + 8 * fq;
        const float* bp = bgu + (size_t)e * 2048 + 2 * j0;
        const f32x4 b0 = *(const f32x4*)(bp), b1 = *(const f32x4*)(bp + 4), b2 = *(const f32x4*)(bp + 8), b3 = *(const f32x4*)(bp + 12);
        const f32x4 bg0 = (f32x4){b0[0], b0[2], b1[0], b1[2]}, bu0 = (f32x4){b0[1], b0[3], b1[1], b1[3]}, bg1 = (f32x4){b2[0], b2[2], b3[0], b3[2]}, bu1 = (f32x4){b2[1], b2[3], b3[1], b3[3]};
#pragma unroll
        for (int ai = 0; ai < 2; ++ai)
#pragma unroll
            for (int m = 0; m < 4; ++m) {
                const int row = row0 + ai * HALF + m * 16;
                f32x4 o[2]; const float lim = 7.0f, nlim = -7.0f;
#pragma unroll
                for (int n = 0; n < 2; ++n) {
                    const f32x4 g = acc[ai][0][m][n] * sc + (n ? bg1 : bg0), up = acc[ai][1][m][n] * sc + (n ? bu1 : bu0);
#pragma unroll
                    for (int j = 0; j < 4; ++j) { float gg, uu;
                        asm("v_min_f32 %0, %2, %1" : "=v"(gg) : "v"(g[j]), "v"(lim)); asm("v_med3_f32 %0, %1, %2, %3" : "=v"(uu) : "v"(up[j]), "v"(nlim), "v"(lim));
                        const float sg = frcp(1.0f + __builtin_amdgcn_exp2f(gg * (-1.702f * 1.4426950408889634f)));
                        o[n][j] = __builtin_fmaf(uu, gg, gg) * sg; }
                }
                if constexpr (OUT8) { u32x2 w8; w8.x = pk4_fp8(o[0][0], o[0][1], o[0][2], o[0][3]); w8.y = pk4_fp8(o[1][0], o[1][1], o[1][2], o[1][3]); __hip_atomic_store((unsigned long long*)((unsigned char*)act + (size_t)row * D + j0), (unsigned long long)w8.x | ((unsigned long long)w8.y << 32), __ATOMIC_RELAXED, __HIP_MEMORY_SCOPE_AGENT); }
                else *(u32x4*)(act + (size_t)row * D + j0) = pack8(o[0], o[1]);
            }
    }
};

struct EpiDown {
    static constexpr bool PERM = true, AFTER_DRAIN = false, HAS_MID = false;
    bf16_t* ybuf; const float* bdn; const int* row_tok; const float* row_w; float sc;
    __device__ __forceinline__ bool keep(const Unit&) const { return false; }
    __device__ __forceinline__ void operator()(f32x4 (&acc)[2][2][4][2], const Unit& u, int wr, int wc, int fr, int fq) const {
        const int e = u.pn >> 2, pnl = u.pn & 3, row0 = u.pm * BM + wr * 64 + fr, col0 = 256 * pnl + 32 * wc + 8 * fq;
        f32x4 bv[2][2];
#pragma unroll
        for (int bj = 0; bj < 2; ++bj)
#pragma unroll
            for (int n = 0; n < 2; ++n) bv[bj][n] = *(const f32x4*)(bdn + (size_t)e * D + col0 + bj * HALF + 4 * n);
        int tks[8]; float ws[8];
#pragma unroll
        for (int i = 0; i < 8; ++i) { const int row = row0 + (i >> 2) * HALF + (i & 3) * 16; tks[i] = row_tok[row]; ws[i] = row_w[row]; }
#pragma unroll
        for (int ai = 0; ai < 2; ++ai)
#pragma unroll
            for (int m = 0; m < 4; ++m) {
                const int tk = tks[ai * 4 + m]; const float w = ws[ai * 4 + m];
                if (tk >= 0) {
#pragma unroll
                    for (int bj = 0; bj < 2; ++bj) {
                        const f32x4 v0 = (acc[ai][bj][m][0] * sc + bv[bj][0]) * w, v1 = (acc[ai][bj][m][1] * sc + bv[bj][1]) * w;
                        *(u32x4*)(ybuf + (size_t)tk * D + col0 + bj * HALF) = pack8(v0, v1);
                    }
                }
            }
    }
};

struct MoeOrder {
    const unsigned* tile_e; int ntiles, G, c; const int* rowidx; const void *a0, *a1, *b0, *b1; unsigned* ready; unsigned* tmo;
    __device__ __forceinline__ int kt0(const Unit&) const { return 0; }
    __device__ __forceinline__ int nkt(const Unit&, int full) const { return full; }
    __device__ __forceinline__ int rowsel(const Unit& u, int r) const { if (u.part) return r; const int v = rowidx[r]; return (v < 0 ? 0 : v) >> 2; }
    __device__ __forceinline__ const void* abase(const Unit& u) const { return u.part ? a1 : a0; }
    __device__ __forceinline__ const void* bbase(const Unit& u) const { return u.part ? b1 : b0; }
    __device__ bool next(int i, Unit& u) const {
        long L = (long)i * G + c; const long n1 = (long)ntiles * 8;
        if (L < n1) { u.pm = (int)(L >> 3); u.pn = (int)tile_e[u.pm] * 8 + (int)(L & 7); u.part = 0; return true; }
        L -= n1; if (L >= (long)ntiles * 4) return false;
        u.pm = (int)(L >> 2); u.pn = (int)tile_e[u.pm] * 4 + (int)(L & 3); u.part = 1; return true;
    }
    __device__ __forceinline__ void a_ready(const Unit& u) const {
        if (u.part == 0) return;
        if (threadIdx.x < 64) {
            unsigned spins = 0;
            while ((unsigned)__builtin_amdgcn_readfirstlane(__hip_atomic_load(ready + 64 * u.pm, __ATOMIC_RELAXED, __HIP_MEMORY_SCOPE_AGENT)) < 64u) {
                __builtin_amdgcn_s_sleep(2);
                if (++spins > (1u << 22)) { if (threadIdx.x == 0) __hip_atomic_store(tmo, 1u, __ATOMIC_RELAXED, __HIP_MEMORY_SCOPE_AGENT); break; } }
            __builtin_amdgcn_fence(__ATOMIC_ACQUIRE, "agent");
            asm volatile("s_waitcnt vmcnt(0)" ::: "memory");
        }
        asm volatile("" ::: "memory"); __builtin_amdgcn_s_barrier(); asm volatile("" ::: "memory");
    }
    __device__ __forceinline__ void done(const Unit& u) const {
        if (u.part != 0) return;
        asm volatile("s_waitcnt vmcnt(0)" ::: "memory");
        if ((threadIdx.x & 63) == 0) __hip_atomic_fetch_add(ready + 64 * u.pm, 1u, __ATOMIC_RELAXED, __HIP_MEMORY_SCOPE_AGENT);
    }
};
struct EpiMoe {
    static constexpr bool PERM = true, AFTER_DRAIN = false, HAS_MID = false;
    EpiSwiGLU<true> e0; EpiDown e1;
    __device__ __forceinline__ bool keep(const Unit&) const { return false; }
    __device__ __forceinline__ void operator()(f32x4 (&acc)[2][2][4][2], const Unit& u, int wr, int wc, int fr, int fq) const {
        if (u.part == 0) e0(acc, u, wr, wc, fr, fq); else e1(acc, u, wr, wc, fr, fq);
    }
};
template <class Epi, class Sched, bool ALIGN_EPI = false, bool SP2 = false, bool FP8 = false, bool GATHER = false, bool MULTI = false>
__device__ __forceinline__ void gemm_phase(PG8_LAS unsigned char* lds, const Gemm g, const Sched& S, const Epi& E) {
    typedef typename FragT<FP8>::type frag_t;
    const int tid = threadIdx.x, wid = __builtin_amdgcn_readfirstlane(tid >> 6), lane = tid & 63, wr = wid >> 2, wc = wid & 3, fr = lane & 15, fq = lane >> 4;
    int K_ = g.K; asm volatile("" : "+s"(K_));
    const int K = K_, ntfull = K / BK;
    unsigned voffA[2], voffB[2];
#pragma unroll
    for (int i = 0; i < 2; ++i) { int R, C; stage_rc(tid * 16 + i * 8192, R, C); const int Rb = Epi::PERM ? ((R & ~31) + perm32(R & 31)) : R;
        voffA[i] = (unsigned)(R * K + C) * 2u; voffB[i] = (unsigned)(Rb * K + C) * 2u; }
    const size_t kstep = (size_t)(BK * 2);
    const size_t hstep = (size_t)HALF * K * 2;
    const size_t tstep = 2 * hstep;
    const unsigned ldsw = (unsigned)wid * 1024u;
    const int aoff = lds_byte(wr * 64 + fr, fq * (FP8 ? 16 : 8)), boff = lds_byte(wc * 32 + fr, fq * (FP8 ? 16 : 8));
    constexpr int NKF = FP8 ? 1 : 2;
#define PG8_SA(b, h) (((b) * 2 + (h)) * HTB)
#define PG8_SB(b, h) ((4 + (b) * 2 + (h)) * HTB)
#define PG8_STAGE(bufoff, gbase, voff) do { _Pragma("unroll") for (int _i = 0; _i < 2; ++_i) \
        __builtin_amdgcn_global_load_lds((const unsigned*)((const char*)(gbase) + (voff)[_i]), (PG8_LAS unsigned*)(lds + (bufoff) + ldsw + _i * 8192), 16, 0, 0); } while (0)
#define PG8_STAGEA(bufoff, gbase, half, isnext) do { if constexpr (GATHER) { unsigned vs_[2]; vs_[0] = (isnext) ? voffAn[half][0] : voffAc[half][0]; vs_[1] = (isnext) ? voffAn[half][1] : voffAc[half][1]; PG8_STAGE(bufoff, gbase, vs_); } \
        else { PG8_STAGE(bufoff, (gbase) + (half) * hstep, voffA); } } while (0)
#define PG8_LDA(dst, b, h) do { _Pragma("unroll") for (int m = 0; m < 4; ++m) _Pragma("unroll") for (int k = 0; k < NKF; ++k) dst[m][k] = *(const PG8_LAS frag_t*)(lds + PG8_SA(b, h) + aoff + m * 2048 + k * 1024); } while (0)
#define PG8_LDB(dst, b, h) do { _Pragma("unroll") for (int n = 0; n < 2; ++n) _Pragma("unroll") for (int k = 0; k < NKF; ++k) dst[n][k] = *(const PG8_LAS frag_t*)(lds + PG8_SB(b, h) + boff + n * 2048 + k * 1024); } while (0)
#define PG8_MMA(ai, bj, At, Bt) do { __builtin_amdgcn_s_setprio(1); \
        if constexpr (FP8) { _Pragma("unroll") for (int m = 0; m < 4; ++m) _Pragma("unroll") for (int n = 0; n < 2; ++n) \
            acc[ai][bj][m][n] = mma8(Bt[n][0], At[m][0], acc[ai][bj][m][n]); } \
        else { _Pragma("unroll") for (int m = 0; m < 4; ++m) _Pragma("unroll") for (int n = 0; n < 2; ++n) _Pragma("unroll") for (int k = 0; k < 2; ++k) \
            acc[ai][bj][m][n] = mma16(Bt[n][k], At[m][k], acc[ai][bj][m][n]); } \
        __builtin_amdgcn_s_setprio(0); } while (0)
#define PG8_WAIT_V(n) asm volatile("s_waitcnt vmcnt(" #n ")" ::: "memory")
#define PG8_WAIT_L(n) asm volatile("s_waitcnt lgkmcnt(" #n ")" ::: "memory")
#define PG8_BAR __builtin_amdgcn_s_barrier()
#define PG8_SCHED __builtin_amdgcn_sched_barrier(0)
    Unit cur, nxt; int ui = 0;
    if (!S.next(0, cur)) return;
    unsigned voffAc[2][2], voffAn[2][2];
#define PG8_GROWS(dst, u_) do { if constexpr (GATHER) { _Pragma("unroll") for (int h_ = 0; h_ < 2; ++h_) _Pragma("unroll") for (int i_ = 0; i_ < 2; ++i_) { int R_, C_; stage_rc(tid * 16 + i_ * 8192, R_, C_); \
        const int ri_ = S.rowsel((u_), (u_).pm * BM + h_ * HALF + R_); dst[h_][i_] = (unsigned)ri_ * (unsigned)(K * 2) + (unsigned)(C_ * 2); } } } while (0)
    PG8_GROWS(voffAc, cur);
    f32x4 acc[2][2][4][2];
#pragma unroll
    for (int a = 0; a < 2; ++a)
#pragma unroll
        for (int b = 0; b < 2; ++b)
#pragma unroll
            for (int m = 0; m < 4; ++m)
#pragma unroll
                for (int n = 0; n < 2; ++n) acc[a][b][m][n] = (f32x4){0.f, 0.f, 0.f, 0.f};
    frag_t At[4][NKF], B0[2][NKF], B1[2][NKF];
    const char* cA = (MULTI ? (const char*)S.abase(cur) : (const char*)g.A) + (GATHER ? (size_t)0 : (size_t)cur.pm * tstep) + (size_t)S.kt0(cur) * kstep; const char* cB = (MULTI ? (const char*)S.bbase(cur) : (const char*)g.Bt) + (size_t)cur.pn * tstep + (size_t)S.kt0(cur) * kstep;
    S.a_ready(cur);
    if constexpr (SP2) {
        PG8_STAGE(PG8_SB(0, 0), cB, voffB); PG8_STAGE(PG8_SB(0, 1), cB + hstep, voffB); PG8_STAGEA(PG8_SA(0, 0), cA, 0, false); PG8_STAGEA(PG8_SA(0, 1), cA, 1, false);
        if (wr == 1) PG8_BAR;
        PG8_WAIT_V(2); PG8_BAR;
        PG8_STAGE(PG8_SB(1, 0), cB + kstep, voffB); PG8_STAGEA(PG8_SA(1, 0), cA + kstep, 0, false); PG8_STAGE(PG8_SB(1, 1), cB + hstep + kstep, voffB);
        PG8_WAIT_V(6); PG8_BAR;
    } else {
        PG8_STAGE(PG8_SB(0, 0), cB, voffB); PG8_STAGEA(PG8_SA(0, 0), cA, 0, false); PG8_STAGE(PG8_SB(0, 1), cB + hstep, voffB); PG8_STAGEA(PG8_SA(0, 1), cA, 1, false);
        if (wr == 1) PG8_BAR;
        PG8_WAIT_V(4); PG8_BAR;
        PG8_STAGE(PG8_SB(1, 0), cB + kstep, voffB); PG8_STAGEA(PG8_SA(1, 0), cA + kstep, 0, false); PG8_STAGE(PG8_SB(1, 1), cB + hstep + kstep, voffB);
        PG8_WAIT_V(6); PG8_BAR;
    }
    for (;;) {
        const bool has_next = S.next(ui + 1, nxt);
        if (has_next) PG8_GROWS(voffAn, nxt);
        else if constexpr (GATHER) { _Pragma("unroll") for (int h_ = 0; h_ < 2; ++h_) _Pragma("unroll") for (int i_ = 0; i_ < 2; ++i_) voffAn[h_][i_] = voffAc[h_][i_]; }
        const char* nA = has_next ? (MULTI ? (const char*)S.abase(nxt) : (const char*)g.A) + (GATHER ? (size_t)0 : (size_t)nxt.pm * tstep) + (size_t)S.kt0(nxt) * kstep : cA; const char* nB = has_next ? (MULTI ? (const char*)S.bbase(nxt) : (const char*)g.Bt) + (size_t)nxt.pn * tstep + (size_t)S.kt0(nxt) * kstep : cB;
        const int nt = S.nkt(cur, ntfull);
        for (int t = 0; t < nt; t += 2) {
            const bool last = (t == nt - 2);
            const char* a1 = cA + (size_t)(t + 1) * kstep;
            const char* a2 = last ? nA : cA + (size_t)(t + 2) * kstep; const char* b2 = last ? nB : cB + (size_t)(t + 2) * kstep;
            const char* a3 = a2 + kstep; const char* b3 = b2 + kstep;
            if (last && has_next) S.a_ready(nxt);
            if constexpr (SP2) {
            PG8_LDB(B0, 0, 0); PG8_LDB(B1, 0, 1); PG8_SCHED; PG8_LDA(At, 0, 0); PG8_STAGEA(PG8_SA(1, 1), a1, 1, false);
            PG8_WAIT_V(8); PG8_WAIT_L(0); PG8_BAR; PG8_MMA(0, 0, At, B0); PG8_MMA(0, 1, At, B1); PG8_BAR; PG8_SCHED;
            PG8_LDA(At, 0, 1); PG8_STAGE(PG8_SB(0, 0), b2, voffB); PG8_STAGE(PG8_SB(0, 1), b2 + hstep, voffB); PG8_STAGEA(PG8_SA(0, 0), a2, 0, last);
            PG8_WAIT_V(8); PG8_WAIT_L(0); PG8_BAR; PG8_MMA(1, 0, At, B0); PG8_MMA(1, 1, At, B1); PG8_BAR; PG8_SCHED;
            PG8_LDB(B0, 1, 0); PG8_LDB(B1, 1, 1); PG8_SCHED; PG8_LDA(At, 1, 0); PG8_STAGEA(PG8_SA(0, 1), a2, 1, last);
            PG8_WAIT_V(8); PG8_WAIT_L(0); PG8_BAR; PG8_MMA(0, 0, At, B0); PG8_MMA(0, 1, At, B1); PG8_BAR; PG8_SCHED;
            PG8_LDA(At, 1, 1); PG8_STAGE(PG8_SB(1, 0), b3, voffB); PG8_STAGE(PG8_SB(1, 1), b3 + hstep, voffB); PG8_STAGEA(PG8_SA(1, 0), a3, 0, last);
            PG8_WAIT_V(8); PG8_WAIT_L(0); PG8_BAR; PG8_MMA(1, 0, At, B0); PG8_MMA(1, 1, At, B1); PG8_BAR; PG8_SCHED;
            } else {
            PG8_LDB(B0, 0, 0); PG8_SCHED; PG8_LDA(At, 0, 0); PG8_STAGEA(PG8_SA(1, 1), a1, 1, false);
            PG8_WAIT_L(8); PG8_BAR; PG8_WAIT_L(0); PG8_MMA(0, 0, At, B0); PG8_BAR; PG8_SCHED;
            PG8_LDB(B1, 0, 1); PG8_STAGE(PG8_SB(0, 0), b2, voffB);
            PG8_BAR; PG8_WAIT_L(0); PG8_MMA(0, 1, At, B1); PG8_BAR;
            PG8_LDA(At, 0, 1); PG8_STAGEA(PG8_SA(0, 0), a2, 0, last);
            PG8_BAR; PG8_WAIT_L(0); PG8_MMA(1, 0, At, B0); PG8_BAR; PG8_SCHED;
            PG8_STAGE(PG8_SB(0, 1), b2 + hstep, voffB);
            PG8_WAIT_V(6); PG8_BAR; PG8_MMA(1, 1, At, B1); PG8_BAR;
            PG8_LDB(B0, 1, 0); PG8_SCHED; PG8_LDA(At, 1, 0); PG8_STAGEA(PG8_SA(0, 1), a2, 1, last);
            PG8_WAIT_L(8); PG8_BAR; PG8_WAIT_L(0); PG8_MMA(0, 0, At, B0); PG8_BAR; PG8_SCHED;
            PG8_LDB(B1, 1, 1); PG8_STAGE(PG8_SB(1, 0), b3, voffB);
            PG8_BAR; PG8_WAIT_L(0); PG8_MMA(0, 1, At, B1); PG8_BAR;
            PG8_LDA(At, 1, 1); PG8_STAGEA(PG8_SA(1, 0), a3, 0, last);
            PG8_BAR; PG8_WAIT_L(0); PG8_MMA(1, 0, At, B0); PG8_BAR; PG8_SCHED;
            PG8_STAGE(PG8_SB(1, 1), b3 + hstep, voffB);
            PG8_WAIT_V(6); PG8_BAR; PG8_MMA(1, 1, At, B1); PG8_BAR;
            }
        }
        if constexpr (FP8) asm volatile("s_nop 15\n\ts_nop 15" ::: "memory");
        if constexpr (ALIGN_EPI) { if (wr == 0) PG8_BAR; }
        if constexpr (!Epi::AFTER_DRAIN) { E(acc, cur, wr, wc, fr, fq); S.done(cur); }
        if (!has_next) break;
        if (!E.keep(cur)) {
#pragma unroll
        for (int a = 0; a < 2; ++a)
#pragma unroll
            for (int b = 0; b < 2; ++b)
#pragma unroll
                for (int m = 0; m < 4; ++m)
#pragma unroll
                    for (int n = 0; n < 2; ++n) acc[a][b][m][n] = (f32x4){0.f, 0.f, 0.f, 0.f};
        }
        cur = nxt; cA = nA; cB = nB; ++ui;
        if constexpr (GATHER) { _Pragma("unroll") for (int h_ = 0; h_ < 2; ++h_) _Pragma("unroll") for (int i_ = 0; i_ < 2; ++i_) voffAc[h_][i_] = voffAn[h_][i_]; }
        if constexpr (ALIGN_EPI) { if (wr == 1) PG8_BAR; }
    }
    PG8_WAIT_V(0);
    if constexpr (!ALIGN_EPI) { if (wr == 0) PG8_BAR; }
    PG8_BAR;
    if constexpr (Epi::AFTER_DRAIN) { E.fused(acc, cur, wr, wc, fr, fq, lds, wid, lane); S.done(cur); }
#undef PG8_SA
#undef PG8_SB
#undef PG8_STAGE
#undef PG8_LDA
#undef PG8_STAGEA
#undef PG8_GROWS
#undef PG8_LDB
#undef PG8_MMA
#undef PG8_WAIT_V
#undef PG8_WAIT_L
#undef PG8_BAR
#undef PG8_SCHED
}
}
#define XB_TMO      128
#define XB_XCNT(j)  (256  + 64 * (j))
#define XB_XSUB(j)  (1280 + 64 * (j))
#define XB_XGEN(j)  (2304 + 64 * (j))
#define XB_TOP      3328
#define XB_TOPGEN   3392
#define XCD_BAR_WORDS 3456
#define XB_SPIN_CAP (1u << 24)

__device__ __forceinline__ unsigned xb_ld(unsigned* p)              { return __hip_atomic_load(p, __ATOMIC_RELAXED, __HIP_MEMORY_SCOPE_AGENT); }
__device__ __forceinline__ unsigned xb_add(unsigned* p, unsigned v) { return __hip_atomic_fetch_add(p, v, __ATOMIC_RELAXED, __HIP_MEMORY_SCOPE_AGENT); }
__device__ __forceinline__ unsigned xb_xcc_id() { return (unsigned)__builtin_amdgcn_s_getreg((3 << 11) | 20) & 0xFu; }
#define XB_SPIN(cond, bar) do { unsigned _sp = 0; while (cond) { __builtin_amdgcn_s_sleep(1); \
    if ((++_sp & 255u) == 0u) { if (xb_ld(&(bar)[XB_TMO])) break; if (_sp > XB_SPIN_CAP) { atomicAdd(&(bar)[XB_TMO], 1u); break; } } } } while (0)

struct XcdBarrier {
    unsigned* bar; unsigned x;
    volatile LAS unsigned* st;
};

__device__ __forceinline__ XcdBarrier xcd_barrier_post(unsigned* bar, volatile LAS unsigned* st) {
    XcdBarrier b; b.bar = bar; b.x = xb_xcc_id(); b.st = st;
    if (threadIdx.x == 0) (void)xb_add(&bar[XB_XCNT(b.x)], 1u);
    return b;
}
__device__ __forceinline__ void xcd_barrier_complete(unsigned* bar, unsigned x, unsigned& nloc, unsigned& nx) {
    const unsigned G = gridDim.x * gridDim.y * gridDim.z;
    unsigned sum, cnt, mine, sp = 0u;
    for (;;) {
        sum = 0u; cnt = 0u; mine = 0u;
#pragma unroll
        for (unsigned j = 0; j < 16; ++j) { const unsigned c = xb_ld(&bar[XB_XCNT(j)]); sum += c; cnt += (c > 0u) ? 1u : 0u; mine = (j == x) ? c : mine; }
        if (sum == G) break;
        __builtin_amdgcn_s_sleep(1);
        if ((++sp & 255u) == 0u) { if (xb_ld(&bar[XB_TMO])) break; if (sp > XB_SPIN_CAP) { atomicAdd(&bar[XB_TMO], 1u); break; } }
    }
    nloc = mine > 0u ? mine : 1u; nx = cnt > 0u ? cnt : 1u;
}

__device__ __forceinline__ void xcd_barrier(const XcdBarrier& b) {
    asm volatile("s_waitcnt vmcnt(0)" ::: "memory");
    __syncthreads();
    if (threadIdx.x == 0) {
        unsigned* bar = b.bar;
        __builtin_amdgcn_s_waitcnt(0);
        unsigned nloc = b.st[0], nx = b.st[1];
        if (nloc == 0u) { xcd_barrier_complete(bar, b.x, nloc, nx); b.st[0] = nloc; b.st[1] = nx; }
        const unsigned old = xb_add(&bar[XB_XSUB(b.x)], 1u);
        const unsigned gen = old / nloc;
        if (old + 1u == (gen + 1u) * nloc) {
            __builtin_amdgcn_fence(__ATOMIC_RELEASE, "agent");
            asm volatile("s_waitcnt vmcnt(0)" ::: "memory");
            const unsigned og = xb_add(&bar[XB_TOP], 1u);
            const unsigned tg = og / nx;
            if (og + 1u == (tg + 1u) * nx) xb_add(&bar[XB_TOPGEN], 1u);
            else XB_SPIN(xb_ld(&bar[XB_TOPGEN]) == tg, bar);
            __builtin_amdgcn_fence(__ATOMIC_ACQUIRE, "agent");
            xb_add(&bar[XB_XGEN(b.x)], 1u);
            asm volatile("s_waitcnt vmcnt(0)" ::: "memory");
        } else {
            XB_SPIN(xb_ld(&bar[XB_XGEN(b.x)]) == gen, bar);
            __builtin_amdgcn_fence(__ATOMIC_ACQUIRE, "agent");
            asm volatile("s_waitcnt vmcnt(0)" ::: "memory");
        }
    }
    __syncthreads();
}

struct Frame {
    LAS unsigned char* lds;
    unsigned* ctl;
    int tid, lane, wave, vcu, G, gw, NGW;
    const float *x, *g_mix, *w_in, *conv_qk, *b_if, *g_mnorm, *w_attn_out, *w_mlstm_out, *w_mix_out, *g_ffn, *w_router, *b_router, *w_gate_up, *b_gate_up, *w_down, *b_down, *g_final;
    const int* positions;
    float* out;
    bf16 *WinT, *WamT, *WoT, *WguT, *WdnT, *XN, *PROJ, *OG, *AM, *MERGED, *XS, *ACT, *YBUF;
    float *GATES, *ROPE, *LSE, *HT, *H, *QC, *KC, *ROW_W, *TOK_W;
    int *TOK_E, *TOK_SLOT, *ROW_TOK;
};

__constant__ double ROPE_REV[16] = {
    1.59154943091895346e-01, 7.00865215877985032e-02, 3.08637634047012298e-02, 1.35913706361939050e-02, 5.98518571271370540e-03, 2.63567589866741401e-03, 1.16066364124006098e-03, 5.11117504537543857e-04,
    2.25079079039276525e-04, 9.91173093690193548e-05, 4.36479527928028909e-05, 1.92211006849448627e-05, 8.46433080824140138e-06, 3.72740860191535193e-06, 1.64142626279503449e-06, 7.22829306883286479e-07};

template <int MAP>
__device__ __forceinline__ void transpose_item(const float* W, int Nsrc, bf16* WT, int ldk, int kofs, int nblk, LAS float* scr, int item, int lane) {
    const int kb = item / nblk, nb = item % nblk, k0 = 64 * kb, n0 = 32 * nb;
    const int np = n0 + (lane & 31);
    const int sc = (MAP == 1) ? win_logical_col(np) : (MAP == 2) ? wgu_logical_col(np) : np;
    float tv[32];
#pragma unroll
    for (int i = 0; i < 32; ++i) tv[i] = W[(size_t)(k0 + 2 * i + (lane >> 5)) * Nsrc + sc];
#pragma unroll
    for (int i = 0; i < 32; ++i) scr[(2 * i + (lane >> 5)) * 33 + (lane & 31)] = tv[i];
    asm volatile("s_waitcnt lgkmcnt(0)" ::: "memory");
    const int c = lane & 7;
#pragma unroll
    for (int j = 0; j < 4; ++j) { const int n = (lane >> 3) + 8 * j; const LAS float* s = scr + (8 * c) * 33 + n;
        u32x4 o; o.x = pk2(s[0 * 33], s[1 * 33]); o.y = pk2(s[2 * 33], s[3 * 33]); o.z = pk2(s[4 * 33], s[5 * 33]); o.w = pk2(s[6 * 33], s[7 * 33]);
        *(u32x4*)(WT + (size_t)(n0 + n) * ldk + kofs + k0 + 8 * c) = o; }
    asm volatile("s_waitcnt lgkmcnt(0)" ::: "memory");
}

template <int MAP>
__device__ __forceinline__ void transpose_item_fp8(const float* W, int Nsrc, unsigned char* WT, int ldk, int nblk, LAS float* scr, int item, int lane, float scale) {
    const int kb = item / nblk, nb = item % nblk, k0 = 64 * kb, n0 = 32 * nb;
    const int np = n0 + (lane & 31);
    const int sc = (MAP == 1) ? win_logical_col(np) : (MAP == 2) ? wgu_logical_col(np) : np;
    float tv[32];
#pragma unroll
    for (int i = 0; i < 32; ++i) tv[i] = W[(size_t)(k0 + 2 * i + (lane >> 5)) * Nsrc + sc];
#pragma unroll
    for (int i = 0; i < 32; ++i) scr[(2 * i + (lane >> 5)) * 33 + (lane & 31)] = tv[i] * scale;
    asm volatile("s_waitcnt lgkmcnt(0)" ::: "memory");
    const int n = lane >> 1, c = lane & 1;
#pragma unroll
    for (int q = 0; q < 2; ++q) { const LAS float* s = scr + (32 * c + 16 * q) * 33 + n;
        u32x4 o; o.x = pk4_fp8(s[0 * 33], s[1 * 33], s[2 * 33], s[3 * 33]); o.y = pk4_fp8(s[4 * 33], s[5 * 33], s[6 * 33], s[7 * 33]);
        o.z = pk4_fp8(s[8 * 33], s[9 * 33], s[10 * 33], s[11 * 33]); o.w = pk4_fp8(s[12 * 33], s[13 * 33], s[14 * 33], s[15 * 33]);
        *(u32x4*)(WT + (size_t)(n0 + n) * ldk + k0 + 32 * c + 16 * q) = o; }
    asm volatile("s_waitcnt lgkmcnt(0)" ::: "memory");
}

template <int MAP>
__device__ __forceinline__ void tr8_load(const float* W, int Nsrc, int nblk, int item, int lane, float (&tv)[32]) {
    const int kb = item / nblk, nb = item % nblk, k0 = 64 * kb, np = 32 * nb + (lane & 31);
    const int sc = (MAP == 1) ? win_logical_col(np) : (MAP == 2) ? wgu_logical_col(np) : np;
#pragma unroll
    for (int i = 0; i < 32; ++i) tv[i] = W[(size_t)(k0 + 2 * i + (lane >> 5)) * Nsrc + sc];
}
__device__ __forceinline__ void tr8_store(const float (&tv)[32], unsigned char* WT, int ldk, int nblk, LAS float* scr, int item, int lane, float scale) {
    const int kb = item / nblk, nb = item % nblk, k0 = 64 * kb, n0 = 32 * nb;
#pragma unroll
    for (int i = 0; i < 32; ++i) scr[(2 * i + (lane >> 5)) * 33 + (lane & 31)] = tv[i] * scale;
    asm volatile("s_waitcnt lgkmcnt(0)" ::: "memory");
    const int n = lane >> 1, c = lane & 1;
#pragma unroll
    for (int q = 0; q < 2; ++q) { const LAS float* s = scr + (32 * c + 16 * q) * 33 + n;
        u32x4 o; o.x = pk4_fp8(s[0 * 33], s[1 * 33], s[2 * 33], s[3 * 33]); o.y = pk4_fp8(s[4 * 33], s[5 * 33], s[6 * 33], s[7 * 33]);
        o.z = pk4_fp8(s[8 * 33], s[9 * 33], s[10 * 33], s[11 * 33]); o.w = pk4_fp8(s[12 * 33], s[13 * 33], s[14 * 33], s[15 * 33]);
        *(u32x4*)(WT + (size_t)(n0 + n) * ldk + k0 + 32 * c + 16 * q) = o; }
    asm volatile("s_waitcnt lgkmcnt(0)" ::: "memory");
}

__device__ __forceinline__ void p0_weights(Frame& F) {
    LAS float* scr = (LAS float*)(F.lds + F.wave * 16384);
    constexpr int I_IN = (D / 64) * (NP / 32), I_A = (512 / 64) * (D / 32), I_M = (D / 64) * (D / 32), I_O = I_M;
    constexpr int I_GU1 = (D / 64) * (2048 / 32), I_DN1 = (D / 64) * (D / 32);
    constexpr int NITEMS = I_IN + I_A + I_M + I_O + ((MOE_FP8 && STEAL) ? 0 : NE * I_GU1 + NE * I_DN1);
    for (int it = F.gw; it < NITEMS; it += F.NGW) {
        int r = it;
#if P1_FP8
        if (r < I_IN) { const int pn = (r % (NP / 32)) >> 3;
            if (pn < 18 || pn >= P1_HI) transpose_item_fp8<1>(F.w_in, DIN, (unsigned char*)F.WinT - (pn >= P1_HI ? (size_t)(P1_HI - 18) * 256 * D : (size_t)0), D, NP / 32, scr, r, F.lane, 32.0f);
            else transpose_item<1>(F.w_in, DIN, F.WinT, D, 0, NP / 32, scr, r, F.lane);
            continue; } r -= I_IN;
#else
        if (r < I_IN) { transpose_item<1>(F.w_in, DIN, F.WinT, D, 0, NP / 32, scr, r, F.lane); continue; } r -= I_IN;
#endif
        if (r < I_A) { transpose_item<0>(F.w_attn_out, D, F.WamT, AMLD, 0, D / 32, scr, r, F.lane); continue; } r -= I_A;
        if (r < I_M) { transpose_item<0>(F.w_mlstm_out, D, F.WamT, AMLD, 512, D / 32, scr, r, F.lane); continue; } r -= I_M;
        if (r < I_O) { transpose_item<0>(F.w_mix_out, D, F.WamT, AMLD, 1536, D / 32, scr, r, F.lane); continue; } r -= I_O;
#if MOE_FP8 && STEAL
        (void)r;
#elif MOE_FP8
        if (r < NE * I_GU1) { const int e = r / I_GU1; transpose_item_fp8<2>(F.w_gate_up + (size_t)e * D * 2048, 2048, (unsigned char*)F.WguT + (size_t)e * 2048 * D, D, 2048 / 32, scr, r % I_GU1, F.lane, 32.0f); continue; } r -= NE * I_GU1;
        { const int e = r / I_DN1; transpose_item_fp8<0>(F.w_down + (size_t)e * D * D, D, (unsigned char*)F.WdnT + (size_t)e * D * D, D, D / 32, scr, r % I_DN1, F.lane, 32.0f); }
#else
        if (r < NE * I_GU1) { const int e = r / I_GU1; transpose_item<2>(F.w_gate_up + (size_t)e * D * 2048, 2048, F.WguT + (size_t)e * 2048 * D, D, 0, 2048 / 32, scr, r % I_GU1, F.lane); continue; } r -= NE * I_GU1;
        { const int e = r / I_DN1; transpose_item<0>(F.w_down + (size_t)e * D * D, D, F.WdnT + (size_t)e * D * D, D, 0, D / 32, scr, r % I_DN1, F.lane); }
#endif
    }
}

__device__ __forceinline__ void p0_rows(Frame& F) {
    LAS float* w8t = (LAS float*)(F.lds);
    __syncthreads();
    { float w8v[16];
#pragma unroll
      for (int j = 0; j < 16; ++j) { const int i = F.tid + j * NTHREADS; w8v[j] = F.w_in[(size_t)(i >> 3) * DIN + 8704 + (i & 7)]; }
#pragma unroll
      for (int j = 0; j < 16; ++j) { const int i = F.tid + j * NTHREADS; w8t[(i & 7) * 1024 + (i >> 3)] = w8v[j]; } }
    __syncthreads();
    f32x4 vnx[4];
    if (F.gw < T) { const f32x4* xr = (const f32x4*)(F.x + (size_t)F.gw * D) + F.lane;
#pragma unroll
        for (int j = 0; j < 4; ++j) vnx[j] = xr[64 * j]; }
    for (int row = F.gw; row < T; row += F.NGW) {
        f32x4 v[4]; float s = 0.f;
#pragma unroll
        for (int j = 0; j < 4; ++j) { v[j] = vnx[j]; s += (v[j].x * v[j].x + v[j].y * v[j].y) + (v[j].z * v[j].z + v[j].w * v[j].w); }
        if (row + F.NGW < T) { const f32x4* xr = (const f32x4*)(F.x + (size_t)(row + F.NGW) * D) + F.lane;
#pragma unroll
            for (int j = 0; j < 4; ++j) vnx[j] = xr[64 * j]; }
        const float rstd = 1.0f / sqrtf(wave_sum(s) * (1.0f / D) + RMS_EPS);
        float ga[8];
#pragma unroll
        for (int o = 0; o < 8; ++o) ga[o] = 0.f;
        unsigned long long* o8 = (unsigned long long*)(F.XN + (size_t)row * D) + F.lane;
#pragma unroll
        for (int j = 0; j < 4; ++j) {
            const f32x4 g = *((const f32x4*)F.g_mix + F.lane + 64 * j);
            v[j] = v[j] * rstd * g;
            o8[64 * j] = (unsigned long long)pk2(v[j].x, v[j].y) | ((unsigned long long)pk2(v[j].z, v[j].w) << 32);
#if P1_FP8
            ((unsigned*)((unsigned char*)F.ctl + WS_XN8 + (size_t)row * D))[F.lane + 64 * j] = pk4_fp8(v[j].x, v[j].y, v[j].z, v[j].w);
#endif
#pragma unroll
            for (int o = 0; o < 8; ++o) { const f32x4 w = *((const LAS f32x4*)(w8t + o * 1024) + F.lane + 64 * j); ga[o] += (v[j].x * w.x + v[j].y * w.y) + (v[j].z * w.z + v[j].w * w.w); }
        }
#pragma unroll
        for (int o = 0; o < 8; ++o) ga[o] = wave_sum(ga[o]);
        if (F.lane < 8) { float gv = ga[0];
#pragma unroll
            for (int o = 1; o < 8; ++o) gv = (F.lane == o) ? ga[o] : gv;
            F.GATES[(size_t)row * 8 + F.lane] = gv + F.b_if[F.lane]; }
        if (F.lane < 16) {
            const int pos = F.positions[row];
            double rev = (double)pos * ROPE_REV[F.lane]; rev -= floor(rev);
            const float fr = (float)rev;
            F.ROPE[(size_t)row * 32 + F.lane] = __builtin_amdgcn_cosf(fr);
            F.ROPE[(size_t)row * 32 + 16 + F.lane] = __builtin_amdgcn_sinf(fr);
        }
    }
}

template <int RT, class AF, class BF, class EP>
__device__ __forceinline__ void naive_gemm(Frame& F, int M, int N, int K, AF af, BF bf, EP ep) {
    const long gthreads = (long)F.G * NTHREADS, gtid = (long)blockIdx.x * NTHREADS + F.tid;
    for (long it = gtid; it < (long)(M / RT) * N; it += gthreads) {
        const int col = (int)(it % N), r0 = (int)(it / N) * RT;
        float acc[RT];
#pragma unroll
        for (int r = 0; r < RT; ++r) acc[r] = 0.f;
        for (int k = 0; k < K; ++k) { const float b = bf(k, col);
#pragma unroll
            for (int r = 0; r < RT; ++r) acc[r] += af(r0 + r, k) * b; }
#pragma unroll
        for (int r = 0; r < RT; ++r) ep(r0 + r, col, acc[r]);
    }
}

__device__ __forceinline__ void naive_p1(Frame& F) {
    const bf16* XN = F.XN; const float* W = F.w_in; bf16* P = F.PROJ;
    naive_gemm<8>(F, T, NP, D,
        [=](int r, int k) { return bf2f(XN[(size_t)r * D + k]); },
        [=](int k, int c) { return bf2f(f2bf(W[(size_t)k * DIN + win_logical_col(c)])); },
        [=](int r, int c, float a) { P[(size_t)r * NP + c] = (bf16)f2bf(a * (c < C_AK ? QSCALE : 1.0f)); });
}
__device__ __forceinline__ void naive_p1_rope(Frame& F) {
    const long gthreads = (long)F.G * NTHREADS, gtid = (long)blockIdx.x * NTHREADS + F.tid;
    for (long it = gtid; it < (long)T * 24 * 16; it += gthreads) {
        const int i = (int)(it & 15), hh = (int)((it >> 4) % 24), row = (int)(it / (24 * 16));
        const int a = i >> 2, j = i & 3; bf16* p = F.PROJ + (size_t)row * NP + hh * 128;
        const float x1 = bf2f(p[8 * a + j]), x2 = bf2f(p[8 * a + 4 + j]), cs = F.ROPE[(size_t)row * 32 + i], sn = F.ROPE[(size_t)row * 32 + 16 + i];
        p[8 * a + j] = (bf16)f2bf(x1 * cs - x2 * sn); p[8 * a + 4 + j] = (bf16)f2bf(x2 * cs + x1 * sn);
    }
}
__device__ __forceinline__ void naive_attn(Frame& F) {
    for (int it = F.gw; it < T * 12; it += F.NGW) {
        const int row = it / 12, gh = it % 12, g = gh >> 2, h = gh & 3, b = row / SEQ, t = row % SEQ, d = (g == 0) ? 1 : (g == 1) ? 4 : 16, i = t / d, r = t % d;
        const int hc = g * 512 + h * 128 + 2 * F.lane;
        const unsigned qw = *(const unsigned*)(F.PROJ + (size_t)row * NP + C_AQ + hc); const float q0 = bflo(qw), q1 = bfhi(qw);
        float m = -INFINITY, l = 0.f, o0 = 0.f, o1 = 0.f;
        for (int ii = (i > 128 ? i - 128 : 0); ii <= i; ++ii) {
            const size_t kr = (size_t)(b * SEQ + r + d * ii) * NP;
            const unsigned kw = *(const unsigned*)(F.PROJ + kr + C_AK + hc), vw = *(const unsigned*)(F.PROJ + kr + C_AV + hc);
            const float s = wave_sum(q0 * bflo(kw) + q1 * bfhi(kw));
            const float mn = fmaxf(m, s), al = exp2f(m - mn), p = exp2f(s - mn);
            l = l * al + p; o0 = o0 * al + p * bflo(vw); o1 = o1 * al + p * bfhi(vw); m = mn;
        }
        const float il = 1.0f / l;
        *(unsigned*)(F.OG + ((size_t)g * T + row) * 512 + h * 128 + 2 * F.lane) = pk2(o0 * il, o1 * il);
        if (F.lane == 0) F.LSE[((size_t)g * T + row) * 4 + h] = m + log2f(l);
    }
}
__device__ __forceinline__ void naive_conv(Frame& F) {
    const long gthreads = (long)F.G * NTHREADS, gtid = (long)blockIdx.x * NTHREADS + F.tid;
    for (long it = gtid; it < (long)T * 2048; it += gthreads) {
        const int c = (int)(it & 2047), row = (int)(it >> 11), t = row % SEQ;
        float a = 0.f;
#pragma unroll
        for (int j = 0; j < 4; ++j) if (t - 3 + j >= 0) a += F.conv_qk[j * 2048 + c] * bf2f(F.PROJ[(size_t)(row - 3 + j) * NP + C_MQ + c]);
        const float y = a / (1.0f + __expf(-a));
        if (c < 1024) F.QC[(size_t)row * 1024 + c] = y; else F.KC[(size_t)row * 1024 + c - 1024] = y * 0.0625f;
    }
}
__device__ __forceinline__ void naive_mlstm(Frame& F) {
    LAS float* sq = (LAS float*)F.lds; LAS float* sk = sq + 256; LAS float* red = sk + 256; LAS float* redn = red + 512;
    for (int item = blockIdx.x; item < NB * 4 * 8; item += F.G) {
        const int sl = item & 7, h = (item >> 3) & 3, b = item >> 5, dvl = F.tid & 31, dkp = F.tid >> 5;
        float c[16], n[16];
#pragma unroll
        for (int j = 0; j < 16; ++j) { c[j] = 0.f; n[j] = 0.f; }
        float m = 0.f;
        for (int t = 0; t < SEQ; ++t) {
            const size_t row = (size_t)b * SEQ + t;
            __syncthreads();
            if (F.tid < 256) sq[F.tid] = F.QC[row * 1024 + h * 256 + F.tid]; else sk[F.tid - 256] = F.KC[row * 1024 + h * 256 + F.tid - 256];
            const float v = bf2f(F.PROJ[row * NP + C_MV + h * 256 + sl * 32 + dvl]);
            const float ir = F.GATES[row * 8 + h], fr = F.GATES[row * 8 + 4 + h];
            const float logf = fminf(fr, 0.f) - log1pf(__expf(-fabsf(fr)));
            const float mn = fmaxf(logf + m, ir), fa = __expf(logf + m - mn), ia = __expf(ir - mn);
            m = mn;
            __syncthreads();
            float pn = 0.f, pd = 0.f;
#pragma unroll
            for (int j = 0; j < 16; ++j) { const float kk = sk[dkp * 16 + j], qq = sq[dkp * 16 + j]; c[j] = fa * c[j] + ia * kk * v; n[j] = fa * n[j] + ia * kk; pn += qq * c[j]; pd += qq * n[j]; }
            red[dkp * 32 + dvl] = pn; redn[dkp * 32 + dvl] = pd;
            __syncthreads();
            if (F.tid < 32) { float num = 0.f, den = 0.f;
#pragma unroll
                for (int p = 0; p < 16; ++p) { num += red[p * 32 + F.tid]; den += redn[p * 32 + F.tid]; }
                F.HT[row * 1024 + h * 256 + sl * 32 + F.tid] = num / fmaxf(fabsf(den), __expf(-mn)); }
        }
    }
}
__device__ __forceinline__ void naive_p4(Frame& F) {
    const bf16 *AM = F.AM, *PJ = F.PROJ; const float *WA = F.w_attn_out, *WM = F.w_mlstm_out; bf16* O = F.AM + 1536;
    float* tmp = F.QC;
    naive_gemm<8>(F, T, D, 512, [=](int r, int k) { return bf2f(AM[(size_t)r * AMLD + k]); }, [=](int k, int c) { return bf2f(f2bf(WA[(size_t)k * D + c])); },
        [=](int r, int c, float a) { tmp[(size_t)r * D + c] = a * sigmoidf_(bf2f(PJ[(size_t)r * NP + C_GA + c])); });
    __threadfence();
    naive_gemm<8>(F, T, D, D, [=](int r, int k) { return bf2f(AM[(size_t)r * AMLD + 512 + k]); }, [=](int k, int c) { return bf2f(f2bf(WM[(size_t)k * D + c])); },
        [=](int r, int c, float a) { O[(size_t)r * AMLD + c] = (bf16)f2bf(tmp[(size_t)r * D + c] + a * sigmoidf_(bf2f(PJ[(size_t)r * NP + C_GM + c]))); });
}
__device__ __forceinline__ void naive_p5(Frame& F) {
    const bf16* MG = F.AM + 1536; const float *WO = F.w_mix_out, *X = F.x; float* H = F.H;
    naive_gemm<8>(F, T, D, D, [=](int r, int k) { return bf2f(MG[(size_t)r * AMLD + k]); }, [=](int k, int c) { return bf2f(f2bf(WO[(size_t)k * D + c])); },
        [=](int r, int c, float a) { H[(size_t)r * D + c] = X[(size_t)r * D + c] + a; });
}
__device__ __forceinline__ void naive_p8(Frame& F, int ntiles) {
    const long gthreads = (long)F.G * NTHREADS, gtid = (long)blockIdx.x * NTHREADS + F.tid;
    const unsigned* tile_e = F.ctl + CW_TILEE;
    for (long it = gtid; it < (long)ntiles * 256 * D; it += gthreads) {
        const int j = (int)(it & 1023), row = (int)(it >> 10), e = (int)tile_e[row >> 8];
        if (F.ROW_TOK[row] < 0) { F.ACT[(size_t)row * D + j] = 0; continue; }
        const float* W = F.w_gate_up + (size_t)e * D * 2048; float g = 0.f, u = 0.f;
        for (int k = 0; k < D; ++k) { const float a = bf2f(F.XS[(size_t)row * D + k]); g += a * bf2f(f2bf(W[(size_t)k * 2048 + 2 * j])); u += a * bf2f(f2bf(W[(size_t)k * 2048 + 2 * j + 1])); }
        g += F.b_gate_up[e * 2048 + 2 * j]; u += F.b_gate_up[e * 2048 + 2 * j + 1];
        const float gg = fminf(g, 7.0f), uu = fminf(fmaxf(u, -7.0f), 7.0f);
        F.ACT[(size_t)row * D + j] = (bf16)f2bf((uu + 1.0f) * gg / (1.0f + __expf(-1.702f * gg)));
    }
}
__device__ __forceinline__ void naive_p9(Frame& F, int ntiles) {
    const long gthreads = (long)F.G * NTHREADS, gtid = (long)blockIdx.x * NTHREADS + F.tid;
    const unsigned* tile_e = F.ctl + CW_TILEE;
    for (long it = gtid; it < (long)ntiles * 256 * D; it += gthreads) {
        const int c = (int)(it & 1023), row = (int)(it >> 10), e = (int)tile_e[row >> 8], tk = F.ROW_TOK[row];
        if (tk < 0) continue;
        const float* W = F.w_down + (size_t)e * D * D; float y = 0.f;
        for (int k = 0; k < D; ++k) y += bf2f(F.ACT[(size_t)row * D + k]) * bf2f(f2bf(W[(size_t)k * D + c]));
        F.YBUF[(size_t)tk * D + c] = (bf16)f2bf((y + F.b_down[e * D + c]) * F.ROW_W[row]);
    }
}

__device__ __forceinline__ void p3_post_mixer(Frame& F) {
    for (int row = F.gw; row < T; row += F.NGW) {
        { const int h = F.lane >> 4; float l0 = F.LSE[((size_t)0 * T + row) * 4 + h], l1 = F.LSE[((size_t)1 * T + row) * 4 + h], l2 = F.LSE[((size_t)2 * T + row) * 4 + h];
          const float mx = fmaxf(l0, fmaxf(l1, l2)); float w0 = exp2f(l0 - mx), w1 = exp2f(l1 - mx), w2 = exp2f(l2 - mx); const float inv = 1.0f / (w0 + w1 + w2); w0 *= inv; w1 *= inv; w2 *= inv;
          const u32x4 a = *(const u32x4*)(F.OG + ((size_t)0 * T + row) * 512 + 8 * F.lane), b = *(const u32x4*)(F.OG + ((size_t)1 * T + row) * 512 + 8 * F.lane), c = *(const u32x4*)(F.OG + ((size_t)2 * T + row) * 512 + 8 * F.lane);
          f32x4 a0, a1, b0, b1, c0, c1; pg8::unpack8(a, a0, a1); pg8::unpack8(b, b0, b1); pg8::unpack8(c, c0, c1);
          const f32x4 o0 = a0 * w0 + b0 * w1 + c0 * w2, o1 = a1 * w0 + b1 * w1 + c1 * w2;
          u32x4 w; w.x = pk2(o0[0], o0[1]); w.y = pk2(o0[2], o0[3]); w.z = pk2(o1[0], o1[1]); w.w = pk2(o1[2], o1[3]);
          *(u32x4*)(F.AM + (size_t)row * AMLD + 8 * F.lane) = w; }
        { f32x4 v[4]; float s = 0.f;
#if FAST_MLSTM
          { const bf16* hp = (const bf16*)F.HT + (size_t)row * D + 16 * F.lane; const u32x4 w0 = *(const u32x4*)hp, w1 = *(const u32x4*)(hp + 8); pg8::unpack8(w0, v[0], v[1]); pg8::unpack8(w1, v[2], v[3]); }
#else
          { const float* hp = F.HT + (size_t)row * D + 16 * F.lane;
#pragma unroll
            for (int j = 0; j < 4; ++j) v[j] = *(const f32x4*)(hp + 4 * j); }
#endif
#pragma unroll
          for (int j = 0; j < 4; ++j) s += (v[j].x + v[j].y) + (v[j].z + v[j].w);
          s += __shfl_xor(s, 1); s += __shfl_xor(s, 2); s += __shfl_xor(s, 4); s += __shfl_xor(s, 8);
          const float mu = s * (1.0f / 256.0f); float q = 0.f;
#pragma unroll
          for (int j = 0; j < 4; ++j) { v[j] = v[j] - mu; q += (v[j].x * v[j].x + v[j].y * v[j].y) + (v[j].z * v[j].z + v[j].w * v[j].w); }
          q += __shfl_xor(q, 1); q += __shfl_xor(q, 2); q += __shfl_xor(q, 4); q += __shfl_xor(q, 8);
          const float rstd = 1.0f / sqrtf(q * (1.0f / 256.0f) + LN_EPS);
          const bf16* mo = F.PROJ + (size_t)row * NP + C_MO + 16 * F.lane; bf16* op = F.AM + (size_t)row * AMLD + 512 + 16 * F.lane;
#pragma unroll
          for (int jj = 0; jj < 2; ++jj) { const u32x4 mw = *(const u32x4*)(mo + 8 * jj); f32x4 m0, m1; pg8::unpack8(mw, m0, m1);
              const f32x4 g0 = *(const f32x4*)(F.g_mnorm + 16 * F.lane + 8 * jj), g1 = *(const f32x4*)(F.g_mnorm + 16 * F.lane + 8 * jj + 4);
              const f32x4 o0 = v[2 * jj] * rstd * g0 * pg8::sig4(m0), o1 = v[2 * jj + 1] * rstd * g1 * pg8::sig4(m1);
              u32x4 w; w.x = pk2(o0[0], o0[1]); w.y = pk2(o0[2], o0[3]); w.z = pk2(o1[0], o1[1]); w.w = pk2(o1[2], o1[3]);
              *(u32x4*)(op + 8 * jj) = w; } }
    }
}

constexpr int RT_WS = 1028;
constexpr int RT_TAB = NE * RT_WS * 4, RT_CNT = RT_TAB + 64 * 4 * 12;
static_assert(RT_CNT + 256 <= LDSCTL_OFF, "router LDS map");
__device__ __forceinline__ void p6_router(Frame& F) {
    LAS float* wt = (LAS float*)F.lds;
    LAS int* tab = (LAS int*)(F.lds + RT_TAB); LAS int* cntl = (LAS int*)(F.lds + RT_CNT); LAS int* basel = cntl + 32;
    const int lane = F.lane;
    for (int r0 = 0; r0 < T; r0 += F.NGW * 8) {
        __syncthreads();
        if (r0 == 0) for (int i = F.tid; i < D * NE; i += NTHREADS) wt[(i & 31) * RT_WS + (i >> 5)] = F.w_router[i];
        if (F.tid < 32) cntl[F.tid] = 0;
        __syncthreads();
        f32x4 vn[4];
        { const int row = r0 + F.gw; if (row < T) { const f32x4* hr = (const f32x4*)(F.H + (size_t)row * D) + lane;
#pragma unroll
            for (int j = 0; j < 4; ++j) vn[j] = hr[64 * j]; } }
        for (int ri = 0; ri < 8; ++ri) {
            const int row = r0 + ri * F.NGW + F.gw; if (row >= T) break;
            f32x4 v[4]; float s = 0.f;
#pragma unroll
            for (int j = 0; j < 4; ++j) { v[j] = vn[j]; s += (v[j].x * v[j].x + v[j].y * v[j].y) + (v[j].z * v[j].z + v[j].w * v[j].w); }
            { const int rown = row + F.NGW; if (ri + 1 < 8 && rown < T) { const f32x4* hr = (const f32x4*)(F.H + (size_t)rown * D) + lane;
#pragma unroll
                for (int j = 0; j < 4; ++j) vn[j] = hr[64 * j]; } }
            const float rstd = 1.0f / sqrtf(wave_sum(s) * (1.0f / D) + RMS_EPS);
            unsigned long long* o8 = (unsigned long long*)(F.XN + (size_t)row * D) + lane;
#pragma unroll
            for (int j = 0; j < 4; ++j) { const f32x4 g = *((const f32x4*)F.g_ffn + lane + 64 * j); v[j] = v[j] * rstd * g;
#if MOE_FP8
                ((unsigned*)((unsigned char*)F.XN + (size_t)row * D))[lane + 64 * j] = pk4_fp8(v[j].x, v[j].y, v[j].z, v[j].w); }
#else
                o8[64 * j] = (unsigned long long)pk2(v[j].x, v[j].y) | ((unsigned long long)pk2(v[j].z, v[j].w) << 32); }
#endif
            float lg[32];
#pragma unroll
            for (int e = 0; e < 32; ++e) { float a = 0.f;
#pragma unroll
                for (int j = 0; j < 4; ++j) { const f32x4 w = *((const LAS f32x4*)(wt + e * RT_WS) + lane + 64 * j); a += (v[j].x * w.x + v[j].y * w.y) + (v[j].z * w.z + v[j].w * w.w); }
                lg[e] = a; if ((e & 3) == 3) asm volatile("" ::: "memory"); }
#define RT_BF(N_, O_) do { const bool up = (lane & (O_)) != 0; _Pragma("unroll") for (int i = 0; i < (N_); ++i) { const float send = up ? lg[i] : lg[i + (N_)]; const float keep = up ? lg[i + (N_)] : lg[i]; lg[i] = keep + __shfl_xor(send, (O_)); } } while (0)
            RT_BF(16, 32); RT_BF(8, 16); RT_BF(4, 8); RT_BF(2, 4); RT_BF(1, 2);
#undef RT_BF
            float lgt = lg[0] + __shfl_xor(lg[0], 1);
            const int e = (lane >> 1) & 31;
            lgt += F.b_router[e];
            float tv[4]; int ti[4]; float cur = lgt;
#pragma unroll
            for (int r = 0; r < 4; ++r) { float bv = cur; int bi = e;
#pragma unroll
                for (int o = 2; o < 64; o <<= 1) { const float ov = __shfl_xor(bv, o); const int oi = __shfl_xor(bi, o); if (ov > bv || (ov == bv && oi < bi)) { bv = ov; bi = oi; } }
                tv[r] = bv; ti[r] = bi; if (e == bi) cur = -INFINITY; }
            const float e1 = __expf(tv[1] - tv[0]), e2 = __expf(tv[2] - tv[0]), e3 = __expf(tv[3] - tv[0]), inv = 1.0f / (1.0f + e1 + e2 + e3);
            if (lane < 4) {
                const int ee = (lane == 0) ? ti[0] : (lane == 1) ? ti[1] : (lane == 2) ? ti[2] : ti[3];
                const float ww = ((lane == 0) ? 1.0f : (lane == 1) ? e1 : (lane == 2) ? e2 : e3) * inv;
                const int loc = __hip_atomic_fetch_add(cntl + ee, 1, __ATOMIC_RELAXED, __HIP_MEMORY_SCOPE_WORKGROUP);
                LAS int* tp = tab + ((ri * 8 + F.wave) * 4 + lane) * 3; tp[0] = ee; tp[1] = loc; tp[2] = __float_as_int(ww);
            }
        }
        __syncthreads();
        if (F.tid < 32) basel[F.tid] = (int)atomicAdd(F.ctl + CW_CNT + 64 * F.tid, (unsigned)cntl[F.tid]);
        __syncthreads();
        if (lane < 4) for (int ri = 0; ri < 8; ++ri) {
            const int row = r0 + ri * F.NGW + F.gw; if (row >= T) break;
            const LAS int* tp = tab + ((ri * 8 + F.wave) * 4 + lane) * 3; const int ee = tp[0];
            F.TOK_E[row * 4 + lane] = ee; F.TOK_SLOT[row * 4 + lane] = basel[ee] + tp[1]; F.TOK_W[row * 4 + lane] = __int_as_float(tp[2]);
        }
    }
}

constexpr int RM_WS = 2064;
constexpr int RM_HI = 0, RM_LO = NE * RM_WS, RM_RSTD = 2 * NE * RM_WS, RM_TAB = RM_RSTD + 256, RM_CNT = RM_TAB + 64 * 4 * 12;
static_assert(RM_CNT + 256 <= LDSCTL_OFF, "router LDS map");
__device__ __forceinline__ void p6_router_mfma(Frame& F) {
    LAS unsigned char* L = F.lds;
    LAS float* rstdl = (LAS float*)(L + RM_RSTD); LAS int* tab = (LAS int*)(L + RM_TAB); LAS int* cntl = (LAS int*)(L + RM_CNT); LAS int* basel = cntl + 32;
    const int lane = F.lane, fr = lane & 15, fq = lane >> 4, w = F.wave;
    __syncthreads();
    for (int i0 = F.tid; i0 < D * NE; i0 += 16 * NTHREADS) {
        float wv[16], gv[16];
#pragma unroll
        for (int j = 0; j < 16; ++j) { const int i = i0 + j * NTHREADS; wv[j] = F.w_router[i]; gv[j] = F.g_ffn[i >> 5]; }
#pragma unroll
        for (int j = 0; j < 16; ++j) { const int i = i0 + j * NTHREADS, k = i >> 5, e = i & 31; const float w = wv[j] * gv[j];
            const unsigned hi = f2bf(w), lo = f2bf(w - bf2f(hi));
            *(LAS bf16*)(L + RM_HI + e * RM_WS + 2 * k) = (bf16)hi; *(LAS bf16*)(L + RM_LO + e * RM_WS + 2 * k) = (bf16)lo; } }
    const float br0 = F.b_router[fr], br1 = F.b_router[16 + fr];
    for (int rg = F.vcu; rg < T / 64; rg += F.G) {
        __syncthreads();
        if (F.tid < 32) cntl[F.tid] = 0;
        __syncthreads();
        if (w < 4) {
            const int row0 = rg * 64 + 16 * w;
            const float* hp = F.H + (size_t)(row0 + fr) * D + 8 * fq;
            const LAS unsigned char* bh = L + RM_HI + fr * RM_WS + 16 * fq; const LAS unsigned char* bl = L + RM_LO + fr * RM_WS + 16 * fq;
            f32x4 acc[2] = {(f32x4){0.f, 0.f, 0.f, 0.f}, (f32x4){0.f, 0.f, 0.f, 0.f}}; float ss = 0.f;
#pragma unroll 4
            for (int ks = 0; ks < 32; ++ks) {
                const f32x4 a0 = *(const f32x4*)(hp + 32 * ks), a1 = *(const f32x4*)(hp + 32 * ks + 4);
                ss += (a0.x * a0.x + a0.y * a0.y) + (a0.z * a0.z + a0.w * a0.w) + (a1.x * a1.x + a1.y * a1.y) + (a1.z * a1.z + a1.w * a1.w);
                u32x4 hw; hw.x = pk2(a0.x, a0.y); hw.y = pk2(a0.z, a0.w); hw.z = pk2(a1.x, a1.y); hw.w = pk2(a1.z, a1.w);
                u32x4 lw; lw.x = pk2(a0.x - bflo(hw.x), a0.y - bfhi(hw.x)); lw.y = pk2(a0.z - bflo(hw.y), a0.w - bfhi(hw.y));
                lw.z = pk2(a1.x - bflo(hw.z), a1.y - bfhi(hw.z)); lw.w = pk2(a1.z - bflo(hw.w), a1.w - bfhi(hw.w));
                const bf16x8 ahi = __builtin_bit_cast(bf16x8, hw), alo = __builtin_bit_cast(bf16x8, lw);
#pragma unroll
                for (int nt = 0; nt < 2; ++nt) { const bf16x8 bhi = *(const LAS bf16x8*)(bh + 16 * nt * RM_WS + 64 * ks), blo = *(const LAS bf16x8*)(bl + 16 * nt * RM_WS + 64 * ks);
                    acc[nt] = __builtin_amdgcn_mfma_f32_16x16x32_bf16(ahi, bhi, acc[nt], 0, 0, 0);
                    acc[nt] = __builtin_amdgcn_mfma_f32_16x16x32_bf16(ahi, blo, acc[nt], 0, 0, 0);
                    acc[nt] = __builtin_amdgcn_mfma_f32_16x16x32_bf16(alo, bhi, acc[nt], 0, 0, 0); }
            }
            ss += __shfl_xor(ss, 16); ss += __shfl_xor(ss, 32);
            const float rstd = 1.0f / sqrtf(ss * (1.0f / D) + RMS_EPS);
            if (fq == 0) rstdl[16 * w + fr] = rstd;
#pragma unroll
            for (int reg = 0; reg < 4; ++reg) {
                const float rs = __shfl(rstd, 4 * fq + reg);
                float c0 = acc[0][reg] * rs + br0, c1 = acc[1][reg] * rs + br1;
                float tv[4]; int ti[4];
#pragma unroll
                for (int r = 0; r < 4; ++r) { float bv = (c0 >= c1) ? c0 : c1; int bi = (c0 >= c1) ? fr : 16 + fr;
#pragma unroll
                    for (int o = 1; o < 16; o <<= 1) { const float ov = __shfl_xor(bv, o); const int oi = __shfl_xor(bi, o); if (ov > bv || (ov == bv && oi < bi)) { bv = ov; bi = oi; } }
                    tv[r] = bv; ti[r] = bi; if (bi == fr) c0 = -INFINITY; if (bi == 16 + fr) c1 = -INFINITY; }
                const float e1 = __expf(tv[1] - tv[0]), e2 = __expf(tv[2] - tv[0]), e3 = __expf(tv[3] - tv[0]), inv = 1.0f / (1.0f + e1 + e2 + e3);
                if (fr < 4) {
                    const int ee = (fr == 0) ? ti[0] : (fr == 1) ? ti[1] : (fr == 2) ? ti[2] : ti[3];
                    const float ww = ((fr == 0) ? 1.0f : (fr == 1) ? e1 : (fr == 2) ? e2 : e3) * inv;
                    const int loc = __hip_atomic_fetch_add(cntl + ee, 1, __ATOMIC_RELAXED, __HIP_MEMORY_SCOPE_WORKGROUP);
                    LAS int* tp = tab + ((16 * w + 4 * fq + reg) * 4 + fr) * 3; tp[0] = ee; tp[1] = loc; tp[2] = __float_as_int(ww);
                }
            }
        }
        __syncthreads();
        if (F.tid < 32) basel[F.tid] = (int)atomicAdd(F.ctl + CW_CNT + 64 * F.tid, (unsigned)cntl[F.tid]);
#pragma unroll 2
        for (int i = 0; i < 8; ++i) { const int rl = 8 * w + i, row = rg * 64 + rl; const float rs = rstdl[rl];
            const f32x4* hr = (const f32x4*)(F.H + (size_t)row * D) + lane;
#pragma unroll
            for (int j = 0; j < 4; ++j) { const f32x4 g = *((const f32x4*)F.g_ffn + lane + 64 * j); const f32x4 v = hr[64 * j] * rs * g;
                ((unsigned*)((unsigned char*)F.XN + (size_t)row * D))[lane + 64 * j] = pk4_fp8(v.x, v.y, v.z, v.w); } }
        __syncthreads();
        if (F.tid < 256) { const int rl = F.tid >> 2, k = F.tid & 3, row = rg * 64 + rl; const LAS int* tp = tab + (rl * 4 + k) * 3; const int ee = tp[0];
            F.TOK_E[row * 4 + k] = ee; F.TOK_SLOT[row * 4 + k] = basel[ee] + tp[1]; F.TOK_W[row * 4 + k] = __int_as_float(tp[2]); }
    }
}

__device__ __forceinline__ void p7_gather(Frame& F) {
    LAS int* pst = (LAS int*)F.lds;
    LAS int* cntl = pst + 64;
    int tid = (int)threadIdx.x; asm volatile("" : "+v"(tid));
    __syncthreads();
    if (tid < NE) cntl[tid] = (int)F.ctl[CW_CNT + 64 * tid];
    __syncthreads();
    if (tid == 0) { int acc = 0; for (int e = 0; e < NE; ++e) { pst[e] = acc; acc += (cntl[e] + 255) & ~255; } pst[NE] = acc; }
    __syncthreads();
    if (blockIdx.x == 0) {
        if (tid == 0) F.ctl[CW_NTILES] = (unsigned)(pst[NE] >> 8);
        if (tid < NE) { const int t0 = pst[tid] >> 8, t1 = pst[tid + 1] >> 8; for (int k = t0; k < t1; ++k) F.ctl[CW_TILEE + k] = (unsigned)tid; }
    }
#if MOE_FP8
    { const int gthreads = F.G * NTHREADS, gtid = F.vcu * NTHREADS + F.tid;
      for (int a = gtid; a < NA; a += gthreads) { const int e = F.TOK_E[a], dest = pst[e] + F.TOK_SLOT[a]; F.ROW_TOK[dest] = a; F.ROW_W[dest] = F.TOK_W[a]; }
      for (int e = 0; e < NE; ++e) { const int c = cntl[e], pe = (c + 255) & ~255;
          for (int r = c + gtid; r < pe; r += gthreads) { F.ROW_TOK[pst[e] + r] = -1; F.ROW_W[pst[e] + r] = 0.f; } } }
#else
    for (int a = F.gw; a < NA; a += F.NGW) {
        const int e = F.TOK_E[a], dest = pst[e] + F.TOK_SLOT[a];
        { const u32x4* src = (const u32x4*)(F.XN + (size_t)(a >> 2) * D) + F.lane; u32x4* dst = (u32x4*)(F.XS + (size_t)dest * D) + F.lane;
        const u32x4 v0 = src[0], v1 = src[64]; dst[0] = v0; dst[64] = v1; }
        if (F.lane == 0) { F.ROW_TOK[dest] = a; F.ROW_W[dest] = F.TOK_W[a]; }
    }
    for (int e = 0; e < NE; ++e) { const int c = cntl[e], pe = (c + 255) & ~255;
        for (int r = c + F.gw; r < pe; r += F.NGW) { const int dest = pst[e] + r; const u32x4 z = (u32x4){0u, 0u, 0u, 0u};
            { u32x4* dst = (u32x4*)(F.XS + (size_t)dest * D) + F.lane; dst[0] = z; dst[64] = z; }
            if (F.lane == 0) { F.ROW_TOK[dest] = -1; F.ROW_W[dest] = 0.f; } } }
#endif
}

__device__ __forceinline__ void p10_final(Frame& F) {
    f32x4 hn[4]; u32x2 yn[4][4];
#define P10_LOAD(r_) do { const f32x4* hr_ = (const f32x4*)(F.H + (size_t)(r_) * D) + F.lane; \
        _Pragma("unroll") for (int j = 0; j < 4; ++j) { hn[j] = hr_[64 * j]; _Pragma("unroll") for (int k = 0; k < 4; ++k) yn[j][k] = *((const u32x2*)(F.YBUF + ((size_t)(r_) * 4 + k) * D) + F.lane + 64 * j); } } while (0)
    if (F.gw < T) P10_LOAD(F.gw);
    for (int row = F.gw; row < T; row += F.NGW) {
        f32x4 v[4]; float s = 0.f;
#pragma unroll
        for (int j = 0; j < 4; ++j) { v[j] = hn[j];
#pragma unroll
            for (int k = 0; k < 4; ++k) { const u32x2 w = yn[j][k]; v[j].x += bflo(w.x); v[j].y += bfhi(w.x); v[j].z += bflo(w.y); v[j].w += bfhi(w.y); }
            s += (v[j].x * v[j].x + v[j].y * v[j].y) + (v[j].z * v[j].z + v[j].w * v[j].w); }
        if (row + F.NGW < T) P10_LOAD(row + F.NGW);
        const float rstd = 1.0f / sqrtf(wave_sum(s) * (1.0f / D) + RMS_EPS);
        f32x4* orow = (f32x4*)(F.out + (size_t)row * D) + F.lane;
#pragma unroll
        for (int j = 0; j < 4; ++j) { const f32x4 g = *((const f32x4*)F.g_final + F.lane + 64 * j); orow[64 * j] = v[j] * rstd * g; }
    }
#undef P10_LOAD
}

typedef float f32x16 __attribute__((ext_vector_type(16)));
typedef short s16x4 __attribute__((ext_vector_type(4)));
constexpr int ATT_SCR_OFF = RING_BYTES;
__device__ __forceinline__ int crow16(int r, int hi) { return (r & 3) + 8 * (r >> 2) + 4 * hi; }
__device__ __forceinline__ s16x4 lds_tr16(const LAS unsigned char* p) { return __builtin_bit_cast(s16x4, __builtin_amdgcn_ds_read_tr16_b64_v4i16((LAS s16x4*)p)); }

struct AttItem { int b, g, hd, r, n, d; };
__device__ __forceinline__ AttItem att_decode(int it) {
    AttItem a; const int i = it >> 8, c = it & 255; a.g = i % 3; const int idx = (i / 3) * 256 + c, rn = idx & 15; a.b = idx >> 6; a.hd = (idx >> 4) & 3;
    a.r = (a.g == 0) ? 0 : (a.g == 1) ? (rn >> 2) : rn; a.n = (a.g == 0) ? rn : (a.g == 1) ? (rn & 3) : 0; a.d = (a.g == 0) ? 1 : (a.g == 1) ? 4 : 16; return a;
}
__device__ __forceinline__ const bf16* att_base(Frame& F, const AttItem& a) { return F.PROJ + (size_t)(a.b * SEQ + a.r) * NP + a.g * 512 + a.hd * 128; }
#define ATT_LOADKV(dst, a_, coff_) do { const bf16* base_ = att_base(F, a_) + (coff_) + 8 * (F.tid & 15); const size_t rs_ = (size_t)(a_).d * NP; const int i0_ = 128 * ((a_).n - 1) + (F.tid >> 4); \
        _Pragma("unroll") for (int p_ = 0; p_ < 8; ++p_) { if ((a_).n == 0 && p_ < 4) continue; dst[p_] = *(const u32x4*)(base_ + (size_t)(i0_ + 32 * p_) * rs_); } } while (0)

__device__ __forceinline__ void attn_phase(Frame& F) {
    const int lane = F.lane, w = F.wave, fr = lane & 15, fq = lane >> 4;
    LAS unsigned char* Ks = F.lds; LAS unsigned char* Vs = F.lds + 65536;
    const int kc = F.tid & 15, kk0 = F.tid >> 4;
    u32x4 kreg[8], vreg[8]; bf16x8 qn[4];
#define ATT_LOADQ(dst, a_) do { const bf16* qrow_ = att_base(F, a_) + (size_t)(128 * (a_).n + 16 * w + fr) * ((size_t)(a_).d * NP) + C_AQ + 8 * fq; \
        _Pragma("unroll") for (int s_ = 0; s_ < 4; ++s_) dst[s_] = *(const bf16x8*)(qrow_ + 32 * s_); } while (0)
#if ATT_QUEUE
    LAS int* slot = (LAS int*)(F.lds + RING_BYTES);
    int pend = 0;
    __syncthreads();
    if (F.tid == 0) { const int g0 = (int)atomicAdd(F.ctl + CW_ACTR, 2u); slot[0] = g0; pend = g0 + 1; }
    __syncthreads();
    int it = __builtin_amdgcn_readfirstlane(slot[0]);
#else
    int it = F.vcu;
#endif
    if (it < 1536) { const AttItem a0 = att_decode(it); ATT_LOADKV(kreg, a0, C_AK); ATT_LOADKV(vreg, a0, C_AV); ATT_LOADQ(qn, a0); }
    while (it < 1536) {
        const AttItem a = att_decode(it); const int n = a.n, d = a.d;
        __syncthreads();
#if ATT_QUEUE
        if (F.tid == 0) { slot[0] = pend; pend = (int)atomicAdd(F.ctl + CW_ACTR, 1u); }
#endif
#pragma unroll
        for (int pass = 0; pass < 8; ++pass) { if (n == 0 && pass < 4) continue; const int key = pass * 32 + kk0;
            *(LAS u32x4*)(Ks + key * 256 + ((kc ^ (key & 15)) << 4)) = kreg[pass];
            *(LAS u32x4*)(Vs + key * 256 + ((((kc >> 2) ^ (key & 3)) << 6) | ((kc & 3) << 4))) = vreg[pass]; }
        bf16x8 qf[4];
#pragma unroll
        for (int s = 0; s < 4; ++s) qf[s] = qn[s];
        __syncthreads();
        f32x4 S[10];
#pragma unroll
        for (int i = 0; i < 9; ++i) {
            const int kt = w + i; const bool act = !(n == 0 && kt < 8);
            f32x4 acc = (f32x4){0.f, 0.f, 0.f, 0.f};
            if (act) {
                const LAS unsigned char* kp = Ks + (kt * 16 + fr) * 256;
#pragma unroll
                for (int s = 0; s < 4; ++s) { const bf16x8 kf = *(const LAS bf16x8*)(kp + (((4 * s + fq) ^ fr) << 4)); acc = __builtin_amdgcn_mfma_f32_16x16x32_bf16(kf, qf[s], acc, 0, 0, 0); }
                if (i == 0) {
#pragma unroll
                    for (int r = 0; r < 4; ++r) if (4 * fq + r < fr) acc[r] = -INFINITY; }
                if (i == 8) {
#pragma unroll
                    for (int r = 0; r < 4; ++r) if (4 * fq + r > fr) acc[r] = -INFINITY; }
            } else acc = (f32x4){-INFINITY, -INFINITY, -INFINITY, -INFINITY};
            S[i] = acc;
        }
        float m = -INFINITY;
#pragma unroll
        for (int i = 0; i < 9; ++i)
#pragma unroll
            for (int r = 0; r < 4; ++r) m = fmaxf(m, S[i][r]);
        m = fmaxf(m, __shfl_xor(m, 16)); m = fmaxf(m, __shfl_xor(m, 32));
        float l = 0.f;
#pragma unroll
        for (int i = 0; i < 9; ++i)
#pragma unroll
            for (int r = 0; r < 4; ++r) { const float p = __builtin_amdgcn_exp2f(S[i][r] - m); S[i][r] = p; l += p; }
        l += __shfl_xor(l, 16); l += __shfl_xor(l, 32);
        S[9] = (f32x4){0.f, 0.f, 0.f, 0.f};
#if ATT_QUEUE
        const int itn = __builtin_amdgcn_readfirstlane(slot[0]);
#else
        const int itn = it + F.G;
#endif
        if (itn < 1536) { const AttItem an = att_decode(itn); ATT_LOADKV(kreg, an, C_AK); ATT_LOADKV(vreg, an, C_AV); ATT_LOADQ(qn, an); }
        f32x4 O[8];
#pragma unroll
        for (int t = 0; t < 8; ++t) O[t] = (f32x4){0.f, 0.f, 0.f, 0.f};
        const int q4 = fr >> 2, p4 = lane & 3;
#pragma unroll
        for (int p = 0; p < 5; ++p) {
            const int kt0 = w + 2 * p, kt1 = kt0 + 1;
            const bool act0 = !(n == 0 && kt0 < 8), act1 = (2 * p + 1 < 9) && !(n == 0 && kt1 < 8);
            if (act0 || act1) {
                u32x4 pw; pw.x = pg8::cvt_pk_bf16(S[2 * p][0], S[2 * p][1]); pw.y = pg8::cvt_pk_bf16(S[2 * p][2], S[2 * p][3]);
                pw.z = pg8::cvt_pk_bf16(S[2 * p + 1][0], S[2 * p + 1][1]); pw.w = pg8::cvt_pk_bf16(S[2 * p + 1][2], S[2 * p + 1][3]);
                const bf16x8 pa = __builtin_bit_cast(bf16x8, pw);
                const int key0 = kt0 * 16 + 4 * fq + q4, key1 = kt1 * 16 + 4 * fq + q4;
#pragma unroll
                for (int t = 0; t < 8; ++t) {
                    const int col = 16 * t + 4 * p4;
                    const int coff = ((((col >> 5) ^ q4) << 6) | ((col & 31) << 1));
                    s16x4 lo = (s16x4){0, 0, 0, 0}, hi = (s16x4){0, 0, 0, 0};
                    if (act0) lo = lds_tr16(Vs + key0 * 256 + coff);
                    if (act1) hi = lds_tr16(Vs + key1 * 256 + coff);
                    const bf16x8 vb = (bf16x8){lo[0], lo[1], lo[2], lo[3], hi[0], hi[1], hi[2], hi[3]};
                    O[t] = __builtin_amdgcn_mfma_f32_16x16x32_bf16(pa, vb, O[t], 0, 0, 0);
                }
            }
        }
        const float linv = frcp(l);
        const size_t tok0 = (size_t)a.b * SEQ + a.r + (size_t)d * (128 * n + 16 * w);
        if (fq == 0) F.LSE[((size_t)a.g * T + tok0 + (size_t)d * fr) * 4 + a.hd] = m + __log2f(l);
#pragma unroll
        for (int r = 0; r < 4; ++r) {
            const int q = 4 * fq + r; const float rl = __shfl(linv, q);
            bf16* op = F.OG + ((size_t)a.g * T + tok0 + (size_t)d * q) * 512 + a.hd * 128 + fr;
#pragma unroll
            for (int t = 0; t < 8; ++t) op[16 * t] = (bf16)f2bf(O[t][r] * rl);
        }
        it = itn;
    }
    __syncthreads();
}
#undef ATT_LOADKV
#undef ATT_LOADQ

constexpr int ML_QS = 528, ML_AS = 144;
constexpr int ML_Q = 0, ML_K = 33792;
constexpr int SC_U = 0, SC_MX = 64, SC_EBD = 128, SC_WI = 192, SC_WK = 256, SC_DEC = 320;
__device__ __forceinline__ f32x4 mfma16(bf16x8 a, bf16x8 b, f32x4 c) { return __builtin_amdgcn_mfma_f32_16x16x32_bf16(a, b, c, 0, 0, 0); }


constexpr size_t WS_QK = WS_QC, WS_SCAL = WS_KC;
__device__ __forceinline__ void mlstm_prepass(Frame& F) {
    const int tid = F.tid, lane = F.lane;
    float* SCAL = (float*)((unsigned char*)F.ctl + WS_SCAL);
    bf16* QK = (bf16*)((unsigned char*)F.ctl + WS_QK);
    if (F.vcu < 32) {
        const int b = F.vcu >> 2, h = F.vcu & 3; const float* gbase = F.GATES + (size_t)(b * SEQ) * 8;
        LAS float* lu = (LAS float*)F.lds; LAS float* lpm = lu + 2048; LAS float* lbc = lpm + 2048; LAS float* lm = lbc + 2048;
        __syncthreads();
#pragma unroll
        for (int i = 0; i < 4; ++i) { const int c = 4 * F.wave + i;
            const float gi = gbase[(size_t)(64 * c + lane) * 8 + h], gf = gbase[(size_t)(64 * c + lane) * 8 + 4 + h];
            const float logf = fminf(gf, 0.f) - __logf(1.0f + __expf(-fabsf(gf)));
            float bc = logf;
#pragma unroll
            for (int o = 1; o < 64; o <<= 1) { const float v = __shfl_up(bc, o); if (lane >= o) bc += v; }
            const float u = gi - bc; float pm = u;
#pragma unroll
            for (int o = 1; o < 64; o <<= 1) { const float v = __shfl_up(pm, o); if (lane >= o) pm = fmaxf(pm, v); }
            lu[64 * c + lane] = u; lpm[64 * c + lane] = pm; lbc[64 * c + lane] = bc; }
        __syncthreads();
        if (tid == 0) { float m = 0.f; for (int c = 0; c < 32; ++c) { const float M63 = fmaxf(m, lpm[64 * c + 63]); lm[c] = m; lm[32 + c] = M63; m = lbc[64 * c + 63] + M63; } }
        __syncthreads();
#pragma unroll
        for (int i = 0; i < 4; ++i) { const int c = 4 * F.wave + i; const float m_carry = lm[c], M63 = lm[32 + c];
            const float u = lu[64 * c + lane], bc = lbc[64 * c + lane], Mx = fmaxf(m_carry, lpm[64 * c + lane]);
            float* sp = SCAL + ((size_t)F.vcu * 32 + c) * 384;
            sp[SC_U + lane] = u; sp[SC_MX + lane] = Mx; sp[SC_EBD + lane] = __expf(-(bc + Mx)); sp[SC_WI + lane] = __expf(m_carry - Mx); sp[SC_WK + lane] = __expf(u - M63);
            sp[SC_DEC + lane] = __expf(m_carry - M63); }
        __syncthreads();
    }
    const int rb = tid >> 8, half = (tid >> 7) & 1, cg = tid & 127;
    float cw[4][8];
#pragma unroll
    for (int j = 0; j < 4; ++j) { const float* p = F.conv_qk + j * 2048 + half * 1024 + 8 * cg; const f32x4 a = *(const f32x4*)p, c = *(const f32x4*)(p + 4);
        cw[j][0] = a[0]; cw[j][1] = a[1]; cw[j][2] = a[2]; cw[j][3] = a[3]; cw[j][4] = c[0]; cw[j][5] = c[1]; cw[j][6] = c[2]; cw[j][7] = c[3]; }
    const float oscale = half ? 0.0625f : 1.0f;
    for (int step = F.vcu; step < T / 16; step += F.G) {
        const int row0 = step * 16 + rb * 8, ts0 = row0 & (SEQ - 1);
        const bf16* src = F.PROJ + (size_t)row0 * NP + (half ? C_MK : C_MQ) + 8 * cg;
        u32x4 raw[11];
#pragma unroll
        for (int r = 0; r < 11; ++r) raw[r] = (ts0 - 3 + r >= 0) ? *(const u32x4*)(src + (ptrdiff_t)(r - 3) * NP) : (u32x4){0u, 0u, 0u, 0u};
        bf16* dst = QK + (size_t)row0 * 2048 + half * 1024 + 8 * cg;
        float xf[11][8];
#pragma unroll
        for (int r = 0; r < 11; ++r) { const u32x4 rw = raw[r]; xf[r][0] = bflo(rw.x); xf[r][1] = bfhi(rw.x); xf[r][2] = bflo(rw.y); xf[r][3] = bfhi(rw.y); xf[r][4] = bflo(rw.z); xf[r][5] = bfhi(rw.z); xf[r][6] = bflo(rw.w); xf[r][7] = bfhi(rw.w); }
#pragma unroll
        for (int o = 0; o < 8; ++o) {
            float y[8];
#pragma unroll
            for (int i = 0; i < 8; ++i) y[i] = (cw[0][i] * xf[o][i] + cw[1][i] * xf[o + 1][i]) + (cw[2][i] * xf[o + 2][i] + cw[3][i] * xf[o + 3][i]);
#pragma unroll
            for (int i = 0; i < 8; ++i) y[i] = y[i] * oscale * frcp(1.0f + __expf(-y[i]));
            u32x4 pw; pw.x = pk2(y[0], y[1]); pw.y = pk2(y[2], y[3]); pw.z = pk2(y[4], y[5]); pw.w = pk2(y[6], y[7]);
            *(u32x4*)(dst + (size_t)o * 2048) = pw; }
    }
}

template <int NDT> struct MLMap {
    static constexpr int VROWS = 16 * (NDT + 1), CT = ML_K + 64 * ML_QS, A = CT + VROWS * ML_QS, VT = A + 64 * ML_AS, VWT = VT + VROWS * ML_AS, SC = VWT + VROWS * ML_AS, END = SC + 4 * 384;
    static_assert(END <= LDSCTL_OFF, "mLSTM LDS map");
};
template <int NDT>
__device__ __forceinline__ void mlstm_item(Frame& F, int b, int h, int sl) {
    typedef MLMap<NDT> MP; constexpr int VROWS = MP::VROWS, PARTS = 2 * NDT, NT2 = NDT / 2, NB5 = NDT + 1;
    const int tid = F.tid, lane = F.lane, w = F.wave, fr = lane & 15, fq = lane >> 4;
    LAS unsigned char* L = F.lds; LAS float* SC = (LAS float*)(L + MP::SC);
    const bf16* qkbase = (const bf16*)((const unsigned char*)F.ctl + WS_QK) + (size_t)(b * SEQ) * 2048 + h * 256 + 8 * (tid & 31);
#ifndef VMAP
#define VMAP 1
#endif
    const bool vact = tid < 64 * PARTS; const int vs = VMAP ? (tid & 63) : (tid / PARTS), vpart = VMAP ? (tid >> 6) : (tid % PARTS);
    const bf16* vbase = F.PROJ + (size_t)(b * SEQ) * NP + C_MV + h * 256 + sl * (16 * NDT) + 8 * vpart;
    const float* scbase = (const float*)((const unsigned char*)F.ctl + WS_SCAL) + (size_t)((b * 4 + h) * 32) * 384 + (tid < 384 ? tid : 0);
    const float* wkbase = (const float*)((const unsigned char*)F.ctl + WS_SCAL) + (size_t)((b * 4 + h) * 32) * 384 + SC_WK + vs;
    __syncthreads();
    for (int i = tid; i < (MP::A - MP::CT) / 4; i += NTHREADS) ((LAS unsigned*)(L + MP::CT))[i] = 0u;
    for (int i = tid; i < (MP::SC - MP::VT) / 4; i += NTHREADS) ((LAS unsigned*)(L + MP::VT))[i] = 0u;
    __syncthreads();
    if (tid < 32) ((LAS unsigned*)(L + MP::VT + (16 * NDT) * ML_AS))[tid] = 0x3F803F80u;
    f32x4 C[2][NB5];
#pragma unroll
    for (int a = 0; a < 2; ++a)
#pragma unroll
        for (int bb = 0; bb < NB5; ++bb) C[a][bb] = (f32x4){0.f, 0.f, 0.f, 0.f};
    u32x4 qk[8]; u32x4 vraw = (u32x4){0u, 0u, 0u, 0u}; float scv = 0.f, wkv = 0.f;
    unsigned hpk[NT2][2];
#define ML_ISSUE(c_) do { const int t0_ = 64 * (c_); \
        _Pragma("unroll") for (int i_ = 0; i_ < 4; ++i_) { const bf16* p_ = qkbase + (size_t)(t0_ + (tid >> 5) + 16 * i_) * 2048; qk[i_] = *(const u32x4*)p_; qk[4 + i_] = *(const u32x4*)(p_ + 1024); } \
        if (vact) { vraw = *(const u32x4*)(vbase + (size_t)(t0_ + vs) * NP); wkv = wkbase[(size_t)(c_) * 384]; } \
        if (tid < 384) scv = scbase[(size_t)(c_) * 384]; } while (0)
    ML_ISSUE(0);
    for (int c = 0; c < 32; ++c) {
        { LAS unsigned char* dq = L + ML_Q + (tid >> 5) * ML_QS + 16 * (tid & 31);
#pragma unroll
          for (int i = 0; i < 4; ++i) { *(LAS u32x4*)(dq + 16 * i * ML_QS) = qk[i]; *(LAS u32x4*)(dq + (ML_K - ML_Q) + 16 * i * ML_QS) = qk[4 + i]; } }
        if (vact) { LAS bf16* vt = (LAS bf16*)(L + MP::VT) + vs; LAS bf16* vw = (LAS bf16*)(L + MP::VWT) + vs;
            const float vf[8] = {bflo(vraw.x), bfhi(vraw.x), bflo(vraw.y), bfhi(vraw.y), bflo(vraw.z), bfhi(vraw.z), bflo(vraw.w), bfhi(vraw.w)};
            const unsigned vr[4] = {vraw.x, vraw.y, vraw.z, vraw.w};
#pragma unroll
            for (int i = 0; i < 4; ++i) { const unsigned pw = pk2(vf[2 * i] * wkv, vf[2 * i + 1] * wkv);
                vt[(8 * vpart + 2 * i) * (ML_AS / 2)] = (bf16)(vr[i] & 0xffffu); vt[(8 * vpart + 2 * i + 1) * (ML_AS / 2)] = (bf16)(vr[i] >> 16);
                vw[(8 * vpart + 2 * i) * (ML_AS / 2)] = (bf16)(pw & 0xffffu); vw[(8 * vpart + 2 * i + 1) * (ML_AS / 2)] = (bf16)(pw >> 16); } }
        if (tid >= 256 && tid < 320) ((LAS bf16*)(L + MP::VWT))[(16 * NDT) * (ML_AS / 2) + tid - 256] = (bf16)f2bf(scv);
        if (tid < 384) SC[tid] = scv;
        __syncthreads();
        if (c > 0) { bf16* hpp = (bf16*)F.HT + (size_t)(b * SEQ + 64 * (c - 1) + 16 * (w & 3) + 4 * fq) * D + h * 256 + sl * (16 * NDT) + 16 * ((w >> 2) * NT2) + fr;
#pragma unroll
            for (int j = 0; j < NT2; ++j) { hpp[16 * j] = (bf16)(hpk[j][0] & 0xffffu); hpp[(size_t)D + 16 * j] = (bf16)(hpk[j][0] >> 16); hpp[(size_t)2 * D + 16 * j] = (bf16)(hpk[j][1] & 0xffffu); hpp[(size_t)3 * D + 16 * j] = (bf16)(hpk[j][1] >> 16); } }
        if (c + 1 < 32) ML_ISSUE(c + 1);
        const int ti = w & 3;
#ifndef DUP_B
#define DUP_B 1
#endif
        for (int dupb = 0; dupb < DUP_B; ++dupb)
        { const int si0 = (w >> 2) * 2;
          const LAS unsigned char* qp = L + ML_Q + (16 * ti + fr) * ML_QS + 16 * fq;
          const LAS unsigned char* kp = L + ML_K + (16 * si0 + fr) * ML_QS + 16 * fq;
          f32x4 sacc[2] = {(f32x4){0.f, 0.f, 0.f, 0.f}, (f32x4){0.f, 0.f, 0.f, 0.f}};
#pragma unroll
          for (int hb = 0; hb < 2; ++hb) {
              bf16x8 qa[4], k0[4], k1[4];
#pragma unroll
              for (int kk = 0; kk < 4; ++kk) { qa[kk] = *(const LAS bf16x8*)(qp + 64 * (4 * hb + kk)); k0[kk] = *(const LAS bf16x8*)(kp + 64 * (4 * hb + kk)); k1[kk] = *(const LAS bf16x8*)(kp + 16 * ML_QS + 64 * (4 * hb + kk)); }
              __builtin_amdgcn_sched_barrier(0);
#pragma unroll
              for (int kk = 0; kk < 4; ++kk) { sacc[0] = mfma16(k0[kk], qa[kk], sacc[0]); sacc[1] = mfma16(k1[kk], qa[kk], sacc[1]); }
          }
          { const int t = 16 * ti + fr; const float mxt = SC[SC_MX + t];
#pragma unroll
            for (int si = 0; si < 2; ++si) { const int s0 = 16 * (si0 + si) + 4 * fq; const f32x4 us = *(const LAS f32x4*)(SC + SC_U + s0); float val[4];
#pragma unroll
                for (int r = 0; r < 4; ++r) val[r] = (s0 + r <= t) ? sacc[si][r] * __expf(us[r] - mxt) : 0.f;
                u32x2 pw; pw.x = pk2(val[0], val[1]); pw.y = pk2(val[2], val[3]);
                *(LAS u32x2*)(L + MP::A + t * ML_AS + 2 * s0) = pw; } } }
        __syncthreads();
        { const int dj0 = (w >> 2) * NT2;
          const LAS unsigned char* ap = L + MP::A + (16 * ti + fr) * ML_AS + 16 * fq;
          const LAS unsigned char* vp = L + MP::VT + (16 * dj0 + fr) * ML_AS + 16 * fq; const LAS unsigned char* ep = L + MP::VT + (16 * NDT + fr) * ML_AS + 16 * fq;
          const LAS unsigned char* cp = L + MP::CT + (16 * dj0 + fr) * ML_QS + 16 * fq; const LAS unsigned char* cep = L + MP::CT + (16 * NDT + fr) * ML_QS + 16 * fq;
          bf16x8 aa[2], vv[NT2][2], ee[2], afr[2][2], bw[2][NB5];
#pragma unroll
          for (int ks = 0; ks < 2; ++ks) { aa[ks] = *(const LAS bf16x8*)(ap + 64 * ks); ee[ks] = *(const LAS bf16x8*)(ep + 64 * ks);
#pragma unroll
              for (int j = 0; j < NT2; ++j) vv[j][ks] = *(const LAS bf16x8*)(vp + 16 * j * ML_AS + 64 * ks); }
          const int q4 = fr >> 2, p4 = lane & 3;
#pragma unroll
          for (int ks = 0; ks < 2; ++ks) {
#pragma unroll
              for (int a = 0; a < 2; ++a) { const LAS unsigned char* kp = L + ML_K + (32 * ks + 8 * fq + q4) * ML_QS + (16 * (2 * w + a) + 4 * p4) * 2;
                  const s16x4 lo = lds_tr16(kp), hi = lds_tr16(kp + 4 * ML_QS); afr[ks][a] = (bf16x8){lo[0], lo[1], lo[2], lo[3], hi[0], hi[1], hi[2], hi[3]}; }
#pragma unroll
              for (int bb = 0; bb < NB5; ++bb) bw[ks][bb] = *(const LAS bf16x8*)(L + MP::VWT + (16 * bb + fr) * ML_AS + 16 * fq + 64 * ks); }
          const float dec = SC[SC_DEC];
          f32x4 wi4, eb4;
#pragma unroll
          for (int r = 0; r < 4; ++r) { wi4[r] = SC[SC_WI + 16 * ti + 4 * fq + r]; eb4[r] = SC[SC_EBD + 16 * ti + 4 * fq + r]; }
          __builtin_amdgcn_sched_barrier(0);
          f32x4 av[NT2], av2[NT2], ae = (f32x4){0.f, 0.f, 0.f, 0.f}, ae2 = ae;
#pragma unroll
          for (int j = 0; j < NT2; ++j) { av[j] = (f32x4){0.f, 0.f, 0.f, 0.f}; av2[j] = av[j]; }
#pragma unroll
          for (int a = 0; a < 2; ++a)
#pragma unroll
              for (int bb = 0; bb < NB5; ++bb) C[a][bb] *= dec;
#pragma unroll
          for (int ks = 0; ks < 2; ++ks) { ae = mfma16(aa[ks], ee[ks], ae);
#pragma unroll
              for (int j = 0; j < NT2; ++j) av[j] = mfma16(aa[ks], vv[j][ks], av[j]); }
#pragma unroll
          for (int ks = 0; ks < 2; ++ks)
#pragma unroll
              for (int bb = 0; bb < NB5; ++bb) { C[0][bb] = mfma16(afr[ks][0], bw[ks][bb], C[0][bb]); C[1][bb] = mfma16(afr[ks][1], bw[ks][bb], C[1][bb]); }
          __builtin_amdgcn_sched_barrier(0);
          { const LAS unsigned char* qp = L + ML_Q + (16 * ti + fr) * ML_QS + 16 * fq;
#pragma unroll
            for (int hb = 0; hb < 2; ++hb) {
                bf16x8 qa[4], cc[NT2][4], ce[4];
#pragma unroll
                for (int kk = 0; kk < 4; ++kk) { qa[kk] = *(const LAS bf16x8*)(qp + 64 * (4 * hb + kk)); ce[kk] = *(const LAS bf16x8*)(cep + 64 * (4 * hb + kk));
#pragma unroll
                    for (int j = 0; j < NT2; ++j) cc[j][kk] = *(const LAS bf16x8*)(cp + 16 * j * ML_QS + 64 * (4 * hb + kk)); }
                __builtin_amdgcn_sched_barrier(0);
#pragma unroll
                for (int kk = 0; kk < 4; ++kk) { ae2 = mfma16(qa[kk], ce[kk], ae2);
#pragma unroll
                    for (int j = 0; j < NT2; ++j) av2[j] = mfma16(qa[kk], cc[j][kk], av2[j]); }
            } }
          float rd[4];
#pragma unroll
          for (int r = 0; r < 4; ++r) { float dn = ae[r] + wi4[r] * ae2[r]; dn = __shfl(dn, lane & 48); rd[r] = frcp(fmaxf(fabsf(dn), eb4[r])); }
#pragma unroll
          for (int j = 0; j < NT2; ++j) { hpk[j][0] = pk2((av[j][0] + wi4[0] * av2[j][0]) * rd[0], (av[j][1] + wi4[1] * av2[j][1]) * rd[1]);
              hpk[j][1] = pk2((av[j][2] + wi4[2] * av2[j][2]) * rd[2], (av[j][3] + wi4[3] * av2[j][3]) * rd[3]); } }
        __syncthreads();
#pragma unroll
        for (int a = 0; a < 2; ++a)
#pragma unroll
            for (int bb = 0; bb < NB5; ++bb) { u32x2 pw; pw.x = pk2(C[a][bb][0], C[a][bb][1]); pw.y = pk2(C[a][bb][2], C[a][bb][3]);
                *(LAS u32x2*)(L + MP::CT + (16 * bb + fr) * ML_QS + (16 * (2 * w + a) + 4 * fq) * 2) = pw; }
    }
#undef ML_ISSUE
    { bf16* hpp = (bf16*)F.HT + (size_t)(b * SEQ + 64 * 31 + 16 * (w & 3) + 4 * fq) * D + h * 256 + sl * (16 * NDT) + 16 * ((w >> 2) * NT2) + fr;
#pragma unroll
      for (int j = 0; j < NT2; ++j) { hpp[16 * j] = (bf16)(hpk[j][0] & 0xffffu); hpp[(size_t)D + 16 * j] = (bf16)(hpk[j][0] >> 16); hpp[(size_t)2 * D + 16 * j] = (bf16)(hpk[j][1] & 0xffffu); hpp[(size_t)3 * D + 16 * j] = (bf16)(hpk[j][1] >> 16); } }
    __syncthreads();
}

constexpr int CQ_TS = 144, CQ_SCR = 2 * 32 * CQ_TS;
struct CqItem { const float* W; unsigned char* WT; int Nsrc, c0, k0, row0, row1, rstep; };
__device__ __forceinline__ CqItem cq_decode(Frame& F, int r) {
    constexpr int I_GU1 = (D / 128) * (2048 / 64), I_DN1 = (D / 128) * (D / 64);
    CqItem it;
    if (r < NE * I_GU1) { const int e = r / I_GU1, q = r % I_GU1, kb = q / 32, cb = q % 32, j0 = 32 * cb;
        it.W = F.w_gate_up + (size_t)e * D * 2048; it.WT = (unsigned char*)F.WguT + (size_t)e * 2048 * D; it.Nsrc = 2048; it.c0 = 2 * j0; it.k0 = 128 * kb;
        it.row0 = (j0 >> 7) * 256 + (j0 & 127); it.row1 = it.row0 + 128; it.rstep = 1; }
    else { r -= NE * I_GU1; const int e = r / I_DN1, q = r % I_DN1, kb = q / 16, cb = q % 16;
        it.W = F.w_down + (size_t)e * D * D; it.WT = (unsigned char*)F.WdnT + (size_t)e * D * D; it.Nsrc = D; it.c0 = 64 * cb; it.k0 = 128 * kb;
        it.row0 = 64 * cb; it.row1 = 64 * cb + 1; it.rstep = 2; }
    return it;
}
__device__ __forceinline__ void cq_load(const CqItem& it, int half, int lane, f32x2 (&v)[32]) {
    const float* p = it.W + (size_t)(it.k0 + 64 * half + 4 * (lane >> 5)) * it.Nsrc + it.c0 + 2 * (lane & 31);
#pragma unroll
    for (int pp = 0; pp < 8; ++pp)
#pragma unroll
        for (int i = 0; i < 4; ++i) v[4 * pp + i] = *(const f32x2*)(p + (size_t)(8 * pp + i) * it.Nsrc);
}
__device__ __forceinline__ void cq_pack(const f32x2 (&v)[32], int half, int lane, LAS unsigned char* scr, float sc) {
    LAS unsigned char* t0 = scr + (lane & 31) * CQ_TS + 4 * (16 * half + (lane >> 5));
#pragma unroll
    for (int pp = 0; pp < 8; ++pp) {
        *(LAS unsigned*)(t0 + 8 * pp) = pk4_fp8(v[4 * pp].x * sc, v[4 * pp + 1].x * sc, v[4 * pp + 2].x * sc, v[4 * pp + 3].x * sc);
        *(LAS unsigned*)(t0 + 32 * CQ_TS + 8 * pp) = pk4_fp8(v[4 * pp].y * sc, v[4 * pp + 1].y * sc, v[4 * pp + 2].y * sc, v[4 * pp + 3].y * sc); }
}
__device__ __forceinline__ void cq_store(const CqItem& it, int lane, LAS unsigned char* scr) {
    asm volatile("s_waitcnt lgkmcnt(0)" ::: "memory");
    const int r = lane >> 1, hf = lane & 1;
#pragma unroll
    for (int t = 0; t < 2; ++t) { const LAS unsigned char* s = scr + t * 32 * CQ_TS + r * CQ_TS + 64 * hf;
        unsigned char* d = it.WT + (size_t)((t ? it.row1 : it.row0) + r * it.rstep) * D + it.k0 + 64 * hf;
#pragma unroll
        for (int j = 0; j < 4; ++j) *(u32x4*)(d + 16 * j) = *(const LAS u32x4*)(s + 16 * j); }
    asm volatile("s_waitcnt lgkmcnt(0)" ::: "memory");
}
constexpr int CS_GRAB = 8;
__device__ __forceinline__ void convert_steal(Frame& F) {
    constexpr int I_GU1 = (D / 128) * (2048 / 64), I_DN1 = (D / 128) * (D / 64), NIT = NE * (I_GU1 + I_DN1);
    static_assert(NIT % CS_GRAB == 0, "conversion items per grab");
    LAS unsigned char* scr = F.lds + F.wave * CQ_SCR; LAS int* slot = (LAS int*)(F.lds + 8 * CQ_SCR);
    int nxt = 0;
    __syncthreads();
    if (F.tid == 0) nxt = (int)atomicAdd(F.ctl + CW_QCTR, (unsigned)CS_GRAB);
    for (;;) {
        if (F.tid == 0) slot[0] = nxt;
        __syncthreads();
        const int base = slot[0]; if (base >= NIT) break;
        if (F.tid == 0) nxt = (int)atomicAdd(F.ctl + CW_QCTR, (unsigned)CS_GRAB);
        const CqItem it = cq_decode(F, base + F.wave);
        f32x2 va[32], vb[32];
        cq_load(it, 0, F.lane, va);
        cq_load(it, 1, F.lane, vb);
        cq_pack(va, 0, F.lane, scr, 32.0f);
        cq_pack(vb, 1, F.lane, scr, 32.0f);
        cq_store(it, F.lane, scr);
        __syncthreads();
    }
}

#ifndef ML_NDT
#define ML_NDT 4
#endif
__device__ __forceinline__ void mlstm_phase(Frame& F) {
    constexpr int SLICES = 16 / ML_NDT, NITEMS = NB * 4 * SLICES;
    for (int item = F.vcu; item < NITEMS; item += F.G) mlstm_item<ML_NDT>(F, item / (4 * SLICES), (item / SLICES) & 3, item % SLICES);
#if FAST_ATTN && ATT_QUEUE
    attn_phase(F);
#endif
#if MOE_FP8 && STEAL
#if defined(PROBE_NOSTEAL)
    if (F.vcu >= NITEMS)
#endif
#if defined(PROBE_CONV64)
    if (F.vcu < NITEMS || F.vcu >= 192)
#endif
    convert_steal(F);
#endif
}

constexpr int N_PHASES = 13;
struct Args { const void* in[18]; float* out; unsigned char* ws; int ph_lo, ph_hi; };

__device__ __forceinline__ int opaque_int(int v) { asm volatile("" : "+s"(v)); return v; }
__global__ void __launch_bounds__(NTHREADS, 2) mega_fwd(Args args) {
    extern __shared__ __attribute__((aligned(16))) unsigned char lds[];
    Frame F;
    F.lds = (LAS unsigned char*)lds;
    F.tid = threadIdx.x; F.lane = F.tid & 63; F.wave = __builtin_amdgcn_readfirstlane(F.tid >> 6);
    F.G = gridDim.x; { const int bx = blockIdx.x; F.vcu = (F.G % 8 == 0) ? (bx % 8) * (F.G / 8) + bx / 8 : bx; }
    F.gw = F.vcu * NWAVES + F.wave; F.NGW = F.G * NWAVES;
    unsigned char* ws = args.ws;
    F.ctl = (unsigned*)(ws + WS_CTL);
    F.x = (const float*)args.in[0]; F.positions = (const int*)args.in[1]; F.g_mix = (const float*)args.in[2]; F.w_in = (const float*)args.in[3]; F.conv_qk = (const float*)args.in[4];
    F.b_if = (const float*)args.in[5]; F.g_mnorm = (const float*)args.in[6]; F.w_attn_out = (const float*)args.in[7]; F.w_mlstm_out = (const float*)args.in[8]; F.w_mix_out = (const float*)args.in[9];
    F.g_ffn = (const float*)args.in[10]; F.w_router = (const float*)args.in[11]; F.b_router = (const float*)args.in[12]; F.w_gate_up = (const float*)args.in[13]; F.b_gate_up = (const float*)args.in[14];
    F.w_down = (const float*)args.in[15]; F.b_down = (const float*)args.in[16]; F.g_final = (const float*)args.in[17]; F.out = args.out;
    F.WinT = (bf16*)(ws + WS_WIN); F.WamT = (bf16*)(ws + WS_WAM); F.WoT = (bf16*)(ws + WS_WO); F.WguT = (bf16*)(ws + WS_WGU); F.WdnT = (bf16*)(ws + WS_WDN);
    F.XN = (bf16*)(ws + WS_XN); F.PROJ = (bf16*)(ws + WS_PROJ); F.OG = (bf16*)(ws + WS_OG); F.AM = (bf16*)(ws + WS_AM); F.MERGED = (bf16*)(ws + WS_MERGED);
    F.XS = (bf16*)(ws + WS_XS); F.ACT = (bf16*)(ws + WS_ACT); F.YBUF = (bf16*)(ws + WS_YBUF);
    F.GATES = (float*)(ws + WS_GATES); F.ROPE = (float*)(ws + WS_ROPE); F.LSE = (float*)(ws + WS_LSE); F.HT = (float*)(ws + WS_HT); F.H = (float*)(ws + WS_H);
    F.QC = (float*)(ws + WS_QC); F.KC = (float*)(ws + WS_KC);
    F.TOK_E = (int*)(ws + WS_ROUTE); F.TOK_SLOT = F.TOK_E + NA; F.TOK_W = (float*)(F.TOK_SLOT + NA);
    F.ROW_TOK = (int*)(ws + WS_ROWMETA); F.ROW_W = (float*)(F.ROW_TOK + XS_ROWS);

    const int lo = args.ph_lo, hi = args.ph_hi;
    for (int u = F.tid; u < (LDS_BYTES - LDSCTL_OFF) / 4; u += NTHREADS) ((LAS unsigned*)(F.lds + LDSCTL_OFF))[u] = 0u;
    __syncthreads();
    XcdBarrier bar; bar.bar = F.ctl + CW_BAR; bar.x = 0; bar.st = nullptr;
    if (hi - lo > 1) bar = xcd_barrier_post(F.ctl + CW_BAR, (volatile LAS unsigned*)(F.lds + MISC_OFF) + 8);
#ifndef PH_MASK
#define PH_MASK 0xffffffffu
#endif
#ifndef REP_MASK
#define REP_MASK 0u
#endif
#define IN(k) (((PH_MASK >> (k)) & 1u) && lo <= (k) && (k) < hi)
#define REPS(k) for (int rep_ = 0, nrep_ = ((REP_MASK >> (k)) & 1u) ? opaque_int(2) : 1; rep_ < nrep_; ++rep_)
#define SEAM(k) do { if (IN(k) && IN((k) + 1)) { GRID_BAR(); } } while (0)
#define GRID_BAR() xcd_barrier(bar)

    if (IN(0)) REPS(0) { p0_weights(F); p0_rows(F); }
    SEAM(0);
    if (IN(1)) REPS(1) {
#if FAST_P1
#if P1_FP8
        constexpr int NF8 = 64 * (18 + 42 - P1_HI), NBF = 64 * (P1_HI - 18);
        constexpr bool SPLIT = (NF8 == 128 * 15 && NBF == 128 * 6);
        { pg8::Gemm g{(const bf16*)((const unsigned char*)F.ctl + WS_XN8), F.WinT, T, (18 + 42 - P1_HI) * 256, D / 2}; pg8::SplitOrder S; S.base.init(T, (18 + 42 - P1_HI) * 256, F.G, (int)blockIdx.x);
          S.nA = SPLIT ? 9 : -1; S.nB = SPLIT ? 6 : -1;
          pg8::EpiProj<1> E{F.PROJ, F.ROPE};
          pg8::gemm_phase<pg8::EpiProj<1>, pg8::SplitOrder, true, true, true>(F.lds, g, S, E); }
        { pg8::Gemm g{F.XN, F.WinT + (size_t)18 * 256 * D, T, (P1_HI - 18) * 256, D}; pg8::SplitOrder S; S.base.init(T, (P1_HI - 18) * 256, F.G, (int)blockIdx.x);
          S.nA = SPLIT ? 2 : -1; S.nB = SPLIT ? 4 : -1;
          pg8::EpiProj<2> E{F.PROJ, F.ROPE};
          pg8::gemm_phase<pg8::EpiProj<2>, pg8::SplitOrder, true, true>(F.lds, g, S, E); }
#else
        pg8::Gemm g{F.XN, F.WinT, T, NP, D}; pg8::StaticOrder S; S.init(T, NP, F.G, (int)blockIdx.x);
        pg8::EpiProj<0> E{F.PROJ, F.ROPE};
        pg8::gemm_phase<pg8::EpiProj<0>, pg8::StaticOrder, true, true>(F.lds, g, S, E);
#endif
#else
        naive_p1(F);
#endif
    }
    SEAM(1);
    if (IN(2)) REPS(2) {
#if !FAST_P1
        naive_p1_rope(F);
#endif
    }
#if !FAST_P1
    SEAM(2);
#endif
    if (IN(3)) REPS(3) {
#if !FAST_MLSTM
        naive_conv(F);
#endif
#if FAST_MLSTM
        mlstm_prepass(F);
#endif
#if FAST_ATTN && !(ATT_QUEUE && FAST_MLSTM)
        attn_phase(F);
#elif !FAST_ATTN
        naive_attn(F);
#endif
    }
    SEAM(3);
    if (IN(4)) REPS(4) {
#if FAST_MLSTM
        mlstm_phase(F);
#else
        naive_mlstm(F);
#endif
    }
    SEAM(4);
    if (IN(5)) REPS(5) p3_post_mixer(F);
    SEAM(5);
    if (IN(6)) REPS(6) {
#if FAST_P4
        constexpr bool STREAM = (MIX_STREAM && FAST_P5);
        pg8::Gemm g{F.AM, F.WamT, T, D, AMLD};
        { pg8::MergedOrder S; S.base.init(T, D, F.G, (int)blockIdx.x); S.nparts = 2; S.pub = STREAM; S.ready = F.ctl + CW_READY2; S.tmo = F.ctl + CW_TMO;
          pg8::EpiMerged E{F.AM + 1536, F.PROJ, F.x, F.H, false};
          pg8::gemm_phase<pg8::EpiMerged, pg8::MergedOrder, false, true>(F.lds, g, S, E); }
        if (STREAM) {
          pg8::MergedOrder S; S.base.init(T, D, F.G, (int)blockIdx.x); S.nparts = 1; S.pub = true; S.ready = F.ctl + CW_READY2; S.tmo = F.ctl + CW_TMO;
          pg8::EpiMerged E{F.AM + 1536, F.PROJ, F.x, F.H, false};
          pg8::gemm_phase<pg8::EpiMerged, pg8::MergedOrder, false, true>(F.lds, g, S, E); }
#else
        naive_p4(F);
#endif
    }
#if !(MIX_STREAM && FAST_P4 && FAST_P5)
    SEAM(6);
#endif
    if (IN(7)) REPS(7) {
#if FAST_P5
#if !(MIX_STREAM && FAST_P4)
        { pg8::Gemm g{F.AM, F.WamT, T, D, AMLD}; pg8::MergedOrder S; S.base.init(T, D, F.G, (int)blockIdx.x); S.nparts = 1; S.pub = false; S.ready = F.ctl + CW_READY2; S.tmo = F.ctl + CW_TMO;
          pg8::EpiMerged E{F.AM + 1536, F.PROJ, F.x, F.H, false};
          pg8::gemm_phase<pg8::EpiMerged, pg8::MergedOrder, false, true>(F.lds, g, S, E); }
#endif
#else
        naive_p5(F);
#endif
    }
    SEAM(7);
#if MOE_FP8 && ROUTER_MFMA
    if (IN(8)) REPS(8) p6_router_mfma(F);
#else
    if (IN(8)) REPS(8) p6_router(F);
#endif
    SEAM(8);
    if (IN(9)) REPS(9) p7_gather(F);
    SEAM(9);
#if MOE_FP8 && MOE_STREAM && FAST_MOE
    if (IN(10)) REPS(10) {
        const int ntiles = (int)F.ctl[CW_NTILES];
        pg8::MoeOrder S{F.ctl + CW_TILEE, ntiles, F.G, (int)blockIdx.x, F.ROW_TOK, F.XN, F.ACT, F.WguT, F.WdnT, F.ctl + CW_READY, F.ctl + CW_TMO};
        pg8::Gemm g{F.XN, F.WguT, ntiles * 256, NE * 2048, D / 2};
        pg8::EpiMoe E{{F.ACT, F.b_gate_up, 1.0f / 32.0f}, {F.YBUF, F.b_down, F.ROW_TOK, F.ROW_W, 1.0f / 32.0f}};
        pg8::gemm_phase<pg8::EpiMoe, pg8::MoeOrder, true, true, true, true, true>(F.lds, g, S, E);
    }
#else
    if (IN(10)) REPS(10) {
        const int ntiles = (int)F.ctl[CW_NTILES];
#if FAST_MOE
        pg8::GroupedOrder S{F.ctl + CW_TILEE, ntiles, 8, F.G, (int)blockIdx.x, F.ROW_TOK};
#if MOE_FP8
        pg8::Gemm g{F.XN, F.WguT, ntiles * 256, NE * 2048, D / 2}; pg8::EpiSwiGLU<true> E{F.ACT, F.b_gate_up, 1.0f / 32.0f};
        pg8::gemm_phase<pg8::EpiSwiGLU<true>, pg8::GroupedOrder, true, true, true, true>(F.lds, g, S, E);
#else
        pg8::Gemm g{F.XS, F.WguT, ntiles * 256, NE * 2048, D}; pg8::EpiSwiGLU<false> E{F.ACT, F.b_gate_up, 1.0f};
        pg8::gemm_phase<pg8::EpiSwiGLU<false>, pg8::GroupedOrder, true, true, false>(F.lds, g, S, E);
#endif
#else
        naive_p8(F, ntiles);
#endif
    }
    SEAM(10);
    if (IN(11)) REPS(11) {
        const int ntiles = (int)F.ctl[CW_NTILES];
#if FAST_MOE
        pg8::GroupedOrder S{F.ctl + CW_TILEE, ntiles, 4, F.G, (int)blockIdx.x, F.ROW_TOK};
#if MOE_FP8
        pg8::Gemm g{F.ACT, F.WdnT, ntiles * 256, NE * D, D / 2}; pg8::EpiDown E{F.YBUF, F.b_down, F.ROW_TOK, F.ROW_W, 1.0f / 32.0f};
        pg8::gemm_phase<pg8::EpiDown, pg8::GroupedOrder, true, true, true>(F.lds, g, S, E);
#else
        pg8::Gemm g{F.ACT, F.WdnT, ntiles * 256, NE * D, D}; pg8::EpiDown E{F.YBUF, F.b_down, F.ROW_TOK, F.ROW_W, 1.0f};
        pg8::gemm_phase<pg8::EpiDown, pg8::GroupedOrder, true, true, false>(F.lds, g, S, E);
#endif
#else
        naive_p9(F, ntiles);
#endif
    }
#endif
    SEAM(11);
    if (IN(12)) REPS(12) p10_final(F);
#undef IN
#undef SEAM
}

extern "C" void kernel_launch(void* const* d_in, const int* in_sizes, int n_in, void* d_out, int out_size, void* d_ws, size_t ws_size, hipStream_t stream) {
    static int grid = 0;
    if (grid == 0) {
        if (n_in != 18 || out_size != T * D || ws_size < WS_END) { fprintf(stderr, "kernel_launch: unexpected shapes (n_in %d, out %d, ws %zu)\n", n_in, out_size, ws_size); grid = -1; return; }
        int dev = 0, cus = 0;
        if (hipGetDevice(&dev) != hipSuccess || hipDeviceGetAttribute(&cus, hipDeviceAttributeMultiprocessorCount, dev) != hipSuccess) { grid = -1; return; }
        if (hipFuncSetAttribute((const void*)mega_fwd, hipFuncAttributeMaxDynamicSharedMemorySize, LDS_BYTES) != hipSuccess) { fprintf(stderr, "kernel_launch: hipFuncSetAttribute failed\n"); grid = -1; return; }
        int per_cu = 0;
        if (hipOccupancyMaxActiveBlocksPerMultiprocessor(&per_cu, (const void*)mega_fwd, NTHREADS, LDS_BYTES) != hipSuccess || per_cu < 1) { fprintf(stderr, "kernel_launch: occupancy query says %d blocks per CU\n", per_cu); (void)hipGetLastError(); grid = -1; return; }
        grid = cus;
    }
    if (grid < 0) return;
    (void)hipMemsetAsync((char*)d_ws + WS_CTL, 0, CTL_ZERO_BYTES, stream);
    Args a{};
    for (int i = 0; i < 18; ++i) a.in[i] = d_in[i];
    a.out = (float*)d_out; a.ws = (unsigned char*)d_ws;
#if defined(MK_MULTI)
    for (int p = 0; p < N_PHASES; ++p) {
        a.ph_lo = p; a.ph_hi = p + 1;
        hipLaunchKernelGGL(mega_fwd, dim3(grid), dim3(NTHREADS), LDS_BYTES, stream, a);
    }
#else
#if defined(PROBE_HI)
    a.ph_lo = 0; a.ph_hi = PROBE_HI;
    hipLaunchKernelGGL(mega_fwd, dim3(grid), dim3(NTHREADS), LDS_BYTES, stream, a);
    (void)hipMemsetAsync((char*)d_ws + WS_CTL, 0, CTL_ZERO_BYTES, stream);
#endif
    a.ph_lo = 0; a.ph_hi = N_PHASES;
    hipLaunchKernelGGL(mega_fwd, dim3(grid), dim3(NTHREADS), LDS_BYTES, stream, a);
#endif
}
```

```cpp
#include <hip/hip_runtime.h>
#include <cstdio>
#include <cstdint>

#define LAS __attribute__((address_space(3)))
#define GAS __attribute__((address_space(1)))
typedef unsigned short bf16;
typedef float f32x4 __attribute__((ext_vector_type(4)));
typedef float f32x2 __attribute__((ext_vector_type(2)));
typedef unsigned u32x4 __attribute__((ext_vector_type(4)));
typedef unsigned u32x2 __attribute__((ext_vector_type(2)));
typedef short bf16x8 __attribute__((ext_vector_type(8)));

#ifndef FAST_P1
#define FAST_P1 1
#endif
#ifndef FAST_P4
#define FAST_P4 1
#endif
#ifndef FAST_P5
#define FAST_P5 1
#endif
#ifndef FAST_MOE
#define FAST_MOE 1
#endif
#ifndef MOE_FP8
#define MOE_FP8 1
#endif
#ifndef P1_FP8
#define P1_FP8 1
#endif
#ifndef STEAL
#define STEAL 1
#endif
#ifndef ROUTER_MFMA
#define ROUTER_MFMA 1
#endif
#ifndef P1_HI
#define P1_HI 30
#endif
#ifndef MOE_STREAM
#define MOE_STREAM 1
#endif
#ifndef ATT_QUEUE
#define ATT_QUEUE 1
#endif
#ifndef FAST_ATTN
#define FAST_ATTN 1
#endif
#ifndef FAST_MLSTM
#define FAST_MLSTM 1
#endif

constexpr int T = 16384, D = 1024, SEQ = 2048, NB = 8;
constexpr int DIN = 10760, NP = 10752;
constexpr int C_AQ = 0, C_AK = 1536, C_AV = 3072, C_MQ = 4608, C_MK = 5632, C_MV = 6656, C_MO = 7680, C_GA = 8704, C_GM = 9728;
constexpr int NE = 32, TOPK = 4, NA = T * TOPK, MAXTILES = NA / 256 + NE, XS_ROWS = MAXTILES * 256;
constexpr float QSCALE = 0.08838834764831845f * 1.4426950408889634f;
constexpr float RMS_EPS = 1e-5f, LN_EPS = 1e-5f;

constexpr size_t MiB = 1u << 20;
constexpr size_t WS_CTL = 0, CTL_ZERO_BYTES = 1 * MiB;
constexpr size_t WS_WIN = 2 * MiB, WS_WAM = 23 * MiB, WS_WO = 26 * MiB, WS_WGU = 28 * MiB, WS_WDN = 156 * MiB;
constexpr size_t WS_XN = 220 * MiB, WS_GATES = 252 * MiB, WS_ROPE = 253 * MiB, WS_ROUTE = 255 * MiB;
constexpr size_t WS_H = 256 * MiB, WS_MERGED = 320 * MiB;
constexpr size_t WS_OG = 352 * MiB, WS_LSE = 400 * MiB, WS_HT = 401 * MiB, WS_AM = 433 * MiB;
constexpr int AMLD = 2560;
#ifndef MIX_STREAM
#define MIX_STREAM 0
#endif
constexpr size_t WS_YBUF = 352 * MiB;
constexpr size_t WS_PROJ = 513 * MiB;
constexpr size_t WS_XS = 513 * MiB, WS_ACT = 657 * MiB;
constexpr size_t WS_ROWMETA = 801 * MiB;
constexpr size_t WS_QC = 849 * MiB, WS_KC = 913 * MiB, WS_XN8 = 916 * MiB, WS_END = 977 * MiB;
constexpr int CW_TMO = 0, CW_BAR = 4096, CW_CNT = 8192  , CW_NTILES = 12288, CW_TILEE = 12352, CW_QCTR = 16384, CW_ACTR = 16448  , CW_READY = 32768  , CW_READY2 = 65536  ;

constexpr int RING_BYTES = 131072, LDS_BYTES = 147456, LDSCTL_OFF = LDS_BYTES - 256, MISC_OFF = LDSCTL_OFF;
constexpr int NWAVES = 8, NTHREADS = 512;

__device__ __forceinline__ unsigned f2bf(float f) { unsigned u = __builtin_bit_cast(unsigned, f); return (u + 0x7fffu + ((u >> 16) & 1u)) >> 16; }
__device__ __forceinline__ unsigned pk2(float lo, float hi) { unsigned r; asm("v_cvt_pk_bf16_f32 %0, %1, %2" : "=v"(r) : "v"(lo), "v"(hi)); return r; }
__device__ __forceinline__ unsigned pk4_fp8(float a, float b, float c, float d) { int w = __builtin_amdgcn_cvt_pk_fp8_f32(a, b, 0, false); w = __builtin_amdgcn_cvt_pk_fp8_f32(c, d, w, true); return (unsigned)w; }
__device__ __forceinline__ float frcp(float x) { return __builtin_amdgcn_rcpf(x); }
__device__ __forceinline__ float bf2f(unsigned b) { return __builtin_bit_cast(float, b << 16); }
__device__ __forceinline__ float bflo(unsigned w) { return __builtin_bit_cast(float, w << 16); }
__device__ __forceinline__ float bfhi(unsigned w) { return __builtin_bit_cast(float, w & 0xffff0000u); }
__device__ __forceinline__ float wave_sum(float v) {
#pragma unroll
    for (int o = 1; o < 64; o <<= 1) v += __shfl_xor(v, o);
    return v;
}
__device__ __forceinline__ float wave_max(float v) {
#pragma unroll
    for (int o = 1; o < 64; o <<= 1) v = fmaxf(v, __shfl_xor(v, o));
    return v;
}
__device__ __forceinline__ float sigmoidf_(float x) { return frcp(1.0f + __expf(-x)); }

__host__ __device__ __forceinline__ int win_logical_col(int c) {
    if (c < C_AV) { const int p = c & 127; if (p < 32) { const int a = p >> 3, n = (p >> 2) & 1, j = p & 3; return (c - p) + 16 * n + 4 * a + j; } return c; }
    return c < C_GA ? c : c + 8;
}
__host__ __device__ __forceinline__ int wgu_logical_col(int c) { const int pn = c >> 8, bj = (c >> 7) & 1, jl = c & 127; return 2 * (128 * pn + jl) + bj; }
namespace pg8 {
#define PG8_LAS __attribute__((address_space(3)))
typedef unsigned short bf16_t;
typedef short bf16x8 __attribute__((ext_vector_type(8)));
typedef float f32x4 __attribute__((ext_vector_type(4)));
typedef unsigned u32x4 __attribute__((ext_vector_type(4)));
constexpr int BM = 256, BK = 64, HALF = 128, HTB = HALF * BK * 2  , STAGE_BYTES = 8 * HTB, NXCD = 8, WGM = 8;

__host__ __device__ __forceinline__ int lds_byte(int r, int c) { const int st = (r >> 4) * 2 + (c >> 5), rr = r & 15, cc = c & 31, ob = rr * 64 + cc * 2; return st * 1024 + (ob ^ (((ob >> 9) & 1) << 5)); }
__host__ __device__ __forceinline__ void stage_rc(int b, int& R, int& C) { const int st = b / 1024, sb = b % 1024, swz = sb ^ (((sb >> 9) & 1) << 5); R = (st >> 1) * 16 + swz / 64; C = (st & 1) * 32 + (swz % 64) / 2; }
__host__ __device__ __forceinline__ int perm32(int rho) { const int n = rho >> 4, i = rho & 15; return 8 * (i >> 2) + 4 * n + (i & 3); }

typedef int i32x4 __attribute__((ext_vector_type(4)));
typedef int i32x8 __attribute__((ext_vector_type(8)));
template <bool FP8> struct FragT { typedef bf16x8 type; };
template <> struct FragT<true> { typedef i32x8 type; };
__device__ __forceinline__ f32x4 mma16(bf16x8 a, bf16x8 b, f32x4 c) { return __builtin_amdgcn_mfma_f32_16x16x32_bf16(a, b, c, 0, 0, 0); }
__device__ __forceinline__ f32x4 mma16(i32x8, i32x8, f32x4 c) { return c; }
__device__ __forceinline__ f32x4 mma8(i32x8 a, i32x8 b, f32x4 c) { const int one = 0x7F7F7F7F;
    asm volatile("v_mfma_scale_f32_16x16x128_f8f6f4 %0, %1, %2, %0, %3, %3 op_sel_hi:[0,0,0]" : "+v"(c) : "v"(a), "v"(b), "v"(one)); return c; }
__device__ __forceinline__ f32x4 mma8(bf16x8, bf16x8, f32x4 c) { return c; }
struct Unit { int pm, pn, part; };
struct Gemm { const bf16_t* A; const bf16_t* Bt; int M, N, K; };

struct StaticOrder {
    int nM, nN, nwg, G, c;
    __host__ __device__ void init(int M, int N, int G_, int c_) { nM = M / BM; nN = N / BM; nwg = nM * nN; G = G_; c = c_; }
    __host__ __device__ bool next(int i, Unit& u) const { return at((long)i * G + c, u); }
    __host__ __device__ bool at(long L, Unit& u) const {
        if (L >= nwg) return false;
        int wgid = (int)L; { const int q = nwg / NXCD, r = nwg % NXCD, xcd = wgid % NXCD, off = wgid / NXCD; wgid = (xcd < r ? xcd * (q + 1) : r * (q + 1) + (xcd - r) * q) + off; }
        const int nig = WGM * nN, gid = wgid / nig, fm = gid * WGM, gsz = (nM - fm) < WGM ? (nM - fm) : WGM;
        u.pm = fm + ((wgid % nig) % gsz); u.pn = (wgid % nig) / gsz; u.part = 0; return true;
    }
    __device__ __forceinline__ int kt0(const Unit&) const { return 0; }
    __device__ __forceinline__ int nkt(const Unit&, int full) const { return full; }
    __device__ __forceinline__ int rowsel(const Unit&, int r) const { return r; }
    __device__ __forceinline__ const void* abase(const Unit&) const { return nullptr; }
    __device__ __forceinline__ const void* bbase(const Unit&) const { return nullptr; }
    __device__ __forceinline__ void a_ready(const Unit&) const {}
    __device__ __forceinline__ void done(const Unit&) const {}
};


__device__ __forceinline__ unsigned cvt_pk_bf16(float lo, float hi) { unsigned r; asm volatile("v_cvt_pk_bf16_f32 %0, %1, %2" : "=v"(r) : "v"(lo), "v"(hi)); return r; }
__device__ __forceinline__ u32x4 pack8(const f32x4 v0, const f32x4 v1) { u32x4 w; w.x = cvt_pk_bf16(v0[0], v0[1]); w.y = cvt_pk_bf16(v0[2], v0[3]); w.z = cvt_pk_bf16(v1[0], v1[1]); w.w = cvt_pk_bf16(v1[2], v1[3]); return w; }
__device__ __forceinline__ void unpack8(const u32x4 w, f32x4& v0, f32x4& v1) {
    v0[0] = __builtin_bit_cast(float, w.x << 16); v0[1] = __builtin_bit_cast(float, w.x & 0xffff0000u); v0[2] = __builtin_bit_cast(float, w.y << 16); v0[3] = __builtin_bit_cast(float, w.y & 0xffff0000u);
    v1[0] = __builtin_bit_cast(float, w.z << 16); v1[1] = __builtin_bit_cast(float, w.z & 0xffff0000u); v1[2] = __builtin_bit_cast(float, w.w << 16); v1[3] = __builtin_bit_cast(float, w.w & 0xffff0000u);
}
__device__ __forceinline__ f32x4 sig4(const f32x4 x) { f32x4 r; r[0] = frcp(1.0f + __expf(-x[0])); r[1] = frcp(1.0f + __expf(-x[1])); r[2] = frcp(1.0f + __expf(-x[2])); r[3] = frcp(1.0f + __expf(-x[3])); return r; }

struct GroupedOrder {
    const unsigned* tile_e; int ntiles, nN, G, c; const int* rowidx;
    __device__ __forceinline__ int kt0(const Unit&) const { return 0; }
    __device__ __forceinline__ int nkt(const Unit&, int full) const { return full; }
    __device__ __forceinline__ int rowsel(const Unit&, int r) const { const int v = rowidx[r]; return (v < 0 ? 0 : v) >> 2; }
    __device__ __forceinline__ const void* abase(const Unit&) const { return nullptr; }
    __device__ __forceinline__ const void* bbase(const Unit&) const { return nullptr; }
    __device__ bool next(int i, Unit& u) const {
        const long L = (long)i * G + c; if (L >= (long)ntiles * nN) return false;
        u.pm = (int)(L / nN); const int e = (int)tile_e[u.pm]; u.pn = e * nN + (int)(L % nN); u.part = 0; return true;
    }
    __device__ __forceinline__ void a_ready(const Unit&) const {}
    __device__ __forceinline__ void done(const Unit&) const {}
};

template <int MODE> struct EpiProj {
    static constexpr bool PERM = true, AFTER_DRAIN = false, HAS_MID = false;
    bf16_t* O; const float* rope;
    __device__ __forceinline__ bool keep(const Unit&) const { return false; }
    __device__ __forceinline__ void operator()(f32x4 (&acc)[2][2][4][2], const Unit& u, int wr, int wc, int fr, int fq) const {
        const int pnp = (MODE == 0) ? u.pn : (MODE == 1) ? (u.pn < 18 ? u.pn : u.pn + (P1_HI - 18)) : u.pn + 18;
        const int row0 = u.pm * BM + wr * 64 + fr, col0 = pnp * BM + wc * 32 + 8 * fq;
        const float sc = ((pnp < 6) ? QSCALE : 1.0f) * ((MODE == 1) ? (1.0f / 32.0f) : 1.0f);
        const bool dorope = (pnp < 12) && (wc == 0);
#pragma unroll
        for (int ai = 0; ai < 2; ++ai)
#pragma unroll
            for (int m = 0; m < 4; ++m) {
                const int row = row0 + ai * HALF + m * 16; bf16_t* rowp = O + (size_t)row * NP + col0;
                f32x4 cs = (f32x4){1.f, 1.f, 1.f, 1.f}, sn = (f32x4){0.f, 0.f, 0.f, 0.f};
                if (dorope) { cs = *(const f32x4*)(rope + (size_t)row * 32 + 4 * fq); sn = *(const f32x4*)(rope + (size_t)row * 32 + 16 + 4 * fq); }
#pragma unroll
                for (int bj = 0; bj < 2; ++bj) {
                    f32x4 v0 = acc[ai][bj][m][0], v1 = acc[ai][bj][m][1];
                    if (dorope) { const f32x4 t0 = v0 * cs - v1 * sn, t1 = v1 * cs + v0 * sn; v0 = t0; v1 = t1; }
                    v0 = v0 * sc; v1 = v1 * sc;
                    *(u32x4*)(rowp + bj * HALF) = pack8(v0, v1);
                }
            }
    }
};

struct SplitOrder {
    StaticOrder base; int nA, nB;
    __device__ bool next(int i, Unit& u) const {
        const int c = base.c;
        if (base.G != 256 || nA < 0) return base.next(i, u);
        if (c < 128) { if (i >= nA) return false; return base.at((long)i * 128 + c, u); }
        if (i >= nB) return false; return base.at((long)128 * nA + (long)i * 128 + (c - 128), u);
    }
    __device__ __forceinline__ int kt0(const Unit&) const { return 0; }
    __device__ __forceinline__ int nkt(const Unit&, int full) const { return full; }
    __device__ __forceinline__ int rowsel(const Unit&, int r) const { return r; }
    __device__ __forceinline__ const void* abase(const Unit&) const { return nullptr; }
    __device__ __forceinline__ const void* bbase(const Unit&) const { return nullptr; }
    __device__ __forceinline__ void a_ready(const Unit&) const {}
    __device__ __forceinline__ void done(const Unit&) const {}
};
struct MergedOrder {
    StaticOrder base; int nparts; unsigned* ready; unsigned* tmo;
    bool pub;
    __device__ bool next(int i, Unit& u) const { if (!base.next(i / nparts, u)) return false; u.part = (nparts == 1) ? 2 : (i % nparts); return true; }
    __device__ __forceinline__ int kt0(const Unit& u) const { return u.part == 0 ? 0 : (u.part == 1 ? 8 : 24); }
    __device__ __forceinline__ int nkt(const Unit& u, int) const { return u.part == 0 ? 8 : 16; }
    __device__ __forceinline__ int rowsel(const Unit&, int r) const { return r; }
    __device__ __forceinline__ const void* abase(const Unit&) const { return nullptr; }
    __device__ __forceinline__ const void* bbase(const Unit&) const { return nullptr; }
    __device__ __forceinline__ void a_ready(const Unit& u) const {
        if (u.part != 2 || !pub) return;
        if (threadIdx.x < 64) {
            unsigned spins = 0;
            while ((unsigned)__builtin_amdgcn_readfirstlane(__hip_atomic_load(ready + 64 * u.pm, __ATOMIC_RELAXED, __HIP_MEMORY_SCOPE_AGENT)) < 32u) {
                __builtin_amdgcn_s_sleep(2);
                if (++spins > (1u << 22)) { if (threadIdx.x == 0) __hip_atomic_store(tmo, 1u, __ATOMIC_RELAXED, __HIP_MEMORY_SCOPE_AGENT); break; } }
            __builtin_amdgcn_fence(__ATOMIC_ACQUIRE, "agent");
            asm volatile("s_waitcnt vmcnt(0)" ::: "memory");
        }
        asm volatile("" ::: "memory"); __builtin_amdgcn_s_barrier(); asm volatile("" ::: "memory");
    }
    __device__ __forceinline__ void done(const Unit& u) const {
        if (!pub || u.part != 1) return;
        asm volatile("s_waitcnt vmcnt(0)" ::: "memory");
        __builtin_amdgcn_s_barrier(); asm volatile("" ::: "memory");
        if (threadIdx.x == 0) { __builtin_amdgcn_fence(__ATOMIC_RELEASE, "agent"); asm volatile("s_waitcnt vmcnt(0)" ::: "memory");
                                __hip_atomic_fetch_add(ready + 64 * u.pm, 8u, __ATOMIC_RELAXED, __HIP_MEMORY_SCOPE_AGENT); }
    }
};
struct EpiMerged {
    static constexpr bool PERM = true, AFTER_DRAIN = false, HAS_MID = false;
    bf16_t* O; const bf16_t* proj; const float* x; float* h; bool wt;
    __device__ __forceinline__ bool keep(const Unit& u) const { return u.part == 0; }
    __device__ __forceinline__ void operator()(f32x4 (&acc)[2][2][4][2], const Unit& u, int wr, int wc, int fr, int fq) const {
        const int row0 = u.pm * BM + wr * 64 + fr, col0 = u.pn * BM + wc * 32 + 8 * fq;
        if (u.part == 0) {
#pragma unroll
            for (int ai = 0; ai < 2; ++ai)
#pragma unroll
                for (int m = 0; m < 4; ++m) {
                    const bf16_t* rowp = proj + (size_t)(row0 + ai * HALF + m * 16) * NP + col0;
#pragma unroll
                    for (int bj = 0; bj < 2; ++bj) {
                        const u32x4 ga = *(const u32x4*)(rowp + C_GA + bj * HALF), gm = *(const u32x4*)(rowp + C_GM + bj * HALF);
                        f32x4 a0, a1, m0, m1; unpack8(ga, a0, a1); unpack8(gm, m0, m1);
                        f32x4 r0, r1;
#pragma unroll
                        for (int j = 0; j < 4; ++j) { r0[j] = (1.0f + __expf(-m0[j])) * frcp(1.0f + __expf(-a0[j])); r1[j] = (1.0f + __expf(-m1[j])) * frcp(1.0f + __expf(-a1[j])); }
                        acc[ai][bj][m][0] *= r0; acc[ai][bj][m][1] *= r1;
                    }
                    if (m & 1) asm volatile("" ::: "memory");
                }
        } else if (u.part == 1) {
#pragma unroll
            for (int ai = 0; ai < 2; ++ai)
#pragma unroll
                for (int m = 0; m < 4; ++m) {
                    const int row = row0 + ai * HALF + m * 16;
#pragma unroll
                    for (int bj = 0; bj < 2; ++bj) {
                        const u32x4 gm = *(const u32x4*)(proj + (size_t)row * NP + C_GM + col0 + bj * HALF);
                        f32x4 m0, m1; unpack8(gm, m0, m1);
                        const f32x4 v0 = acc[ai][bj][m][0] * sig4(m0), v1 = acc[ai][bj][m][1] * sig4(m1);
                        const u32x4 pw = pack8(v0, v1); bf16_t* dst = O + (size_t)row * AMLD + col0 + bj * HALF;
                        if (wt) { __hip_atomic_store((unsigned long long*)dst, (unsigned long long)pw.x | ((unsigned long long)pw.y << 32), __ATOMIC_RELAXED, __HIP_MEMORY_SCOPE_AGENT);
                                  __hip_atomic_store((unsigned long long*)dst + 1, (unsigned long long)pw.z | ((unsigned long long)pw.w << 32), __ATOMIC_RELAXED, __HIP_MEMORY_SCOPE_AGENT); }
                        else *(u32x4*)dst = pw;
                    }
                }
        } else {
#pragma unroll
            for (int ai = 0; ai < 2; ++ai)
#pragma unroll
                for (int m = 0; m < 4; ++m) {
                    const size_t off = (size_t)(row0 + ai * HALF + m * 16) * D + col0;
#pragma unroll
                    for (int bj = 0; bj < 2; ++bj)
#pragma unroll
                        for (int n = 0; n < 2; ++n) *(f32x4*)(h + off + bj * HALF + 4 * n) = *(const f32x4*)(x + off + bj * HALF + 4 * n) + acc[ai][bj][m][n];
                }
        }
    }
};

struct EpiResid {
    static constexpr bool PERM = false, AFTER_DRAIN = false, HAS_MID = false;
    const float* x; float* h;
    __device__ __forceinline__ bool keep(const Unit&) const { return false; }
    __device__ __forceinline__ void operator()(f32x4 (&acc)[2][2][4][2], const Unit& u, int wr, int wc, int fr, int fq) const {
        const int row0 = u.pm * BM + wr * 64 + fr, col0 = u.pn * BM + wc * 32 + 4 * fq;
#pragma unroll
        for (int ai = 0; ai < 2; ++ai)
#pragma unroll
            for (int m = 0; m < 4; ++m) {
                const size_t off = (size_t)(row0 + ai * HALF + m * 16) * D + col0;
#pragma unroll
                for (int bj = 0; bj < 2; ++bj)
#pragma unroll
                    for (int n = 0; n < 2; ++n) *(f32x4*)(h + off + bj * HALF + n * 16) = *(const f32x4*)(x + off + bj * HALF + n * 16) + acc[ai][bj][m][n];
            }
    }
};

template <bool OUT8> struct EpiSwiGLU {
    static constexpr bool PERM = true, AFTER_DRAIN = false, HAS_MID = false;
    bf16_t* act; const float* bgu; float sc;
    __device__ __forceinline__ bool keep(const Unit&) const { return false; }
    __device__ __forceinline__ void operator()(f32x4 (&acc)[2][2][4][2], const Unit& u, int wr, int wc, int fr, int fq) const {
        const int e = u.pn >> 3, pnl = u.pn & 7, row0 = u.pm * BM + wr * 64 + fr, j0 = 128 * pnl + 32 * wc + 8 * fq;
        const float* bp = bgu + (size_t)e * 2048 + 2 * j0;
        const f32x4 b0 = *(const f32x4*)(bp), b1 = *(const f32x4*)(bp + 4), b2 = *(const f32x4*)(bp + 8), b3 = *(const f32x4*)(bp + 12);
        const f32x4 bg0 = (f32x4){b0[0], b0[2], b1[0], b1[2]}, bu0 = (f32x4){b0[1], b0[3], b1[1], b1[3]}, bg1 = (f32x4){b2[0], b2[2], b3[0], b3[2]}, bu1 = (f32x4){b2[1], b2[3], b3[1], b3[3]};
#pragma unroll
        for (int ai = 0; ai < 2; ++ai)
#pragma unroll
            for (int m = 0; m < 4; ++m) {
                const int row = row0 + ai * HALF + m * 16;
                f32x4 o[2]; const float lim = 7.0f, nlim = -7.0f;
#pragma unroll
                for (int n = 0; n < 2; ++n) {
                    const f32x4 g = acc[ai][0][m][n] * sc + (n ? bg1 : bg0), up = acc[ai][1][m][n] * sc + (n ? bu1 : bu0);
#pragma unroll
                    for (int j = 0; j < 4; ++j) { float gg, uu;
                        asm("v_min_f32 %0, %2, %1" : "=v"(gg) : "v"(g[j]), "v"(lim)); asm("v_med3_f32 %0, %1, %2, %3" : "=v"(uu) : "v"(up[j]), "v"(nlim), "v"(lim));
                        const float sg = frcp(1.0f + __builtin_amdgcn_exp2f(gg * (-1.702f * 1.4426950408889634f)));
                        o[n][j] = __builtin_fmaf(uu, gg, gg) * sg; }
                }
                if constexpr (OUT8) { u32x2 w8; w8.x = pk4_fp8(o[0][0], o[0][1], o[0][2], o[0][3]); w8.y = pk4_fp8(o[1][0], o[1][1], o[1][2], o[1][3]); __hip_atomic_store((unsigned long long*)((unsigned char*)act + (size_t)row * D + j0), (unsigned long long)w8.x | ((unsigned long long)w8.y << 32), __ATOMIC_RELAXED, __HIP_MEMORY_SCOPE_AGENT); }
                else *(u32x4*)(act + (size_t)row * D + j0) = pack8(o[0], o[1]);
            }
    }
};

struct EpiDown {
    static constexpr bool PERM = true, AFTER_DRAIN = false, HAS_MID = false;
    bf16_t* ybuf; const float* bdn; const int* row_tok; const float* row_w; float sc;
    __device__ __forceinline__ bool keep(const Unit&) const { return false; }
    __device__ __forceinline__ void operator()(f32x4 (&acc)[2][2][4][2], const Unit& u, int wr, int wc, int fr, int fq) const {
        const int e = u.pn >> 2, pnl = u.pn & 3, row0 = u.pm * BM + wr * 64 + fr, col0 = 256 * pnl + 32 * wc + 8 * fq;
        f32x4 bv[2][2];
#pragma unroll
        for (int bj = 0; bj < 2; ++bj)
#pragma unroll
            for (int n = 0; n < 2; ++n) bv[bj][n] = *(const f32x4*)(bdn + (size_t)e * D + col0 + bj * HALF + 4 * n);
        int tks[8]; float ws[8];
#pragma unroll
        for (int i = 0; i < 8; ++i) { const int row = row0 + (i >> 2) * HALF + (i & 3) * 16; tks[i] = row_tok[row]; ws[i] = row_w[row]; }
#pragma unroll
        for (int ai = 0; ai < 2; ++ai)
#pragma unroll
            for (int m = 0; m < 4; ++m) {
                const int tk = tks[ai * 4 + m]; const float w = ws[ai * 4 + m];
                if (tk >= 0) {
#pragma unroll
                    for (int bj = 0; bj < 2; ++bj) {
                        const f32x4 v0 = (acc[ai][bj][m][0] * sc + bv[bj][0]) * w, v1 = (acc[ai][bj][m][1] * sc + bv[bj][1]) * w;
                        *(u32x4*)(ybuf + (size_t)tk * D + col0 + bj * HALF) = pack8(v0, v1);
                    }
                }
            }
    }
};

struct MoeOrder {
    const unsigned* tile_e; int ntiles, G, c; const int* rowidx; const void *a0, *a1, *b0, *b1; unsigned* ready; unsigned* tmo;
    __device__ __forceinline__ int kt0(const Unit&) const { return 0; }
    __device__ __forceinline__ int nkt(const Unit&, int full) const { return full; }
    __device__ __forceinline__ int rowsel(const Unit& u, int r) const { if (u.part) return r; const int v = rowidx[r]; return (v < 0 ? 0 : v) >> 2; }
    __device__ __forceinline__ const void* abase(const Unit& u) const { return u.part ? a1 : a0; }
    __device__ __forceinline__ const void* bbase(const Unit& u) const { return u.part ? b1 : b0; }
    __device__ bool next(int i, Unit& u) const {
        long L = (long)i * G + c; const long n1 = (long)ntiles * 8;
        if (L < n1) { u.pm = (int)(L >> 3); u.pn = (int)tile_e[u.pm] * 8 + (int)(L & 7); u.part = 0; return true; }
        L -= n1; if (L >= (long)ntiles * 4) return false;
        u.pm = (int)(L >> 2); u.pn = (int)tile_e[u.pm] * 4 + (int)(L & 3); u.part = 1; return true;
    }
    __device__ __forceinline__ void a_ready(const Unit& u) const {
        if (u.part == 0) return;
        if (threadIdx.x < 64) {
            unsigned spins = 0;
            while ((unsigned)__builtin_amdgcn_readfirstlane(__hip_atomic_load(ready + 64 * u.pm, __ATOMIC_RELAXED, __HIP_MEMORY_SCOPE_AGENT)) < 64u) {
                __builtin_amdgcn_s_sleep(2);
                if (++spins > (1u << 22)) { if (threadIdx.x == 0) __hip_atomic_store(tmo, 1u, __ATOMIC_RELAXED, __HIP_MEMORY_SCOPE_AGENT); break; } }
            __builtin_amdgcn_fence(__ATOMIC_ACQUIRE, "agent");
            asm volatile("s_waitcnt vmcnt(0)" ::: "memory");
        }
        asm volatile("" ::: "memory"); __builtin_amdgcn_s_barrier(); asm volatile("" ::: "memory");
    }
    __device__ __forceinline__ void done(const Unit& u) const {
        if (u.part != 0) return;
        asm volatile("s_waitcnt vmcnt(0)" ::: "memory");
        if ((threadIdx.x & 63) == 0) __hip_atomic_fetch_add(ready + 64 * u.pm, 1u, __ATOMIC_RELAXED, __HIP_MEMORY_SCOPE_AGENT);
    }
};
struct EpiMoe {
    static constexpr bool PERM = true, AFTER_DRAIN = false, HAS_MID = false;
    EpiSwiGLU<true> e0; EpiDown e1;
    __device__ __forceinline__ bool keep(const Unit&) const { return false; }
    __device__ __forceinline__ void operator()(f32x4 (&acc)[2][2][4][2], const Unit& u, int wr, int wc, int fr, int fq) const {
        if (u.part == 0) e0(acc, u, wr, wc, fr, fq); else e1(acc, u, wr, wc, fr, fq);
    }
};
template <class Epi, class Sched, bool ALIGN_EPI = false, bool SP2 = false, bool FP8 = false, bool GATHER = false, bool MULTI = false>
__device__ __forceinline__ void gemm_phase(PG8_LAS unsigned char* lds, const Gemm g, const Sched& S, const Epi& E) {
    typedef typename FragT<FP8>::type frag_t;
    const int tid = threadIdx.x, wid = __builtin_amdgcn_readfirstlane(tid >> 6), lane = tid & 63, wr = wid >> 2, wc = wid & 3, fr = lane & 15, fq = lane >> 4;
    int K_ = g.K; asm volatile("" : "+s"(K_));
    const int K = K_, ntfull = K / BK;
    unsigned voffA[2], voffB[2];
#pragma unroll
    for (int i = 0; i < 2; ++i) { int R, C; stage_rc(tid * 16 + i * 8192, R, C); const int Rb = Epi::PERM ? ((R & ~31) + perm32(R & 31)) : R;
        voffA[i] = (unsigned)(R * K + C) * 2u; voffB[i] = (unsigned)(Rb * K + C) * 2u; }
    const size_t kstep = (size_t)(BK * 2);
    const size_t hstep = (size_t)HALF * K * 2;
    const size_t tstep = 2 * hstep;
    const unsigned ldsw = (unsigned)wid * 1024u;
    const int aoff = lds_byte(wr * 64 + fr, fq * (FP8 ? 16 : 8)), boff = lds_byte(wc * 32 + fr, fq * (FP8 ? 16 : 8));
    constexpr int NKF = FP8 ? 1 : 2;
#define PG8_SA(b, h) (((b) * 2 + (h)) * HTB)
#define PG8_SB(b, h) ((4 + (b) * 2 + (h)) * HTB)
#define PG8_STAGE(bufoff, gbase, voff) do { _Pragma("unroll") for (int _i = 0; _i < 2; ++_i) \
        __builtin_amdgcn_global_load_lds((const unsigned*)((const char*)(gbase) + (voff)[_i]), (PG8_LAS unsigned*)(lds + (bufoff) + ldsw + _i * 8192), 16, 0, 0); } while (0)
#define PG8_STAGEA(bufoff, gbase, half, isnext) do { if constexpr (GATHER) { unsigned vs_[2]; vs_[0] = (isnext) ? voffAn[half][0] : voffAc[half][0]; vs_[1] = (isnext) ? voffAn[half][1] : voffAc[half][1]; PG8_STAGE(bufoff, gbase, vs_); } \
        else { PG8_STAGE(bufoff, (gbase) + (half) * hstep, voffA); } } while (0)
#define PG8_LDA(dst, b, h) do { _Pragma("unroll") for (int m = 0; m < 4; ++m) _Pragma("unroll") for (int k = 0; k < NKF; ++k) dst[m][k] = *(const PG8_LAS frag_t*)(lds + PG8_SA(b, h) + aoff + m * 2048 + k * 1024); } while (0)
#define PG8_LDB(dst, b, h) do { _Pragma("unroll") for (int n = 0; n < 2; ++n) _Pragma("unroll") for (int k = 0; k < NKF; ++k) dst[n][k] = *(const PG8_LAS frag_t*)(lds + PG8_SB(b, h) + boff + n * 2048 + k * 1024); } while (0)
#define PG8_MMA(ai, bj, At, Bt) do { __builtin_amdgcn_s_setprio(1); \
        if constexpr (FP8) { _Pragma("unroll") for (int m = 0; m < 4; ++m) _Pragma("unroll") for (int n = 0; n < 2; ++n) \
            acc[ai][bj][m][n] = mma8(Bt[n][0], At[m][0], acc[ai][bj][m][n]); } \
        else { _Pragma("unroll") for (int m = 0; m < 4; ++m) _Pragma("unroll") for (int n = 0; n < 2; ++n) _Pragma("unroll") for (int k = 0; k < 2; ++k) \
            acc[ai][bj][m][n] = mma16(Bt[n][k], At[m][k], acc[ai][bj][m][n]); } \
        __builtin_amdgcn_s_setprio(0); } while (0)
#define PG8_WAIT_V(n) asm volatile("s_waitcnt vmcnt(" #n ")" ::: "memory")
#define PG8_WAIT_L(n) asm volatile("s_waitcnt lgkmcnt(" #n ")" ::: "memory")
#define PG8_BAR __builtin_amdgcn_s_barrier()
#define PG8_SCHED __builtin_amdgcn_sched_barrier(0)
    Unit cur, nxt; int ui = 0;
    if (!S.next(0, cur)) return;
    unsigned voffAc[2][2], voffAn[2][2];
#define PG8_GROWS(dst, u_) do { if constexpr (GATHER) { _Pragma("unroll") for (int h_ = 0; h_ < 2; ++h_) _Pragma("unroll") for (int i_ = 0; i_ < 2; ++i_) { int R_, C_; stage_rc(tid * 16 + i_ * 8192, R_, C_); \
        const int ri_ = S.rowsel((u_), (u_).pm * BM + h_ * HALF + R_); dst[h_][i_] = (unsigned)ri_ * (unsigned)(K * 2) + (unsigned)(C_ * 2); } } } while (0)
    PG8_GROWS(voffAc, cur);
    f32x4 acc[2][2][4][2];
#pragma unroll
    for (int a = 0; a < 2; ++a)
#pragma unroll
        for (int b = 0; b < 2; ++b)
#pragma unroll
            for (int m = 0; m < 4; ++m)
#pragma unroll
                for (int n = 0; n < 2; ++n) acc[a][b][m][n] = (f32x4){0.f, 0.f, 0.f, 0.f};
    frag_t At[4][NKF], B0[2][NKF], B1[2][NKF];
    const char* cA = (MULTI ? (const char*)S.abase(cur) : (const char*)g.A) + (GATHER ? (size_t)0 : (size_t)cur.pm * tstep) + (size_t)S.kt0(cur) * kstep; const char* cB = (MULTI ? (const char*)S.bbase(cur) : (const char*)g.Bt) + (size_t)cur.pn * tstep + (size_t)S.kt0(cur) * kstep;
    S.a_ready(cur);
    if constexpr (SP2) {
        PG8_STAGE(PG8_SB(0, 0), cB, voffB); PG8_STAGE(PG8_SB(0, 1), cB + hstep, voffB); PG8_STAGEA(PG8_SA(0, 0), cA, 0, false); PG8_STAGEA(PG8_SA(0, 1), cA, 1, false);
        if (wr == 1) PG8_BAR;
        PG8_WAIT_V(2); PG8_BAR;
        PG8_STAGE(PG8_SB(1, 0), cB + kstep, voffB); PG8_STAGEA(PG8_SA(1, 0), cA + kstep, 0, false); PG8_STAGE(PG8_SB(1, 1), cB + hstep + kstep, voffB);
        PG8_WAIT_V(6); PG8_BAR;
    } else {
        PG8_STAGE(PG8_SB(0, 0), cB, voffB); PG8_STAGEA(PG8_SA(0, 0), cA, 0, false); PG8_STAGE(PG8_SB(0, 1), cB + hstep, voffB); PG8_STAGEA(PG8_SA(0, 1), cA, 1, false);
        if (wr == 1) PG8_BAR;
        PG8_WAIT_V(4); PG8_BAR;
        PG8_STAGE(PG8_SB(1, 0), cB + kstep, voffB); PG8_STAGEA(PG8_SA(1, 0), cA + kstep, 0, false); PG8_STAGE(PG8_SB(1, 1), cB + hstep + kstep, voffB);
        PG8_WAIT_V(6); PG8_BAR;
    }
    for (;;) {
        const bool has_next = S.next(ui + 1, nxt);
        if (has_next) PG8_GROWS(voffAn, nxt);
        else if constexpr (GATHER) { _Pragma("unroll") for (int h_ = 0; h_ < 2; ++h_) _Pragma("unroll") for (int i_ = 0; i_ < 2; ++i_) voffAn[h_][i_] = voffAc[h_][i_]; }
        const char* nA = has_next ? (MULTI ? (const char*)S.abase(nxt) : (const char*)g.A) + (GATHER ? (size_t)0 : (size_t)nxt.pm * tstep) + (size_t)S.kt0(nxt) * kstep : cA; const char* nB = has_next ? (MULTI ? (const char*)S.bbase(nxt) : (const char*)g.Bt) + (size_t)nxt.pn * tstep + (size_t)S.kt0(nxt) * kstep : cB;
        const int nt = S.nkt(cur, ntfull);
        for (int t = 0; t < nt; t += 2) {
            const bool last = (t == nt - 2);
            const char* a1 = cA + (size_t)(t + 1) * kstep;
            const char* a2 = last ? nA : cA + (size_t)(t + 2) * kstep; const char* b2 = last ? nB : cB + (size_t)(t + 2) * kstep;
            const char* a3 = a2 + kstep; const char* b3 = b2 + kstep;
            if (last && has_next) S.a_ready(nxt);
            if constexpr (SP2) {
            PG8_LDB(B0, 0, 0); PG8_LDB(B1, 0, 1); PG8_SCHED; PG8_LDA(At, 0, 0); PG8_STAGEA(PG8_SA(1, 1), a1, 1, false);
            PG8_WAIT_V(8); PG8_WAIT_L(0); PG8_BAR; PG8_MMA(0, 0, At, B0); PG8_MMA(0, 1, At, B1); PG8_BAR; PG8_SCHED;
            PG8_LDA(At, 0, 1); PG8_STAGE(PG8_SB(0, 0), b2, voffB); PG8_STAGE(PG8_SB(0, 1), b2 + hstep, voffB); PG8_STAGEA(PG8_SA(0, 0), a2, 0, last);
            PG8_WAIT_V(8); PG8_WAIT_L(0); PG8_BAR; PG8_MMA(1, 0, At, B0); PG8_MMA(1, 1, At, B1); PG8_BAR; PG8_SCHED;
            PG8_LDB(B0, 1, 0); PG8_LDB(B1, 1, 1); PG8_SCHED; PG8_LDA(At, 1, 0); PG8_STAGEA(PG8_SA(0, 1), a2, 1, last);
            PG8_WAIT_V(8); PG8_WAIT_L(0); PG8_BAR; PG8_MMA(0, 0, At, B0); PG8_MMA(0, 1, At, B1); PG8_BAR; PG8_SCHED;
            PG8_LDA(At, 1, 1); PG8_STAGE(PG8_SB(1, 0), b3, voffB); PG8_STAGE(PG8_SB(1, 1), b3 + hstep, voffB); PG8_STAGEA(PG8_SA(1, 0), a3, 0, last);
            PG8_WAIT_V(8); PG8_WAIT_L(0); PG8_BAR; PG8_MMA(1, 0, At, B0); PG8_MMA(1, 1, At, B1); PG8_BAR; PG8_SCHED;
            } else {
            PG8_LDB(B0, 0, 0); PG8_SCHED; PG8_LDA(At, 0, 0); PG8_STAGEA(PG8_SA(1, 1), a1, 1, false);
            PG8_WAIT_L(8); PG8_BAR; PG8_WAIT_L(0); PG8_MMA(0, 0, At, B0); PG8_BAR; PG8_SCHED;
            PG8_LDB(B1, 0, 1); PG8_STAGE(PG8_SB(0, 0), b2, voffB);
            PG8_BAR; PG8_WAIT_L(0); PG8_MMA(0, 1, At, B1); PG8_BAR;
            PG8_LDA(At, 0, 1); PG8_STAGEA(PG8_SA(0, 0), a2, 0, last);
            PG8_BAR; PG8_WAIT_L(0); PG8_MMA(1, 0, At, B0); PG8_BAR; PG8_SCHED;
            PG8_STAGE(PG8_SB(0, 1), b2 + hstep, voffB);
            PG8_WAIT_V(6); PG8_BAR; PG8_MMA(1, 1, At, B1); PG8_BAR;
            PG8_LDB(B0, 1, 0); PG8_SCHED; PG8_LDA(At, 1, 0); PG8_STAGEA(PG8_SA(0, 1), a2, 1, last);
            PG8_WAIT_L(8); PG8_BAR; PG8_WAIT_L(0); PG8_MMA(0, 0, At, B0); PG8_BAR; PG8_SCHED;
            PG8_LDB(B1, 1, 1); PG8_STAGE(PG8_SB(1, 0), b3, voffB);
            PG8_BAR; PG8_WAIT_L(0); PG8_MMA(0, 1, At, B1); PG8_BAR;
            PG8_LDA(At, 1, 1); PG8_STAGEA(PG8_SA(1, 0), a3, 0, last);
            PG8_BAR; PG8_WAIT_L(0); PG8_MMA(1, 0, At, B0); PG8_BAR; PG8_SCHED;
            PG8_STAGE(PG8_SB(1, 1), b3 + hstep, voffB);
            PG8_WAIT_V(6); PG8_BAR; PG8_MMA(1, 1, At, B1); PG8_BAR;
            }
        }
        if constexpr (FP8) asm volatile("s_nop 15\n\ts_nop 15" ::: "memory");
        if constexpr (ALIGN_EPI) { if (wr == 0) PG8_BAR; }
        if constexpr (!Epi::AFTER_DRAIN) { E(acc, cur, wr, wc, fr, fq); S.done(cur); }
        if (!has_next) break;
        if (!E.keep(cur)) {
#pragma unroll
        for (int a = 0; a < 2; ++a)
#pragma unroll
            for (int b = 0; b < 2; ++b)
#pragma unroll
                for (int m = 0; m < 4; ++m)
#pragma unroll
                    for (int n = 0; n < 2; ++n) acc[a][b][m][n] = (f32x4){0.f, 0.f, 0.f, 0.f};
        }
        cur = nxt; cA = nA; cB = nB; ++ui;
        if constexpr (GATHER) { _Pragma("unroll") for (int h_ = 0; h_ < 2; ++h_) _Pragma("unroll") for (int i_ = 0; i_ < 2; ++i_) voffAc[h_][i_] = voffAn[h_][i_]; }
        if constexpr (ALIGN_EPI) { if (wr == 1) PG8_BAR; }
    }
    PG8_WAIT_V(0);
    if constexpr (!ALIGN_EPI) { if (wr == 0) PG8_BAR; }
    PG8_BAR;
    if constexpr (Epi::AFTER_DRAIN) { E.fused(acc, cur, wr, wc, fr, fq, lds, wid, lane); S.done(cur); }
#undef PG8_SA
#undef PG8_SB
#undef PG8_STAGE
#undef PG8_LDA
#undef PG8_STAGEA
#undef PG8_GROWS
#undef PG8_LDB
#undef PG8_MMA
#undef PG8_WAIT_V
#undef PG8_WAIT_L
#undef PG8_BAR
#undef PG8_SCHED
}
}
#define XB_TMO      128
#define XB_XCNT(j)  (256  + 64 * (j))
#define XB_XSUB(j)  (1280 + 64 * (j))
#define XB_XGEN(j)  (2304 + 64 * (j))
#define XB_TOP      3328
#define XB_TOPGEN   3392
#define XCD_BAR_WORDS 3456
#define XB_SPIN_CAP (1u << 24)

__device__ __forceinline__ unsigned xb_ld(unsigned* p)              { return __hip_atomic_load(p, __ATOMIC_RELAXED, __HIP_MEMORY_SCOPE_AGENT); }
__device__ __forceinline__ unsigned xb_add(unsigned* p, unsigned v) { return __hip_atomic_fetch_add(p, v, __ATOMIC_RELAXED, __HIP_MEMORY_SCOPE_AGENT); }
__device__ __forceinline__ unsigned xb_xcc_id() { return (unsigned)__builtin_amdgcn_s_getreg((3 << 11) | 20) & 0xFu; }
#define XB_SPIN(cond, bar) do { unsigned _sp = 0; while (cond) { __builtin_amdgcn_s_sleep(1); \
    if ((++_sp & 255u) == 0u) { if (xb_ld(&(bar)[XB_TMO])) break; if (_sp > XB_SPIN_CAP) { atomicAdd(&(bar)[XB_TMO], 1u); break; } } } } while (0)

struct XcdBarrier {
    unsigned* bar; unsigned x;
    volatile LAS unsigned* st;
};

__device__ __forceinline__ XcdBarrier xcd_barrier_post(unsigned* bar, volatile LAS unsigned* st) {
    XcdBarrier b; b.bar = bar; b.x = xb_xcc_id(); b.st = st;
    if (threadIdx.x == 0) (void)xb_add(&bar[XB_XCNT(b.x)], 1u);
    return b;
}
__device__ __forceinline__ void xcd_barrier_complete(unsigned* bar, unsigned x, unsigned& nloc, unsigned& nx) {
    const unsigned G = gridDim.x * gridDim.y * gridDim.z;
    unsigned sum, cnt, mine, sp = 0u;
    for (;;) {
        sum = 0u; cnt = 0u; mine = 0u;
#pragma unroll
        for (unsigned j = 0; j < 16; ++j) { const unsigned c = xb_ld(&bar[XB_XCNT(j)]); sum += c; cnt += (c > 0u) ? 1u : 0u; mine = (j == x) ? c : mine; }
        if (sum == G) break;
        __builtin_amdgcn_s_sleep(1);
        if ((++sp & 255u) == 0u) { if (xb_ld(&bar[XB_TMO])) break; if (sp > XB_SPIN_CAP) { atomicAdd(&bar[XB_TMO], 1u); break; } }
    }
    nloc = mine > 0u ? mine : 1u; nx = cnt > 0u ? cnt : 1u;
}

__device__ __forceinline__ void xcd_barrier(const XcdBarrier& b) {
    asm volatile("s_waitcnt vmcnt(0)" ::: "memory");
    __syncthreads();
    if (threadIdx.x == 0) {
        unsigned* bar = b.bar;
        __builtin_amdgcn_s_waitcnt(0);
        unsigned nloc = b.st[0], nx = b.st[1];
        if (nloc == 0u) { xcd_barrier_complete(bar, b.x, nloc, nx); b.st[0] = nloc; b.st[1] = nx; }
        const unsigned old = xb_add(&bar[XB_XSUB(b.x)], 1u);
        const unsigned gen = old / nloc;
        if (old + 1u == (gen + 1u) * nloc) {
            __builtin_amdgcn_fence(__ATOMIC_RELEASE, "agent");
            asm volatile("s_waitcnt vmcnt(0)" ::: "memory");
            const unsigned og = xb_add(&bar[XB_TOP], 1u);
            const unsigned tg = og / nx;
            if (og + 1u == (tg + 1u) * nx) xb_add(&bar[XB_TOPGEN], 1u);
            else XB_SPIN(xb_ld(&bar[XB_TOPGEN]) == tg, bar);
            __builtin_amdgcn_fence(__ATOMIC_ACQUIRE, "agent");
            xb_add(&bar[XB_XGEN(b.x)], 1u);
            asm volatile("s_waitcnt vmcnt(0)" ::: "memory");
        } else {
            XB_SPIN(xb_ld(&bar[XB_XGEN(b.x)]) == gen, bar);
            __builtin_amdgcn_fence(__ATOMIC_ACQUIRE, "agent");
            asm volatile("s_waitcnt vmcnt(0)" ::: "memory");
        }
    }
    __syncthreads();
}

struct Frame {
    LAS unsigned char* lds;
    unsigned* ctl;
    int tid, lane, wave, vcu, G, gw, NGW;
    const float *x, *g_mix, *w_in, *conv_qk, *b_if, *g_mnorm, *w_attn_out, *w_mlstm_out, *w_mix_out, *g_ffn, *w_router, *b_router, *w_gate_up, *b_gate_up, *w_down, *b_down, *g_final;
    const int* positions;
    float* out;
    bf16 *WinT, *WamT, *WoT, *WguT, *WdnT, *XN, *PROJ, *OG, *AM, *MERGED, *XS, *ACT, *YBUF;
    float *GATES, *ROPE, *LSE, *HT, *H, *QC, *KC, *ROW_W, *TOK_W;
    int *TOK_E, *TOK_SLOT, *ROW_TOK;
};

__constant__ double ROPE_REV[16] = {
    1.59154943091895346e-01, 7.00865215877985032e-02, 3.08637634047012298e-02, 1.35913706361939050e-02, 5.98518571271370540e-03, 2.63567589866741401e-03, 1.16066364124006098e-03, 5.11117504537543857e-04,
    2.25079079039276525e-04, 9.91173093690193548e-05, 4.36479527928028909e-05, 1.92211006849448627e-05, 8.46433080824140138e-06, 3.72740860191535193e-06, 1.64142626279503449e-06, 7.22829306883286479e-07};

template <int MAP>
__device__ __forceinline__ void transpose_item(const float* W, int Nsrc, bf16* WT, int ldk, int kofs, int nblk, LAS float* scr, int item, int lane) {
    const int kb = item / nblk, nb = item % nblk, k0 = 64 * kb, n0 = 32 * nb;
    const int np = n0 + (lane & 31);
    const int sc = (MAP == 1) ? win_logical_col(np) : (MAP == 2) ? wgu_logical_col(np) : np;
    float tv[32];
#pragma unroll
    for (int i = 0; i < 32; ++i) tv[i] = W[(size_t)(k0 + 2 * i + (lane >> 5)) * Nsrc + sc];
#pragma unroll
    for (int i = 0; i < 32; ++i) scr[(2 * i + (lane >> 5)) * 33 + (lane & 31)] = tv[i];
    asm volatile("s_waitcnt lgkmcnt(0)" ::: "memory");
    const int c = lane & 7;
#pragma unroll
    for (int j = 0; j < 4; ++j) { const int n = (lane >> 3) + 8 * j; const LAS float* s = scr + (8 * c) * 33 + n;
        u32x4 o; o.x = pk2(s[0 * 33], s[1 * 33]); o.y = pk2(s[2 * 33], s[3 * 33]); o.z = pk2(s[4 * 33], s[5 * 33]); o.w = pk2(s[6 * 33], s[7 * 33]);
        *(u32x4*)(WT + (size_t)(n0 + n) * ldk + kofs + k0 + 8 * c) = o; }
    asm volatile("s_waitcnt lgkmcnt(0)" ::: "memory");
}

template <int MAP>
__device__ __forceinline__ void transpose_item_fp8(const float* W, int Nsrc, unsigned char* WT, int ldk, int nblk, LAS float* scr, int item, int lane, float scale) {
    const int kb = item / nblk, nb = item % nblk, k0 = 64 * kb, n0 = 32 * nb;
    const int np = n0 + (lane & 31);
    const int sc = (MAP == 1) ? win_logical_col(np) : (MAP == 2) ? wgu_logical_col(np) : np;
    float tv[32];
#pragma unroll
    for (int i = 0; i < 32; ++i) tv[i] = W[(size_t)(k0 + 2 * i + (lane >> 5)) * Nsrc + sc];
#pragma unroll
    for (int i = 0; i < 32; ++i) scr[(2 * i + (lane >> 5)) * 33 + (lane & 31)] = tv[i] * scale;
    asm volatile("s_waitcnt lgkmcnt(0)" ::: "memory");
    const int n = lane >> 1, c = lane & 1;
#pragma unroll
    for (int q = 0; q < 2; ++q) { const LAS float* s = scr + (32 * c + 16 * q) * 33 + n;
        u32x4 o; o.x = pk4_fp8(s[0 * 33], s[1 * 33], s[2 * 33], s[3 * 33]); o.y = pk4_fp8(s[4 * 33], s[5 * 33], s[6 * 33], s[7 * 33]);
        o.z = pk4_fp8(s[8 * 33], s[9 * 33], s[10 * 33], s[11 * 33]); o.w = pk4_fp8(s[12 * 33], s[13 * 33], s[14 * 33], s[15 * 33]);
        *(u32x4*)(WT + (size_t)(n0 + n) * ldk + k0 + 32 * c + 16 * q) = o; }
    asm volatile("s_waitcnt lgkmcnt(0)" ::: "memory");
}

template <int MAP>
__device__ __forceinline__ void tr8_load(const float* W, int Nsrc, int nblk, int item, int lane, float (&tv)[32]) {
    const int kb = item / nblk, nb = item % nblk, k0 = 64 * kb, np = 32 * nb + (lane & 31);
    const int sc = (MAP == 1) ? win_logical_col(np) : (MAP == 2) ? wgu_logical_col(np) : np;
#pragma unroll
    for (int i = 0; i < 32; ++i) tv[i] = W[(size_t)(k0 + 2 * i + (lane >> 5)) * Nsrc + sc];
}
__device__ __forceinline__ void tr8_store(const float (&tv)[32], unsigned char* WT, int ldk, int nblk, LAS float* scr, int item, int lane, float scale) {
    const int kb = item / nblk, nb = item % nblk, k0 = 64 * kb, n0 = 32 * nb;
#pragma unroll
    for (int i = 0; i < 32; ++i) scr[(2 * i + (lane >> 5)) * 33 + (lane & 31)] = tv[i] * scale;
    asm volatile("s_waitcnt lgkmcnt(0)" ::: "memory");
    const int n = lane >> 1, c = lane & 1;
#pragma unroll
    for (int q = 0; q < 2; ++q) { const LAS float* s = scr + (32 * c + 16 * q) * 33 + n;
        u32x4 o; o.x = pk4_fp8(s[0 * 33], s[1 * 33], s[2 * 33], s[3 * 33]); o.y = pk4_fp8(s[4 * 33], s[5 * 33], s[6 * 33], s[7 * 33]);
        o.z = pk4_fp8(s[8 * 33], s[9 * 33], s[10 * 33], s[11 * 33]); o.w = pk4_fp8(s[12 * 33], s[13 * 33], s[14 * 33], s[15 * 33]);
        *(u32x4*)(WT + (size_t)(n0 + n) * ldk + k0 + 32 * c + 16 * q) = o; }
    asm volatile("s_waitcnt lgkmcnt(0)" ::: "memory");
}

__device__ __forceinline__ void p0_weights(Frame& F) {
    LAS float* scr = (LAS float*)(F.lds + F.wave * 16384);
    constexpr int I_IN = (D / 64) * (NP / 32), I_A = (512 / 64) * (D / 32), I_M = (D / 64) * (D / 32), I_O = I_M;
    constexpr int I_GU1 = (D / 64) * (2048 / 32), I_DN1 = (D / 64) * (D / 32);
    constexpr int NITEMS = I_IN + I_A + I_M + I_O + ((MOE_FP8 && STEAL) ? 0 : NE * I_GU1 + NE * I_DN1);
    for (int it = F.gw; it < NITEMS; it += F.NGW) {
        int r = it;
#if P1_FP8
        if (r < I_IN) { const int pn = (r % (NP / 32)) >> 3;
            if (pn < 18 || pn >= P1_HI) transpose_item_fp8<1>(F.w_in, DIN, (unsigned char*)F.WinT - (pn >= P1_HI ? (size_t)(P1_HI - 18) * 256 * D : (size_t)0), D, NP / 32, scr, r, F.lane, 32.0f);
            else transpose_item<1>(F.w_in, DIN, F.WinT, D, 0, NP / 32, scr, r, F.lane);
            continue; } r -= I_IN;
#else
        if (r < I_IN) { transpose_item<1>(F.w_in, DIN, F.WinT, D, 0, NP / 32, scr, r, F.lane); continue; } r -= I_IN;
#endif
        if (r < I_A) { transpose_item<0>(F.w_attn_out, D, F.WamT, AMLD, 0, D / 32, scr, r, F.lane); continue; } r -= I_A;
        if (r < I_M) { transpose_item<0>(F.w_mlstm_out, D, F.WamT, AMLD, 512, D / 32, scr, r, F.lane); continue; } r -= I_M;
        if (r < I_O) { transpose_item<0>(F.w_mix_out, D, F.WamT, AMLD, 1536, D / 32, scr, r, F.lane); continue; } r -= I_O;
#if MOE_FP8 && STEAL
        (void)r;
#elif MOE_FP8
        if (r < NE * I_GU1) { const int e = r / I_GU1; transpose_item_fp8<2>(F.w_gate_up + (size_t)e * D * 2048, 2048, (unsigned char*)F.WguT + (size_t)e * 2048 * D, D, 2048 / 32, scr, r % I_GU1, F.lane, 32.0f); continue; } r -= NE * I_GU1;
        { const int e = r / I_DN1; transpose_item_fp8<0>(F.w_down + (size_t)e * D * D, D, (unsigned char*)F.WdnT + (size_t)e * D * D, D, D / 32, scr, r % I_DN1, F.lane, 32.0f); }
#else
        if (r < NE * I_GU1) { const int e = r / I_GU1; transpose_item<2>(F.w_gate_up + (size_t)e * D * 2048, 2048, F.WguT + (size_t)e * 2048 * D, D, 0, 2048 / 32, scr, r % I_GU1, F.lane); continue; } r -= NE * I_GU1;
        { const int e = r / I_DN1; transpose_item<0>(F.w_down + (size_t)e * D * D, D, F.WdnT + (size_t)e * D * D, D, 0, D / 32, scr, r % I_DN1, F.lane); }
#endif
    }
}

__device__ __forceinline__ void p0_rows(Frame& F) {
    LAS float* w8t = (LAS float*)(F.lds);
    __syncthreads();
    { float w8v[16];
#pragma unroll
      for (int j = 0; j < 16; ++j) { const int i = F.tid + j * NTHREADS; w8v[j] = F.w_in[(size_t)(i >> 3) * DIN + 8704 + (i & 7)]; }
#pragma unroll
      for (int j = 0; j < 16; ++j) { const int i = F.tid + j * NTHREADS; w8t[(i & 7) * 1024 + (i >> 3)] = w8v[j]; } }
    __syncthreads();
    f32x4 vnx[4];
    if (F.gw < T) { const f32x4* xr = (const f32x4*)(F.x + (size_t)F.gw * D) + F.lane;
#pragma unroll
        for (int j = 0; j < 4; ++j) vnx[j] = xr[64 * j]; }
    for (int row = F.gw; row < T; row += F.NGW) {
        f32x4 v[4]; float s = 0.f;
#pragma unroll
        for (int j = 0; j < 4; ++j) { v[j] = vnx[j]; s += (v[j].x * v[j].x + v[j].y * v[j].y) + (v[j].z * v[j].z + v[j].w * v[j].w); }
        if (row + F.NGW < T) { const f32x4* xr = (const f32x4*)(F.x + (size_t)(row + F.NGW) * D) + F.lane;
#pragma unroll
            for (int j = 0; j < 4; ++j) vnx[j] = xr[64 * j]; }
        const float rstd = 1.0f / sqrtf(wave_sum(s) * (1.0f / D) + RMS_EPS);
        float ga[8];
#pragma unroll
        for (int o = 0; o < 8; ++o) ga[o] = 0.f;
        unsigned long long* o8 = (unsigned long long*)(F.XN + (size_t)row * D) + F.lane;
#pragma unroll
        for (int j = 0; j < 4; ++j) {
            const f32x4 g = *((const f32x4*)F.g_mix + F.lane + 64 * j);
            v[j] = v[j] * rstd * g;
            o8[64 * j] = (unsigned long long)pk2(v[j].x, v[j].y) | ((unsigned long long)pk2(v[j].z, v[j].w) << 32);
#if P1_FP8
            ((unsigned*)((unsigned char*)F.ctl + WS_XN8 + (size_t)row * D))[F.lane + 64 * j] = pk4_fp8(v[j].x, v[j].y, v[j].z, v[j].w);
#endif
#pragma unroll
            for (int o = 0; o < 8; ++o) { const f32x4 w = *((const LAS f32x4*)(w8t + o * 1024) + F.lane + 64 * j); ga[o] += (v[j].x * w.x + v[j].y * w.y) + (v[j].z * w.z + v[j].w * w.w); }
        }
#pragma unroll
        for (int o = 0; o < 8; ++o) ga[o] = wave_sum(ga[o]);
        if (F.lane < 8) { float gv = ga[0];
#pragma unroll
            for (int o = 1; o < 8; ++o) gv = (F.lane == o) ? ga[o] : gv;
            F.GATES[(size_t)row * 8 + F.lane] = gv + F.b_if[F.lane]; }
        if (F.lane < 16) {
            const int pos = F.positions[row];
            double rev = (double)pos * ROPE_REV[F.lane]; rev -= floor(rev);
            const float fr = (float)rev;
            F.ROPE[(size_t)row * 32 + F.lane] = __builtin_amdgcn_cosf(fr);
            F.ROPE[(size_t)row * 32 + 16 + F.lane] = __builtin_amdgcn_sinf(fr);
        }
    }
}

template <int RT, class AF, class BF, class EP>
__device__ __forceinline__ void naive_gemm(Frame& F, int M, int N, int K, AF af, BF bf, EP ep) {
    const long gthreads = (long)F.G * NTHREADS, gtid = (long)blockIdx.x * NTHREADS + F.tid;
    for (long it = gtid; it < (long)(M / RT) * N; it += gthreads) {
        const int col = (int)(it % N), r0 = (int)(it / N) * RT;
        float acc[RT];
#pragma unroll
        for (int r = 0; r < RT; ++r) acc[r] = 0.f;
        for (int k = 0; k < K; ++k) { const float b = bf(k, col);
#pragma unroll
            for (int r = 0; r < RT; ++r) acc[r] += af(r0 + r, k) * b; }
#pragma unroll
        for (int r = 0; r < RT; ++r) ep(r0 + r, col, acc[r]);
    }
}

__device__ __forceinline__ void naive_p1(Frame& F) {
    const bf16* XN = F.XN; const float* W = F.w_in; bf16* P = F.PROJ;
    naive_gemm<8>(F, T, NP, D,
        [=](int r, int k) { return bf2f(XN[(size_t)r * D + k]); },
        [=](int k, int c) { return bf2f(f2bf(W[(size_t)k * DIN + win_logical_col(c)])); },
        [=](int r, int c, float a) { P[(size_t)r * NP + c] = (bf16)f2bf(a * (c < C_AK ? QSCALE : 1.0f)); });
}
__device__ __forceinline__ void naive_p1_rope(Frame& F) {
    const long gthreads = (long)F.G * NTHREADS, gtid = (long)blockIdx.x * NTHREADS + F.tid;
    for (long it = gtid; it < (long)T * 24 * 16; it += gthreads) {
        const int i = (int)(it & 15), hh = (int)((it >> 4) % 24), row = (int)(it / (24 * 16));
        const int a = i >> 2, j = i & 3; bf16* p = F.PROJ + (size_t)row * NP + hh * 128;
        const float x1 = bf2f(p[8 * a + j]), x2 = bf2f(p[8 * a + 4 + j]), cs = F.ROPE[(size_t)row * 32 + i], sn = F.ROPE[(size_t)row * 32 + 16 + i];
        p[8 * a + j] = (bf16)f2bf(x1 * cs - x2 * sn); p[8 * a + 4 + j] = (bf16)f2bf(x2 * cs + x1 * sn);
    }
}
__device__ __forceinline__ void naive_attn(Frame& F) {
    for (int it = F.gw; it < T * 12; it += F.NGW) {
        const int row = it / 12, gh = it % 12, g = gh >> 2, h = gh & 3, b = row / SEQ, t = row % SEQ, d = (g == 0) ? 1 : (g == 1) ? 4 : 16, i = t / d, r = t % d;
        const int hc = g * 512 + h * 128 + 2 * F.lane;
        const unsigned qw = *(const unsigned*)(F.PROJ + (size_t)row * NP + C_AQ + hc); const float q0 = bflo(qw), q1 = bfhi(qw);
        float m = -INFINITY, l = 0.f, o0 = 0.f, o1 = 0.f;
        for (int ii = (i > 128 ? i - 128 : 0); ii <= i; ++ii) {
            const size_t kr = (size_t)(b * SEQ + r + d * ii) * NP;
            const unsigned kw = *(const unsigned*)(F.PROJ + kr + C_AK + hc), vw = *(const unsigned*)(F.PROJ + kr + C_AV + hc);
            const float s = wave_sum(q0 * bflo(kw) + q1 * bfhi(kw));
            const float mn = fmaxf(m, s), al = exp2f(m - mn), p = exp2f(s - mn);
            l = l * al + p; o0 = o0 * al + p * bflo(vw); o1 = o1 * al + p * bfhi(vw); m = mn;
        }
        const float il = 1.0f / l;
        *(unsigned*)(F.OG + ((size_t)g * T + row) * 512 + h * 128 + 2 * F.lane) = pk2(o0 * il, o1 * il);
        if (F.lane == 0) F.LSE[((size_t)g * T + row) * 4 + h] = m + log2f(l);
    }
}
__device__ __forceinline__ void naive_conv(Frame& F) {
    const long gthreads = (long)F.G * NTHREADS, gtid = (long)blockIdx.x * NTHREADS + F.tid;
    for (long it = gtid; it < (long)T * 2048; it += gthreads) {
        const int c = (int)(it & 2047), row = (int)(it >> 11), t = row % SEQ;
        float a = 0.f;
#pragma unroll
        for (int j = 0; j < 4; ++j) if (t - 3 + j >= 0) a += F.conv_qk[j * 2048 + c] * bf2f(F.PROJ[(size_t)(row - 3 + j) * NP + C_MQ + c]);
        const float y = a / (1.0f + __expf(-a));
        if (c < 1024) F.QC[(size_t)row * 1024 + c] = y; else F.KC[(size_t)row * 1024 + c - 1024] = y * 0.0625f;
    }
}
__device__ __forceinline__ void naive_mlstm(Frame& F) {
    LAS float* sq = (LAS float*)F.lds; LAS float* sk = sq + 256; LAS float* red = sk + 256; LAS float* redn = red + 512;
    for (int item = blockIdx.x; item < NB * 4 * 8; item += F.G) {
        const int sl = item & 7, h = (item >> 3) & 3, b = item >> 5, dvl = F.tid & 31, dkp = F.tid >> 5;
        float c[16], n[16];
#pragma unroll
        for (int j = 0; j < 16; ++j) { c[j] = 0.f; n[j] = 0.f; }
        float m = 0.f;
        for (int t = 0; t < SEQ; ++t) {
            const size_t row = (size_t)b * SEQ + t;
            __syncthreads();
            if (F.tid < 256) sq[F.tid] = F.QC[row * 1024 + h * 256 + F.tid]; else sk[F.tid - 256] = F.KC[row * 1024 + h * 256 + F.tid - 256];
            const float v = bf2f(F.PROJ[row * NP + C_MV + h * 256 + sl * 32 + dvl]);
            const float ir = F.GATES[row * 8 + h], fr = F.GATES[row * 8 + 4 + h];
            const float logf = fminf(fr, 0.f) - log1pf(__expf(-fabsf(fr)));
            const float mn = fmaxf(logf + m, ir), fa = __expf(logf + m - mn), ia = __expf(ir - mn);
            m = mn;
            __syncthreads();
            float pn = 0.f, pd = 0.f;
#pragma unroll
            for (int j = 0; j < 16; ++j) { const float kk = sk[dkp * 16 + j], qq = sq[dkp * 16 + j]; c[j] = fa * c[j] + ia * kk * v; n[j] = fa * n[j] + ia * kk; pn += qq * c[j]; pd += qq * n[j]; }
            red[dkp * 32 + dvl] = pn; redn[dkp * 32 + dvl] = pd;
            __syncthreads();
            if (F.tid < 32) { float num = 0.f, den = 0.f;
#pragma unroll
                for (int p = 0; p < 16; ++p) { num += red[p * 32 + F.tid]; den += redn[p * 32 + F.tid]; }
                F.HT[row * 1024 + h * 256 + sl * 32 + F.tid] = num / fmaxf(fabsf(den), __expf(-mn)); }
        }
    }
}
__device__ __forceinline__ void naive_p4(Frame& F) {
    const bf16 *AM = F.AM, *PJ = F.PROJ; const float *WA = F.w_attn_out, *WM = F.w_mlstm_out; bf16* O = F.AM + 1536;
    float* tmp = F.QC;
    naive_gemm<8>(F, T, D, 512, [=](int r, int k) { return bf2f(AM[(size_t)r * AMLD + k]); }, [=](int k, int c) { return bf2f(f2bf(WA[(size_t)k * D + c])); },
        [=](int r, int c, float a) { tmp[(size_t)r * D + c] = a * sigmoidf_(bf2f(PJ[(size_t)r * NP + C_GA + c])); });
    __threadfence();
    naive_gemm<8>(F, T, D, D, [=](int r, int k) { return bf2f(AM[(size_t)r * AMLD + 512 + k]); }, [=](int k, int c) { return bf2f(f2bf(WM[(size_t)k * D + c])); },
        [=](int r, int c, float a) { O[(size_t)r * AMLD + c] = (bf16)f2bf(tmp[(size_t)r * D + c] + a * sigmoidf_(bf2f(PJ[(size_t)r * NP + C_GM + c]))); });
}
__device__ __forceinline__ void naive_p5(Frame& F) {
    const bf16* MG = F.AM + 1536; const float *WO = F.w_mix_out, *X = F.x; float* H = F.H;
    naive_gemm<8>(F, T, D, D, [=](int r, int k) { return bf2f(MG[(size_t)r * AMLD + k]); }, [=](int k, int c) { return bf2f(f2bf(WO[(size_t)k * D + c])); },
        [=](int r, int c, float a) { H[(size_t)r * D + c] = X[(size_t)r * D + c] + a; });
}
__device__ __forceinline__ void naive_p8(Frame& F, int ntiles) {
    const long gthreads = (long)F.G * NTHREADS, gtid = (long)blockIdx.x * NTHREADS + F.tid;
    const unsigned* tile_e = F.ctl + CW_TILEE;
    for (long it = gtid; it < (long)ntiles * 256 * D; it += gthreads) {
        const int j = (int)(it & 1023), row = (int)(it >> 10), e = (int)tile_e[row >> 8];
        if (F.ROW_TOK[row] < 0) { F.ACT[(size_t)row * D + j] = 0; continue; }
        const float* W = F.w_gate_up + (size_t)e * D * 2048; float g = 0.f, u = 0.f;
        for (int k = 0; k < D; ++k) { const float a = bf2f(F.XS[(size_t)row * D + k]); g += a * bf2f(f2bf(W[(size_t)k * 2048 + 2 * j])); u += a * bf2f(f2bf(W[(size_t)k * 2048 + 2 * j + 1])); }
        g += F.b_gate_up[e * 2048 + 2 * j]; u += F.b_gate_up[e * 2048 + 2 * j + 1];
        const float gg = fminf(g, 7.0f), uu = fminf(fmaxf(u, -7.0f), 7.0f);
        F.ACT[(size_t)row * D + j] = (bf16)f2bf((uu + 1.0f) * gg / (1.0f + __expf(-1.702f * gg)));
    }
}
__device__ __forceinline__ void naive_p9(Frame& F, int ntiles) {
    const long gthreads = (long)F.G * NTHREADS, gtid = (long)blockIdx.x * NTHREADS + F.tid;
    const unsigned* tile_e = F.ctl + CW_TILEE;
    for (long it = gtid; it < (long)ntiles * 256 * D; it += gthreads) {
        const int c = (int)(it & 1023), row = (int)(it >> 10), e = (int)tile_e[row >> 8], tk = F.ROW_TOK[row];
        if (tk < 0) continue;
        const float* W = F.w_down + (size_t)e * D * D; float y = 0.f;
        for (int k = 0; k < D; ++k) y += bf2f(F.ACT[(size_t)row * D + k]) * bf2f(f2bf(W[(size_t)k * D + c]));
        F.YBUF[(size_t)tk * D + c] = (bf16)f2bf((y + F.b_down[e * D + c]) * F.ROW_W[row]);
    }
}

__device__ __forceinline__ void p3_post_mixer(Frame& F) {
    for (int row = F.gw; row < T; row += F.NGW) {
        { const int h = F.lane >> 4; float l0 = F.LSE[((size_t)0 * T + row) * 4 + h], l1 = F.LSE[((size_t)1 * T + row) * 4 + h], l2 = F.LSE[((size_t)2 * T + row) * 4 + h];
          const float mx = fmaxf(l0, fmaxf(l1, l2)); float w0 = exp2f(l0 - mx), w1 = exp2f(l1 - mx), w2 = exp2f(l2 - mx); const float inv = 1.0f / (w0 + w1 + w2); w0 *= inv; w1 *= inv; w2 *= inv;
          const u32x4 a = *(const u32x4*)(F.OG + ((size_t)0 * T + row) * 512 + 8 * F.lane), b = *(const u32x4*)(F.OG + ((size_t)1 * T + row) * 512 + 8 * F.lane), c = *(const u32x4*)(F.OG + ((size_t)2 * T + row) * 512 + 8 * F.lane);
          f32x4 a0, a1, b0, b1, c0, c1; pg8::unpack8(a, a0, a1); pg8::unpack8(b, b0, b1); pg8::unpack8(c, c0, c1);
          const f32x4 o0 = a0 * w0 + b0 * w1 + c0 * w2, o1 = a1 * w0 + b1 * w1 + c1 * w2;
          u32x4 w; w.x = pk2(o0[0], o0[1]); w.y = pk2(o0[2], o0[3]); w.z = pk2(o1[0], o1[1]); w.w = pk2(o1[2], o1[3]);
          *(u32x4*)(F.AM + (size_t)row * AMLD + 8 * F.lane) = w; }
        { f32x4 v[4]; float s = 0.f;
#if FAST_MLSTM
          { const bf16* hp = (const bf16*)F.HT + (size_t)row * D + 16 * F.lane; const u32x4 w0 = *(const u32x4*)hp, w1 = *(const u32x4*)(hp + 8); pg8::unpack8(w0, v[0], v[1]); pg8::unpack8(w1, v[2], v[3]); }
#else
          { const float* hp = F.HT + (size_t)row * D + 16 * F.lane;
#pragma unroll
            for (int j = 0; j < 4; ++j) v[j] = *(const f32x4*)(hp + 4 * j); }
#endif
#pragma unroll
          for (int j = 0; j < 4; ++j) s += (v[j].x + v[j].y) + (v[j].z + v[j].w);
          s += __shfl_xor(s, 1); s += __shfl_xor(s, 2); s += __shfl_xor(s, 4); s += __shfl_xor(s, 8);
          const float mu = s * (1.0f / 256.0f); float q = 0.f;
#pragma unroll
          for (int j = 0; j < 4; ++j) { v[j] = v[j] - mu; q += (v[j].x * v[j].x + v[j].y * v[j].y) + (v[j].z * v[j].z + v[j].w * v[j].w); }
          q += __shfl_xor(q, 1); q += __shfl_xor(q, 2); q += __shfl_xor(q, 4); q += __shfl_xor(q, 8);
          const float rstd = 1.0f / sqrtf(q * (1.0f / 256.0f) + LN_EPS);
          const bf16* mo = F.PROJ + (size_t)row * NP + C_MO + 16 * F.lane; bf16* op = F.AM + (size_t)row * AMLD + 512 + 16 * F.lane;
#pragma unroll
          for (int jj = 0; jj < 2; ++jj) { const u32x4 mw = *(const u32x4*)(mo + 8 * jj); f32x4 m0, m1; pg8::unpack8(mw, m0, m1);
              const f32x4 g0 = *(const f32x4*)(F.g_mnorm + 16 * F.lane + 8 * jj), g1 = *(const f32x4*)(F.g_mnorm + 16 * F.lane + 8 * jj + 4);
              const f32x4 o0 = v[2 * jj] * rstd * g0 * pg8::sig4(m0), o1 = v[2 * jj + 1] * rstd * g1 * pg8::sig4(m1);
              u32x4 w; w.x = pk2(o0[0], o0[1]); w.y = pk2(o0[2], o0[3]); w.z = pk2(o1[0], o1[1]); w.w = pk2(o1[2], o1[3]);
              *(u32x4*)(op + 8 * jj) = w; } }
    }
}

constexpr int RT_WS = 1028;
constexpr int RT_TAB = NE * RT_WS * 4, RT_CNT = RT_TAB + 64 * 4 * 12;
static_assert(RT_CNT + 256 <= LDSCTL_OFF, "router LDS map");
__device__ __forceinline__ void p6_router(Frame& F) {
    LAS float* wt = (LAS float*)F.lds;
    LAS int* tab = (LAS int*)(F.lds + RT_TAB); LAS int* cntl = (LAS int*)(F.lds + RT_CNT); LAS int* basel = cntl + 32;
    const int lane = F.lane;
    for (int r0 = 0; r0 < T; r0 += F.NGW * 8) {
        __syncthreads();
        if (r0 == 0) for (int i = F.tid; i < D * NE; i += NTHREADS) wt[(i & 31) * RT_WS + (i >> 5)] = F.w_router[i];
        if (F.tid < 32) cntl[F.tid] = 0;
        __syncthreads();
        f32x4 vn[4];
        { const int row = r0 + F.gw; if (row < T) { const f32x4* hr = (const f32x4*)(F.H + (size_t)row * D) + lane;
#pragma unroll
            for (int j = 0; j < 4; ++j) vn[j] = hr[64 * j]; } }
        for (int ri = 0; ri < 8; ++ri) {
            const int row = r0 + ri * F.NGW + F.gw; if (row >= T) break;
            f32x4 v[4]; float s = 0.f;
#pragma unroll
            for (int j = 0; j < 4; ++j) { v[j] = vn[j]; s += (v[j].x * v[j].x + v[j].y * v[j].y) + (v[j].z * v[j].z + v[j].w * v[j].w); }
            { const int rown = row + F.NGW; if (ri + 1 < 8 && rown < T) { const f32x4* hr = (const f32x4*)(F.H + (size_t)rown * D) + lane;
#pragma unroll
                for (int j = 0; j < 4; ++j) vn[j] = hr[64 * j]; } }
            const float rstd = 1.0f / sqrtf(wave_sum(s) * (1.0f / D) + RMS_EPS);
            unsigned long long* o8 = (unsigned long long*)(F.XN + (size_t)row * D) + lane;
#pragma unroll
            for (int j = 0; j < 4; ++j) { const f32x4 g = *((const f32x4*)F.g_ffn + lane + 64 * j); v[j] = v[j] * rstd * g;
#if MOE_FP8
                ((unsigned*)((unsigned char*)F.XN + (size_t)row * D))[lane + 64 * j] = pk4_fp8(v[j].x, v[j].y, v[j].z, v[j].w); }
#else
                o8[64 * j] = (unsigned long long)pk2(v[j].x, v[j].y) | ((unsigned long long)pk2(v[j].z, v[j].w) << 32); }
#endif
            float lg[32];
#pragma unroll
            for (int e = 0; e < 32; ++e) { float a = 0.f;
#pragma unroll
                for (int j = 0; j < 4; ++j) { const f32x4 w = *((const LAS f32x4*)(wt + e * RT_WS) + lane + 64 * j); a += (v[j].x * w.x + v[j].y * w.y) + (v[j].z * w.z + v[j].w * w.w); }
                lg[e] = a; if ((e & 3) == 3) asm volatile("" ::: "memory"); }
#define RT_BF(N_, O_) do { const bool up = (lane & (O_)) != 0; _Pragma("unroll") for (int i = 0; i < (N_); ++i) { const float send = up ? lg[i] : lg[i + (N_)]; const float keep = up ? lg[i + (N_)] : lg[i]; lg[i] = keep + __shfl_xor(send, (O_)); } } while (0)
            RT_BF(16, 32); RT_BF(8, 16); RT_BF(4, 8); RT_BF(2, 4); RT_BF(1, 2);
#undef RT_BF
            float lgt = lg[0] + __shfl_xor(lg[0], 1);
            const int e = (lane >> 1) & 31;
            lgt += F.b_router[e];
            float tv[4]; int ti[4]; float cur = lgt;
#pragma unroll
            for (int r = 0; r < 4; ++r) { float bv = cur; int bi = e;
#pragma unroll
                for (int o = 2; o < 64; o <<= 1) { const float ov = __shfl_xor(bv, o); const int oi = __shfl_xor(bi, o); if (ov > bv || (ov == bv && oi < bi)) { bv = ov; bi = oi; } }
                tv[r] = bv; ti[r] = bi; if (e == bi) cur = -INFINITY; }
            const float e1 = __expf(tv[1] - tv[0]), e2 = __expf(tv[2] - tv[0]), e3 = __expf(tv[3] - tv[0]), inv = 1.0f / (1.0f + e1 + e2 + e3);
            if (lane < 4) {
                const int ee = (lane == 0) ? ti[0] : (lane == 1) ? ti[1] : (lane == 2) ? ti[2] : ti[3];
                const float ww = ((lane == 0) ? 1.0f : (lane == 1) ? e1 : (lane == 2) ? e2 : e3) * inv;
                const int loc = __hip_atomic_fetch_add(cntl + ee, 1, __ATOMIC_RELAXED, __HIP_MEMORY_SCOPE_WORKGROUP);
                LAS int* tp = tab + ((ri * 8 + F.wave) * 4 + lane) * 3; tp[0] = ee; tp[1] = loc; tp[2] = __float_as_int(ww);
            }
        }
        __syncthreads();
        if (F.tid < 32) basel[F.tid] = (int)atomicAdd(F.ctl + CW_CNT + 64 * F.tid, (unsigned)cntl[F.tid]);
        __syncthreads();
        if (lane < 4) for (int ri = 0; ri < 8; ++ri) {
            const int row = r0 + ri * F.NGW + F.gw; if (row >= T) break;
            const LAS int* tp = tab + ((ri * 8 + F.wave) * 4 + lane) * 3; const int ee = tp[0];
            F.TOK_E[row * 4 + lane] = ee; F.TOK_SLOT[row * 4 + lane] = basel[ee] + tp[1]; F.TOK_W[row * 4 + lane] = __int_as_float(tp[2]);
        }
    }
}

constexpr int RM_WS = 2064;
constexpr int RM_HI = 0, RM_LO = NE * RM_WS, RM_RSTD = 2 * NE * RM_WS, RM_TAB = RM_RSTD + 256, RM_CNT = RM_TAB + 64 * 4 * 12;
static_assert(RM_CNT + 256 <= LDSCTL_OFF, "router LDS map");
__device__ __forceinline__ void p6_router_mfma(Frame& F) {
    LAS unsigned char* L = F.lds;
    LAS float* rstdl = (LAS float*)(L + RM_RSTD); LAS int* tab = (LAS int*)(L + RM_TAB); LAS int* cntl = (LAS int*)(L + RM_CNT); LAS int* basel = cntl + 32;
    const int lane = F.lane, fr = lane & 15, fq = lane >> 4, w = F.wave;
    __syncthreads();
    for (int i0 = F.tid; i0 < D * NE; i0 += 16 * NTHREADS) {
        float wv[16], gv[16];
#pragma unroll
        for (int j = 0; j < 16; ++j) { const int i = i0 + j * NTHREADS; wv[j] = F.w_router[i]; gv[j] = F.g_ffn[i >> 5]; }
#pragma unroll
        for (int j = 0; j < 16; ++j) { const int i = i0 + j * NTHREADS, k = i >> 5, e = i & 31; const float w = wv[j] * gv[j];
            const unsigned hi = f2bf(w), lo = f2bf(w - bf2f(hi));
            *(LAS bf16*)(L + RM_HI + e * RM_WS + 2 * k) = (bf16)hi; *(LAS bf16*)(L + RM_LO + e * RM_WS + 2 * k) = (bf16)lo; } }
    const float br0 = F.b_router[fr], br1 = F.b_router[16 + fr];
    for (int rg = F.vcu; rg < T / 64; rg += F.G) {
        __syncthreads();
        if (F.tid < 32) cntl[F.tid] = 0;
        __syncthreads();
        if (w < 4) {
            const int row0 = rg * 64 + 16 * w;
            const float* hp = F.H + (size_t)(row0 + fr) * D + 8 * fq;
            const LAS unsigned char* bh = L + RM_HI + fr * RM_WS + 16 * fq; const LAS unsigned char* bl = L + RM_LO + fr * RM_WS + 16 * fq;
            f32x4 acc[2] = {(f32x4){0.f, 0.f, 0.f, 0.f}, (f32x4){0.f, 0.f, 0.f, 0.f}}; float ss = 0.f;
#pragma unroll 4
            for (int ks = 0; ks < 32; ++ks) {
                const f32x4 a0 = *(const f32x4*)(hp + 32 * ks), a1 = *(const f32x4*)(hp + 32 * ks + 4);
                ss += (a0.x * a0.x + a0.y * a0.y) + (a0.z * a0.z + a0.w * a0.w) + (a1.x * a1.x + a1.y * a1.y) + (a1.z * a1.z + a1.w * a1.w);
                u32x4 hw; hw.x = pk2(a0.x, a0.y); hw.y = pk2(a0.z, a0.w); hw.z = pk2(a1.x, a1.y); hw.w = pk2(a1.z, a1.w);
                u32x4 lw; lw.x = pk2(a0.x - bflo(hw.x), a0.y - bfhi(hw.x)); lw.y = pk2(a0.z - bflo(hw.y), a0.w - bfhi(hw.y));
                lw.z = pk2(a1.x - bflo(hw.z), a1.y - bfhi(hw.z)); lw.w = pk2(a1.z - bflo(hw.w), a1.w - bfhi(hw.w));
                const bf16x8 ahi = __builtin_bit_cast(bf16x8, hw), alo = __builtin_bit_cast(bf16x8, lw);
#pragma unroll
                for (int nt = 0; nt < 2; ++nt) { const bf16x8 bhi = *(const LAS bf16x8*)(bh + 16 * nt * RM_WS + 64 * ks), blo = *(const LAS bf16x8*)(bl + 16 * nt * RM_WS + 64 * ks);
                    acc[nt] = __builtin_amdgcn_mfma_f32_16x16x32_bf16(ahi, bhi, acc[nt], 0, 0, 0);
                    acc[nt] = __builtin_amdgcn_mfma_f32_16x16x32_bf16(ahi, blo, acc[nt], 0, 0, 0);
                    acc[nt] = __builtin_amdgcn_mfma_f32_16x16x32_bf16(alo, bhi, acc[nt], 0, 0, 0); }
            }
            ss += __shfl_xor(ss, 16); ss += __shfl_xor(ss, 32);
            const float rstd = 1.0f / sqrtf(ss * (1.0f / D) + RMS_EPS);
            if (fq == 0) rstdl[16 * w + fr] = rstd;
#pragma unroll
            for (int reg = 0; reg < 4; ++reg) {
                const float rs = __shfl(rstd, 4 * fq + reg);
                float c0 = acc[0][reg] * rs + br0, c1 = acc[1][reg] * rs + br1;
                float tv[4]; int ti[4];
#pragma unroll
                for (int r = 0; r < 4; ++r) { float bv = (c0 >= c1) ? c0 : c1; int bi = (c0 >= c1) ? fr : 16 + fr;
#pragma unroll
                    for (int o = 1; o < 16; o <<= 1) { const float ov = __shfl_xor(bv, o); const int oi = __shfl_xor(bi, o); if (ov > bv || (ov == bv && oi < bi)) { bv = ov; bi = oi; } }
                    tv[r] = bv; ti[r] = bi; if (bi == fr) c0 = -INFINITY; if (bi == 16 + fr) c1 = -INFINITY; }
                const float e1 = __expf(tv[1] - tv[0]), e2 = __expf(tv[2] - tv[0]), e3 = __expf(tv[3] - tv[0]), inv = 1.0f / (1.0f + e1 + e2 + e3);
                if (fr < 4) {
                    const int ee = (fr == 0) ? ti[0] : (fr == 1) ? ti[1] : (fr == 2) ? ti[2] : ti[3];
                    const float ww = ((fr == 0) ? 1.0f : (fr == 1) ? e1 : (fr == 2) ? e2 : e3) * inv;
                    const int loc = __hip_atomic_fetch_add(cntl + ee, 1, __ATOMIC_RELAXED, __HIP_MEMORY_SCOPE_WORKGROUP);
                    LAS int* tp = tab + ((16 * w + 4 * fq + reg) * 4 + fr) * 3; tp[0] = ee; tp[1] = loc; tp[2] = __float_as_int(ww);
                }
            }
        }
        __syncthreads();
        if (F.tid < 32) basel[F.tid] = (int)atomicAdd(F.ctl + CW_CNT + 64 * F.tid, (unsigned)cntl[F.tid]);
#pragma unroll 2
        for (int i = 0; i < 8; ++i) { const int rl = 8 * w + i, row = rg * 64 + rl; const float rs = rstdl[rl];
            const f32x4* hr = (const f32x4*)(F.H + (size_t)row * D) + lane;
#pragma unroll
            for (int j = 0; j < 4; ++j) { const f32x4 g = *((const f32x4*)F.g_ffn + lane + 64 * j); const f32x4 v = hr[64 * j] * rs * g;
                ((unsigned*)((unsigned char*)F.XN + (size_t)row * D))[lane + 64 * j] = pk4_fp8(v.x, v.y, v.z, v.w); } }
        __syncthreads();
        if (F.tid < 256) { const int rl = F.tid >> 2, k = F.tid & 3, row = rg * 64 + rl; const LAS int* tp = tab + (rl * 4 + k) * 3; const int ee = tp[0];
            F.TOK_E[row * 4 + k] = ee; F.TOK_SLOT[row * 4 + k] = basel[ee] + tp[1]; F.TOK_W[row * 4 + k] = __int_as_float(tp[2]); }
    }
}

__device__ __forceinline__ void p7_gather(Frame& F) {
    LAS int* pst = (LAS int*)F.lds;
    LAS int* cntl = pst + 64;
    int tid = (int)threadIdx.x; asm volatile("" : "+v"(tid));
    __syncthreads();
    if (tid < NE) cntl[tid] = (int)F.ctl[CW_CNT + 64 * tid];
    __syncthreads();
    if (tid == 0) { int acc = 0; for (int e = 0; e < NE; ++e) { pst[e] = acc; acc += (cntl[e] + 255) & ~255; } pst[NE] = acc; }
    __syncthreads();
    if (blockIdx.x == 0) {
        if (tid == 0) F.ctl[CW_NTILES] = (unsigned)(pst[NE] >> 8);
        if (tid < NE) { const int t0 = pst[tid] >> 8, t1 = pst[tid + 1] >> 8; for (int k = t0; k < t1; ++k) F.ctl[CW_TILEE + k] = (unsigned)tid; }
    }
#if MOE_FP8
    { const int gthreads = F.G * NTHREADS, gtid = F.vcu * NTHREADS + F.tid;
      for (int a = gtid; a < NA; a += gthreads) { const int e = F.TOK_E[a], dest = pst[e] + F.TOK_SLOT[a]; F.ROW_TOK[dest] = a; F.ROW_W[dest] = F.TOK_W[a]; }
      for (int e = 0; e < NE; ++e) { const int c = cntl[e], pe = (c + 255) & ~255;
          for (int r = c + gtid; r < pe; r += gthreads) { F.ROW_TOK[pst[e] + r] = -1; F.ROW_W[pst[e] + r] = 0.f; } } }
#else
    for (int a = F.gw; a < NA; a += F.NGW) {
        const int e = F.TOK_E[a], dest = pst[e] + F.TOK_SLOT[a];
        { const u32x4* src = (const u32x4*)(F.XN + (size_t)(a >> 2) * D) + F.lane; u32x4* dst = (u32x4*)(F.XS + (size_t)dest * D) + F.lane;
        const u32x4 v0 = src[0], v1 = src[64]; dst[0] = v0; dst[64] = v1; }
        if (F.lane == 0) { F.ROW_TOK[dest] = a; F.ROW_W[dest] = F.TOK_W[a]; }
    }
    for (int e = 0; e < NE; ++e) { const int c = cntl[e], pe = (c + 255) & ~255;
        for (int r = c + F.gw; r < pe; r += F.NGW) { const int dest = pst[e] + r; const u32x4 z = (u32x4){0u, 0u, 0u, 0u};
            { u32x4* dst = (u32x4*)(F.XS + (size_t)dest * D) + F.lane; dst[0] = z; dst[64] = z; }
            if (F.lane == 0) { F.ROW_TOK[dest] = -1; F.ROW_W[dest] = 0.f; } } }
#endif
}

__device__ __forceinline__ void p10_final(Frame& F) {
    f32x4 hn[4]; u32x2 yn[4][4];
#define P10_LOAD(r_) do { const f32x4* hr_ = (const f32x4*)(F.H + (size_t)(r_) * D) + F.lane; \
        _Pragma("unroll") for (int j = 0; j < 4; ++j) { hn[j] = hr_[64 * j]; _Pragma("unroll") for (int k = 0; k < 4; ++k) yn[j][k] = *((const u32x2*)(F.YBUF + ((size_t)(r_) * 4 + k) * D) + F.lane + 64 * j); } } while (0)
    if (F.gw < T) P10_LOAD(F.gw);
    for (int row = F.gw; row < T; row += F.NGW) {
        f32x4 v[4]; float s = 0.f;
#pragma unroll
        for (int j = 0; j < 4; ++j) { v[j] = hn[j];
#pragma unroll
            for (int k = 0; k < 4; ++k) { const u32x2 w = yn[j][k]; v[j].x += bflo(w.x); v[j].y += bfhi(w.x); v[j].z += bflo(w.y); v[j].w += bfhi(w.y); }
            s += (v[j].x * v[j].x + v[j].y * v[j].y) + (v[j].z * v[j].z + v[j].w * v[j].w); }
        if (row + F.NGW < T) P10_LOAD(row + F.NGW);
        const float rstd = 1.0f / sqrtf(wave_sum(s) * (1.0f / D) + RMS_EPS);
        f32x4* orow = (f32x4*)(F.out + (size_t)row * D) + F.lane;
#pragma unroll
        for (int j = 0; j < 4; ++j) { const f32x4 g = *((const f32x4*)F.g_final + F.lane + 64 * j); orow[64 * j] = v[j] * rstd * g; }
    }
#undef P10_LOAD
}

typedef float f32x16 __attribute__((ext_vector_type(16)));
typedef short s16x4 __attribute__((ext_vector_type(4)));
constexpr int ATT_SCR_OFF = RING_BYTES;
__device__ __forceinline__ int crow16(int r, int hi) { return (r & 3) + 8 * (r >> 2) + 4 * hi; }
__device__ __forceinline__ s16x4 lds_tr16(const LAS unsigned char* p) { return __builtin_bit_cast(s16x4, __builtin_amdgcn_ds_read_tr16_b64_v4i16((LAS s16x4*)p)); }

struct AttItem { int b, g, hd, r, n, d; };
__device__ __forceinline__ AttItem att_decode(int it) {
    AttItem a; const int i = it >> 8, c = it & 255; a.g = i % 3; const int idx = (i / 3) * 256 + c, rn = idx & 15; a.b = idx >> 6; a.hd = (idx >> 4) & 3;
    a.r = (a.g == 0) ? 0 : (a.g == 1) ? (rn >> 2) : rn; a.n = (a.g == 0) ? rn : (a.g == 1) ? (rn & 3) : 0; a.d = (a.g == 0) ? 1 : (a.g == 1) ? 4 : 16; return a;
}
__device__ __forceinline__ const bf16* att_base(Frame& F, const AttItem& a) { return F.PROJ + (size_t)(a.b * SEQ + a.r) * NP + a.g * 512 + a.hd * 128; }
#define ATT_LOADKV(dst, a_, coff_) do { const bf16* base_ = att_base(F, a_) + (coff_) + 8 * (F.tid & 15); const size_t rs_ = (size_t)(a_).d * NP; const int i0_ = 128 * ((a_).n - 1) + (F.tid >> 4); \
        _Pragma("unroll") for (int p_ = 0; p_ < 8; ++p_) { if ((a_).n == 0 && p_ < 4) continue; dst[p_] = *(const u32x4*)(base_ + (size_t)(i0_ + 32 * p_) * rs_); } } while (0)

__device__ __forceinline__ void attn_phase(Frame& F) {
    const int lane = F.lane, w = F.wave, fr = lane & 15, fq = lane >> 4;
    LAS unsigned char* Ks = F.lds; LAS unsigned char* Vs = F.lds + 65536;
    const int kc = F.tid & 15, kk0 = F.tid >> 4;
    u32x4 kreg[8], vreg[8]; bf16x8 qn[4];
#define ATT_LOADQ(dst, a_) do { const bf16* qrow_ = att_base(F, a_) + (size_t)(128 * (a_).n + 16 * w + fr) * ((size_t)(a_).d * NP) + C_AQ + 8 * fq; \
        _Pragma("unroll") for (int s_ = 0; s_ < 4; ++s_) dst[s_] = *(const bf16x8*)(qrow_ + 32 * s_); } while (0)
#if ATT_QUEUE
    LAS int* slot = (LAS int*)(F.lds + RING_BYTES);
    int pend = 0;
    __syncthreads();
    if (F.tid == 0) { const int g0 = (int)atomicAdd(F.ctl + CW_ACTR, 2u); slot[0] = g0; pend = g0 + 1; }
    __syncthreads();
    int it = __builtin_amdgcn_readfirstlane(slot[0]);
#else
    int it = F.vcu;
#endif
    if (it < 1536) { const AttItem a0 = att_decode(it); ATT_LOADKV(kreg, a0, C_AK); ATT_LOADKV(vreg, a0, C_AV); ATT_LOADQ(qn, a0); }
    while (it < 1536) {
        const AttItem a = att_decode(it); const int n = a.n, d = a.d;
        __syncthreads();
#if ATT_QUEUE
        if (F.tid == 0) { slot[0] = pend; pend = (int)atomicAdd(F.ctl + CW_ACTR, 1u); }
#endif
#pragma unroll
        for (int pass = 0; pass < 8; ++pass) { if (n == 0 && pass < 4) continue; const int key = pass * 32 + kk0;
            *(LAS u32x4*)(Ks + key * 256 + ((kc ^ (key & 15)) << 4)) = kreg[pass];
            *(LAS u32x4*)(Vs + key * 256 + ((((kc >> 2) ^ (key & 3)) << 6) | ((kc & 3) << 4))) = vreg[pass]; }
        bf16x8 qf[4];
#pragma unroll
        for (int s = 0; s < 4; ++s) qf[s] = qn[s];
        __syncthreads();
#if ATT_QUEUE
        const int itn = __builtin_amdgcn_readfirstlane(slot[0]);
#else
        const int itn = it + F.G;
#endif
        if (itn < 1536) { const AttItem an = att_decode(itn); ATT_LOADKV(kreg, an, C_AK); ATT_LOADKV(vreg, an, C_AV); ATT_LOADQ(qn, an); }
        f32x4 S[10];
#pragma unroll
        for (int i = 0; i < 9; ++i) {
            const int kt = w + i; const bool act = !(n == 0 && kt < 8);
            f32x4 acc = (f32x4){0.f, 0.f, 0.f, 0.f};
            if (act) {
                const LAS unsigned char* kp = Ks + (kt * 16 + fr) * 256;
#pragma unroll
                for (int s = 0; s < 4; ++s) { const bf16x8 kf = *(const LAS bf16x8*)(kp + (((4 * s + fq) ^ fr) << 4)); acc = __builtin_amdgcn_mfma_f32_16x16x32_bf16(kf, qf[s], acc, 0, 0, 0); }
                if (i == 0) {
#pragma unroll
                    for (int r = 0; r < 4; ++r) if (4 * fq + r < fr) acc[r] = -INFINITY; }
                if (i == 8) {
#pragma unroll
                    for (int r = 0; r < 4; ++r) if (4 * fq + r > fr) acc[r] = -INFINITY; }
            } else acc = (f32x4){-INFINITY, -INFINITY, -INFINITY, -INFINITY};
            S[i] = acc;
        }
        float m = -INFINITY;
#pragma unroll
        for (int i = 0; i < 9; ++i)
#pragma unroll
            for (int r = 0; r < 4; ++r) m = fmaxf(m, S[i][r]);
        m = fmaxf(m, __shfl_xor(m, 16)); m = fmaxf(m, __shfl_xor(m, 32));
        float l = 0.f;
#pragma unroll
        for (int i = 0; i < 9; ++i)
#pragma unroll
            for (int r = 0; r < 4; ++r) { const float p = __builtin_amdgcn_exp2f(S[i][r] - m); S[i][r] = p; l += p; }
        l += __shfl_xor(l, 16); l += __shfl_xor(l, 32);
        S[9] = (f32x4){0.f, 0.f, 0.f, 0.f};
        f32x4 O[8];
#pragma unroll
        for (int t = 0; t < 8; ++t) O[t] = (f32x4){0.f, 0.f, 0.f, 0.f};
        const int q4 = fr >> 2, p4 = lane & 3;
#pragma unroll
        for (int p = 0; p < 5; ++p) {
            const int kt0 = w + 2 * p, kt1 = kt0 + 1;
            const bool act0 = !(n == 0 && kt0 < 8), act1 = (2 * p + 1 < 9) && !(n == 0 && kt1 < 8);
            if (act0 || act1) {
                u32x4 pw; pw.x = pg8::cvt_pk_bf16(S[2 * p][0], S[2 * p][1]); pw.y = pg8::cvt_pk_bf16(S[2 * p][2], S[2 * p][3]);
                pw.z = pg8::cvt_pk_bf16(S[2 * p + 1][0], S[2 * p + 1][1]); pw.w = pg8::cvt_pk_bf16(S[2 * p + 1][2], S[2 * p + 1][3]);
                const bf16x8 pa = __builtin_bit_cast(bf16x8, pw);
                const int key0 = kt0 * 16 + 4 * fq + q4, key1 = kt1 * 16 + 4 * fq + q4;
#pragma unroll
                for (int t = 0; t < 8; ++t) {
                    const int col = 16 * t + 4 * p4;
                    const int coff = ((((col >> 5) ^ q4) << 6) | ((col & 31) << 1));
                    s16x4 lo = (s16x4){0, 0, 0, 0}, hi = (s16x4){0, 0, 0, 0};
                    if (act0) lo = lds_tr16(Vs + key0 * 256 + coff);
                    if (act1) hi = lds_tr16(Vs + key1 * 256 + coff);
                    const bf16x8 vb = (bf16x8){lo[0], lo[1], lo[2], lo[3], hi[0], hi[1], hi[2], hi[3]};
                    O[t] = __builtin_amdgcn_mfma_f32_16x16x32_bf16(pa, vb, O[t], 0, 0, 0);
                }
            }
        }
        const float linv = frcp(l);
        const size_t tok0 = (size_t)a.b * SEQ + a.r + (size_t)d * (128 * n + 16 * w);
        if (fq == 0) F.LSE[((size_t)a.g * T + tok0 + (size_t)d * fr) * 4 + a.hd] = m + __log2f(l);
#pragma unroll
        for (int r = 0; r < 4; ++r) {
            const int q = 4 * fq + r; const float rl = __shfl(linv, q);
            bf16* op = F.OG + ((size_t)a.g * T + tok0 + (size_t)d * q) * 512 + a.hd * 128 + fr;
#pragma unroll
            for (int t = 0; t < 8; ++t) op[16 * t] = (bf16)f2bf(O[t][r] * rl);
        }
        it = itn;
    }
    __syncthreads();
}
#undef ATT_LOADKV
#undef ATT_LOADQ

constexpr int ML_QS = 528, ML_AS = 144;
constexpr int ML_Q = 0, ML_K = 33792;
constexpr int SC_U = 0, SC_MX = 64, SC_EBD = 128, SC_WI = 192, SC_WK = 256, SC_DEC = 320;
__device__ __forceinline__ f32x4 mfma16(bf16x8 a, bf16x8 b, f32x4 c) { return __builtin_amdgcn_mfma_f32_16x16x32_bf16(a, b, c, 0, 0, 0); }


constexpr size_t WS_QK = WS_QC, WS_SCAL = WS_KC;
__device__ __forceinline__ void mlstm_prepass(Frame& F) {
    const int tid = F.tid, lane = F.lane;
    float* SCAL = (float*)((unsigned char*)F.ctl + WS_SCAL);
    bf16* QK = (bf16*)((unsigned char*)F.ctl + WS_QK);
    if (F.vcu < 32) {
        const int b = F.vcu >> 2, h = F.vcu & 3; const float* gbase = F.GATES + (size_t)(b * SEQ) * 8;
        LAS float* lu = (LAS float*)F.lds; LAS float* lpm = lu + 2048; LAS float* lbc = lpm + 2048; LAS float* lm = lbc + 2048;
        __syncthreads();
#pragma unroll
        for (int i = 0; i < 4; ++i) { const int c = 4 * F.wave + i;
            const float gi = gbase[(size_t)(64 * c + lane) * 8 + h], gf = gbase[(size_t)(64 * c + lane) * 8 + 4 + h];
            const float logf = fminf(gf, 0.f) - __logf(1.0f + __expf(-fabsf(gf)));
            float bc = logf;
#pragma unroll
            for (int o = 1; o < 64; o <<= 1) { const float v = __shfl_up(bc, o); if (lane >= o) bc += v; }
            const float u = gi - bc; float pm = u;
#pragma unroll
            for (int o = 1; o < 64; o <<= 1) { const float v = __shfl_up(pm, o); if (lane >= o) pm = fmaxf(pm, v); }
            lu[64 * c + lane] = u; lpm[64 * c + lane] = pm; lbc[64 * c + lane] = bc; }
        __syncthreads();
        if (tid == 0) { float m = 0.f; for (int c = 0; c < 32; ++c) { const float M63 = fmaxf(m, lpm[64 * c + 63]); lm[c] = m; lm[32 + c] = M63; m = lbc[64 * c + 63] + M63; } }
        __syncthreads();
#pragma unroll
        for (int i = 0; i < 4; ++i) { const int c = 4 * F.wave + i; const float m_carry = lm[c], M63 = lm[32 + c];
            const float u = lu[64 * c + lane], bc = lbc[64 * c + lane], Mx = fmaxf(m_carry, lpm[64 * c + lane]);
            float* sp = SCAL + ((size_t)F.vcu * 32 + c) * 384;
            sp[SC_U + lane] = u; sp[SC_MX + lane] = Mx; sp[SC_EBD + lane] = __expf(-(bc + Mx)); sp[SC_WI + lane] = __expf(m_carry - Mx); sp[SC_WK + lane] = __expf(u - M63);
            sp[SC_DEC + lane] = __expf(m_carry - M63); }
        __syncthreads();
    }
    const int rb = tid >> 8, half = (tid >> 7) & 1, cg = tid & 127;
    float cw[4][8];
#pragma unroll
    for (int j = 0; j < 4; ++j) { const float* p = F.conv_qk + j * 2048 + half * 1024 + 8 * cg; const f32x4 a = *(const f32x4*)p, c = *(const f32x4*)(p + 4);
        cw[j][0] = a[0]; cw[j][1] = a[1]; cw[j][2] = a[2]; cw[j][3] = a[3]; cw[j][4] = c[0]; cw[j][5] = c[1]; cw[j][6] = c[2]; cw[j][7] = c[3]; }
    const float oscale = half ? 0.0625f : 1.0f;
    for (int step = F.vcu; step < T / 16; step += F.G) {
        const int row0 = step * 16 + rb * 8, ts0 = row0 & (SEQ - 1);
        const bf16* src = F.PROJ + (size_t)row0 * NP + (half ? C_MK : C_MQ) + 8 * cg;
        u32x4 raw[11];
#pragma unroll
        for (int r = 0; r < 11; ++r) raw[r] = (ts0 - 3 + r >= 0) ? *(const u32x4*)(src + (ptrdiff_t)(r - 3) * NP) : (u32x4){0u, 0u, 0u, 0u};
        bf16* dst = QK + (size_t)row0 * 2048 + half * 1024 + 8 * cg;
        float xf[11][8];
#pragma unroll
        for (int r = 0; r < 11; ++r) { const u32x4 rw = raw[r]; xf[r][0] = bflo(rw.x); xf[r][1] = bfhi(rw.x); xf[r][2] = bflo(rw.y); xf[r][3] = bfhi(rw.y); xf[r][4] = bflo(rw.z); xf[r][5] = bfhi(rw.z); xf[r][6] = bflo(rw.w); xf[r][7] = bfhi(rw.w); }
#pragma unroll
        for (int o = 0; o < 8; ++o) {
            float y[8];
#pragma unroll
            for (int i = 0; i < 8; ++i) y[i] = (cw[0][i] * xf[o][i] + cw[1][i] * xf[o + 1][i]) + (cw[2][i] * xf[o + 2][i] + cw[3][i] * xf[o + 3][i]);
#pragma unroll
            for (int i = 0; i < 8; ++i) y[i] = y[i] * oscale * frcp(1.0f + __expf(-y[i]));
            u32x4 pw; pw.x = pk2(y[0], y[1]); pw.y = pk2(y[2], y[3]); pw.z = pk2(y[4], y[5]); pw.w = pk2(y[6], y[7]);
            *(u32x4*)(dst + (size_t)o * 2048) = pw; }
    }
}

template <int NDT> struct MLMap {
    static constexpr int VROWS = 16 * (NDT + 1), CT = ML_K + 64 * ML_QS, A = CT + VROWS * ML_QS, VT = A + 64 * ML_AS, VWT = VT + VROWS * ML_AS, SC = VWT + VROWS * ML_AS, END = SC + 4 * 384;
    static_assert(END <= LDSCTL_OFF, "mLSTM LDS map");
};
template <int NDT>
__device__ __forceinline__ void mlstm_item(Frame& F, int b, int h, int sl) {
    typedef MLMap<NDT> MP; constexpr int VROWS = MP::VROWS, PARTS = 2 * NDT, NT2 = NDT / 2, NB5 = NDT + 1;
    const int tid = F.tid, lane = F.lane, w = F.wave, fr = lane & 15, fq = lane >> 4;
    LAS unsigned char* L = F.lds; LAS float* SC = (LAS float*)(L + MP::SC);
    const bf16* qkbase = (const bf16*)((const unsigned char*)F.ctl + WS_QK) + (size_t)(b * SEQ) * 2048 + h * 256 + 8 * (tid & 31);
#ifndef VMAP
#define VMAP 1
#endif
    const bool vact = tid < 64 * PARTS; const int vs = VMAP ? (tid & 63) : (tid / PARTS), vpart = VMAP ? (tid >> 6) : (tid % PARTS);
    const bf16* vbase = F.PROJ + (size_t)(b * SEQ) * NP + C_MV + h * 256 + sl * (16 * NDT) + 8 * vpart;
    const float* scbase = (const float*)((const unsigned char*)F.ctl + WS_SCAL) + (size_t)((b * 4 + h) * 32) * 384 + (tid < 384 ? tid : 0);
    const float* wkbase = (const float*)((const unsigned char*)F.ctl + WS_SCAL) + (size_t)((b * 4 + h) * 32) * 384 + SC_WK + vs;
    __syncthreads();
    for (int i = tid; i < (MP::A - MP::CT) / 4; i += NTHREADS) ((LAS unsigned*)(L + MP::CT))[i] = 0u;
    for (int i = tid; i < (MP::SC - MP::VT) / 4; i += NTHREADS) ((LAS unsigned*)(L + MP::VT))[i] = 0u;
    __syncthreads();
    if (tid < 32) ((LAS unsigned*)(L + MP::VT + (16 * NDT) * ML_AS))[tid] = 0x3F803F80u;
    f32x4 C[2][NB5];
#pragma unroll
    for (int a = 0; a < 2; ++a)
#pragma unroll
        for (int bb = 0; bb < NB5; ++bb) C[a][bb] = (f32x4){0.f, 0.f, 0.f, 0.f};
    u32x4 qk[8]; u32x4 vraw = (u32x4){0u, 0u, 0u, 0u}; float scv = 0.f, wkv = 0.f;
    unsigned hpk[NT2][2];
#define ML_ISSUE(c_) do { const int t0_ = 64 * (c_); \
        _Pragma("unroll") for (int i_ = 0; i_ < 4; ++i_) { const bf16* p_ = qkbase + (size_t)(t0_ + (tid >> 5) + 16 * i_) * 2048; qk[i_] = *(const u32x4*)p_; qk[4 + i_] = *(const u32x4*)(p_ + 1024); } \
        if (vact) { vraw = *(const u32x4*)(vbase + (size_t)(t0_ + vs) * NP); wkv = wkbase[(size_t)(c_) * 384]; } \
        if (tid < 384) scv = scbase[(size_t)(c_) * 384]; } while (0)
    ML_ISSUE(0);
    for (int c = 0; c < 32; ++c) {
        { LAS unsigned char* dq = L + ML_Q + (tid >> 5) * ML_QS + 16 * (tid & 31);
#pragma unroll
          for (int i = 0; i < 4; ++i) { *(LAS u32x4*)(dq + 16 * i * ML_QS) = qk[i]; *(LAS u32x4*)(dq + (ML_K - ML_Q) + 16 * i * ML_QS) = qk[4 + i]; } }
        if (vact) { LAS bf16* vt = (LAS bf16*)(L + MP::VT) + vs; LAS bf16* vw = (LAS bf16*)(L + MP::VWT) + vs;
            const float vf[8] = {bflo(vraw.x), bfhi(vraw.x), bflo(vraw.y), bfhi(vraw.y), bflo(vraw.z), bfhi(vraw.z), bflo(vraw.w), bfhi(vraw.w)};
            const unsigned vr[4] = {vraw.x, vraw.y, vraw.z, vraw.w};
#pragma unroll
            for (int i = 0; i < 4; ++i) { const unsigned pw = pk2(vf[2 * i] * wkv, vf[2 * i + 1] * wkv);
                vt[(8 * vpart + 2 * i) * (ML_AS / 2)] = (bf16)(vr[i] & 0xffffu); vt[(8 * vpart + 2 * i + 1) * (ML_AS / 2)] = (bf16)(vr[i] >> 16);
                vw[(8 * vpart + 2 * i) * (ML_AS / 2)] = (bf16)(pw & 0xffffu); vw[(8 * vpart + 2 * i + 1) * (ML_AS / 2)] = (bf16)(pw >> 16); } }
        if (tid >= 256 && tid < 320) ((LAS bf16*)(L + MP::VWT))[(16 * NDT) * (ML_AS / 2) + tid - 256] = (bf16)f2bf(scv);
        if (tid < 384) SC[tid] = scv;
        __syncthreads();
        if (c > 0) { bf16* hpp = (bf16*)F.HT + (size_t)(b * SEQ + 64 * (c - 1) + 16 * (w & 3) + 4 * fq) * D + h * 256 + sl * (16 * NDT) + 16 * ((w >> 2) * NT2) + fr;
#pragma unroll
            for (int j = 0; j < NT2; ++j) { hpp[16 * j] = (bf16)(hpk[j][0] & 0xffffu); hpp[(size_t)D + 16 * j] = (bf16)(hpk[j][0] >> 16); hpp[(size_t)2 * D + 16 * j] = (bf16)(hpk[j][1] & 0xffffu); hpp[(size_t)3 * D + 16 * j] = (bf16)(hpk[j][1] >> 16); } }
        if (c + 1 < 32) ML_ISSUE(c + 1);
        const int ti = w & 3;
#ifndef DUP_B
#define DUP_B 1
#endif
        for (int dupb = 0; dupb < DUP_B; ++dupb)
        { const int si0 = (w >> 2) * 2;
          const LAS unsigned char* qp = L + ML_Q + (16 * ti + fr) * ML_QS + 16 * fq;
          const LAS unsigned char* kp = L + ML_K + (16 * si0 + fr) * ML_QS + 16 * fq;
          f32x4 sacc[2] = {(f32x4){0.f, 0.f, 0.f, 0.f}, (f32x4){0.f, 0.f, 0.f, 0.f}};
#pragma unroll
          for (int hb = 0; hb < 2; ++hb) {
              bf16x8 qa[4], k0[4], k1[4];
#pragma unroll
              for (int kk = 0; kk < 4; ++kk) { qa[kk] = *(const LAS bf16x8*)(qp + 64 * (4 * hb + kk)); k0[kk] = *(const LAS bf16x8*)(kp + 64 * (4 * hb + kk)); k1[kk] = *(const LAS bf16x8*)(kp + 16 * ML_QS + 64 * (4 * hb + kk)); }
              __builtin_amdgcn_sched_barrier(0);
#pragma unroll
              for (int kk = 0; kk < 4; ++kk) { sacc[0] = mfma16(k0[kk], qa[kk], sacc[0]); sacc[1] = mfma16(k1[kk], qa[kk], sacc[1]); }
          }
          { const int t = 16 * ti + fr; const float mxt = SC[SC_MX + t];
#pragma unroll
            for (int si = 0; si < 2; ++si) { const int s0 = 16 * (si0 + si) + 4 * fq; const f32x4 us = *(const LAS f32x4*)(SC + SC_U + s0); float val[4];
#pragma unroll
                for (int r = 0; r < 4; ++r) val[r] = (s0 + r <= t) ? sacc[si][r] * __expf(us[r] - mxt) : 0.f;
                u32x2 pw; pw.x = pk2(val[0], val[1]); pw.y = pk2(val[2], val[3]);
                *(LAS u32x2*)(L + MP::A + t * ML_AS + 2 * s0) = pw; } } }
        __syncthreads();
        { const int dj0 = (w >> 2) * NT2;
          const LAS unsigned char* ap = L + MP::A + (16 * ti + fr) * ML_AS + 16 * fq;
          const LAS unsigned char* vp = L + MP::VT + (16 * dj0 + fr) * ML_AS + 16 * fq; const LAS unsigned char* ep = L + MP::VT + (16 * NDT + fr) * ML_AS + 16 * fq;
          const LAS unsigned char* cp = L + MP::CT + (16 * dj0 + fr) * ML_QS + 16 * fq; const LAS unsigned char* cep = L + MP::CT + (16 * NDT + fr) * ML_QS + 16 * fq;
          bf16x8 aa[2], vv[NT2][2], ee[2], afr[2][2], bw[2][NB5];
#pragma unroll
          for (int ks = 0; ks < 2; ++ks) { aa[ks] = *(const LAS bf16x8*)(ap + 64 * ks); ee[ks] = *(const LAS bf16x8*)(ep + 64 * ks);
#pragma unroll
              for (int j = 0; j < NT2; ++j) vv[j][ks] = *(const LAS bf16x8*)(vp + 16 * j * ML_AS + 64 * ks); }
          const int q4 = fr >> 2, p4 = lane & 3;
#pragma unroll
          for (int ks = 0; ks < 2; ++ks) {
#pragma unroll
              for (int a = 0; a < 2; ++a) { const LAS unsigned char* kp = L + ML_K + (32 * ks + 8 * fq + q4) * ML_QS + (16 * (2 * w + a) + 4 * p4) * 2;
                  const s16x4 lo = lds_tr16(kp), hi = lds_tr16(kp + 4 * ML_QS); afr[ks][a] = (bf16x8){lo[0], lo[1], lo[2], lo[3], hi[0], hi[1], hi[2], hi[3]}; }
#pragma unroll
              for (int bb = 0; bb < NB5; ++bb) bw[ks][bb] = *(const LAS bf16x8*)(L + MP::VWT + (16 * bb + fr) * ML_AS + 16 * fq + 64 * ks); }
          const float dec = SC[SC_DEC];
          f32x4 wi4, eb4;
#pragma unroll
          for (int r = 0; r < 4; ++r) { wi4[r] = SC[SC_WI + 16 * ti + 4 * fq + r]; eb4[r] = SC[SC_EBD + 16 * ti + 4 * fq + r]; }
          __builtin_amdgcn_sched_barrier(0);
          f32x4 av[NT2], av2[NT2], ae = (f32x4){0.f, 0.f, 0.f, 0.f}, ae2 = ae;
#pragma unroll
          for (int j = 0; j < NT2; ++j) { av[j] = (f32x4){0.f, 0.f, 0.f, 0.f}; av2[j] = av[j]; }
#pragma unroll
          for (int a = 0; a < 2; ++a)
#pragma unroll
              for (int bb = 0; bb < NB5; ++bb) C[a][bb] *= dec;
#pragma unroll
          for (int ks = 0; ks < 2; ++ks) { ae = mfma16(aa[ks], ee[ks], ae);
#pragma unroll
              for (int j = 0; j < NT2; ++j) av[j] = mfma16(aa[ks], vv[j][ks], av[j]); }
#pragma unroll
          for (int ks = 0; ks < 2; ++ks)
#pragma unroll
              for (int bb = 0; bb < NB5; ++bb) { C[0][bb] = mfma16(afr[ks][0], bw[ks][bb], C[0][bb]); C[1][bb] = mfma16(afr[ks][1], bw[ks][bb], C[1][bb]); }
          __builtin_amdgcn_sched_barrier(0);
          { const LAS unsigned char* qp = L + ML_Q + (16 * ti + fr) * ML_QS + 16 * fq;
#pragma unroll
            for (int hb = 0; hb < 2; ++hb) {
                bf16x8 qa[4], cc[NT2][4], ce[4];
#pragma unroll
                for (int kk = 0; kk < 4; ++kk) { qa[kk] = *(const LAS bf16x8*)(qp + 64 * (4 * hb + kk)); ce[kk] = *(const LAS bf16x8*)(cep + 64 * (4 * hb + kk));
#pragma unroll
                    for (int j = 0; j < NT2; ++j) cc[j][kk] = *(const LAS bf16x8*)(cp + 16 * j * ML_QS + 64 * (4 * hb + kk)); }
                __builtin_amdgcn_sched_barrier(0);
#pragma unroll
                for (int kk = 0; kk < 4; ++kk) { ae2 = mfma16(qa[kk], ce[kk], ae2);
#pragma unroll
                    for (int j = 0; j < NT2; ++j) av2[j] = mfma16(qa[kk], cc[j][kk], av2[j]); }
            } }
          float rd[4];
#pragma unroll
          for (int r = 0; r < 4; ++r) { float dn = ae[r] + wi4[r] * ae2[r]; dn = __shfl(dn, lane & 48); rd[r] = frcp(fmaxf(fabsf(dn), eb4[r])); }
#pragma unroll
          for (int j = 0; j < NT2; ++j) { hpk[j][0] = pk2((av[j][0] + wi4[0] * av2[j][0]) * rd[0], (av[j][1] + wi4[1] * av2[j][1]) * rd[1]);
              hpk[j][1] = pk2((av[j][2] + wi4[2] * av2[j][2]) * rd[2], (av[j][3] + wi4[3] * av2[j][3]) * rd[3]); } }
        __syncthreads();
#pragma unroll
        for (int a = 0; a < 2; ++a)
#pragma unroll
            for (int bb = 0; bb < NB5; ++bb) { u32x2 pw; pw.x = pk2(C[a][bb][0], C[a][bb][1]); pw.y = pk2(C[a][bb][2], C[a][bb][3]);
                *(LAS u32x2*)(L + MP::CT + (16 * bb + fr) * ML_QS + (16 * (2 * w + a) + 4 * fq) * 2) = pw; }
    }
#undef ML_ISSUE
    { bf16* hpp = (bf16*)F.HT + (size_t)(b * SEQ + 64 * 31 + 16 * (w & 3) + 4 * fq) * D + h * 256 + sl * (16 * NDT) + 16 * ((w >> 2) * NT2) + fr;
#pragma unroll
      for (int j = 0; j < NT2; ++j) { hpp[16 * j] = (bf16)(hpk[j][0] & 0xffffu); hpp[(size_t)D + 16 * j] = (bf16)(hpk[j][0] >> 16); hpp[(size_t)2 * D + 16 * j] = (bf16)(hpk[j][1] & 0xffffu); hpp[(size_t)3 * D + 16 * j] = (bf16)(hpk[j][1] >> 16); } }
    __syncthreads();
}

constexpr int CQ_TS = 144, CQ_SCR = 2 * 32 * CQ_TS;
struct CqItem { const float* W; unsigned char* WT; int Nsrc, c0, k0, row0, row1, rstep; };
__device__ __forceinline__ CqItem cq_decode(Frame& F, int r) {
    constexpr int I_GU1 = (D / 128) * (2048 / 64), I_DN1 = (D / 128) * (D / 64);
    CqItem it;
    if (r < NE * I_GU1) { const int e = r / I_GU1, q = r % I_GU1, kb = q / 32, cb = q % 32, j0 = 32 * cb;
        it.W = F.w_gate_up + (size_t)e * D * 2048; it.WT = (unsigned char*)F.WguT + (size_t)e * 2048 * D; it.Nsrc = 2048; it.c0 = 2 * j0; it.k0 = 128 * kb;
        it.row0 = (j0 >> 7) * 256 + (j0 & 127); it.row1 = it.row0 + 128; it.rstep = 1; }
    else { r -= NE * I_GU1; const int e = r / I_DN1, q = r % I_DN1, kb = q / 16, cb = q % 16;
        it.W = F.w_down + (size_t)e * D * D; it.WT = (unsigned char*)F.WdnT + (size_t)e * D * D; it.Nsrc = D; it.c0 = 64 * cb; it.k0 = 128 * kb;
        it.row0 = 64 * cb; it.row1 = 64 * cb + 1; it.rstep = 2; }
    return it;
}
__device__ __forceinline__ void cq_load(const CqItem& it, int half, int lane, f32x4 (&v)[16]) {
    const float* p = it.W + (size_t)(it.k0 + 64 * half + 4 * (lane >> 4)) * it.Nsrc + it.c0 + 4 * (lane & 15);
#pragma unroll
    for (int pp = 0; pp < 4; ++pp)
#pragma unroll
        for (int i = 0; i < 4; ++i) v[4 * pp + i] = *(const f32x4*)(p + (size_t)(16 * pp + i) * it.Nsrc);
}
__device__ __forceinline__ void cq_pack(const f32x4 (&v)[16], int half, int lane, LAS unsigned char* scr, float sc) {
    LAS unsigned char* t0 = scr + (2 * (lane & 15)) * CQ_TS + 4 * (16 * half + (lane >> 4));
#pragma unroll
    for (int pp = 0; pp < 4; ++pp)
#pragma unroll
        for (int c = 0; c < 4; ++c)
            *(LAS unsigned*)(t0 + (c & 1) * 32 * CQ_TS + (c >> 1) * CQ_TS + 16 * pp) = pk4_fp8(v[4 * pp][c] * sc, v[4 * pp + 1][c] * sc, v[4 * pp + 2][c] * sc, v[4 * pp + 3][c] * sc);
}
__device__ __forceinline__ void cq_store(const CqItem& it, int lane, LAS unsigned char* scr) {
    asm volatile("s_waitcnt lgkmcnt(0)" ::: "memory");
    const int r = lane >> 1, hf = lane & 1;
#pragma unroll
    for (int t = 0; t < 2; ++t) { const LAS unsigned char* s = scr + t * 32 * CQ_TS + r * CQ_TS + 64 * hf;
        unsigned char* d = it.WT + (size_t)((t ? it.row1 : it.row0) + r * it.rstep) * D + it.k0 + 64 * hf;
#pragma unroll
        for (int j = 0; j < 4; ++j) *(u32x4*)(d + 16 * j) = *(const LAS u32x4*)(s + 16 * j); }
    asm volatile("s_waitcnt lgkmcnt(0)" ::: "memory");
}
constexpr int CS_GRAB = 8;
__device__ __forceinline__ void convert_steal(Frame& F) {
    constexpr int I_GU1 = (D / 128) * (2048 / 64), I_DN1 = (D / 128) * (D / 64), NIT = NE * (I_GU1 + I_DN1);
    static_assert(NIT % CS_GRAB == 0, "conversion items per grab");
    LAS unsigned char* scr = F.lds + F.wave * CQ_SCR; LAS int* slot = (LAS int*)(F.lds + 8 * CQ_SCR);
    int nxt = 0;
    __syncthreads();
    if (F.tid == 0) nxt = (int)atomicAdd(F.ctl + CW_QCTR, (unsigned)CS_GRAB);
    for (;;) {
        if (F.tid == 0) slot[0] = nxt;
        __syncthreads();
        const int base = slot[0]; if (base >= NIT) break;
        if (F.tid == 0) nxt = (int)atomicAdd(F.ctl + CW_QCTR, (unsigned)CS_GRAB);
        const CqItem it = cq_decode(F, base + F.wave);
        f32x4 va[16], vb[16];
        cq_load(it, 0, F.lane, va);
        cq_load(it, 1, F.lane, vb);
        cq_pack(va, 0, F.lane, scr, 32.0f);
        cq_pack(vb, 1, F.lane, scr, 32.0f);
        cq_store(it, F.lane, scr);
        __syncthreads();
    }
}

#ifndef ML_NDT
#define ML_NDT 4
#endif
__device__ __forceinline__ void mlstm_phase(Frame& F) {
    constexpr int SLICES = 16 / ML_NDT, NITEMS = NB * 4 * SLICES;
    for (int item = F.vcu; item < NITEMS; item += F.G) mlstm_item<ML_NDT>(F, item / (4 * SLICES), (item / SLICES) & 3, item % SLICES);
#if FAST_ATTN && ATT_QUEUE
    attn_phase(F);
#endif
#if MOE_FP8 && STEAL
#if defined(PROBE_NOSTEAL)
    if (F.vcu >= NITEMS)
#endif
#if defined(PROBE_CONV64)
    if (F.vcu < NITEMS || F.vcu >= 192)
#endif
    convert_steal(F);
#endif
}

constexpr int N_PHASES = 13;
struct Args { const void* in[18]; float* out; unsigned char* ws; int ph_lo, ph_hi; };

__device__ __forceinline__ int opaque_int(int v) { asm volatile("" : "+s"(v)); return v; }
__global__ void __launch_bounds__(NTHREADS, 2) mega_fwd(Args args) {
    extern __shared__ __attribute__((aligned(16))) unsigned char lds[];
    Frame F;
    F.lds = (LAS unsigned char*)lds;
    F.tid = threadIdx.x; F.lane = F.tid & 63; F.wave = __builtin_amdgcn_readfirstlane(F.tid >> 6);
    F.G = gridDim.x; { const int bx = blockIdx.x; F.vcu = (F.G % 8 == 0) ? (bx % 8) * (F.G / 8) + bx / 8 : bx; }
    F.gw = F.vcu * NWAVES + F.wave; F.NGW = F.G * NWAVES;
    unsigned char* ws = args.ws;
    F.ctl = (unsigned*)(ws + WS_CTL);
    F.x = (const float*)args.in[0]; F.positions = (const int*)args.in[1]; F.g_mix = (const float*)args.in[2]; F.w_in = (const float*)args.in[3]; F.conv_qk = (const float*)args.in[4];
    F.b_if = (const float*)args.in[5]; F.g_mnorm = (const float*)args.in[6]; F.w_attn_out = (const float*)args.in[7]; F.w_mlstm_out = (const float*)args.in[8]; F.w_mix_out = (const float*)args.in[9];
    F.g_ffn = (const float*)args.in[10]; F.w_router = (const float*)args.in[11]; F.b_router = (const float*)args.in[12]; F.w_gate_up = (const float*)args.in[13]; F.b_gate_up = (const float*)args.in[14];
    F.w_down = (const float*)args.in[15]; F.b_down = (const float*)args.in[16]; F.g_final = (const float*)args.in[17]; F.out = args.out;
    F.WinT = (bf16*)(ws + WS_WIN); F.WamT = (bf16*)(ws + WS_WAM); F.WoT = (bf16*)(ws + WS_WO); F.WguT = (bf16*)(ws + WS_WGU); F.WdnT = (bf16*)(ws + WS_WDN);
    F.XN = (bf16*)(ws + WS_XN); F.PROJ = (bf16*)(ws + WS_PROJ); F.OG = (bf16*)(ws + WS_OG); F.AM = (bf16*)(ws + WS_AM); F.MERGED = (bf16*)(ws + WS_MERGED);
    F.XS = (bf16*)(ws + WS_XS); F.ACT = (bf16*)(ws + WS_ACT); F.YBUF = (bf16*)(ws + WS_YBUF);
    F.GATES = (float*)(ws + WS_GATES); F.ROPE = (float*)(ws + WS_ROPE); F.LSE = (float*)(ws + WS_LSE); F.HT = (float*)(ws + WS_HT); F.H = (float*)(ws + WS_H);
    F.QC = (float*)(ws + WS_QC); F.KC = (float*)(ws + WS_KC);
    F.TOK_E = (int*)(ws + WS_ROUTE); F.TOK_SLOT = F.TOK_E + NA; F.TOK_W = (float*)(F.TOK_SLOT + NA);
    F.ROW_TOK = (int*)(ws + WS_ROWMETA); F.ROW_W = (float*)(F.ROW_TOK + XS_ROWS);

    const int lo = args.ph_lo, hi = args.ph_hi;
    for (int u = F.tid; u < (LDS_BYTES - LDSCTL_OFF) / 4; u += NTHREADS) ((LAS unsigned*)(F.lds + LDSCTL_OFF))[u] = 0u;
    __syncthreads();
    XcdBarrier bar; bar.bar = F.ctl + CW_BAR; bar.x = 0; bar.st = nullptr;
    if (hi - lo > 1) bar = xcd_barrier_post(F.ctl + CW_BAR, (volatile LAS unsigned*)(F.lds + MISC_OFF) + 8);
#ifndef PH_MASK
#define PH_MASK 0xffffffffu
#endif
#ifndef REP_MASK
#define REP_MASK 0u
#endif
#define IN(k) (((PH_MASK >> (k)) & 1u) && lo <= (k) && (k) < hi)
#define REPS(k) for (int rep_ = 0, nrep_ = ((REP_MASK >> (k)) & 1u) ? opaque_int(2) : 1; rep_ < nrep_; ++rep_)
#define SEAM(k) do { if (IN(k) && IN((k) + 1)) { GRID_BAR(); } } while (0)
#define GRID_BAR() xcd_barrier(bar)

    if (IN(0)) REPS(0) { p0_weights(F); p0_rows(F); }
    SEAM(0);
    if (IN(1)) REPS(1) {
#if FAST_P1
#if P1_FP8
        constexpr int NF8 = 64 * (18 + 42 - P1_HI), NBF = 64 * (P1_HI - 18);
        constexpr bool SPLIT = (NF8 == 128 * 15 && NBF == 128 * 6);
        { pg8::Gemm g{(const bf16*)((const unsigned char*)F.ctl + WS_XN8), F.WinT, T, (18 + 42 - P1_HI) * 256, D / 2}; pg8::SplitOrder S; S.base.init(T, (18 + 42 - P1_HI) * 256, F.G, (int)blockIdx.x);
          S.nA = SPLIT ? 9 : -1; S.nB = SPLIT ? 6 : -1;
          pg8::EpiProj<1> E{F.PROJ, F.ROPE};
          pg8::gemm_phase<pg8::EpiProj<1>, pg8::SplitOrder, true, true, true>(F.lds, g, S, E); }
        { pg8::Gemm g{F.XN, F.WinT + (size_t)18 * 256 * D, T, (P1_HI - 18) * 256, D}; pg8::SplitOrder S; S.base.init(T, (P1_HI - 18) * 256, F.G, (int)blockIdx.x);
          S.nA = SPLIT ? 2 : -1; S.nB = SPLIT ? 4 : -1;
          pg8::EpiProj<2> E{F.PROJ, F.ROPE};
          pg8::gemm_phase<pg8::EpiProj<2>, pg8::SplitOrder, true, true>(F.lds, g, S, E); }
#else
        pg8::Gemm g{F.XN, F.WinT, T, NP, D}; pg8::StaticOrder S; S.init(T, NP, F.G, (int)blockIdx.x);
        pg8::EpiProj<0> E{F.PROJ, F.ROPE};
        pg8::gemm_phase<pg8::EpiProj<0>, pg8::StaticOrder, true, true>(F.lds, g, S, E);
#endif
#else
        naive_p1(F);
#endif
    }
    SEAM(1);
    if (IN(2)) REPS(2) {
#if !FAST_P1
        naive_p1_rope(F);
#endif
    }
#if !FAST_P1
    SEAM(2);
#endif
    if (IN(3)) REPS(3) {
#if !FAST_MLSTM
        naive_conv(F);
#endif
#if FAST_MLSTM
        mlstm_prepass(F);
#endif
#if FAST_ATTN && !(ATT_QUEUE && FAST_MLSTM)
        attn_phase(F);
#elif !FAST_ATTN
        naive_attn(F);
#endif
    }
    SEAM(3);
    if (IN(4)) REPS(4) {
#if FAST_MLSTM
        mlstm_phase(F);
#else
        naive_mlstm(F);
#endif
    }
    SEAM(4);
    if (IN(5)) REPS(5) p3_post_mixer(F);
    SEAM(5);
    if (IN(6)) REPS(6) {
#if FAST_P4
        constexpr bool STREAM = (MIX_STREAM && FAST_P5);
        pg8::Gemm g{F.AM, F.WamT, T, D, AMLD};
        { pg8::MergedOrder S; S.base.init(T, D, F.G, (int)blockIdx.x); S.nparts = 2; S.pub = STREAM; S.ready = F.ctl + CW_READY2; S.tmo = F.ctl + CW_TMO;
          pg8::EpiMerged E{F.AM + 1536, F.PROJ, F.x, F.H, false};
          pg8::gemm_phase<pg8::EpiMerged, pg8::MergedOrder, false, true>(F.lds, g, S, E); }
        if (STREAM) {
          pg8::MergedOrder S; S.base.init(T, D, F.G, (int)blockIdx.x); S.nparts = 1; S.pub = true; S.ready = F.ctl + CW_READY2; S.tmo = F.ctl + CW_TMO;
          pg8::EpiMerged E{F.AM + 1536, F.PROJ, F.x, F.H, false};
          pg8::gemm_phase<pg8::EpiMerged, pg8::MergedOrder, false, true>(F.lds, g, S, E); }
#else
        naive_p4(F);
#endif
    }
#if !(MIX_STREAM && FAST_P4 && FAST_P5)
    SEAM(6);
#endif
    if (IN(7)) REPS(7) {
#if FAST_P5
#if !(MIX_STREAM && FAST_P4)
        { pg8::Gemm g{F.AM, F.WamT, T, D, AMLD}; pg8::MergedOrder S; S.base.init(T, D, F.G, (int)blockIdx.x); S.nparts = 1; S.pub = false; S.ready = F.ctl + CW_READY2; S.tmo = F.ctl + CW_TMO;
          pg8::EpiMerged E{F.AM + 1536, F.PROJ, F.x, F.H, false};
          pg8::gemm_phase<pg8::EpiMerged, pg8::MergedOrder, false, true>(F.lds, g, S, E); }
#endif
#else
        naive_p5(F);
#endif
    }
    SEAM(7);
#if MOE_FP8 && ROUTER_MFMA
    if (IN(8)) REPS(8) p6_router_mfma(F);
#else
    if (IN(8)) REPS(8) p6_router(F);
#endif
    SEAM(8);
    if (IN(9)) REPS(9) p7_gather(F);
    SEAM(9);
#if MOE_FP8 && MOE_STREAM && FAST_MOE
    if (IN(10)) REPS(10) {
        const int ntiles = (int)F.ctl[CW_NTILES];
        pg8::MoeOrder S{F.ctl + CW_TILEE, ntiles, F.G, (int)blockIdx.x, F.ROW_TOK, F.XN, F.ACT, F.WguT, F.WdnT, F.ctl + CW_READY, F.ctl + CW_TMO};
        pg8::Gemm g{F.XN, F.WguT, ntiles * 256, NE * 2048, D / 2};
        pg8::EpiMoe E{{F.ACT, F.b_gate_up, 1.0f / 32.0f}, {F.YBUF, F.b_down, F.ROW_TOK, F.ROW_W, 1.0f / 32.0f}};
        pg8::gemm_phase<pg8::EpiMoe, pg8::MoeOrder, true, true, true, true, true>(F.lds, g, S, E);
    }
#else
    if (IN(10)) REPS(10) {
        const int ntiles = (int)F.ctl[CW_NTILES];
#if FAST_MOE
        pg8::GroupedOrder S{F.ctl + CW_TILEE, ntiles, 8, F.G, (int)blockIdx.x, F.ROW_TOK};
#if MOE_FP8
        pg8::Gemm g{F.XN, F.WguT, ntiles * 256, NE * 2048, D / 2}; pg8::EpiSwiGLU<true> E{F.ACT, F.b_gate_up, 1.0f / 32.0f};
        pg8::gemm_phase<pg8::EpiSwiGLU<true>, pg8::GroupedOrder, true, true, true, true>(F.lds, g, S, E);
#else
        pg8::Gemm g{F.XS, F.WguT, ntiles * 256, NE * 2048, D}; pg8::EpiSwiGLU<false> E{F.ACT, F.b_gate_up, 1.0f};
        pg8::gemm_phase<pg8::EpiSwiGLU<false>, pg8::GroupedOrder, true, true, false>(F.lds, g, S, E);
#endif
#else
        naive_p8(F, ntiles);
#endif
    }
    SEAM(10);
    if (IN(11)) REPS(11) {
        const int ntiles = (int)F.ctl[CW_NTILES];
#if FAST_MOE
        pg8::GroupedOrder S{F.ctl + CW_TILEE, ntiles, 4, F.G, (int)blockIdx.x, F.ROW_TOK};
#if MOE_FP8
        pg8::Gemm g{F.ACT, F.WdnT, ntiles * 256, NE * D, D / 2}; pg8::EpiDown E{F.YBUF, F.b_down, F.ROW_TOK, F.ROW_W, 1.0f / 32.0f};
        pg8::gemm_phase<pg8::EpiDown, pg8::GroupedOrder, true, true, true>(F.lds, g, S, E);
#else
        pg8::Gemm g{F.ACT, F.WdnT, ntiles * 256, NE * D, D}; pg8::EpiDown E{F.YBUF, F.b_down, F.ROW_TOK, F.ROW_W, 1.0f};
        pg8::gemm_phase<pg8::EpiDown, pg8::GroupedOrder, true, true, false>(F.lds, g, S, E);
#endif
#else
        naive_p9(F, ntiles);
#endif
    }
#endif
    SEAM(11);
    if (IN(12)) REPS(12) p10_final(F);
#undef IN
#undef SEAM
}

extern "C" void kernel_launch(void* const* d_in, const int* in_sizes, int n_in, void* d_out, int out_size, void* d_ws, size_t ws_size, hipStream_t stream) {
    static int grid = 0;
    if (grid == 0) {
        if (n_in != 18 || out_size != T * D || ws_size < WS_END) { fprintf(stderr, "kernel_launch: unexpected shapes (n_in %d, out %d, ws %zu)\n", n_in, out_size, ws_size); grid = -1; return; }
        int dev = 0, cus = 0;
        if (hipGetDevice(&dev) != hipSuccess || hipDeviceGetAttribute(&cus, hipDeviceAttributeMultiprocessorCount, dev) != hipSuccess) { grid = -1; return; }
        if (hipFuncSetAttribute((const void*)mega_fwd, hipFuncAttributeMaxDynamicSharedMemorySize, LDS_BYTES) != hipSuccess) { fprintf(stderr, "kernel_launch: hipFuncSetAttribute failed\n"); grid = -1; return; }
        int per_cu = 0;
        if (hipOccupancyMaxActiveBlocksPerMultiprocessor(&per_cu, (const void*)mega_fwd, NTHREADS, LDS_BYTES) != hipSuccess || per_cu < 1) { fprintf(stderr, "kernel_launch: occupancy query says %d blocks per CU\n", per_cu); (void)hipGetLastError(); grid = -1; return; }
        grid = cus;
    }
    if (grid < 0) return;
    (void)hipMemsetAsync((char*)d_ws + WS_CTL, 0, CTL_ZERO_BYTES, stream);
    Args a{};
    for (int i = 0; i < 18; ++i) a.in[i] = d_in[i];
    a.out = (float*)d_out; a.ws = (unsigned char*)d_ws;
#if defined(MK_MULTI)
    for (int p = 0; p < N_PHASES; ++p) {
        a.ph_lo = p; a.ph_hi = p + 1;
        hipLaunchKernelGGL(mega_fwd, dim3(grid), dim3(NTHREADS), LDS_BYTES, stream, a);
    }
#else
#if defined(PROBE_HI)
    a.ph_lo = 0; a.ph_hi = PROBE_HI;
    hipLaunchKernelGGL(mega_fwd, dim3(grid), dim3(NTHREADS), LDS_BYTES, stream, a);
    (void)hipMemsetAsync((char*)d_ws + WS_CTL, 0, CTL_ZERO_BYTES, stream);
#endif
    a.ph_lo = 0; a.ph_hi = N_PHASES;
    hipLaunchKernelGGL(mega_fwd, dim3(grid), dim3(NTHREADS), LDS_BYTES, stream, a);
#endif
}
```

```cpp
#include <hip/hip_runtime.h>
#include <cstdio>
#include <cstdint>

#define LAS __attribute__((address_space(3)))
#define GAS __attribute__((address_space(1)))
typedef unsigned short bf16;
typedef float f32x4 __attribute__((ext_vector_type(4)));
typedef float f32x2 __attribute__((ext_vector_type(2)));
typedef unsigned u32x4 __attribute__((ext_vector_type(4)));
typedef unsigned u32x2 __attribute__((ext_vector_type(2)));
typedef short bf16x8 __attribute__((ext_vector_type(8)));

#ifndef FAST_P1
#define FAST_P1 1
#endif
#ifndef FAST_P4
#define FAST_P4 1
#endif
#ifndef FAST_P5
#define FAST_P5 1
#endif
#ifndef FAST_MOE
#define FAST_MOE 1
#endif
#ifndef MOE_FP8
#define MOE_FP8 1
#endif
#ifndef P1_FP8
#define P1_FP8 1
#endif
#ifndef STEAL
#define STEAL 1
#endif
#ifndef ROUTER_MFMA
#define ROUTER_MFMA 1
#endif
#ifndef P1_HI
#define P1_HI 30
#endif
#ifndef MOE_STREAM
#define MOE_STREAM 1
#endif
#ifndef ATT_QUEUE
#define ATT_QUEUE 1
#endif
#ifndef ROWMETA_FUSED
#define ROWMETA_FUSED 1
#endif
#define RM_FUSED (ROWMETA_FUSED && MOE_FP8 && MOE_STREAM && FAST_MOE && ROUTER_MFMA)
#ifndef FAST_ATTN
#define FAST_ATTN 1
#endif
#ifndef FAST_MLSTM
#define FAST_MLSTM 1
#endif

constexpr int T = 16384, D = 1024, SEQ = 2048, NB = 8;
constexpr int DIN = 10760, NP = 10752;
constexpr int C_AQ = 0, C_AK = 1536, C_AV = 3072, C_MQ = 4608, C_MK = 5632, C_MV = 6656, C_MO = 7680, C_GA = 8704, C_GM = 9728;
constexpr int NE = 32, TOPK = 4, NA = T * TOPK, MAXTILES = NA / 256 + NE, XS_ROWS = MAXTILES * 256, ECAP = T;
constexpr float QSCALE = 0.08838834764831845f * 1.4426950408889634f;
constexpr float RMS_EPS = 1e-5f, LN_EPS = 1e-5f;

constexpr size_t MiB = 1u << 20;
constexpr size_t WS_CTL = 0, CTL_ZERO_BYTES = 1 * MiB;
constexpr size_t WS_WIN = 2 * MiB, WS_WAM = 23 * MiB, WS_WO = 26 * MiB, WS_WGU = 28 * MiB, WS_WDN = 156 * MiB;
constexpr size_t WS_XN = 220 * MiB, WS_GATES = 252 * MiB, WS_ROPE = 253 * MiB, WS_ROUTE = 255 * MiB;
constexpr size_t WS_H = 256 * MiB, WS_MERGED = 320 * MiB;
constexpr size_t WS_OG = 352 * MiB, WS_LSE = 400 * MiB, WS_HT = 401 * MiB, WS_AM = 433 * MiB;
constexpr int AMLD = 2560;
#ifndef MIX_STREAM
#define MIX_STREAM 0
#endif
constexpr size_t WS_YBUF = 352 * MiB;
constexpr size_t WS_PROJ = 513 * MiB;
constexpr size_t WS_XS = 513 * MiB, WS_ACT = 657 * MiB;
constexpr size_t WS_ROWMETA = 801 * MiB;
constexpr size_t WS_QC = 849 * MiB, WS_KC = 913 * MiB, WS_XN8 = 916 * MiB, WS_END = 977 * MiB;
constexpr int CW_TMO = 0, CW_BAR = 4096, CW_CNT = 8192  , CW_NTILES = 12288, CW_TILEE = 12352, CW_QCTR = 16384, CW_ACTR = 16448  , CW_READY = 32768  , CW_READY2 = 65536  ;

constexpr int RING_BYTES = 131072, LDS_BYTES = 147456, LDSCTL_OFF = LDS_BYTES - 256, MISC_OFF = LDSCTL_OFF;
constexpr int NWAVES = 8, NTHREADS = 512;

__device__ __forceinline__ unsigned f2bf(float f) { unsigned u = __builtin_bit_cast(unsigned, f); return (u + 0x7fffu + ((u >> 16) & 1u)) >> 16; }
__device__ __forceinline__ unsigned pk2(float lo, float hi) { unsigned r; asm("v_cvt_pk_bf16_f32 %0, %1, %2" : "=v"(r) : "v"(lo), "v"(hi)); return r; }
__device__ __forceinline__ unsigned pk4_fp8(float a, float b, float c, float d) { int w = __builtin_amdgcn_cvt_pk_fp8_f32(a, b, 0, false); w = __builtin_amdgcn_cvt_pk_fp8_f32(c, d, w, true); return (unsigned)w; }
__device__ __forceinline__ float frcp(float x) { return __builtin_amdgcn_rcpf(x); }
__device__ __forceinline__ float bf2f(unsigned b) { return __builtin_bit_cast(float, b << 16); }
__device__ __forceinline__ float bflo(unsigned w) { return __builtin_bit_cast(float, w << 16); }
__device__ __forceinline__ float bfhi(unsigned w) { return __builtin_bit_cast(float, w & 0xffff0000u); }
__device__ __forceinline__ float wave_sum(float v) {
#pragma unroll
    for (int o = 1; o < 64; o <<= 1) v += __shfl_xor(v, o);
    return v;
}
__device__ __forceinline__ float wave_max(float v) {
#pragma unroll
    for (int o = 1; o < 64; o <<= 1) v = fmaxf(v, __shfl_xor(v, o));
    return v;
}
__device__ __forceinline__ float sigmoidf_(float x) { return frcp(1.0f + __expf(-x)); }

__host__ __device__ __forceinline__ int win_logical_col(int c) {
    if (c < C_AV) { const int p = c & 127; if (p < 32) { const int a = p >> 3, n = (p >> 2) & 1, j = p & 3; return (c - p) + 16 * n + 4 * a + j; } return c; }
    return c < C_GA ? c : c + 8;
}
__host__ __device__ __forceinline__ int wgu_logical_col(int c) { const int pn = c >> 8, bj = (c >> 7) & 1, jl = c & 127; return 2 * (128 * pn + jl) + bj; }
namespace pg8 {
#define PG8_LAS __attribute__((address_space(3)))
typedef unsigned short bf16_t;
typedef short bf16x8 __attribute__((ext_vector_type(8)));
typedef float f32x4 __attribute__((ext_vector_type(4)));
typedef unsigned u32x4 __attribute__((ext_vector_type(4)));
constexpr int BM = 256, BK = 64, HALF = 128, HTB = HALF * BK * 2  , STAGE_BYTES = 8 * HTB, NXCD = 8, WGM = 8;

__host__ __device__ __forceinline__ int lds_byte(int r, int c) { const int st = (r >> 4) * 2 + (c >> 5), rr = r & 15, cc = c & 31, ob = rr * 64 + cc * 2; return st * 1024 + (ob ^ (((ob >> 9) & 1) << 5)); }
__host__ __device__ __forceinline__ void stage_rc(int b, int& R, int& C) { const int st = b / 1024, sb = b % 1024, swz = sb ^ (((sb >> 9) & 1) << 5); R = (st >> 1) * 16 + swz / 64; C = (st & 1) * 32 + (swz % 64) / 2; }
__host__ __device__ __forceinline__ int perm32(int rho) { const int n = rho >> 4, i = rho & 15; return 8 * (i >> 2) + 4 * n + (i & 3); }

typedef int i32x4 __attribute__((ext_vector_type(4)));
typedef int i32x8 __attribute__((ext_vector_type(8)));
template <bool FP8> struct FragT { typedef bf16x8 type; };
template <> struct FragT<true> { typedef i32x8 type; };
__device__ __forceinline__ f32x4 mma16(bf16x8 a, bf16x8 b, f32x4 c) { return __builtin_amdgcn_mfma_f32_16x16x32_bf16(a, b, c, 0, 0, 0); }
__device__ __forceinline__ f32x4 mma16(i32x8, i32x8, f32x4 c) { return c; }
__device__ __forceinline__ f32x4 mma8(i32x8 a, i32x8 b, f32x4 c) { const int one = 0x7F7F7F7F;
    asm volatile("v_mfma_scale_f32_16x16x128_f8f6f4 %0, %1, %2, %0, %3, %3 op_sel_hi:[0,0,0]" : "+v"(c) : "v"(a), "v"(b), "v"(one)); return c; }
__device__ __forceinline__ f32x4 mma8(bf16x8, bf16x8, f32x4 c) { return c; }
struct Unit { int pm, pn, part; };
struct Gemm { const bf16_t* A; const bf16_t* Bt; int M, N, K; };

struct StaticOrder {
    int nM, nN, nwg, G, c;
    __host__ __device__ void init(int M, int N, int G_, int c_) { nM = M / BM; nN = N / BM; nwg = nM * nN; G = G_; c = c_; }
    __host__ __device__ bool next(int i, Unit& u) const { return at((long)i * G + c, u); }
    __host__ __device__ bool at(long L, Unit& u) const {
        if (L >= nwg) return false;
        int wgid = (int)L; { const int q = nwg / NXCD, r = nwg % NXCD, xcd = wgid % NXCD, off = wgid / NXCD; wgid = (xcd < r ? xcd * (q + 1) : r * (q + 1) + (xcd - r) * q) + off; }
        const int nig = WGM * nN, gid = wgid / nig, fm = gid * WGM, gsz = (nM - fm) < WGM ? (nM - fm) : WGM;
        u.pm = fm + ((wgid % nig) % gsz); u.pn = (wgid % nig) / gsz; u.part = 0; return true;
    }
    __device__ __forceinline__ int kt0(const Unit&) const { return 0; }
    __device__ __forceinline__ int nkt(const Unit&, int full) const { return full; }
    __device__ __forceinline__ int rowsel(const Unit&, int r) const { return r; }
    __device__ __forceinline__ const void* abase(const Unit&) const { return nullptr; }
    __device__ __forceinline__ const void* bbase(const Unit&) const { return nullptr; }
    __device__ __forceinline__ void a_ready(const Unit&) const {}
    __device__ __forceinline__ void done(const Unit&) const {}
};


__device__ __forceinline__ unsigned cvt_pk_bf16(float lo, float hi) { unsigned r; asm volatile("v_cvt_pk_bf16_f32 %0, %1, %2" : "=v"(r) : "v"(lo), "v"(hi)); return r; }
__device__ __forceinline__ u32x4 pack8(const f32x4 v0, const f32x4 v1) { u32x4 w; w.x = cvt_pk_bf16(v0[0], v0[1]); w.y = cvt_pk_bf16(v0[2], v0[3]); w.z = cvt_pk_bf16(v1[0], v1[1]); w.w = cvt_pk_bf16(v1[2], v1[3]); return w; }
__device__ __forceinline__ void unpack8(const u32x4 w, f32x4& v0, f32x4& v1) {
    v0[0] = __builtin_bit_cast(float, w.x << 16); v0[1] = __builtin_bit_cast(float, w.x & 0xffff0000u); v0[2] = __builtin_bit_cast(float, w.y << 16); v0[3] = __builtin_bit_cast(float, w.y & 0xffff0000u);
    v1[0] = __builtin_bit_cast(float, w.z << 16); v1[1] = __builtin_bit_cast(float, w.z & 0xffff0000u); v1[2] = __builtin_bit_cast(float, w.w << 16); v1[3] = __builtin_bit_cast(float, w.w & 0xffff0000u);
}
__device__ __forceinline__ f32x4 sig4(const f32x4 x) { f32x4 r; r[0] = frcp(1.0f + __expf(-x[0])); r[1] = frcp(1.0f + __expf(-x[1])); r[2] = frcp(1.0f + __expf(-x[2])); r[3] = frcp(1.0f + __expf(-x[3])); return r; }

struct GroupedOrder {
    const unsigned* tile_e; int ntiles, nN, G, c; const int* rowidx;
    __device__ __forceinline__ int kt0(const Unit&) const { return 0; }
    __device__ __forceinline__ int nkt(const Unit&, int full) const { return full; }
    __device__ __forceinline__ int rowsel(const Unit&, int r) const { const int v = rowidx[r]; return (v < 0 ? 0 : v) >> 2; }
    __device__ __forceinline__ const void* abase(const Unit&) const { return nullptr; }
    __device__ __forceinline__ const void* bbase(const Unit&) const { return nullptr; }
    __device__ bool next(int i, Unit& u) const {
        const long L = (long)i * G + c; if (L >= (long)ntiles * nN) return false;
        u.pm = (int)(L / nN); const int e = (int)tile_e[u.pm]; u.pn = e * nN + (int)(L % nN); u.part = 0; return true;
    }
    __device__ __forceinline__ void a_ready(const Unit&) const {}
    __device__ __forceinline__ void done(const Unit&) const {}
};

template <int MODE> struct EpiProj {
    static constexpr bool PERM = true, AFTER_DRAIN = false, HAS_MID = false;
    bf16_t* O; const float* rope;
    __device__ __forceinline__ bool keep(const Unit&) const { return false; }
    __device__ __forceinline__ void operator()(f32x4 (&acc)[2][2][4][2], const Unit& u, int wr, int wc, int fr, int fq) const {
        const int pnp = (MODE == 0) ? u.pn : (MODE == 1) ? (u.pn < 18 ? u.pn : u.pn + (P1_HI - 18)) : u.pn + 18;
        const int row0 = u.pm * BM + wr * 64 + fr, col0 = pnp * BM + wc * 32 + 8 * fq;
        const float sc = ((pnp < 6) ? QSCALE : 1.0f) * ((MODE == 1) ? (1.0f / 32.0f) : 1.0f);
        const bool dorope = (pnp < 12) && (wc == 0);
#pragma unroll
        for (int ai = 0; ai < 2; ++ai)
#pragma unroll
            for (int m = 0; m < 4; ++m) {
                const int row = row0 + ai * HALF + m * 16; bf16_t* rowp = O + (size_t)row * NP + col0;
                f32x4 cs = (f32x4){1.f, 1.f, 1.f, 1.f}, sn = (f32x4){0.f, 0.f, 0.f, 0.f};
                if (dorope) { cs = *(const f32x4*)(rope + (size_t)row * 32 + 4 * fq); sn = *(const f32x4*)(rope + (size_t)row * 32 + 16 + 4 * fq); }
#pragma unroll
                for (int bj = 0; bj < 2; ++bj) {
                    f32x4 v0 = acc[ai][bj][m][0], v1 = acc[ai][bj][m][1];
                    if (dorope) { const f32x4 t0 = v0 * cs - v1 * sn, t1 = v1 * cs + v0 * sn; v0 = t0; v1 = t1; }
                    v0 = v0 * sc; v1 = v1 * sc;
                    *(u32x4*)(rowp + bj * HALF) = pack8(v0, v1);
                }
            }
    }
};

struct SplitOrder {
    StaticOrder base; int nA, nB;
    __device__ bool next(int i, Unit& u) const {
        const int c = base.c;
        if (base.G != 256 || nA < 0) return base.next(i, u);
        if (c < 128) { if (i >= nA) return false; return base.at((long)i * 128 + c, u); }
        if (i >= nB) return false; return base.at((long)128 * nA + (long)i * 128 + (c - 128), u);
    }
    __device__ __forceinline__ int kt0(const Unit&) const { return 0; }
    __device__ __forceinline__ int nkt(const Unit&, int full) const { return full; }
    __device__ __forceinline__ int rowsel(const Unit&, int r) const { return r; }
    __device__ __forceinline__ const void* abase(const Unit&) const { return nullptr; }
    __device__ __forceinline__ const void* bbase(const Unit&) const { return nullptr; }
    __device__ __forceinline__ void a_ready(const Unit&) const {}
    __device__ __forceinline__ void done(const Unit&) const {}
};
struct MergedOrder {
    StaticOrder base; int nparts; unsigned* ready; unsigned* tmo;
    bool pub;
    __device__ bool next(int i, Unit& u) const { if (!base.next(i / nparts, u)) return false; u.part = (nparts == 1) ? 2 : (i % nparts); return true; }
    __device__ __forceinline__ int kt0(const Unit& u) const { return u.part == 0 ? 0 : (u.part == 1 ? 8 : 24); }
    __device__ __forceinline__ int nkt(const Unit& u, int) const { return u.part == 0 ? 8 : 16; }
    __device__ __forceinline__ int rowsel(const Unit&, int r) const { return r; }
    __device__ __forceinline__ const void* abase(const Unit&) const { return nullptr; }
    __device__ __forceinline__ const void* bbase(const Unit&) const { return nullptr; }
    __device__ __forceinline__ void a_ready(const Unit& u) const {
        if (u.part != 2 || !pub) return;
        if (threadIdx.x < 64) {
            unsigned spins = 0;
            while ((unsigned)__builtin_amdgcn_readfirstlane(__hip_atomic_load(ready + 64 * u.pm, __ATOMIC_RELAXED, __HIP_MEMORY_SCOPE_AGENT)) < 32u) {
                __builtin_amdgcn_s_sleep(2);
                if (++spins > (1u << 22)) { if (threadIdx.x == 0) __hip_atomic_store(tmo, 1u, __ATOMIC_RELAXED, __HIP_MEMORY_SCOPE_AGENT); break; } }
            __builtin_amdgcn_fence(__ATOMIC_ACQUIRE, "agent");
            asm volatile("s_waitcnt vmcnt(0)" ::: "memory");
        }
        asm volatile("" ::: "memory"); __builtin_amdgcn_s_barrier(); asm volatile("" ::: "memory");
    }
    __device__ __forceinline__ void done(const Unit& u) const {
        if (!pub || u.part != 1) return;
        asm volatile("s_waitcnt vmcnt(0)" ::: "memory");
        __builtin_amdgcn_s_barrier(); asm volatile("" ::: "memory");
        if (threadIdx.x == 0) { __builtin_amdgcn_fence(__ATOMIC_RELEASE, "agent"); asm volatile("s_waitcnt vmcnt(0)" ::: "memory");
                                __hip_atomic_fetch_add(ready + 64 * u.pm, 8u, __ATOMIC_RELAXED, __HIP_MEMORY_SCOPE_AGENT); }
    }
};
struct EpiMerged {
    static constexpr bool PERM = true, AFTER_DRAIN = false, HAS_MID = false;
    bf16_t* O; const bf16_t* proj; const float* x; float* h; bool wt;
    __device__ __forceinline__ bool keep(const Unit& u) const { return u.part == 0; }
    __device__ __forceinline__ void operator()(f32x4 (&acc)[2][2][4][2], const Unit& u, int wr, int wc, int fr, int fq) const {
        const int row0 = u.pm * BM + wr * 64 + fr, col0 = u.pn * BM + wc * 32 + 8 * fq;
        if (u.part == 0) {
#pragma unroll
            for (int ai = 0; ai < 2; ++ai)
#pragma unroll
                for (int m = 0; m < 4; ++m) {
                    const bf16_t* rowp = proj + (size_t)(row0 + ai * HALF + m * 16) * NP + col0;
#pragma unroll
                    for (int bj = 0; bj < 2; ++bj) {
                        const u32x4 ga = *(const u32x4*)(rowp + C_GA + bj * HALF), gm = *(const u32x4*)(rowp + C_GM + bj * HALF);
                        f32x4 a0, a1, m0, m1; unpack8(ga, a0, a1); unpack8(gm, m0, m1);
                        f32x4 r0, r1;
#pragma unroll
                        for (int j = 0; j < 4; ++j) { r0[j] = (1.0f + __expf(-m0[j])) * frcp(1.0f + __expf(-a0[j])); r1[j] = (1.0f + __expf(-m1[j])) * frcp(1.0f + __expf(-a1[j])); }
                        acc[ai][bj][m][0] *= r0; acc[ai][bj][m][1] *= r1;
                    }
                    if (m & 1) asm volatile("" ::: "memory");
                }
        } else if (u.part == 1) {
#pragma unroll
            for (int ai = 0; ai < 2; ++ai)
#pragma unroll
                for (int m = 0; m < 4; ++m) {
                    const int row = row0 + ai * HALF + m * 16;
#pragma unroll
                    for (int bj = 0; bj < 2; ++bj) {
                        const u32x4 gm = *(const u32x4*)(proj + (size_t)row * NP + C_GM + col0 + bj * HALF);
                        f32x4 m0, m1; unpack8(gm, m0, m1);
                        const f32x4 v0 = acc[ai][bj][m][0] * sig4(m0), v1 = acc[ai][bj][m][1] * sig4(m1);
                        const u32x4 pw = pack8(v0, v1); bf16_t* dst = O + (size_t)row * AMLD + col0 + bj * HALF;
                        if (wt) { __hip_atomic_store((unsigned long long*)dst, (unsigned long long)pw.x | ((unsigned long long)pw.y << 32), __ATOMIC_RELAXED, __HIP_MEMORY_SCOPE_AGENT);
                                  __hip_atomic_store((unsigned long long*)dst + 1, (unsigned long long)pw.z | ((unsigned long long)pw.w << 32), __ATOMIC_RELAXED, __HIP_MEMORY_SCOPE_AGENT); }
                        else *(u32x4*)dst = pw;
                    }
                }
        } else {
#pragma unroll
            for (int ai = 0; ai < 2; ++ai)
#pragma unroll
                for (int m = 0; m < 4; ++m) {
                    const size_t off = (size_t)(row0 + ai * HALF + m * 16) * D + col0;
#pragma unroll
                    for (int bj = 0; bj < 2; ++bj)
#pragma unroll
                        for (int n = 0; n < 2; ++n) *(f32x4*)(h + off + bj * HALF + 4 * n) = *(const f32x4*)(x + off + bj * HALF + 4 * n) + acc[ai][bj][m][n];
                }
        }
    }
};

struct EpiResid {
    static constexpr bool PERM = false, AFTER_DRAIN = false, HAS_MID = false;
    const float* x; float* h;
    __device__ __forceinline__ bool keep(const Unit&) const { return false; }
    __device__ __forceinline__ void operator()(f32x4 (&acc)[2][2][4][2], const Unit& u, int wr, int wc, int fr, int fq) const {
        const int row0 = u.pm * BM + wr * 64 + fr, col0 = u.pn * BM + wc * 32 + 4 * fq;
#pragma unroll
        for (int ai = 0; ai < 2; ++ai)
#pragma unroll
            for (int m = 0; m < 4; ++m) {
                const size_t off = (size_t)(row0 + ai * HALF + m * 16) * D + col0;
#pragma unroll
                for (int bj = 0; bj < 2; ++bj)
#pragma unroll
                    for (int n = 0; n < 2; ++n) *(f32x4*)(h + off + bj * HALF + n * 16) = *(const f32x4*)(x + off + bj * HALF + n * 16) + acc[ai][bj][m][n];
            }
    }
};

template <bool OUT8> struct EpiSwiGLU {
    static constexpr bool PERM = true, AFTER_DRAIN = false, HAS_MID = false;
    bf16_t* act; const float* bgu; float sc;
    __device__ __forceinline__ bool keep(const Unit&) const { return false; }
    __device__ __forceinline__ void operator()(f32x4 (&acc)[2][2][4][2], const Unit& u, int wr, int wc, int fr, int fq) const {
        const int e = u.pn >> 3, pnl = u.pn & 7, row0 = u.pm * BM + wr * 64 + fr, j0 = 128 * pnl + 32 * wc + 8 * fq;
        const float* bp = bgu + (size_t)e * 2048 + 2 * j0;
        const f32x4 b0 = *(const f32x4*)(bp), b1 = *(const f32x4*)(bp + 4), b2 = *(const f32x4*)(bp + 8), b3 = *(const f32x4*)(bp + 12);
        const f32x4 bg0 = (f32x4){b0[0], b0[2], b1[0], b1[2]}, bu0 = (f32x4){b0[1], b0[3], b1[1], b1[3]}, bg1 = (f32x4){b2[0], b2[2], b3[0], b3[2]}, bu1 = (f32x4){b2[1], b2[3], b3[1], b3[3]};
#pragma unroll
        for (int ai = 0; ai < 2; ++ai)
#pragma unroll
            for (int m = 0; m < 4; ++m) {
                const int row = row0 + ai * HALF + m * 16;
                f32x4 o[2]; const float lim = 7.0f, nlim = -7.0f;
#pragma unroll
                for (int n = 0; n < 2; ++n) {
                    const f32x4 g = acc[ai][0][m][n] * sc + (n ? bg1 : bg0), up = acc[ai][1][m][n] * sc + (n ? bu1 : bu0);
#pragma unroll
                    for (int j = 0; j < 4; ++j) { float gg, uu;
                        asm("v_min_f32 %0, %2, %1" : "=v"(gg) : "v"(g[j]), "v"(lim)); asm("v_med3_f32 %0, %1, %2, %3" : "=v"(uu) : "v"(up[j]), "v"(nlim), "v"(lim));
                        const float sg = frcp(1.0f + __builtin_amdgcn_exp2f(gg * (-1.702f * 1.4426950408889634f)));
                        o[n][j] = __builtin_fmaf(uu, gg, gg) * sg; }
                }
                if constexpr (OUT8) { u32x2 w8; w8.x = pk4_fp8(o[0][0], o[0][1], o[0][2], o[0][3]); w8.y = pk4_fp8(o[1][0], o[1][1], o[1][2], o[1][3]); __hip_atomic_store((unsigned long long*)((unsigned char*)act + (size_t)row * D + j0), (unsigned long long)w8.x | ((unsigned long long)w8.y << 32), __ATOMIC_RELAXED, __HIP_MEMORY_SCOPE_AGENT); }
                else *(u32x4*)(act + (size_t)row * D + j0) = pack8(o[0], o[1]);
            }
    }
};

struct EpiDown {
    static constexpr bool PERM = true, AFTER_DRAIN = false, HAS_MID = false;
    bf16_t* ybuf; const float* bdn; const int* row_tok; const float* row_w; float sc;
    const LAS int* tbase; const LAS int* tnv;
    __device__ __forceinline__ bool keep(const Unit&) const { return false; }
    __device__ __forceinline__ void operator()(f32x4 (&acc)[2][2][4][2], const Unit& u, int wr, int wc, int fr, int fq) const {
        const int e = u.pn >> 2, pnl = u.pn & 3, col0 = 256 * pnl + 32 * wc + 8 * fq;
#if RM_FUSED
        const int row0 = tbase[u.pm] + wr * 64 + fr, nvr = tnv[u.pm] - (wr * 64 + fr);
#else
        const int row0 = u.pm * BM + wr * 64 + fr;
#endif
        f32x4 bv[2][2];
#pragma unroll
        for (int bj = 0; bj < 2; ++bj)
#pragma unroll
            for (int n = 0; n < 2; ++n) bv[bj][n] = *(const f32x4*)(bdn + (size_t)e * D + col0 + bj * HALF + 4 * n);
        int tks[8]; float ws[8];
#pragma unroll
#if RM_FUSED
        for (int i = 0; i < 8; ++i) { const int o = (i >> 2) * HALF + (i & 3) * 16; const bool ok = o < nvr; const int row = ok ? row0 + o : 0; tks[i] = row_tok[row]; ws[i] = row_w[row]; if (!ok) tks[i] = -1; }
#else
        for (int i = 0; i < 8; ++i) { const int row = row0 + (i >> 2) * HALF + (i & 3) * 16; tks[i] = row_tok[row]; ws[i] = row_w[row]; }
#endif
#pragma unroll
        for (int ai = 0; ai < 2; ++ai)
#pragma unroll
            for (int m = 0; m < 4; ++m) {
                const int tk = tks[ai * 4 + m]; const float w = ws[ai * 4 + m];
                if (tk >= 0) {
#pragma unroll
                    for (int bj = 0; bj < 2; ++bj) {
                        const f32x4 v0 = (acc[ai][bj][m][0] * sc + bv[bj][0]) * w, v1 = (acc[ai][bj][m][1] * sc + bv[bj][1]) * w;
                        *(u32x4*)(ybuf + (size_t)tk * D + col0 + bj * HALF) = pack8(v0, v1);
                    }
                }
            }
    }
};

struct MoeOrder {
    const LAS unsigned* tile_e; int ntiles, G, c; const int* rowidx; const void *a0, *a1, *b0, *b1; unsigned* ready; unsigned* tmo;
    const LAS int* tbase; const LAS int* tnv;
    __device__ __forceinline__ int kt0(const Unit&) const { return 0; }
    __device__ __forceinline__ int nkt(const Unit&, int full) const { return full; }
#if RM_FUSED
    __device__ __forceinline__ int rowsel(const Unit& u, int r) const { if (u.part) return r; const int lr = r - u.pm * BM; return (lr < tnv[u.pm]) ? (rowidx[tbase[u.pm] + lr] >> 2) : 0; }
#else
    __device__ __forceinline__ int rowsel(const Unit& u, int r) const { if (u.part) return r; const int v = rowidx[r]; return (v < 0 ? 0 : v) >> 2; }
#endif
    __device__ __forceinline__ const void* abase(const Unit& u) const { return u.part ? a1 : a0; }
    __device__ __forceinline__ const void* bbase(const Unit& u) const { return u.part ? b1 : b0; }
    __device__ bool next(int i, Unit& u) const {
        long L = (long)i * G + c; const long n1 = (long)ntiles * 8;
        if (L < n1) { u.pm = (int)(L >> 3); u.pn = (int)tile_e[u.pm] * 8 + (int)(L & 7); u.part = 0; return true; }
        L -= n1; if (L >= (long)ntiles * 4) return false;
        u.pm = (int)(L >> 2); u.pn = (int)tile_e[u.pm] * 4 + (int)(L & 3); u.part = 1; return true;
    }
    __device__ __forceinline__ void a_ready(const Unit& u) const {
        if (u.part == 0) return;
        if (threadIdx.x < 64) {
            unsigned spins = 0;
            while ((unsigned)__builtin_amdgcn_readfirstlane(__hip_atomic_load(ready + 64 * u.pm, __ATOMIC_RELAXED, __HIP_MEMORY_SCOPE_AGENT)) < 64u) {
                __builtin_amdgcn_s_sleep(2);
                if (++spins > (1u << 22)) { if (threadIdx.x == 0) __hip_atomic_store(tmo, 1u, __ATOMIC_RELAXED, __HIP_MEMORY_SCOPE_AGENT); break; } }
            __builtin_amdgcn_fence(__ATOMIC_ACQUIRE, "agent");
            asm volatile("s_waitcnt vmcnt(0)" ::: "memory");
        }
        asm volatile("" ::: "memory"); __builtin_amdgcn_s_barrier(); asm volatile("" ::: "memory");
    }
    __device__ __forceinline__ void done(const Unit& u) const {
        if (u.part != 0) return;
        asm volatile("s_waitcnt vmcnt(0)" ::: "memory");
        if ((threadIdx.x & 63) == 0) __hip_atomic_fetch_add(ready + 64 * u.pm, 1u, __ATOMIC_RELAXED, __HIP_MEMORY_SCOPE_AGENT);
    }
};
struct EpiMoe {
    static constexpr bool PERM = true, AFTER_DRAIN = false, HAS_MID = false;
    EpiSwiGLU<true> e0; EpiDown e1;
    __device__ __forceinline__ bool keep(const Unit&) const { return false; }
    __device__ __forceinline__ void operator()(f32x4 (&acc)[2][2][4][2], const Unit& u, int wr, int wc, int fr, int fq) const {
        if (u.part == 0) e0(acc, u, wr, wc, fr, fq); else e1(acc, u, wr, wc, fr, fq);
    }
};
template <class Epi, class Sched, bool ALIGN_EPI = false, bool SP2 = false, bool FP8 = false, bool GATHER = false, bool MULTI = false>
__device__ __forceinline__ void gemm_phase(PG8_LAS unsigned char* lds, const Gemm g, const Sched& S, const Epi& E) {
    typedef typename FragT<FP8>::type frag_t;
    const int tid = threadIdx.x, wid = __builtin_amdgcn_readfirstlane(tid >> 6), lane = tid & 63, wr = wid >> 2, wc = wid & 3, fr = lane & 15, fq = lane >> 4;
    int K_ = g.K; asm volatile("" : "+s"(K_));
    const int K = K_, ntfull = K / BK;
    unsigned voffA[2], voffB[2];
#pragma unroll
    for (int i = 0; i < 2; ++i) { int R, C; stage_rc(tid * 16 + i * 8192, R, C); const int Rb = Epi::PERM ? ((R & ~31) + perm32(R & 31)) : R;
        voffA[i] = (unsigned)(R * K + C) * 2u; voffB[i] = (unsigned)(Rb * K + C) * 2u; }
    const size_t kstep = (size_t)(BK * 2);
    const size_t hstep = (size_t)HALF * K * 2;
    const size_t tstep = 2 * hstep;
    const unsigned ldsw = (unsigned)wid * 1024u;
    const int aoff = lds_byte(wr * 64 + fr, fq * (FP8 ? 16 : 8)), boff = lds_byte(wc * 32 + fr, fq * (FP8 ? 16 : 8));
    constexpr int NKF = FP8 ? 1 : 2;
#define PG8_SA(b, h) (((b) * 2 + (h)) * HTB)
#define PG8_SB(b, h) ((4 + (b) * 2 + (h)) * HTB)
#define PG8_STAGE(bufoff, gbase, voff) do { _Pragma("unroll") for (int _i = 0; _i < 2; ++_i) \
        __builtin_amdgcn_global_load_lds((const unsigned*)((const char*)(gbase) + (voff)[_i]), (PG8_LAS unsigned*)(lds + (bufoff) + ldsw + _i * 8192), 16, 0, 0); } while (0)
#define PG8_STAGEA(bufoff, gbase, half, isnext) do { if constexpr (GATHER) { unsigned vs_[2]; vs_[0] = (isnext) ? voffAn[half][0] : voffAc[half][0]; vs_[1] = (isnext) ? voffAn[half][1] : voffAc[half][1]; PG8_STAGE(bufoff, gbase, vs_); } \
        else { PG8_STAGE(bufoff, (gbase) + (half) * hstep, voffA); } } while (0)
#define PG8_LDA(dst, b, h) do { _Pragma("unroll") for (int m = 0; m < 4; ++m) _Pragma("unroll") for (int k = 0; k < NKF; ++k) dst[m][k] = *(const PG8_LAS frag_t*)(lds + PG8_SA(b, h) + aoff + m * 2048 + k * 1024); } while (0)
#define PG8_LDB(dst, b, h) do { _Pragma("unroll") for (int n = 0; n < 2; ++n) _Pragma("unroll") for (int k = 0; k < NKF; ++k) dst[n][k] = *(const PG8_LAS frag_t*)(lds + PG8_SB(b, h) + boff + n * 2048 + k * 1024); } while (0)
#define PG8_MMA(ai, bj, At, Bt) do { __builtin_amdgcn_s_setprio(1); \
        if constexpr (FP8) { _Pragma("unroll") for (int m = 0; m < 4; ++m) _Pragma("unroll") for (int n = 0; n < 2; ++n) \
            acc[ai][bj][m][n] = mma8(Bt[n][0], At[m][0], acc[ai][bj][m][n]); } \
        else { _Pragma("unroll") for (int m = 0; m < 4; ++m) _Pragma("unroll") for (int n = 0; n < 2; ++n) _Pragma("unroll") for (int k = 0; k < 2; ++k) \
            acc[ai][bj][m][n] = mma16(Bt[n][k], At[m][k], acc[ai][bj][m][n]); } \
        __builtin_amdgcn_s_setprio(0); } while (0)
#define PG8_WAIT_V(n) asm volatile("s_waitcnt vmcnt(" #n ")" ::: "memory")
#define PG8_WAIT_L(n) asm volatile("s_waitcnt lgkmcnt(" #n ")" ::: "memory")
#define PG8_BAR __builtin_amdgcn_s_barrier()
#define PG8_SCHED __builtin_amdgcn_sched_barrier(0)
    Unit cur, nxt; int ui = 0;
    if (!S.next(0, cur)) return;
    unsigned voffAc[2][2], voffAn[2][2];
#define PG8_GROWS(dst, u_) do { if constexpr (GATHER) { _Pragma("unroll") for (int h_ = 0; h_ < 2; ++h_) _Pragma("unroll") for (int i_ = 0; i_ < 2; ++i_) { int R_, C_; stage_rc(tid * 16 + i_ * 8192, R_, C_); \
        const int ri_ = S.rowsel((u_), (u_).pm * BM + h_ * HALF + R_); dst[h_][i_] = (unsigned)ri_ * (unsigned)(K * 2) + (unsigned)(C_ * 2); } } } while (0)
    PG8_GROWS(voffAc, cur);
    f32x4 acc[2][2][4][2];
#pragma unroll
    for (int a = 0; a < 2; ++a)
#pragma unroll
        for (int b = 0; b < 2; ++b)
#pragma unroll
            for (int m = 0; m < 4; ++m)
#pragma unroll
                for (int n = 0; n < 2; ++n) acc[a][b][m][n] = (f32x4){0.f, 0.f, 0.f, 0.f};
    frag_t At[4][NKF], B0[2][NKF], B1[2][NKF];
    const char* cA = (MULTI ? (const char*)S.abase(cur) : (const char*)g.A) + (GATHER ? (size_t)0 : (size_t)cur.pm * tstep) + (size_t)S.kt0(cur) * kstep; const char* cB = (MULTI ? (const char*)S.bbase(cur) : (const char*)g.Bt) + (size_t)cur.pn * tstep + (size_t)S.kt0(cur) * kstep;
    S.a_ready(cur);
    if constexpr (SP2) {
        PG8_STAGE(PG8_SB(0, 0), cB, voffB); PG8_STAGE(PG8_SB(0, 1), cB + hstep, voffB); PG8_STAGEA(PG8_SA(0, 0), cA, 0, false); PG8_STAGEA(PG8_SA(0, 1), cA, 1, false);
        if (wr == 1) PG8_BAR;
        PG8_WAIT_V(2); PG8_BAR;
        PG8_STAGE(PG8_SB(1, 0), cB + kstep, voffB); PG8_STAGEA(PG8_SA(1, 0), cA + kstep, 0, false); PG8_STAGE(PG8_SB(1, 1), cB + hstep + kstep, voffB);
        PG8_WAIT_V(6); PG8_BAR;
    } else {
        PG8_STAGE(PG8_SB(0, 0), cB, voffB); PG8_STAGEA(PG8_SA(0, 0), cA, 0, false); PG8_STAGE(PG8_SB(0, 1), cB + hstep, voffB); PG8_STAGEA(PG8_SA(0, 1), cA, 1, false);
        if (wr == 1) PG8_BAR;
        PG8_WAIT_V(4); PG8_BAR;
        PG8_STAGE(PG8_SB(1, 0), cB + kstep, voffB); PG8_STAGEA(PG8_SA(1, 0), cA + kstep, 0, false); PG8_STAGE(PG8_SB(1, 1), cB + hstep + kstep, voffB);
        PG8_WAIT_V(6); PG8_BAR;
    }
    for (;;) {
        const bool has_next = S.next(ui + 1, nxt);
        if (has_next) PG8_GROWS(voffAn, nxt);
        else if constexpr (GATHER) { _Pragma("unroll") for (int h_ = 0; h_ < 2; ++h_) _Pragma("unroll") for (int i_ = 0; i_ < 2; ++i_) voffAn[h_][i_] = voffAc[h_][i_]; }
        const char* nA = has_next ? (MULTI ? (const char*)S.abase(nxt) : (const char*)g.A) + (GATHER ? (size_t)0 : (size_t)nxt.pm * tstep) + (size_t)S.kt0(nxt) * kstep : cA; const char* nB = has_next ? (MULTI ? (const char*)S.bbase(nxt) : (const char*)g.Bt) + (size_t)nxt.pn * tstep + (size_t)S.kt0(nxt) * kstep : cB;
        const int nt = S.nkt(cur, ntfull);
        for (int t = 0; t < nt; t += 2) {
            const bool last = (t == nt - 2);
            const char* a1 = cA + (size_t)(t + 1) * kstep;
            const char* a2 = last ? nA : cA + (size_t)(t + 2) * kstep; const char* b2 = last ? nB : cB + (size_t)(t + 2) * kstep;
            const char* a3 = a2 + kstep; const char* b3 = b2 + kstep;
            if (last && has_next) S.a_ready(nxt);
            if constexpr (SP2) {
            PG8_LDB(B0, 0, 0); PG8_LDB(B1, 0, 1); PG8_SCHED; PG8_LDA(At, 0, 0); PG8_STAGEA(PG8_SA(1, 1), a1, 1, false);
            PG8_WAIT_V(8); PG8_WAIT_L(0); PG8_BAR; PG8_MMA(0, 0, At, B0); PG8_MMA(0, 1, At, B1); PG8_BAR; PG8_SCHED;
            PG8_LDA(At, 0, 1); PG8_STAGE(PG8_SB(0, 0), b2, voffB); PG8_STAGE(PG8_SB(0, 1), b2 + hstep, voffB); PG8_STAGEA(PG8_SA(0, 0), a2, 0, last);
            PG8_WAIT_V(8); PG8_WAIT_L(0); PG8_BAR; PG8_MMA(1, 0, At, B0); PG8_MMA(1, 1, At, B1); PG8_BAR; PG8_SCHED;
            PG8_LDB(B0, 1, 0); PG8_LDB(B1, 1, 1); PG8_SCHED; PG8_LDA(At, 1, 0); PG8_STAGEA(PG8_SA(0, 1), a2, 1, last);
            PG8_WAIT_V(8); PG8_WAIT_L(0); PG8_BAR; PG8_MMA(0, 0, At, B0); PG8_MMA(0, 1, At, B1); PG8_BAR; PG8_SCHED;
            PG8_LDA(At, 1, 1); PG8_STAGE(PG8_SB(1, 0), b3, voffB); PG8_STAGE(PG8_SB(1, 1), b3 + hstep, voffB); PG8_STAGEA(PG8_SA(1, 0), a3, 0, last);
            PG8_WAIT_V(8); PG8_WAIT_L(0); PG8_BAR; PG8_MMA(1, 0, At, B0); PG8_MMA(1, 1, At, B1); PG8_BAR; PG8_SCHED;
            } else {
            PG8_LDB(B0, 0, 0); PG8_SCHED; PG8_LDA(At, 0, 0); PG8_STAGEA(PG8_SA(1, 1), a1, 1, false);
            PG8_WAIT_L(8); PG8_BAR; PG8_WAIT_L(0); PG8_MMA(0, 0, At, B0); PG8_BAR; PG8_SCHED;
            PG8_LDB(B1, 0, 1); PG8_STAGE(PG8_SB(0, 0), b2, voffB);
            PG8_BAR; PG8_WAIT_L(0); PG8_MMA(0, 1, At, B1); PG8_BAR;
            PG8_LDA(At, 0, 1); PG8_STAGEA(PG8_SA(0, 0), a2, 0, last);
            PG8_BAR; PG8_WAIT_L(0); PG8_MMA(1, 0, At, B0); PG8_BAR; PG8_SCHED;
            PG8_STAGE(PG8_SB(0, 1), b2 + hstep, voffB);
            PG8_WAIT_V(6); PG8_BAR; PG8_MMA(1, 1, At, B1); PG8_BAR;
            PG8_LDB(B0, 1, 0); PG8_SCHED; PG8_LDA(At, 1, 0); PG8_STAGEA(PG8_SA(0, 1), a2, 1, last);
            PG8_WAIT_L(8); PG8_BAR; PG8_WAIT_L(0); PG8_MMA(0, 0, At, B0); PG8_BAR; PG8_SCHED;
            PG8_LDB(B1, 1, 1); PG8_STAGE(PG8_SB(1, 0), b3, voffB);
            PG8_BAR; PG8_WAIT_L(0); PG8_MMA(0, 1, At, B1); PG8_BAR;
            PG8_LDA(At, 1, 1); PG8_STAGEA(PG8_SA(1, 0), a3, 0, last);
            PG8_BAR; PG8_WAIT_L(0); PG8_MMA(1, 0, At, B0); PG8_BAR; PG8_SCHED;
            PG8_STAGE(PG8_SB(1, 1), b3 + hstep, voffB);
            PG8_WAIT_V(6); PG8_BAR; PG8_MMA(1, 1, At, B1); PG8_BAR;
            }
        }
        if constexpr (FP8) asm volatile("s_nop 15\n\ts_nop 15" ::: "memory");
        if constexpr (ALIGN_EPI) { if (wr == 0) PG8_BAR; }
        if constexpr (!Epi::AFTER_DRAIN) { E(acc, cur, wr, wc, fr, fq); S.done(cur); }
        if (!has_next) break;
        if (!E.keep(cur)) {
#pragma unroll
        for (int a = 0; a < 2; ++a)
#pragma unroll
            for (int b = 0; b < 2; ++b)
#pragma unroll
                for (int m = 0; m < 4; ++m)
#pragma unroll
                    for (int n = 0; n < 2; ++n) acc[a][b][m][n] = (f32x4){0.f, 0.f, 0.f, 0.f};
        }
        cur = nxt; cA = nA; cB = nB; ++ui;
        if constexpr (GATHER) { _Pragma("unroll") for (int h_ = 0; h_ < 2; ++h_) _Pragma("unroll") for (int i_ = 0; i_ < 2; ++i_) voffAc[h_][i_] = voffAn[h_][i_]; }
        if constexpr (ALIGN_EPI) { if (wr == 1) PG8_BAR; }
    }
    PG8_WAIT_V(0);
    if constexpr (!ALIGN_EPI) { if (wr == 0) PG8_BAR; }
    PG8_BAR;
    if constexpr (Epi::AFTER_DRAIN) { E.fused(acc, cur, wr, wc, fr, fq, lds, wid, lane); S.done(cur); }
#undef PG8_SA
#undef PG8_SB
#undef PG8_STAGE
#undef PG8_LDA
#undef PG8_STAGEA
#undef PG8_GROWS
#undef PG8_LDB
#undef PG8_MMA
#undef PG8_WAIT_V
#undef PG8_WAIT_L
#undef PG8_BAR
#undef PG8_SCHED
}
}
#define XB_TMO      128
#define XB_XCNT(j)  (256  + 64 * (j))
#define XB_XSUB(j)  (1280 + 64 * (j))
#define XB_XGEN(j)  (2304 + 64 * (j))
#define XB_TOP      3328
#define XB_TOPGEN   3392
#define XCD_BAR_WORDS 3456
#define XB_SPIN_CAP (1u << 24)

__device__ __forceinline__ unsigned xb_ld(unsigned* p)              { return __hip_atomic_load(p, __ATOMIC_RELAXED, __HIP_MEMORY_SCOPE_AGENT); }
__device__ __forceinline__ unsigned xb_add(unsigned* p, unsigned v) { return __hip_atomic_fetch_add(p, v, __ATOMIC_RELAXED, __HIP_MEMORY_SCOPE_AGENT); }
__device__ __forceinline__ unsigned xb_xcc_id() { return (unsigned)__builtin_amdgcn_s_getreg((3 << 11) | 20) & 0xFu; }
#define XB_SPIN(cond, bar) do { unsigned _sp = 0; while (cond) { __builtin_amdgcn_s_sleep(1); \
    if ((++_sp & 255u) == 0u) { if (xb_ld(&(bar)[XB_TMO])) break; if (_sp > XB_SPIN_CAP) { atomicAdd(&(bar)[XB_TMO], 1u); break; } } } } while (0)

struct XcdBarrier {
    unsigned* bar; unsigned x;
    volatile LAS unsigned* st;
};

__device__ __forceinline__ XcdBarrier xcd_barrier_post(unsigned* bar, volatile LAS unsigned* st) {
    XcdBarrier b; b.bar = bar; b.x = xb_xcc_id(); b.st = st;
    if (threadIdx.x == 0) (void)xb_add(&bar[XB_XCNT(b.x)], 1u);
    return b;
}
__device__ __forceinline__ void xcd_barrier_complete(unsigned* bar, unsigned x, unsigned& nloc, unsigned& nx) {
    const unsigned G = gridDim.x * gridDim.y * gridDim.z;
    unsigned sum, cnt, mine, sp = 0u;
    for (;;) {
        sum = 0u; cnt = 0u; mine = 0u;
#pragma unroll
        for (unsigned j = 0; j < 16; ++j) { const unsigned c = xb_ld(&bar[XB_XCNT(j)]); sum += c; cnt += (c > 0u) ? 1u : 0u; mine = (j == x) ? c : mine; }
        if (sum == G) break;
        __builtin_amdgcn_s_sleep(1);
        if ((++sp & 255u) == 0u) { if (xb_ld(&bar[XB_TMO])) break; if (sp > XB_SPIN_CAP) { atomicAdd(&bar[XB_TMO], 1u); break; } }
    }
    nloc = mine > 0u ? mine : 1u; nx = cnt > 0u ? cnt : 1u;
}

__device__ __forceinline__ void xcd_barrier(const XcdBarrier& b) {
    asm volatile("s_waitcnt vmcnt(0)" ::: "memory");
    __syncthreads();
    if (threadIdx.x == 0) {
        unsigned* bar = b.bar;
        __builtin_amdgcn_s_waitcnt(0);
        unsigned nloc = b.st[0], nx = b.st[1];
        if (nloc == 0u) { xcd_barrier_complete(bar, b.x, nloc, nx); b.st[0] = nloc; b.st[1] = nx; }
        const unsigned old = xb_add(&bar[XB_XSUB(b.x)], 1u);
        const unsigned gen = old / nloc;
        if (old + 1u == (gen + 1u) * nloc) {
            __builtin_amdgcn_fence(__ATOMIC_RELEASE, "agent");
            asm volatile("s_waitcnt vmcnt(0)" ::: "memory");
            const unsigned og = xb_add(&bar[XB_TOP], 1u);
            const unsigned tg = og / nx;
            if (og + 1u == (tg + 1u) * nx) xb_add(&bar[XB_TOPGEN], 1u);
            else XB_SPIN(xb_ld(&bar[XB_TOPGEN]) == tg, bar);
            __builtin_amdgcn_fence(__ATOMIC_ACQUIRE, "agent");
            xb_add(&bar[XB_XGEN(b.x)], 1u);
            asm volatile("s_waitcnt vmcnt(0)" ::: "memory");
        } else {
            XB_SPIN(xb_ld(&bar[XB_XGEN(b.x)]) == gen, bar);
            __builtin_amdgcn_fence(__ATOMIC_ACQUIRE, "agent");
            asm volatile("s_waitcnt vmcnt(0)" ::: "memory");
        }
    }
    __syncthreads();
}

struct Frame {
    LAS unsigned char* lds;
    unsigned* ctl;
    int tid, lane, wave, vcu, G, gw, NGW;
    const float *x, *g_mix, *w_in, *conv_qk, *b_if, *g_mnorm, *w_attn_out, *w_mlstm_out, *w_mix_out, *g_ffn, *w_router, *b_router, *w_gate_up, *b_gate_up, *w_down, *b_down, *g_final;
    const int* positions;
    float* out;
    bf16 *WinT, *WamT, *WoT, *WguT, *WdnT, *XN, *PROJ, *OG, *AM, *MERGED, *XS, *ACT, *YBUF;
    float *GATES, *ROPE, *LSE, *HT, *H, *QC, *KC, *ROW_W, *TOK_W;
    int *TOK_E, *TOK_SLOT, *ROW_TOK;
};

__constant__ double ROPE_REV[16] = {
    1.59154943091895346e-01, 7.00865215877985032e-02, 3.08637634047012298e-02, 1.35913706361939050e-02, 5.98518571271370540e-03, 2.63567589866741401e-03, 1.16066364124006098e-03, 5.11117504537543857e-04,
    2.25079079039276525e-04, 9.91173093690193548e-05, 4.36479527928028909e-05, 1.92211006849448627e-05, 8.46433080824140138e-06, 3.72740860191535193e-06, 1.64142626279503449e-06, 7.22829306883286479e-07};

template <int MAP>
__device__ __forceinline__ void transpose_item(const float* W, int Nsrc, bf16* WT, int ldk, int kofs, int nblk, LAS float* scr, int item, int lane) {
    const int kb = item / nblk, nb = item % nblk, k0 = 64 * kb, n0 = 32 * nb;
    const int np = n0 + (lane & 31);
    const int sc = (MAP == 1) ? win_logical_col(np) : (MAP == 2) ? wgu_logical_col(np) : np;
    float tv[32];
#pragma unroll
    for (int i = 0; i < 32; ++i) tv[i] = W[(size_t)(k0 + 2 * i + (lane >> 5)) * Nsrc + sc];
#pragma unroll
    for (int i = 0; i < 32; ++i) scr[(2 * i + (lane >> 5)) * 33 + (lane & 31)] = tv[i];
    asm volatile("s_waitcnt lgkmcnt(0)" ::: "memory");
    const int c = lane & 7;
#pragma unroll
    for (int j = 0; j < 4; ++j) { const int n = (lane >> 3) + 8 * j; const LAS float* s = scr + (8 * c) * 33 + n;
        u32x4 o; o.x = pk2(s[0 * 33], s[1 * 33]); o.y = pk2(s[2 * 33], s[3 * 33]); o.z = pk2(s[4 * 33], s[5 * 33]); o.w = pk2(s[6 * 33], s[7 * 33]);
        *(u32x4*)(WT + (size_t)(n0 + n) * ldk + kofs + k0 + 8 * c) = o; }
    asm volatile("s_waitcnt lgkmcnt(0)" ::: "memory");
}

template <int MAP>
__device__ __forceinline__ void transpose_item_fp8(const float* W, int Nsrc, unsigned char* WT, int ldk, int nblk, LAS float* scr, int item, int lane, float scale) {
    const int kb = item / nblk, nb = item % nblk, k0 = 64 * kb, n0 = 32 * nb;
    const int np = n0 + (lane & 31);
    const int sc = (MAP == 1) ? win_logical_col(np) : (MAP == 2) ? wgu_logical_col(np) : np;
    float tv[32];
#pragma unroll
    for (int i = 0; i < 32; ++i) tv[i] = W[(size_t)(k0 + 2 * i + (lane >> 5)) * Nsrc + sc];
#pragma unroll
    for (int i = 0; i < 32; ++i) scr[(2 * i + (lane >> 5)) * 33 + (lane & 31)] = tv[i] * scale;
    asm volatile("s_waitcnt lgkmcnt(0)" ::: "memory");
    const int n = lane >> 1, c = lane & 1;
#pragma unroll
    for (int q = 0; q < 2; ++q) { const LAS float* s = scr + (32 * c + 16 * q) * 33 + n;
        u32x4 o; o.x = pk4_fp8(s[0 * 33], s[1 * 33], s[2 * 33], s[3 * 33]); o.y = pk4_fp8(s[4 * 33], s[5 * 33], s[6 * 33], s[7 * 33]);
        o.z = pk4_fp8(s[8 * 33], s[9 * 33], s[10 * 33], s[11 * 33]); o.w = pk4_fp8(s[12 * 33], s[13 * 33], s[14 * 33], s[15 * 33]);
        *(u32x4*)(WT + (size_t)(n0 + n) * ldk + k0 + 32 * c + 16 * q) = o; }
    asm volatile("s_waitcnt lgkmcnt(0)" ::: "memory");
}

template <int MAP>
__device__ __forceinline__ void tr8_load(const float* W, int Nsrc, int nblk, int item, int lane, float (&tv)[32]) {
    const int kb = item / nblk, nb = item % nblk, k0 = 64 * kb, np = 32 * nb + (lane & 31);
    const int sc = (MAP == 1) ? win_logical_col(np) : (MAP == 2) ? wgu_logical_col(np) : np;
#pragma unroll
    for (int i = 0; i < 32; ++i) tv[i] = W[(size_t)(k0 + 2 * i + (lane >> 5)) * Nsrc + sc];
}
__device__ __forceinline__ void tr8_store(const float (&tv)[32], unsigned char* WT, int ldk, int nblk, LAS float* scr, int item, int lane, float scale) {
    const int kb = item / nblk, nb = item % nblk, k0 = 64 * kb, n0 = 32 * nb;
#pragma unroll
    for (int i = 0; i < 32; ++i) scr[(2 * i + (lane >> 5)) * 33 + (lane & 31)] = tv[i] * scale;
    asm volatile("s_waitcnt lgkmcnt(0)" ::: "memory");
    const int n = lane >> 1, c = lane & 1;
#pragma unroll
    for (int q = 0; q < 2; ++q) { const LAS float* s = scr + (32 * c + 16 * q) * 33 + n;
        u32x4 o; o.x = pk4_fp8(s[0 * 33], s[1 * 33], s[2 * 33], s[3 * 33]); o.y = pk4_fp8(s[4 * 33], s[5 * 33], s[6 * 33], s[7 * 33]);
        o.z = pk4_fp8(s[8 * 33], s[9 * 33], s[10 * 33], s[11 * 33]); o.w = pk4_fp8(s[12 * 33], s[13 * 33], s[14 * 33], s[15 * 33]);
        *(u32x4*)(WT + (size_t)(n0 + n) * ldk + k0 + 32 * c + 16 * q) = o; }
    asm volatile("s_waitcnt lgkmcnt(0)" ::: "memory");
}

__device__ __forceinline__ void p0_weights(Frame& F) {
    LAS float* scr = (LAS float*)(F.lds + F.wave * 16384);
    constexpr int I_IN = (D / 64) * (NP / 32), I_A = (512 / 64) * (D / 32), I_M = (D / 64) * (D / 32), I_O = I_M;
    constexpr int I_GU1 = (D / 64) * (2048 / 32), I_DN1 = (D / 64) * (D / 32);
    constexpr int NITEMS = I_IN + I_A + I_M + I_O + ((MOE_FP8 && STEAL) ? 0 : NE * I_GU1 + NE * I_DN1);
    for (int it = F.gw; it < NITEMS; it += F.NGW) {
        int r = it;
#if P1_FP8
        if (r < I_IN) { const int pn = (r % (NP / 32)) >> 3;
            if (pn < 18 || pn >= P1_HI) transpose_item_fp8<1>(F.w_in, DIN, (unsigned char*)F.WinT - (pn >= P1_HI ? (size_t)(P1_HI - 18) * 256 * D : (size_t)0), D, NP / 32, scr, r, F.lane, 32.0f);
            else transpose_item<1>(F.w_in, DIN, F.WinT, D, 0, NP / 32, scr, r, F.lane);
            continue; } r -= I_IN;
#else
        if (r < I_IN) { transpose_item<1>(F.w_in, DIN, F.WinT, D, 0, NP / 32, scr, r, F.lane); continue; } r -= I_IN;
#endif
        if (r < I_A) { transpose_item<0>(F.w_attn_out, D, F.WamT, AMLD, 0, D / 32, scr, r, F.lane); continue; } r -= I_A;
        if (r < I_M) { transpose_item<0>(F.w_mlstm_out, D, F.WamT, AMLD, 512, D / 32, scr, r, F.lane); continue; } r -= I_M;
        if (r < I_O) { transpose_item<0>(F.w_mix_out, D, F.WamT, AMLD, 1536, D / 32, scr, r, F.lane); continue; } r -= I_O;
#if MOE_FP8 && STEAL
        (void)r;
#elif MOE_FP8
        if (r < NE * I_GU1) { const int e = r / I_GU1; transpose_item_fp8<2>(F.w_gate_up + (size_t)e * D * 2048, 2048, (unsigned char*)F.WguT + (size_t)e * 2048 * D, D, 2048 / 32, scr, r % I_GU1, F.lane, 32.0f); continue; } r -= NE * I_GU1;
        { const int e = r / I_DN1; transpose_item_fp8<0>(F.w_down + (size_t)e * D * D, D, (unsigned char*)F.WdnT + (size_t)e * D * D, D, D / 32, scr, r % I_DN1, F.lane, 32.0f); }
#else
        if (r < NE * I_GU1) { const int e = r / I_GU1; transpose_item<2>(F.w_gate_up + (size_t)e * D * 2048, 2048, F.WguT + (size_t)e * 2048 * D, D, 0, 2048 / 32, scr, r % I_GU1, F.lane); continue; } r -= NE * I_GU1;
        { const int e = r / I_DN1; transpose_item<0>(F.w_down + (size_t)e * D * D, D, F.WdnT + (size_t)e * D * D, D, 0, D / 32, scr, r % I_DN1, F.lane); }
#endif
    }
}

__device__ __forceinline__ void p0_rows(Frame& F) {
    LAS float* w8t = (LAS float*)(F.lds);
    __syncthreads();
    { float w8v[16];
#pragma unroll
      for (int j = 0; j < 16; ++j) { const int i = F.tid + j * NTHREADS; w8v[j] = F.w_in[(size_t)(i >> 3) * DIN + 8704 + (i & 7)]; }
#pragma unroll
      for (int j = 0; j < 16; ++j) { const int i = F.tid + j * NTHREADS; w8t[(i & 7) * 1024 + (i >> 3)] = w8v[j]; } }
    __syncthreads();
    f32x4 vnx[4];
    if (F.gw < T) { const f32x4* xr = (const f32x4*)(F.x + (size_t)F.gw * D) + F.lane;
#pragma unroll
        for (int j = 0; j < 4; ++j) vnx[j] = xr[64 * j]; }
    for (int row = F.gw; row < T; row += F.NGW) {
        f32x4 v[4]; float s = 0.f;
#pragma unroll
        for (int j = 0; j < 4; ++j) { v[j] = vnx[j]; s += (v[j].x * v[j].x + v[j].y * v[j].y) + (v[j].z * v[j].z + v[j].w * v[j].w); }
        if (row + F.NGW < T) { const f32x4* xr = (const f32x4*)(F.x + (size_t)(row + F.NGW) * D) + F.lane;
#pragma unroll
            for (int j = 0; j < 4; ++j) vnx[j] = xr[64 * j]; }
        const float rstd = 1.0f / sqrtf(wave_sum(s) * (1.0f / D) + RMS_EPS);
        float ga[8];
#pragma unroll
        for (int o = 0; o < 8; ++o) ga[o] = 0.f;
        unsigned long long* o8 = (unsigned long long*)(F.XN + (size_t)row * D) + F.lane;
#pragma unroll
        for (int j = 0; j < 4; ++j) {
            const f32x4 g = *((const f32x4*)F.g_mix + F.lane + 64 * j);
            v[j] = v[j] * rstd * g;
            o8[64 * j] = (unsigned long long)pk2(v[j].x, v[j].y) | ((unsigned long long)pk2(v[j].z, v[j].w) << 32);
#if P1_FP8
            ((unsigned*)((unsigned char*)F.ctl + WS_XN8 + (size_t)row * D))[F.lane + 64 * j] = pk4_fp8(v[j].x, v[j].y, v[j].z, v[j].w);
#endif
#pragma unroll
            for (int o = 0; o < 8; ++o) { const f32x4 w = *((const LAS f32x4*)(w8t + o * 1024) + F.lane + 64 * j); ga[o] += (v[j].x * w.x + v[j].y * w.y) + (v[j].z * w.z + v[j].w * w.w); }
        }
#pragma unroll
        for (int o = 0; o < 8; ++o) ga[o] = wave_sum(ga[o]);
        if (F.lane < 8) { float gv = ga[0];
#pragma unroll
            for (int o = 1; o < 8; ++o) gv = (F.lane == o) ? ga[o] : gv;
            F.GATES[(size_t)row * 8 + F.lane] = gv + F.b_if[F.lane]; }
        if (F.lane < 16) {
            const int pos = F.positions[row];
            double rev = (double)pos * ROPE_REV[F.lane]; rev -= floor(rev);
            const float fr = (float)rev;
            F.ROPE[(size_t)row * 32 + F.lane] = __builtin_amdgcn_cosf(fr);
            F.ROPE[(size_t)row * 32 + 16 + F.lane] = __builtin_amdgcn_sinf(fr);
        }
    }
}

template <int RT, class AF, class BF, class EP>
__device__ __forceinline__ void naive_gemm(Frame& F, int M, int N, int K, AF af, BF bf, EP ep) {
    const long gthreads = (long)F.G * NTHREADS, gtid = (long)blockIdx.x * NTHREADS + F.tid;
    for (long it = gtid; it < (long)(M / RT) * N; it += gthreads) {
        const int col = (int)(it % N), r0 = (int)(it / N) * RT;
        float acc[RT];
#pragma unroll
        for (int r = 0; r < RT; ++r) acc[r] = 0.f;
        for (int k = 0; k < K; ++k) { const float b = bf(k, col);
#pragma unroll
            for (int r = 0; r < RT; ++r) acc[r] += af(r0 + r, k) * b; }
#pragma unroll
        for (int r = 0; r < RT; ++r) ep(r0 + r, col, acc[r]);
    }
}

__device__ __forceinline__ void naive_p1(Frame& F) {
    const bf16* XN = F.XN; const float* W = F.w_in; bf16* P = F.PROJ;
    naive_gemm<8>(F, T, NP, D,
        [=](int r, int k) { return bf2f(XN[(size_t)r * D + k]); },
        [=](int k, int c) { return bf2f(f2bf(W[(size_t)k * DIN + win_logical_col(c)])); },
        [=](int r, int c, float a) { P[(size_t)r * NP + c] = (bf16)f2bf(a * (c < C_AK ? QSCALE : 1.0f)); });
}
__device__ __forceinline__ void naive_p1_rope(Frame& F) {
    const long gthreads = (long)F.G * NTHREADS, gtid = (long)blockIdx.x * NTHREADS + F.tid;
    for (long it = gtid; it < (long)T * 24 * 16; it += gthreads) {
        const int i = (int)(it & 15), hh = (int)((it >> 4) % 24), row = (int)(it / (24 * 16));
        const int a = i >> 2, j = i & 3; bf16* p = F.PROJ + (size_t)row * NP + hh * 128;
        const float x1 = bf2f(p[8 * a + j]), x2 = bf2f(p[8 * a + 4 + j]), cs = F.ROPE[(size_t)row * 32 + i], sn = F.ROPE[(size_t)row * 32 + 16 + i];
        p[8 * a + j] = (bf16)f2bf(x1 * cs - x2 * sn); p[8 * a + 4 + j] = (bf16)f2bf(x2 * cs + x1 * sn);
    }
}
__device__ __forceinline__ void naive_attn(Frame& F) {
    for (int it = F.gw; it < T * 12; it += F.NGW) {
        const int row = it / 12, gh = it % 12, g = gh >> 2, h = gh & 3, b = row / SEQ, t = row % SEQ, d = (g == 0) ? 1 : (g == 1) ? 4 : 16, i = t / d, r = t % d;
        const int hc = g * 512 + h * 128 + 2 * F.lane;
        const unsigned qw = *(const unsigned*)(F.PROJ + (size_t)row * NP + C_AQ + hc); const float q0 = bflo(qw), q1 = bfhi(qw);
        float m = -INFINITY, l = 0.f, o0 = 0.f, o1 = 0.f;
        for (int ii = (i > 128 ? i - 128 : 0); ii <= i; ++ii) {
            const size_t kr = (size_t)(b * SEQ + r + d * ii) * NP;
            const unsigned kw = *(const unsigned*)(F.PROJ + kr + C_AK + hc), vw = *(const unsigned*)(F.PROJ + kr + C_AV + hc);
            const float s = wave_sum(q0 * bflo(kw) + q1 * bfhi(kw));
            const float mn = fmaxf(m, s), al = exp2f(m - mn), p = exp2f(s - mn);
            l = l * al + p; o0 = o0 * al + p * bflo(vw); o1 = o1 * al + p * bfhi(vw); m = mn;
        }
        const float il = 1.0f / l;
        *(unsigned*)(F.OG + ((size_t)g * T + row) * 512 + h * 128 + 2 * F.lane) = pk2(o0 * il, o1 * il);
        if (F.lane == 0) F.LSE[((size_t)g * T + row) * 4 + h] = m + log2f(l);
    }
}
__device__ __forceinline__ void naive_conv(Frame& F) {
    const long gthreads = (long)F.G * NTHREADS, gtid = (long)blockIdx.x * NTHREADS + F.tid;
    for (long it = gtid; it < (long)T * 2048; it += gthreads) {
        const int c = (int)(it & 2047), row = (int)(it >> 11), t = row % SEQ;
        float a = 0.f;
#pragma unroll
        for (int j = 0; j < 4; ++j) if (t - 3 + j >= 0) a += F.conv_qk[j * 2048 + c] * bf2f(F.PROJ[(size_t)(row - 3 + j) * NP + C_MQ + c]);
        const float y = a / (1.0f + __expf(-a));
        if (c < 1024) F.QC[(size_t)row * 1024 + c] = y; else F.KC[(size_t)row * 1024 + c - 1024] = y * 0.0625f;
    }
}
__device__ __forceinline__ void naive_mlstm(Frame& F) {
    LAS float* sq = (LAS float*)F.lds; LAS float* sk = sq + 256; LAS float* red = sk + 256; LAS float* redn = red + 512;
    for (int item = blockIdx.x; item < NB * 4 * 8; item += F.G) {
        const int sl = item & 7, h = (item >> 3) & 3, b = item >> 5, dvl = F.tid & 31, dkp = F.tid >> 5;
        float c[16], n[16];
#pragma unroll
        for (int j = 0; j < 16; ++j) { c[j] = 0.f; n[j] = 0.f; }
        float m = 0.f;
        for (int t = 0; t < SEQ; ++t) {
            const size_t row = (size_t)b * SEQ + t;
            __syncthreads();
            if (F.tid < 256) sq[F.tid] = F.QC[row * 1024 + h * 256 + F.tid]; else sk[F.tid - 256] = F.KC[row * 1024 + h * 256 + F.tid - 256];
            const float v = bf2f(F.PROJ[row * NP + C_MV + h * 256 + sl * 32 + dvl]);
            const float ir = F.GATES[row * 8 + h], fr = F.GATES[row * 8 + 4 + h];
            const float logf = fminf(fr, 0.f) - log1pf(__expf(-fabsf(fr)));
            const float mn = fmaxf(logf + m, ir), fa = __expf(logf + m - mn), ia = __expf(ir - mn);
            m = mn;
            __syncthreads();
            float pn = 0.f, pd = 0.f;
#pragma unroll
            for (int j = 0; j < 16; ++j) { const float kk = sk[dkp * 16 + j], qq = sq[dkp * 16 + j]; c[j] = fa * c[j] + ia * kk * v; n[j] = fa * n[j] + ia * kk; pn += qq * c[j]; pd += qq * n[j]; }
            red[dkp * 32 + dvl] = pn; redn[dkp * 32 + dvl] = pd;
            __syncthreads();
            if (F.tid < 32) { float num = 0.f, den = 0.f;
#pragma unroll
                for (int p = 0; p < 16; ++p) { num += red[p * 32 + F.tid]; den += redn[p * 32 + F.tid]; }
                F.HT[row * 1024 + h * 256 + sl * 32 + F.tid] = num / fmaxf(fabsf(den), __expf(-mn)); }
        }
    }
}
__device__ __forceinline__ void naive_p4(Frame& F) {
    const bf16 *AM = F.AM, *PJ = F.PROJ; const float *WA = F.w_attn_out, *WM = F.w_mlstm_out; bf16* O = F.AM + 1536;
    float* tmp = F.QC;
    naive_gemm<8>(F, T, D, 512, [=](int r, int k) { return bf2f(AM[(size_t)r * AMLD + k]); }, [=](int k, int c) { return bf2f(f2bf(WA[(size_t)k * D + c])); },
        [=](int r, int c, float a) { tmp[(size_t)r * D + c] = a * sigmoidf_(bf2f(PJ[(size_t)r * NP + C_GA + c])); });
    __threadfence();
    naive_gemm<8>(F, T, D, D, [=](int r, int k) { return bf2f(AM[(size_t)r * AMLD + 512 + k]); }, [=](int k, int c) { return bf2f(f2bf(WM[(size_t)k * D + c])); },
        [=](int r, int c, float a) { O[(size_t)r * AMLD + c] = (bf16)f2bf(tmp[(size_t)r * D + c] + a * sigmoidf_(bf2f(PJ[(size_t)r * NP + C_GM + c]))); });
}
__device__ __forceinline__ void naive_p5(Frame& F) {
    const bf16* MG = F.AM + 1536; const float *WO = F.w_mix_out, *X = F.x; float* H = F.H;
    naive_gemm<8>(F, T, D, D, [=](int r, int k) { return bf2f(MG[(size_t)r * AMLD + k]); }, [=](int k, int c) { return bf2f(f2bf(WO[(size_t)k * D + c])); },
        [=](int r, int c, float a) { H[(size_t)r * D + c] = X[(size_t)r * D + c] + a; });
}
__device__ __forceinline__ void naive_p8(Frame& F, int ntiles) {
    const long gthreads = (long)F.G * NTHREADS, gtid = (long)blockIdx.x * NTHREADS + F.tid;
    const unsigned* tile_e = F.ctl + CW_TILEE;
    for (long it = gtid; it < (long)ntiles * 256 * D; it += gthreads) {
        const int j = (int)(it & 1023), row = (int)(it >> 10), e = (int)tile_e[row >> 8];
        if (F.ROW_TOK[row] < 0) { F.ACT[(size_t)row * D + j] = 0; continue; }
        const float* W = F.w_gate_up + (size_t)e * D * 2048; float g = 0.f, u = 0.f;
        for (int k = 0; k < D; ++k) { const float a = bf2f(F.XS[(size_t)row * D + k]); g += a * bf2f(f2bf(W[(size_t)k * 2048 + 2 * j])); u += a * bf2f(f2bf(W[(size_t)k * 2048 + 2 * j + 1])); }
        g += F.b_gate_up[e * 2048 + 2 * j]; u += F.b_gate_up[e * 2048 + 2 * j + 1];
        const float gg = fminf(g, 7.0f), uu = fminf(fmaxf(u, -7.0f), 7.0f);
        F.ACT[(size_t)row * D + j] = (bf16)f2bf((uu + 1.0f) * gg / (1.0f + __expf(-1.702f * gg)));
    }
}
__device__ __forceinline__ void naive_p9(Frame& F, int ntiles) {
    const long gthreads = (long)F.G * NTHREADS, gtid = (long)blockIdx.x * NTHREADS + F.tid;
    const unsigned* tile_e = F.ctl + CW_TILEE;
    for (long it = gtid; it < (long)ntiles * 256 * D; it += gthreads) {
        const int c = (int)(it & 1023), row = (int)(it >> 10), e = (int)tile_e[row >> 8], tk = F.ROW_TOK[row];
        if (tk < 0) continue;
        const float* W = F.w_down + (size_t)e * D * D; float y = 0.f;
        for (int k = 0; k < D; ++k) y += bf2f(F.ACT[(size_t)row * D + k]) * bf2f(f2bf(W[(size_t)k * D + c]));
        F.YBUF[(size_t)tk * D + c] = (bf16)f2bf((y + F.b_down[e * D + c]) * F.ROW_W[row]);
    }
}

__device__ __forceinline__ void p3_post_mixer(Frame& F) {
    for (int row = F.gw; row < T; row += F.NGW) {
        { const int h = F.lane >> 4; float l0 = F.LSE[((size_t)0 * T + row) * 4 + h], l1 = F.LSE[((size_t)1 * T + row) * 4 + h], l2 = F.LSE[((size_t)2 * T + row) * 4 + h];
          const float mx = fmaxf(l0, fmaxf(l1, l2)); float w0 = exp2f(l0 - mx), w1 = exp2f(l1 - mx), w2 = exp2f(l2 - mx); const float inv = 1.0f / (w0 + w1 + w2); w0 *= inv; w1 *= inv; w2 *= inv;
          const u32x4 a = *(const u32x4*)(F.OG + ((size_t)0 * T + row) * 512 + 8 * F.lane), b = *(const u32x4*)(F.OG + ((size_t)1 * T + row) * 512 + 8 * F.lane), c = *(const u32x4*)(F.OG + ((size_t)2 * T + row) * 512 + 8 * F.lane);
          f32x4 a0, a1, b0, b1, c0, c1; pg8::unpack8(a, a0, a1); pg8::unpack8(b, b0, b1); pg8::unpack8(c, c0, c1);
          const f32x4 o0 = a0 * w0 + b0 * w1 + c0 * w2, o1 = a1 * w0 + b1 * w1 + c1 * w2;
          u32x4 w; w.x = pk2(o0[0], o0[1]); w.y = pk2(o0[2], o0[3]); w.z = pk2(o1[0], o1[1]); w.w = pk2(o1[2], o1[3]);
          *(u32x4*)(F.AM + (size_t)row * AMLD + 8 * F.lane) = w; }
        { f32x4 v[4]; float s = 0.f;
#if FAST_MLSTM
          { const bf16* hp = (const bf16*)F.HT + (size_t)row * D + 16 * F.lane; const u32x4 w0 = *(const u32x4*)hp, w1 = *(const u32x4*)(hp + 8); pg8::unpack8(w0, v[0], v[1]); pg8::unpack8(w1, v[2], v[3]); }
#else
          { const float* hp = F.HT + (size_t)row * D + 16 * F.lane;
#pragma unroll
            for (int j = 0; j < 4; ++j) v[j] = *(const f32x4*)(hp + 4 * j); }
#endif
#pragma unroll
          for (int j = 0; j < 4; ++j) s += (v[j].x + v[j].y) + (v[j].z + v[j].w);
          s += __shfl_xor(s, 1); s += __shfl_xor(s, 2); s += __shfl_xor(s, 4); s += __shfl_xor(s, 8);
          const float mu = s * (1.0f / 256.0f); float q = 0.f;
#pragma unroll
          for (int j = 0; j < 4; ++j) { v[j] = v[j] - mu; q += (v[j].x * v[j].x + v[j].y * v[j].y) + (v[j].z * v[j].z + v[j].w * v[j].w); }
          q += __shfl_xor(q, 1); q += __shfl_xor(q, 2); q += __shfl_xor(q, 4); q += __shfl_xor(q, 8);
          const float rstd = 1.0f / sqrtf(q * (1.0f / 256.0f) + LN_EPS);
          const bf16* mo = F.PROJ + (size_t)row * NP + C_MO + 16 * F.lane; bf16* op = F.AM + (size_t)row * AMLD + 512 + 16 * F.lane;
#pragma unroll
          for (int jj = 0; jj < 2; ++jj) { const u32x4 mw = *(const u32x4*)(mo + 8 * jj); f32x4 m0, m1; pg8::unpack8(mw, m0, m1);
              const f32x4 g0 = *(const f32x4*)(F.g_mnorm + 16 * F.lane + 8 * jj), g1 = *(const f32x4*)(F.g_mnorm + 16 * F.lane + 8 * jj + 4);
              const f32x4 o0 = v[2 * jj] * rstd * g0 * pg8::sig4(m0), o1 = v[2 * jj + 1] * rstd * g1 * pg8::sig4(m1);
              u32x4 w; w.x = pk2(o0[0], o0[1]); w.y = pk2(o0[2], o0[3]); w.z = pk2(o1[0], o1[1]); w.w = pk2(o1[2], o1[3]);
              *(u32x4*)(op + 8 * jj) = w; } }
    }
}

constexpr int RT_WS = 1028;
constexpr int RT_TAB = NE * RT_WS * 4, RT_CNT = RT_TAB + 64 * 4 * 12;
static_assert(RT_CNT + 256 <= LDSCTL_OFF, "router LDS map");
__device__ __forceinline__ void p6_router(Frame& F) {
    LAS float* wt = (LAS float*)F.lds;
    LAS int* tab = (LAS int*)(F.lds + RT_TAB); LAS int* cntl = (LAS int*)(F.lds + RT_CNT); LAS int* basel = cntl + 32;
    const int lane = F.lane;
    for (int r0 = 0; r0 < T; r0 += F.NGW * 8) {
        __syncthreads();
        if (r0 == 0) for (int i = F.tid; i < D * NE; i += NTHREADS) wt[(i & 31) * RT_WS + (i >> 5)] = F.w_router[i];
        if (F.tid < 32) cntl[F.tid] = 0;
        __syncthreads();
        f32x4 vn[4];
        { const int row = r0 + F.gw; if (row < T) { const f32x4* hr = (const f32x4*)(F.H + (size_t)row * D) + lane;
#pragma unroll
            for (int j = 0; j < 4; ++j) vn[j] = hr[64 * j]; } }
        for (int ri = 0; ri < 8; ++ri) {
            const int row = r0 + ri * F.NGW + F.gw; if (row >= T) break;
            f32x4 v[4]; float s = 0.f;
#pragma unroll
            for (int j = 0; j < 4; ++j) { v[j] = vn[j]; s += (v[j].x * v[j].x + v[j].y * v[j].y) + (v[j].z * v[j].z + v[j].w * v[j].w); }
            { const int rown = row + F.NGW; if (ri + 1 < 8 && rown < T) { const f32x4* hr = (const f32x4*)(F.H + (size_t)rown * D) + lane;
#pragma unroll
                for (int j = 0; j < 4; ++j) vn[j] = hr[64 * j]; } }
            const float rstd = 1.0f / sqrtf(wave_sum(s) * (1.0f / D) + RMS_EPS);
            unsigned long long* o8 = (unsigned long long*)(F.XN + (size_t)row * D) + lane;
#pragma unroll
            for (int j = 0; j < 4; ++j) { const f32x4 g = *((const f32x4*)F.g_ffn + lane + 64 * j); v[j] = v[j] * rstd * g;
#if MOE_FP8
                ((unsigned*)((unsigned char*)F.XN + (size_t)row * D))[lane + 64 * j] = pk4_fp8(v[j].x, v[j].y, v[j].z, v[j].w); }
#else
                o8[64 * j] = (unsigned long long)pk2(v[j].x, v[j].y) | ((unsigned long long)pk2(v[j].z, v[j].w) << 32); }
#endif
            float lg[32];
#pragma unroll
            for (int e = 0; e < 32; ++e) { float a = 0.f;
#pragma unroll
                for (int j = 0; j < 4; ++j) { const f32x4 w = *((const LAS f32x4*)(wt + e * RT_WS) + lane + 64 * j); a += (v[j].x * w.x + v[j].y * w.y) + (v[j].z * w.z + v[j].w * w.w); }
                lg[e] = a; if ((e & 3) == 3) asm volatile("" ::: "memory"); }
#define RT_BF(N_, O_) do { const bool up = (lane & (O_)) != 0; _Pragma("unroll") for (int i = 0; i < (N_); ++i) { const float send = up ? lg[i] : lg[i + (N_)]; const float keep = up ? lg[i + (N_)] : lg[i]; lg[i] = keep + __shfl_xor(send, (O_)); } } while (0)
            RT_BF(16, 32); RT_BF(8, 16); RT_BF(4, 8); RT_BF(2, 4); RT_BF(1, 2);
#undef RT_BF
            float lgt = lg[0] + __shfl_xor(lg[0], 1);
            const int e = (lane >> 1) & 31;
            lgt += F.b_router[e];
            float tv[4]; int ti[4]; float cur = lgt;
#pragma unroll
            for (int r = 0; r < 4; ++r) { float bv = cur; int bi = e;
#pragma unroll
                for (int o = 2; o < 64; o <<= 1) { const float ov = __shfl_xor(bv, o); const int oi = __shfl_xor(bi, o); if (ov > bv || (ov == bv && oi < bi)) { bv = ov; bi = oi; } }
                tv[r] = bv; ti[r] = bi; if (e == bi) cur = -INFINITY; }
            const float e1 = __expf(tv[1] - tv[0]), e2 = __expf(tv[2] - tv[0]), e3 = __expf(tv[3] - tv[0]), inv = 1.0f / (1.0f + e1 + e2 + e3);
            if (lane < 4) {
                const int ee = (lane == 0) ? ti[0] : (lane == 1) ? ti[1] : (lane == 2) ? ti[2] : ti[3];
                const float ww = ((lane == 0) ? 1.0f : (lane == 1) ? e1 : (lane == 2) ? e2 : e3) * inv;
                const int loc = __hip_atomic_fetch_add(cntl + ee, 1, __ATOMIC_RELAXED, __HIP_MEMORY_SCOPE_WORKGROUP);
                LAS int* tp = tab + ((ri * 8 + F.wave) * 4 + lane) * 3; tp[0] = ee; tp[1] = loc; tp[2] = __float_as_int(ww);
            }
        }
        __syncthreads();
        if (F.tid < 32) basel[F.tid] = (int)atomicAdd(F.ctl + CW_CNT + 64 * F.tid, (unsigned)cntl[F.tid]);
        __syncthreads();
        if (lane < 4) for (int ri = 0; ri < 8; ++ri) {
            const int row = r0 + ri * F.NGW + F.gw; if (row >= T) break;
            const LAS int* tp = tab + ((ri * 8 + F.wave) * 4 + lane) * 3; const int ee = tp[0];
            F.TOK_E[row * 4 + lane] = ee; F.TOK_SLOT[row * 4 + lane] = basel[ee] + tp[1]; F.TOK_W[row * 4 + lane] = __int_as_float(tp[2]);
        }
    }
}

constexpr int RM_WS = 2064;
constexpr int RM_HI = 0, RM_LO = NE * RM_WS, RM_RSTD = 2 * NE * RM_WS, RM_TAB = RM_RSTD + 256, RM_CNT = RM_TAB + 64 * 4 * 12;
static_assert(RM_CNT + 256 <= LDSCTL_OFF, "router LDS map");
__device__ __forceinline__ void p6_router_mfma(Frame& F) {
    LAS unsigned char* L = F.lds;
    LAS float* rstdl = (LAS float*)(L + RM_RSTD); LAS int* tab = (LAS int*)(L + RM_TAB); LAS int* cntl = (LAS int*)(L + RM_CNT); LAS int* basel = cntl + 32;
    const int lane = F.lane, fr = lane & 15, fq = lane >> 4, w = F.wave;
    __syncthreads();
    for (int i0 = F.tid; i0 < D * NE; i0 += 16 * NTHREADS) {
        float wv[16], gv[16];
#pragma unroll
        for (int j = 0; j < 16; ++j) { const int i = i0 + j * NTHREADS; wv[j] = F.w_router[i]; gv[j] = F.g_ffn[i >> 5]; }
#pragma unroll
        for (int j = 0; j < 16; ++j) { const int i = i0 + j * NTHREADS, k = i >> 5, e = i & 31; const float w = wv[j] * gv[j];
            const unsigned hi = f2bf(w), lo = f2bf(w - bf2f(hi));
            *(LAS bf16*)(L + RM_HI + e * RM_WS + 2 * k) = (bf16)hi; *(LAS bf16*)(L + RM_LO + e * RM_WS + 2 * k) = (bf16)lo; } }
    const float br0 = F.b_router[fr], br1 = F.b_router[16 + fr];
    for (int rg = F.vcu; rg < T / 64; rg += F.G) {
        __syncthreads();
        if (F.tid < 32) cntl[F.tid] = 0;
        __syncthreads();
        if (w < 4) {
            const int row0 = rg * 64 + 16 * w;
            const float* hp = F.H + (size_t)(row0 + fr) * D + 8 * fq;
            const LAS unsigned char* bh = L + RM_HI + fr * RM_WS + 16 * fq; const LAS unsigned char* bl = L + RM_LO + fr * RM_WS + 16 * fq;
            f32x4 acc[2] = {(f32x4){0.f, 0.f, 0.f, 0.f}, (f32x4){0.f, 0.f, 0.f, 0.f}}; float ss = 0.f;
#pragma unroll 4
            for (int ks = 0; ks < 32; ++ks) {
                const f32x4 a0 = *(const f32x4*)(hp + 32 * ks), a1 = *(const f32x4*)(hp + 32 * ks + 4);
                ss += (a0.x * a0.x + a0.y * a0.y) + (a0.z * a0.z + a0.w * a0.w) + (a1.x * a1.x + a1.y * a1.y) + (a1.z * a1.z + a1.w * a1.w);
                u32x4 hw; hw.x = pk2(a0.x, a0.y); hw.y = pk2(a0.z, a0.w); hw.z = pk2(a1.x, a1.y); hw.w = pk2(a1.z, a1.w);
                u32x4 lw; lw.x = pk2(a0.x - bflo(hw.x), a0.y - bfhi(hw.x)); lw.y = pk2(a0.z - bflo(hw.y), a0.w - bfhi(hw.y));
                lw.z = pk2(a1.x - bflo(hw.z), a1.y - bfhi(hw.z)); lw.w = pk2(a1.z - bflo(hw.w), a1.w - bfhi(hw.w));
                const bf16x8 ahi = __builtin_bit_cast(bf16x8, hw), alo = __builtin_bit_cast(bf16x8, lw);
#pragma unroll
                for (int nt = 0; nt < 2; ++nt) { const bf16x8 bhi = *(const LAS bf16x8*)(bh + 16 * nt * RM_WS + 64 * ks), blo = *(const LAS bf16x8*)(bl + 16 * nt * RM_WS + 64 * ks);
                    acc[nt] = __builtin_amdgcn_mfma_f32_16x16x32_bf16(ahi, bhi, acc[nt], 0, 0, 0);
                    acc[nt] = __builtin_amdgcn_mfma_f32_16x16x32_bf16(ahi, blo, acc[nt], 0, 0, 0);
                    acc[nt] = __builtin_amdgcn_mfma_f32_16x16x32_bf16(alo, bhi, acc[nt], 0, 0, 0); }
            }
            ss += __shfl_xor(ss, 16); ss += __shfl_xor(ss, 32);
            const float rstd = 1.0f / sqrtf(ss * (1.0f / D) + RMS_EPS);
            if (fq == 0) rstdl[16 * w + fr] = rstd;
#pragma unroll
            for (int reg = 0; reg < 4; ++reg) {
                const float rs = __shfl(rstd, 4 * fq + reg);
                float c0 = acc[0][reg] * rs + br0, c1 = acc[1][reg] * rs + br1;
                float tv[4]; int ti[4];
#pragma unroll
                for (int r = 0; r < 4; ++r) { float bv = (c0 >= c1) ? c0 : c1; int bi = (c0 >= c1) ? fr : 16 + fr;
#pragma unroll
                    for (int o = 1; o < 16; o <<= 1) { const float ov = __shfl_xor(bv, o); const int oi = __shfl_xor(bi, o); if (ov > bv || (ov == bv && oi < bi)) { bv = ov; bi = oi; } }
                    tv[r] = bv; ti[r] = bi; if (bi == fr) c0 = -INFINITY; if (bi == 16 + fr) c1 = -INFINITY; }
                const float e1 = __expf(tv[1] - tv[0]), e2 = __expf(tv[2] - tv[0]), e3 = __expf(tv[3] - tv[0]), inv = 1.0f / (1.0f + e1 + e2 + e3);
                if (fr < 4) {
                    const int ee = (fr == 0) ? ti[0] : (fr == 1) ? ti[1] : (fr == 2) ? ti[2] : ti[3];
                    const float ww = ((fr == 0) ? 1.0f : (fr == 1) ? e1 : (fr == 2) ? e2 : e3) * inv;
                    const int loc = __hip_atomic_fetch_add(cntl + ee, 1, __ATOMIC_RELAXED, __HIP_MEMORY_SCOPE_WORKGROUP);
                    LAS int* tp = tab + ((16 * w + 4 * fq + reg) * 4 + fr) * 3; tp[0] = ee; tp[1] = loc; tp[2] = __float_as_int(ww);
                }
            }
        }
        __syncthreads();
        if (F.tid < 32) basel[F.tid] = (int)atomicAdd(F.ctl + CW_CNT + 64 * F.tid, (unsigned)cntl[F.tid]);
#pragma unroll 2
        for (int i = 0; i < 8; ++i) { const int rl = 8 * w + i, row = rg * 64 + rl; const float rs = rstdl[rl];
            const f32x4* hr = (const f32x4*)(F.H + (size_t)row * D) + lane;
#pragma unroll
            for (int j = 0; j < 4; ++j) { const f32x4 g = *((const f32x4*)F.g_ffn + lane + 64 * j); const f32x4 v = hr[64 * j] * rs * g;
                ((unsigned*)((unsigned char*)F.XN + (size_t)row * D))[lane + 64 * j] = pk4_fp8(v.x, v.y, v.z, v.w); } }
        __syncthreads();
        if (F.tid < 256) { const int rl = F.tid >> 2, k = F.tid & 3, row = rg * 64 + rl; const LAS int* tp = tab + (rl * 4 + k) * 3; const int ee = tp[0];
#if RM_FUSED
            const int dst = ee * ECAP + basel[ee] + tp[1]; F.ROW_TOK[dst] = row * 4 + k; F.ROW_W[dst] = __int_as_float(tp[2]); }
#else
            F.TOK_E[row * 4 + k] = ee; F.TOK_SLOT[row * 4 + k] = basel[ee] + tp[1]; F.TOK_W[row * 4 + k] = __int_as_float(tp[2]); }
#endif
    }
}

__device__ __forceinline__ void p7_gather(Frame& F) {
    LAS int* pst = (LAS int*)F.lds;
    LAS int* cntl = pst + 64;
    int tid = (int)threadIdx.x; asm volatile("" : "+v"(tid));
    __syncthreads();
    if (tid < NE) cntl[tid] = (int)F.ctl[CW_CNT + 64 * tid];
    __syncthreads();
    if (tid == 0) { int acc = 0; for (int e = 0; e < NE; ++e) { pst[e] = acc; acc += (cntl[e] + 255) & ~255; } pst[NE] = acc; }
    __syncthreads();
    if (blockIdx.x == 0) {
        if (tid == 0) F.ctl[CW_NTILES] = (unsigned)(pst[NE] >> 8);
        if (tid < NE) { const int t0 = pst[tid] >> 8, t1 = pst[tid + 1] >> 8; for (int k = t0; k < t1; ++k) F.ctl[CW_TILEE + k] = (unsigned)tid; }
    }
#if MOE_FP8
    { const int gthreads = F.G * NTHREADS, gtid = F.vcu * NTHREADS + F.tid;
      for (int a = gtid; a < NA; a += gthreads) { const int e = F.TOK_E[a], dest = pst[e] + F.TOK_SLOT[a]; F.ROW_TOK[dest] = a; F.ROW_W[dest] = F.TOK_W[a]; }
      for (int e = 0; e < NE; ++e) { const int c = cntl[e], pe = (c + 255) & ~255;
          for (int r = c + gtid; r < pe; r += gthreads) { F.ROW_TOK[pst[e] + r] = -1; F.ROW_W[pst[e] + r] = 0.f; } } }
#else
    for (int a = F.gw; a < NA; a += F.NGW) {
        const int e = F.TOK_E[a], dest = pst[e] + F.TOK_SLOT[a];
        { const u32x4* src = (const u32x4*)(F.XN + (size_t)(a >> 2) * D) + F.lane; u32x4* dst = (u32x4*)(F.XS + (size_t)dest * D) + F.lane;
        const u32x4 v0 = src[0], v1 = src[64]; dst[0] = v0; dst[64] = v1; }
        if (F.lane == 0) { F.ROW_TOK[dest] = a; F.ROW_W[dest] = F.TOK_W[a]; }
    }
    for (int e = 0; e < NE; ++e) { const int c = cntl[e], pe = (c + 255) & ~255;
        for (int r = c + F.gw; r < pe; r += F.NGW) { const int dest = pst[e] + r; const u32x4 z = (u32x4){0u, 0u, 0u, 0u};
            { u32x4* dst = (u32x4*)(F.XS + (size_t)dest * D) + F.lane; dst[0] = z; dst[64] = z; }
            if (F.lane == 0) { F.ROW_TOK[dest] = -1; F.ROW_W[dest] = 0.f; } } }
#endif
}

__device__ __forceinline__ void p10_final(Frame& F) {
    f32x4 hn[4]; u32x2 yn[4][4];
#define P10_LOAD(r_) do { const f32x4* hr_ = (const f32x4*)(F.H + (size_t)(r_) * D) + F.lane; \
        _Pragma("unroll") for (int j = 0; j < 4; ++j) { hn[j] = hr_[64 * j]; _Pragma("unroll") for (int k = 0; k < 4; ++k) yn[j][k] = *((const u32x2*)(F.YBUF + ((size_t)(r_) * 4 + k) * D) + F.lane + 64 * j); } } while (0)
    if (F.gw < T) P10_LOAD(F.gw);
    for (int row = F.gw; row < T; row += F.NGW) {
        f32x4 v[4]; float s = 0.f;
#pragma unroll
        for (int j = 0; j < 4; ++j) { v[j] = hn[j];
#pragma unroll
            for (int k = 0; k < 4; ++k) { const u32x2 w = yn[j][k]; v[j].x += bflo(w.x); v[j].y += bfhi(w.x); v[j].z += bflo(w.y); v[j].w += bfhi(w.y); }
            s += (v[j].x * v[j].x + v[j].y * v[j].y) + (v[j].z * v[j].z + v[j].w * v[j].w); }
        if (row + F.NGW < T) P10_LOAD(row + F.NGW);
        const float rstd = 1.0f / sqrtf(wave_sum(s) * (1.0f / D) + RMS_EPS);
        f32x4* orow = (f32x4*)(F.out + (size_t)row * D) + F.lane;
#pragma unroll
        for (int j = 0; j < 4; ++j) { const f32x4 g = *((const f32x4*)F.g_final + F.lane + 64 * j); orow[64 * j] = v[j] * rstd * g; }
    }
#undef P10_LOAD
}

typedef float f32x16 __attribute__((ext_vector_type(16)));
typedef short s16x4 __attribute__((ext_vector_type(4)));
constexpr int ATT_SCR_OFF = RING_BYTES;
__device__ __forceinline__ int crow16(int r, int hi) { return (r & 3) + 8 * (r >> 2) + 4 * hi; }
__device__ __forceinline__ s16x4 lds_tr16(const LAS unsigned char* p) { return __builtin_bit_cast(s16x4, __builtin_amdgcn_ds_read_tr16_b64_v4i16((LAS s16x4*)p)); }

struct AttItem { int b, g, hd, r, n, d; };
__device__ __forceinline__ AttItem att_decode(int it) {
    AttItem a; const int i = it >> 8, c = it & 255; a.g = i % 3; const int idx = (i / 3) * 256 + c, rn = idx & 15; a.b = idx >> 6; a.hd = (idx >> 4) & 3;
    a.r = (a.g == 0) ? 0 : (a.g == 1) ? (rn >> 2) : rn; a.n = (a.g == 0) ? rn : (a.g == 1) ? (rn & 3) : 0; a.d = (a.g == 0) ? 1 : (a.g == 1) ? 4 : 16; return a;
}
__device__ __forceinline__ const bf16* att_base(Frame& F, const AttItem& a) { return F.PROJ + (size_t)(a.b * SEQ + a.r) * NP + a.g * 512 + a.hd * 128; }
#define ATT_LOADKV(dst, a_, coff_) do { const bf16* base_ = att_base(F, a_) + (coff_) + 8 * (F.tid & 15); const size_t rs_ = (size_t)(a_).d * NP; const int i0_ = 128 * ((a_).n - 1) + (F.tid >> 4); \
        _Pragma("unroll") for (int p_ = 0; p_ < 8; ++p_) { if ((a_).n == 0 && p_ < 4) continue; dst[p_] = *(const u32x4*)(base_ + (size_t)(i0_ + 32 * p_) * rs_); } } while (0)

__device__ __forceinline__ void attn_phase(Frame& F) {
    const int lane = F.lane, w = F.wave, fr = lane & 15, fq = lane >> 4;
    LAS unsigned char* Ks = F.lds; LAS unsigned char* Vs = F.lds + 65536;
    const int kc = F.tid & 15, kk0 = F.tid >> 4;
    u32x4 kreg[8], vreg[8]; bf16x8 qn[4];
#define ATT_LOADQ(dst, a_) do { const bf16* qrow_ = att_base(F, a_) + (size_t)(128 * (a_).n + 16 * w + fr) * ((size_t)(a_).d * NP) + C_AQ + 8 * fq; \
        _Pragma("unroll") for (int s_ = 0; s_ < 4; ++s_) dst[s_] = *(const bf16x8*)(qrow_ + 32 * s_); } while (0)
#if ATT_QUEUE
    LAS int* slot = (LAS int*)(F.lds + RING_BYTES);
    int pend = 0;
    __syncthreads();
    if (F.tid == 0) { const int g0 = (int)atomicAdd(F.ctl + CW_ACTR, 2u); slot[0] = g0; pend = g0 + 1; }
    __syncthreads();
    int it = __builtin_amdgcn_readfirstlane(slot[0]);
#else
    int it = F.vcu;
#endif
    if (it < 1536) { const AttItem a0 = att_decode(it); ATT_LOADKV(kreg, a0, C_AK); ATT_LOADKV(vreg, a0, C_AV); ATT_LOADQ(qn, a0); }
    while (it < 1536) {
        const AttItem a = att_decode(it); const int n = a.n, d = a.d;
        __syncthreads();
#if ATT_QUEUE
        if (F.tid == 0) { slot[0] = pend; pend = (int)atomicAdd(F.ctl + CW_ACTR, 1u); }
#endif
#pragma unroll
        for (int pass = 0; pass < 8; ++pass) { if (n == 0 && pass < 4) continue; const int key = pass * 32 + kk0;
            *(LAS u32x4*)(Ks + key * 256 + ((kc ^ (key & 15)) << 4)) = kreg[pass];
            *(LAS u32x4*)(Vs + key * 256 + ((((kc >> 2) ^ (key & 3)) << 6) | ((kc & 3) << 4))) = vreg[pass]; }
        bf16x8 qf[4];
#pragma unroll
        for (int s = 0; s < 4; ++s) qf[s] = qn[s];
        __syncthreads();
#if ATT_QUEUE
        const int itn = __builtin_amdgcn_readfirstlane(slot[0]);
#else
        const int itn = it + F.G;
#endif
        if (itn < 1536) { const AttItem an = att_decode(itn); ATT_LOADKV(kreg, an, C_AK); ATT_LOADKV(vreg, an, C_AV); ATT_LOADQ(qn, an); }
        f32x4 S[10];
#pragma unroll
        for (int i = 0; i < 9; ++i) {
            const int kt = w + i; const bool act = !(n == 0 && kt < 8);
            f32x4 acc = (f32x4){0.f, 0.f, 0.f, 0.f};
            if (act) {
                const LAS unsigned char* kp = Ks + (kt * 16 + fr) * 256;
#pragma unroll
                for (int s = 0; s < 4; ++s) { const bf16x8 kf = *(const LAS bf16x8*)(kp + (((4 * s + fq) ^ fr) << 4)); acc = __builtin_amdgcn_mfma_f32_16x16x32_bf16(kf, qf[s], acc, 0, 0, 0); }
                if (i == 0) {
#pragma unroll
                    for (int r = 0; r < 4; ++r) if (4 * fq + r < fr) acc[r] = -INFINITY; }
                if (i == 8) {
#pragma unroll
                    for (int r = 0; r < 4; ++r) if (4 * fq + r > fr) acc[r] = -INFINITY; }
            } else acc = (f32x4){-INFINITY, -INFINITY, -INFINITY, -INFINITY};
            S[i] = acc;
        }
        float m = -INFINITY;
#pragma unroll
        for (int i = 0; i < 9; ++i)
#pragma unroll
            for (int r = 0; r < 4; ++r) m = fmaxf(m, S[i][r]);
        m = fmaxf(m, __shfl_xor(m, 16)); m = fmaxf(m, __shfl_xor(m, 32));
        float l = 0.f;
#pragma unroll
        for (int i = 0; i < 9; ++i)
#pragma unroll
            for (int r = 0; r < 4; ++r) { const float p = __builtin_amdgcn_exp2f(S[i][r] - m); S[i][r] = p; l += p; }
        l += __shfl_xor(l, 16); l += __shfl_xor(l, 32);
        S[9] = (f32x4){0.f, 0.f, 0.f, 0.f};
        f32x4 O[8];
#pragma unroll
        for (int t = 0; t < 8; ++t) O[t] = (f32x4){0.f, 0.f, 0.f, 0.f};
        const int q4 = fr >> 2, p4 = lane & 3;
#pragma unroll
        for (int p = 0; p < 5; ++p) {
            const int kt0 = w + 2 * p, kt1 = kt0 + 1;
            const bool act0 = !(n == 0 && kt0 < 8), act1 = (2 * p + 1 < 9) && !(n == 0 && kt1 < 8);
            if (act0 || act1) {
                u32x4 pw; pw.x = pg8::cvt_pk_bf16(S[2 * p][0], S[2 * p][1]); pw.y = pg8::cvt_pk_bf16(S[2 * p][2], S[2 * p][3]);
                pw.z = pg8::cvt_pk_bf16(S[2 * p + 1][0], S[2 * p + 1][1]); pw.w = pg8::cvt_pk_bf16(S[2 * p + 1][2], S[2 * p + 1][3]);
                const bf16x8 pa = __builtin_bit_cast(bf16x8, pw);
                const int key0 = kt0 * 16 + 4 * fq + q4, key1 = kt1 * 16 + 4 * fq + q4;
#pragma unroll
                for (int t = 0; t < 8; ++t) {
                    const int col = 16 * t + 4 * p4;
                    const int coff = ((((col >> 5) ^ q4) << 6) | ((col & 31) << 1));
                    s16x4 lo = (s16x4){0, 0, 0, 0}, hi = (s16x4){0, 0, 0, 0};
                    if (act0) lo = lds_tr16(Vs + key0 * 256 + coff);
                    if (act1) hi = lds_tr16(Vs + key1 * 256 + coff);
                    const bf16x8 vb = (bf16x8){lo[0], lo[1], lo[2], lo[3], hi[0], hi[1], hi[2], hi[3]};
                    O[t] = __builtin_amdgcn_mfma_f32_16x16x32_bf16(pa, vb, O[t], 0, 0, 0);
                }
            }
        }
        const float linv = frcp(l);
        const size_t tok0 = (size_t)a.b * SEQ + a.r + (size_t)d * (128 * n + 16 * w);
        if (fq == 0) F.LSE[((size_t)a.g * T + tok0 + (size_t)d * fr) * 4 + a.hd] = m + __log2f(l);
#pragma unroll
        for (int r = 0; r < 4; ++r) {
            const int q = 4 * fq + r; const float rl = __shfl(linv, q);
            bf16* op = F.OG + ((size_t)a.g * T + tok0 + (size_t)d * q) * 512 + a.hd * 128 + fr;
#pragma unroll
            for (int t = 0; t < 8; ++t) op[16 * t] = (bf16)f2bf(O[t][r] * rl);
        }
        it = itn;
    }
    __syncthreads();
}
#undef ATT_LOADKV
#undef ATT_LOADQ

constexpr int ML_QS = 528, ML_AS = 144;
constexpr int ML_Q = 0, ML_K = 33792;
constexpr int SC_U = 0, SC_MX = 64, SC_EBD = 128, SC_WI = 192, SC_WK = 256, SC_DEC = 320;
__device__ __forceinline__ f32x4 mfma16(bf16x8 a, bf16x8 b, f32x4 c) { return __builtin_amdgcn_mfma_f32_16x16x32_bf16(a, b, c, 0, 0, 0); }


constexpr size_t WS_QK = WS_QC, WS_SCAL = WS_KC;
__device__ __forceinline__ void mlstm_prepass(Frame& F) {
    const int tid = F.tid, lane = F.lane;
    float* SCAL = (float*)((unsigned char*)F.ctl + WS_SCAL);
    bf16* QK = (bf16*)((unsigned char*)F.ctl + WS_QK);
    if (F.vcu < 32) {
        const int b = F.vcu >> 2, h = F.vcu & 3; const float* gbase = F.GATES + (size_t)(b * SEQ) * 8;
        LAS float* lu = (LAS float*)F.lds; LAS float* lpm = lu + 2048; LAS float* lbc = lpm + 2048; LAS float* lm = lbc + 2048;
        __syncthreads();
#pragma unroll
        for (int i = 0; i < 4; ++i) { const int c = 4 * F.wave + i;
            const float gi = gbase[(size_t)(64 * c + lane) * 8 + h], gf = gbase[(size_t)(64 * c + lane) * 8 + 4 + h];
            const float logf = fminf(gf, 0.f) - __logf(1.0f + __expf(-fabsf(gf)));
            float bc = logf;
#pragma unroll
            for (int o = 1; o < 64; o <<= 1) { const float v = __shfl_up(bc, o); if (lane >= o) bc += v; }
            const float u = gi - bc; float pm = u;
#pragma unroll
            for (int o = 1; o < 64; o <<= 1) { const float v = __shfl_up(pm, o); if (lane >= o) pm = fmaxf(pm, v); }
            lu[64 * c + lane] = u; lpm[64 * c + lane] = pm; lbc[64 * c + lane] = bc; }
        __syncthreads();
        if (tid == 0) { float m = 0.f; for (int c = 0; c < 32; ++c) { const float M63 = fmaxf(m, lpm[64 * c + 63]); lm[c] = m; lm[32 + c] = M63; m = lbc[64 * c + 63] + M63; } }
        __syncthreads();
#pragma unroll
        for (int i = 0; i < 4; ++i) { const int c = 4 * F.wave + i; const float m_carry = lm[c], M63 = lm[32 + c];
            const float u = lu[64 * c + lane], bc = lbc[64 * c + lane], Mx = fmaxf(m_carry, lpm[64 * c + lane]);
            float* sp = SCAL + ((size_t)F.vcu * 32 + c) * 384;
            sp[SC_U + lane] = u; sp[SC_MX + lane] = Mx; sp[SC_EBD + lane] = __expf(-(bc + Mx)); sp[SC_WI + lane] = __expf(m_carry - Mx); sp[SC_WK + lane] = __expf(u - M63);
            sp[SC_DEC + lane] = __expf(m_carry - M63); }
        __syncthreads();
    }
    const int rb = tid >> 8, half = (tid >> 7) & 1, cg = tid & 127;
    float cw[4][8];
#pragma unroll
    for (int j = 0; j < 4; ++j) { const float* p = F.conv_qk + j * 2048 + half * 1024 + 8 * cg; const f32x4 a = *(const f32x4*)p, c = *(const f32x4*)(p + 4);
        cw[j][0] = a[0]; cw[j][1] = a[1]; cw[j][2] = a[2]; cw[j][3] = a[3]; cw[j][4] = c[0]; cw[j][5] = c[1]; cw[j][6] = c[2]; cw[j][7] = c[3]; }
    const float oscale = half ? 0.0625f : 1.0f;
    for (int step = F.vcu; step < T / 16; step += F.G) {
        const int row0 = step * 16 + rb * 8, ts0 = row0 & (SEQ - 1);
        const bf16* src = F.PROJ + (size_t)row0 * NP + (half ? C_MK : C_MQ) + 8 * cg;
        u32x4 raw[11];
#pragma unroll
        for (int r = 0; r < 11; ++r) raw[r] = (ts0 - 3 + r >= 0) ? *(const u32x4*)(src + (ptrdiff_t)(r - 3) * NP) : (u32x4){0u, 0u, 0u, 0u};
        bf16* dst = QK + (size_t)row0 * 2048 + half * 1024 + 8 * cg;
        float xf[11][8];
#pragma unroll
        for (int r = 0; r < 11; ++r) { const u32x4 rw = raw[r]; xf[r][0] = bflo(rw.x); xf[r][1] = bfhi(rw.x); xf[r][2] = bflo(rw.y); xf[r][3] = bfhi(rw.y); xf[r][4] = bflo(rw.z); xf[r][5] = bfhi(rw.z); xf[r][6] = bflo(rw.w); xf[r][7] = bfhi(rw.w); }
#pragma unroll
        for (int o = 0; o < 8; ++o) {
            float y[8];
#pragma unroll
            for (int i = 0; i < 8; ++i) y[i] = (cw[0][i] * xf[o][i] + cw[1][i] * xf[o + 1][i]) + (cw[2][i] * xf[o + 2][i] + cw[3][i] * xf[o + 3][i]);
#pragma unroll
            for (int i = 0; i < 8; ++i) y[i] = y[i] * oscale * frcp(1.0f + __expf(-y[i]));
            u32x4 pw; pw.x = pk2(y[0], y[1]); pw.y = pk2(y[2], y[3]); pw.z = pk2(y[4], y[5]); pw.w = pk2(y[6], y[7]);
            *(u32x4*)(dst + (size_t)o * 2048) = pw; }
    }
}

template <int NDT> struct MLMap {
    static constexpr int VROWS = 16 * (NDT + 1), CT = ML_K + 64 * ML_QS, A = CT + VROWS * ML_QS, VT = A + 64 * ML_AS, VWT = VT + VROWS * ML_AS, SC = VWT + VROWS * ML_AS, END = SC + 4 * 384;
    static_assert(END <= LDSCTL_OFF, "mLSTM LDS map");
};
template <int NDT>
__device__ __forceinline__ void mlstm_item(Frame& F, int b, int h, int sl) {
    typedef MLMap<NDT> MP; constexpr int VROWS = MP::VROWS, PARTS = 2 * NDT, NT2 = NDT / 2, NB5 = NDT + 1;
    const int tid = F.tid, lane = F.lane, w = F.wave, fr = lane & 15, fq = lane >> 4;
    LAS unsigned char* L = F.lds; LAS float* SC = (LAS float*)(L + MP::SC);
    const bf16* qkbase = (const bf16*)((const unsigned char*)F.ctl + WS_QK) + (size_t)(b * SEQ) * 2048 + h * 256 + 8 * (tid & 31);
#ifndef VMAP
#define VMAP 1
#endif
    const bool vact = tid < 64 * PARTS; const int vs = VMAP ? (tid & 63) : (tid / PARTS), vpart = VMAP ? (tid >> 6) : (tid % PARTS);
    const bf16* vbase = F.PROJ + (size_t)(b * SEQ) * NP + C_MV + h * 256 + sl * (16 * NDT) + 8 * vpart;
    const float* scbase = (const float*)((const unsigned char*)F.ctl + WS_SCAL) + (size_t)((b * 4 + h) * 32) * 384 + (tid < 384 ? tid : 0);
    const float* wkbase = (const float*)((const unsigned char*)F.ctl + WS_SCAL) + (size_t)((b * 4 + h) * 32) * 384 + SC_WK + vs;
    __syncthreads();
    for (int i = tid; i < (MP::A - MP::CT) / 4; i += NTHREADS) ((LAS unsigned*)(L + MP::CT))[i] = 0u;
    for (int i = tid; i < (MP::SC - MP::VT) / 4; i += NTHREADS) ((LAS unsigned*)(L + MP::VT))[i] = 0u;
    __syncthreads();
    if (tid < 32) ((LAS unsigned*)(L + MP::VT + (16 * NDT) * ML_AS))[tid] = 0x3F803F80u;
    f32x4 C[2][NB5];
#pragma unroll
    for (int a = 0; a < 2; ++a)
#pragma unroll
        for (int bb = 0; bb < NB5; ++bb) C[a][bb] = (f32x4){0.f, 0.f, 0.f, 0.f};
    u32x4 qk[8]; u32x4 vraw = (u32x4){0u, 0u, 0u, 0u}; float scv = 0.f, wkv = 0.f;
    unsigned hpk[NT2][2];
#define ML_ISSUE(c_) do { const int t0_ = 64 * (c_); \
        _Pragma("unroll") for (int i_ = 0; i_ < 4; ++i_) { const bf16* p_ = qkbase + (size_t)(t0_ + (tid >> 5) + 16 * i_) * 2048; qk[i_] = *(const u32x4*)p_; qk[4 + i_] = *(const u32x4*)(p_ + 1024); } \
        if (vact) { vraw = *(const u32x4*)(vbase + (size_t)(t0_ + vs) * NP); wkv = wkbase[(size_t)(c_) * 384]; } \
        if (tid < 384) scv = scbase[(size_t)(c_) * 384]; } while (0)
    ML_ISSUE(0);
    for (int c = 0; c < 32; ++c) {
        { LAS unsigned char* dq = L + ML_Q + (tid >> 5) * ML_QS + 16 * (tid & 31);
#pragma unroll
          for (int i = 0; i < 4; ++i) { *(LAS u32x4*)(dq + 16 * i * ML_QS) = qk[i]; *(LAS u32x4*)(dq + (ML_K - ML_Q) + 16 * i * ML_QS) = qk[4 + i]; } }
        if (vact) { LAS bf16* vt = (LAS bf16*)(L + MP::VT) + vs; LAS bf16* vw = (LAS bf16*)(L + MP::VWT) + vs;
            const float vf[8] = {bflo(vraw.x), bfhi(vraw.x), bflo(vraw.y), bfhi(vraw.y), bflo(vraw.z), bfhi(vraw.z), bflo(vraw.w), bfhi(vraw.w)};
            const unsigned vr[4] = {vraw.x, vraw.y, vraw.z, vraw.w};
#pragma unroll
            for (int i = 0; i < 4; ++i) { const unsigned pw = pk2(vf[2 * i] * wkv, vf[2 * i + 1] * wkv);
                vt[(8 * vpart + 2 * i) * (ML_AS / 2)] = (bf16)(vr[i] & 0xffffu); vt[(8 * vpart + 2 * i + 1) * (ML_AS / 2)] = (bf16)(vr[i] >> 16);
                vw[(8 * vpart + 2 * i) * (ML_AS / 2)] = (bf16)(pw & 0xffffu); vw[(8 * vpart + 2 * i + 1) * (ML_AS / 2)] = (bf16)(pw >> 16); } }
        if (tid >= 256 && tid < 320) ((LAS bf16*)(L + MP::VWT))[(16 * NDT) * (ML_AS / 2) + tid - 256] = (bf16)f2bf(scv);
        if (tid < 384) SC[tid] = scv;
        __syncthreads();
        if (c > 0) { bf16* hpp = (bf16*)F.HT + (size_t)(b * SEQ + 64 * (c - 1) + 16 * (w & 3) + 4 * fq) * D + h * 256 + sl * (16 * NDT) + 16 * ((w >> 2) * NT2) + fr;
#pragma unroll
            for (int j = 0; j < NT2; ++j) { hpp[16 * j] = (bf16)(hpk[j][0] & 0xffffu); hpp[(size_t)D + 16 * j] = (bf16)(hpk[j][0] >> 16); hpp[(size_t)2 * D + 16 * j] = (bf16)(hpk[j][1] & 0xffffu); hpp[(size_t)3 * D + 16 * j] = (bf16)(hpk[j][1] >> 16); } }
        if (c + 1 < 32) ML_ISSUE(c + 1);
        const int ti = w & 3;
#ifndef DUP_B
#define DUP_B 1
#endif
        for (int dupb = 0; dupb < DUP_B; ++dupb)
        { const int si0 = (w >> 2) * 2;
          const LAS unsigned char* qp = L + ML_Q + (16 * ti + fr) * ML_QS + 16 * fq;
          const LAS unsigned char* kp = L + ML_K + (16 * si0 + fr) * ML_QS + 16 * fq;
          f32x4 sacc[2] = {(f32x4){0.f, 0.f, 0.f, 0.f}, (f32x4){0.f, 0.f, 0.f, 0.f}};
#pragma unroll
          for (int hb = 0; hb < 2; ++hb) {
              bf16x8 qa[4], k0[4], k1[4];
#pragma unroll
              for (int kk = 0; kk < 4; ++kk) { qa[kk] = *(const LAS bf16x8*)(qp + 64 * (4 * hb + kk)); k0[kk] = *(const LAS bf16x8*)(kp + 64 * (4 * hb + kk)); k1[kk] = *(const LAS bf16x8*)(kp + 16 * ML_QS + 64 * (4 * hb + kk)); }
              __builtin_amdgcn_sched_barrier(0);
#pragma unroll
              for (int kk = 0; kk < 4; ++kk) { sacc[0] = mfma16(k0[kk], qa[kk], sacc[0]); sacc[1] = mfma16(k1[kk], qa[kk], sacc[1]); }
          }
          { const int t = 16 * ti + fr; const float mxt = SC[SC_MX + t];
#pragma unroll
            for (int si = 0; si < 2; ++si) { const int s0 = 16 * (si0 + si) + 4 * fq; const f32x4 us = *(const LAS f32x4*)(SC + SC_U + s0); float val[4];
#pragma unroll
                for (int r = 0; r < 4; ++r) val[r] = (s0 + r <= t) ? sacc[si][r] * __expf(us[r] - mxt) : 0.f;
                u32x2 pw; pw.x = pk2(val[0], val[1]); pw.y = pk2(val[2], val[3]);
                *(LAS u32x2*)(L + MP::A + t * ML_AS + 2 * s0) = pw; } } }
        __syncthreads();
        { const int dj0 = (w >> 2) * NT2;
          const LAS unsigned char* ap = L + MP::A + (16 * ti + fr) * ML_AS + 16 * fq;
          const LAS unsigned char* vp = L + MP::VT + (16 * dj0 + fr) * ML_AS + 16 * fq; const LAS unsigned char* ep = L + MP::VT + (16 * NDT + fr) * ML_AS + 16 * fq;
          const LAS unsigned char* cp = L + MP::CT + (16 * dj0 + fr) * ML_QS + 16 * fq; const LAS unsigned char* cep = L + MP::CT + (16 * NDT + fr) * ML_QS + 16 * fq;
          bf16x8 aa[2], vv[NT2][2], ee[2], afr[2][2], bw[2][NB5];
#pragma unroll
          for (int ks = 0; ks < 2; ++ks) { aa[ks] = *(const LAS bf16x8*)(ap + 64 * ks); ee[ks] = *(const LAS bf16x8*)(ep + 64 * ks);
#pragma unroll
              for (int j = 0; j < NT2; ++j) vv[j][ks] = *(const LAS bf16x8*)(vp + 16 * j * ML_AS + 64 * ks); }
          const int q4 = fr >> 2, p4 = lane & 3;
#pragma unroll
          for (int ks = 0; ks < 2; ++ks) {
#pragma unroll
              for (int a = 0; a < 2; ++a) { const LAS unsigned char* kp = L + ML_K + (32 * ks + 8 * fq + q4) * ML_QS + (16 * (2 * w + a) + 4 * p4) * 2;
                  const s16x4 lo = lds_tr16(kp), hi = lds_tr16(kp + 4 * ML_QS); afr[ks][a] = (bf16x8){lo[0], lo[1], lo[2], lo[3], hi[0], hi[1], hi[2], hi[3]}; }
#pragma unroll
              for (int bb = 0; bb < NB5; ++bb) bw[ks][bb] = *(const LAS bf16x8*)(L + MP::VWT + (16 * bb + fr) * ML_AS + 16 * fq + 64 * ks); }
          const float dec = SC[SC_DEC];
          f32x4 wi4, eb4;
#pragma unroll
          for (int r = 0; r < 4; ++r) { wi4[r] = SC[SC_WI + 16 * ti + 4 * fq + r]; eb4[r] = SC[SC_EBD + 16 * ti + 4 * fq + r]; }
          __builtin_amdgcn_sched_barrier(0);
          f32x4 av[NT2], av2[NT2], ae = (f32x4){0.f, 0.f, 0.f, 0.f}, ae2 = ae;
#pragma unroll
          for (int j = 0; j < NT2; ++j) { av[j] = (f32x4){0.f, 0.f, 0.f, 0.f}; av2[j] = av[j]; }
#pragma unroll
          for (int a = 0; a < 2; ++a)
#pragma unroll
              for (int bb = 0; bb < NB5; ++bb) C[a][bb] *= dec;
#pragma unroll
          for (int ks = 0; ks < 2; ++ks) { ae = mfma16(aa[ks], ee[ks], ae);
#pragma unroll
              for (int j = 0; j < NT2; ++j) av[j] = mfma16(aa[ks], vv[j][ks], av[j]); }
#pragma unroll
          for (int ks = 0; ks < 2; ++ks)
#pragma unroll
              for (int bb = 0; bb < NB5; ++bb) { C[0][bb] = mfma16(afr[ks][0], bw[ks][bb], C[0][bb]); C[1][bb] = mfma16(afr[ks][1], bw[ks][bb], C[1][bb]); }
          __builtin_amdgcn_sched_barrier(0);
          { const LAS unsigned char* qp = L + ML_Q + (16 * ti + fr) * ML_QS + 16 * fq;
#pragma unroll
            for (int hb = 0; hb < 2; ++hb) {
                bf16x8 qa[4], cc[NT2][4], ce[4];
#pragma unroll
                for (int kk = 0; kk < 4; ++kk) { qa[kk] = *(const LAS bf16x8*)(qp + 64 * (4 * hb + kk)); ce[kk] = *(const LAS bf16x8*)(cep + 64 * (4 * hb + kk));
#pragma unroll
                    for (int j = 0; j < NT2; ++j) cc[j][kk] = *(const LAS bf16x8*)(cp + 16 * j * ML_QS + 64 * (4 * hb + kk)); }
                __builtin_amdgcn_sched_barrier(0);
#pragma unroll
                for (int kk = 0; kk < 4; ++kk) { ae2 = mfma16(qa[kk], ce[kk], ae2);
#pragma unroll
                    for (int j = 0; j < NT2; ++j) av2[j] = mfma16(qa[kk], cc[j][kk], av2[j]); }
            } }
          float rd[4];
#pragma unroll
          for (int r = 0; r < 4; ++r) { float dn = ae[r] + wi4[r] * ae2[r]; dn = __shfl(dn, lane & 48); rd[r] = frcp(fmaxf(fabsf(dn), eb4[r])); }
#pragma unroll
          for (int j = 0; j < NT2; ++j) { hpk[j][0] = pk2((av[j][0] + wi4[0] * av2[j][0]) * rd[0], (av[j][1] + wi4[1] * av2[j][1]) * rd[1]);
              hpk[j][1] = pk2((av[j][2] + wi4[2] * av2[j][2]) * rd[2], (av[j][3] + wi4[3] * av2[j][3]) * rd[3]); } }
        __syncthreads();
#pragma unroll
        for (int a = 0; a < 2; ++a)
#pragma unroll
            for (int bb = 0; bb < NB5; ++bb) { u32x2 pw; pw.x = pk2(C[a][bb][0], C[a][bb][1]); pw.y = pk2(C[a][bb][2], C[a][bb][3]);
                *(LAS u32x2*)(L + MP::CT + (16 * bb + fr) * ML_QS + (16 * (2 * w + a) + 4 * fq) * 2) = pw; }
    }
#undef ML_ISSUE
    { bf16* hpp = (bf16*)F.HT + (size_t)(b * SEQ + 64 * 31 + 16 * (w & 3) + 4 * fq) * D + h * 256 + sl * (16 * NDT) + 16 * ((w >> 2) * NT2) + fr;
#pragma unroll
      for (int j = 0; j < NT2; ++j) { hpp[16 * j] = (bf16)(hpk[j][0] & 0xffffu); hpp[(size_t)D + 16 * j] = (bf16)(hpk[j][0] >> 16); hpp[(size_t)2 * D + 16 * j] = (bf16)(hpk[j][1] & 0xffffu); hpp[(size_t)3 * D + 16 * j] = (bf16)(hpk[j][1] >> 16); } }
    __syncthreads();
}

constexpr int CQ_TS = 144, CQ_SCR = 2 * 32 * CQ_TS;
struct CqItem { const float* W; unsigned char* WT; int Nsrc, c0, k0, row0, row1, rstep; };
__device__ __forceinline__ CqItem cq_decode(Frame& F, int r) {
    constexpr int I_GU1 = (D / 128) * (2048 / 64), I_DN1 = (D / 128) * (D / 64);
    CqItem it;
    if (r < NE * I_GU1) { const int e = r / I_GU1, q = r % I_GU1, kb = q / 32, cb = q % 32, j0 = 32 * cb;
        it.W = F.w_gate_up + (size_t)e * D * 2048; it.WT = (unsigned char*)F.WguT + (size_t)e * 2048 * D; it.Nsrc = 2048; it.c0 = 2 * j0; it.k0 = 128 * kb;
        it.row0 = (j0 >> 7) * 256 + (j0 & 127); it.row1 = it.row0 + 128; it.rstep = 1; }
    else { r -= NE * I_GU1; const int e = r / I_DN1, q = r % I_DN1, kb = q / 16, cb = q % 16;
        it.W = F.w_down + (size_t)e * D * D; it.WT = (unsigned char*)F.WdnT + (size_t)e * D * D; it.Nsrc = D; it.c0 = 64 * cb; it.k0 = 128 * kb;
        it.row0 = 64 * cb; it.row1 = 64 * cb + 1; it.rstep = 2; }
    return it;
}
__device__ __forceinline__ void cq_load(const CqItem& it, int half, int lane, f32x4 (&v)[16]) {
    const float* p = it.W + (size_t)(it.k0 + 64 * half + 4 * (lane >> 4)) * it.Nsrc + it.c0 + 4 * (lane & 15);
#pragma unroll
    for (int pp = 0; pp < 4; ++pp)
#pragma unroll
        for (int i = 0; i < 4; ++i) v[4 * pp + i] = *(const f32x4*)(p + (size_t)(16 * pp + i) * it.Nsrc);
}
__device__ __forceinline__ void cq_pack(const f32x4 (&v)[16], int half, int lane, LAS unsigned char* scr, float sc) {
    LAS unsigned char* t0 = scr + (2 * (lane & 15)) * CQ_TS + 4 * (16 * half + (lane >> 4));
#pragma unroll
    for (int pp = 0; pp < 4; ++pp)
#pragma unroll
        for (int c = 0; c < 4; ++c)
            *(LAS unsigned*)(t0 + (c & 1) * 32 * CQ_TS + (c >> 1) * CQ_TS + 16 * pp) = pk4_fp8(v[4 * pp][c] * sc, v[4 * pp + 1][c] * sc, v[4 * pp + 2][c] * sc, v[4 * pp + 3][c] * sc);
}
__device__ __forceinline__ void cq_store(const CqItem& it, int lane, LAS unsigned char* scr) {
    asm volatile("s_waitcnt lgkmcnt(0)" ::: "memory");
    const int r = lane >> 1, hf = lane & 1;
#pragma unroll
    for (int t = 0; t < 2; ++t) { const LAS unsigned char* s = scr + t * 32 * CQ_TS + r * CQ_TS + 64 * hf;
        unsigned char* d = it.WT + (size_t)((t ? it.row1 : it.row0) + r * it.rstep) * D + it.k0 + 64 * hf;
#pragma unroll
        for (int j = 0; j < 4; ++j) *(u32x4*)(d + 16 * j) = *(const LAS u32x4*)(s + 16 * j); }
    asm volatile("s_waitcnt lgkmcnt(0)" ::: "memory");
}
constexpr int CS_GRAB = 8;
__device__ __forceinline__ void convert_steal(Frame& F) {
    constexpr int I_GU1 = (D / 128) * (2048 / 64), I_DN1 = (D / 128) * (D / 64), NIT = NE * (I_GU1 + I_DN1);
    static_assert(NIT % CS_GRAB == 0, "conversion items per grab");
    LAS unsigned char* scr = F.lds + F.wave * CQ_SCR; LAS int* slot = (LAS int*)(F.lds + 8 * CQ_SCR);
    int nxt = 0;
    __syncthreads();
    if (F.tid == 0) nxt = (int)atomicAdd(F.ctl + CW_QCTR, (unsigned)CS_GRAB);
    for (;;) {
        if (F.tid == 0) slot[0] = nxt;
        __syncthreads();
        const int base = slot[0]; if (base >= NIT) break;
        if (F.tid == 0) nxt = (int)atomicAdd(F.ctl + CW_QCTR, (unsigned)CS_GRAB);
        const CqItem it = cq_decode(F, base + F.wave);
        f32x4 va[16], vb[16];
        cq_load(it, 0, F.lane, va);
        cq_load(it, 1, F.lane, vb);
        cq_pack(va, 0, F.lane, scr, 32.0f);
        cq_pack(vb, 1, F.lane, scr, 32.0f);
        cq_store(it, F.lane, scr);
        __syncthreads();
    }
}

#ifndef ML_NDT
#define ML_NDT 4
#endif
__device__ __forceinline__ void mlstm_phase(Frame& F) {
    constexpr int SLICES = 16 / ML_NDT, NITEMS = NB * 4 * SLICES;
    for (int item = F.vcu; item < NITEMS; item += F.G) mlstm_item<ML_NDT>(F, item / (4 * SLICES), (item / SLICES) & 3, item % SLICES);
#if FAST_ATTN && ATT_QUEUE
    attn_phase(F);
#endif
#if MOE_FP8 && STEAL
#if defined(PROBE_NOSTEAL)
    if (F.vcu >= NITEMS)
#endif
#if defined(PROBE_CONV64)
    if (F.vcu < NITEMS || F.vcu >= 192)
#endif
    convert_steal(F);
#endif
}

constexpr int N_PHASES = 13;
struct Args { const void* in[18]; float* out; unsigned char* ws; int ph_lo, ph_hi; };

__device__ __forceinline__ int opaque_int(int v) { asm volatile("" : "+s"(v)); return v; }
__global__ void __launch_bounds__(NTHREADS, 2) mega_fwd(Args args) {
    extern __shared__ __attribute__((aligned(16))) unsigned char lds[];
    Frame F;
    F.lds = (LAS unsigned char*)lds;
    F.tid = threadIdx.x; F.lane = F.tid & 63; F.wave = __builtin_amdgcn_readfirstlane(F.tid >> 6);
    F.G = gridDim.x; { const int bx = blockIdx.x; F.vcu = (F.G % 8 == 0) ? (bx % 8) * (F.G / 8) + bx / 8 : bx; }
    F.gw = F.vcu * NWAVES + F.wave; F.NGW = F.G * NWAVES;
    unsigned char* ws = args.ws;
    F.ctl = (unsigned*)(ws + WS_CTL);
    F.x = (const float*)args.in[0]; F.positions = (const int*)args.in[1]; F.g_mix = (const float*)args.in[2]; F.w_in = (const float*)args.in[3]; F.conv_qk = (const float*)args.in[4];
    F.b_if = (const float*)args.in[5]; F.g_mnorm = (const float*)args.in[6]; F.w_attn_out = (const float*)args.in[7]; F.w_mlstm_out = (const float*)args.in[8]; F.w_mix_out = (const float*)args.in[9];
    F.g_ffn = (const float*)args.in[10]; F.w_router = (const float*)args.in[11]; F.b_router = (const float*)args.in[12]; F.w_gate_up = (const float*)args.in[13]; F.b_gate_up = (const float*)args.in[14];
    F.w_down = (const float*)args.in[15]; F.b_down = (const float*)args.in[16]; F.g_final = (const float*)args.in[17]; F.out = args.out;
    F.WinT = (bf16*)(ws + WS_WIN); F.WamT = (bf16*)(ws + WS_WAM); F.WoT = (bf16*)(ws + WS_WO); F.WguT = (bf16*)(ws + WS_WGU); F.WdnT = (bf16*)(ws + WS_WDN);
    F.XN = (bf16*)(ws + WS_XN); F.PROJ = (bf16*)(ws + WS_PROJ); F.OG = (bf16*)(ws + WS_OG); F.AM = (bf16*)(ws + WS_AM); F.MERGED = (bf16*)(ws + WS_MERGED);
    F.XS = (bf16*)(ws + WS_XS); F.ACT = (bf16*)(ws + WS_ACT); F.YBUF = (bf16*)(ws + WS_YBUF);
    F.GATES = (float*)(ws + WS_GATES); F.ROPE = (float*)(ws + WS_ROPE); F.LSE = (float*)(ws + WS_LSE); F.HT = (float*)(ws + WS_HT); F.H = (float*)(ws + WS_H);
    F.QC = (float*)(ws + WS_QC); F.KC = (float*)(ws + WS_KC);
    F.TOK_E = (int*)(ws + WS_ROUTE); F.TOK_SLOT = F.TOK_E + NA; F.TOK_W = (float*)(F.TOK_SLOT + NA);
    F.ROW_TOK = (int*)(ws + WS_ROWMETA); F.ROW_W = (float*)(F.ROW_TOK + (RM_FUSED ? NE * ECAP : XS_ROWS));

    const int lo = args.ph_lo, hi = args.ph_hi;
    for (int u = F.tid; u < (LDS_BYTES - LDSCTL_OFF) / 4; u += NTHREADS) ((LAS unsigned*)(F.lds + LDSCTL_OFF))[u] = 0u;
    __syncthreads();
    XcdBarrier bar; bar.bar = F.ctl + CW_BAR; bar.x = 0; bar.st = nullptr;
    if (hi - lo > 1) bar = xcd_barrier_post(F.ctl + CW_BAR, (volatile LAS unsigned*)(F.lds + MISC_OFF) + 8);
#ifndef PH_MASK
#define PH_MASK 0xffffffffu
#endif
#ifndef REP_MASK
#define REP_MASK 0u
#endif
#define IN(k) (((PH_MASK >> (k)) & 1u) && lo <= (k) && (k) < hi)
#define REPS(k) for (int rep_ = 0, nrep_ = ((REP_MASK >> (k)) & 1u) ? opaque_int(2) : 1; rep_ < nrep_; ++rep_)
#define SEAM(k) do { if (IN(k) && IN((k) + 1)) { GRID_BAR(); } } while (0)
#define GRID_BAR() xcd_barrier(bar)

    if (IN(0)) REPS(0) { p0_weights(F); p0_rows(F); }
    SEAM(0);
    if (IN(1)) REPS(1) {
#if FAST_P1
#if P1_FP8
        constexpr int NF8 = 64 * (18 + 42 - P1_HI), NBF = 64 * (P1_HI - 18);
        constexpr bool SPLIT = (NF8 == 128 * 15 && NBF == 128 * 6);
        { pg8::Gemm g{(const bf16*)((const unsigned char*)F.ctl + WS_XN8), F.WinT, T, (18 + 42 - P1_HI) * 256, D / 2}; pg8::SplitOrder S; S.base.init(T, (18 + 42 - P1_HI) * 256, F.G, (int)blockIdx.x);
          S.nA = SPLIT ? 9 : -1; S.nB = SPLIT ? 6 : -1;
          pg8::EpiProj<1> E{F.PROJ, F.ROPE};
          pg8::gemm_phase<pg8::EpiProj<1>, pg8::SplitOrder, true, true, true>(F.lds, g, S, E); }
        { pg8::Gemm g{F.XN, F.WinT + (size_t)18 * 256 * D, T, (P1_HI - 18) * 256, D}; pg8::SplitOrder S; S.base.init(T, (P1_HI - 18) * 256, F.G, (int)blockIdx.x);
          S.nA = SPLIT ? 2 : -1; S.nB = SPLIT ? 4 : -1;
          pg8::EpiProj<2> E{F.PROJ, F.ROPE};
          pg8::gemm_phase<pg8::EpiProj<2>, pg8::SplitOrder, true, true>(F.lds, g, S, E); }
#else
        pg8::Gemm g{F.XN, F.WinT, T, NP, D}; pg8::StaticOrder S; S.init(T, NP, F.G, (int)blockIdx.x);
        pg8::EpiProj<0> E{F.PROJ, F.ROPE};
        pg8::gemm_phase<pg8::EpiProj<0>, pg8::StaticOrder, true, true>(F.lds, g, S, E);
#endif
#else
        naive_p1(F);
#endif
    }
    SEAM(1);
    if (IN(2)) REPS(2) {
#if !FAST_P1
        naive_p1_rope(F);
#endif
    }
#if !FAST_P1
    SEAM(2);
#endif
    if (IN(3)) REPS(3) {
#if !FAST_MLSTM
        naive_conv(F);
#endif
#if FAST_MLSTM
        mlstm_prepass(F);
#endif
#if FAST_ATTN && !(ATT_QUEUE && FAST_MLSTM)
        attn_phase(F);
#elif !FAST_ATTN
        naive_attn(F);
#endif
    }
    SEAM(3);
    if (IN(4)) REPS(4) {
#if FAST_MLSTM
        mlstm_phase(F);
#else
        naive_mlstm(F);
#endif
    }
    SEAM(4);
    if (IN(5)) REPS(5) p3_post_mixer(F);
    SEAM(5);
    if (IN(6)) REPS(6) {
#if FAST_P4
        constexpr bool STREAM = (MIX_STREAM && FAST_P5);
        pg8::Gemm g{F.AM, F.WamT, T, D, AMLD};
        { pg8::MergedOrder S; S.base.init(T, D, F.G, (int)blockIdx.x); S.nparts = 2; S.pub = STREAM; S.ready = F.ctl + CW_READY2; S.tmo = F.ctl + CW_TMO;
          pg8::EpiMerged E{F.AM + 1536, F.PROJ, F.x, F.H, false};
          pg8::gemm_phase<pg8::EpiMerged, pg8::MergedOrder, false, true>(F.lds, g, S, E); }
        if (STREAM) {
          pg8::MergedOrder S; S.base.init(T, D, F.G, (int)blockIdx.x); S.nparts = 1; S.pub = true; S.ready = F.ctl + CW_READY2; S.tmo = F.ctl + CW_TMO;
          pg8::EpiMerged E{F.AM + 1536, F.PROJ, F.x, F.H, false};
          pg8::gemm_phase<pg8::EpiMerged, pg8::MergedOrder, false, true>(F.lds, g, S, E); }
#else
        naive_p4(F);
#endif
    }
#if !(MIX_STREAM && FAST_P4 && FAST_P5)
    SEAM(6);
#endif
    if (IN(7)) REPS(7) {
#if FAST_P5
#if !(MIX_STREAM && FAST_P4)
        { pg8::Gemm g{F.AM, F.WamT, T, D, AMLD}; pg8::MergedOrder S; S.base.init(T, D, F.G, (int)blockIdx.x); S.nparts = 1; S.pub = false; S.ready = F.ctl + CW_READY2; S.tmo = F.ctl + CW_TMO;
          pg8::EpiMerged E{F.AM + 1536, F.PROJ, F.x, F.H, false};
          pg8::gemm_phase<pg8::EpiMerged, pg8::MergedOrder, false, true>(F.lds, g, S, E); }
#endif
#else
        naive_p5(F);
#endif
    }
    SEAM(7);
#if MOE_FP8 && ROUTER_MFMA
    if (IN(8)) REPS(8) p6_router_mfma(F);
#else
    if (IN(8)) REPS(8) p6_router(F);
#endif
    SEAM(8);
#if !RM_FUSED
    if (IN(9)) REPS(9) p7_gather(F);
    SEAM(9);
#endif
#if MOE_FP8 && MOE_STREAM && FAST_MOE
    if (IN(10)) REPS(10) {
        LAS int* tl_e = (LAS int*)(F.lds + RING_BYTES); LAS int* tl_base = tl_e + 320; LAS int* tl_nv = tl_base + 320; LAS int* tl_n = tl_nv + 320;
        __syncthreads();
        if (F.tid < 64) { const int e = F.lane & 31, cnt = (int)__hip_atomic_load(F.ctl + CW_CNT + 64 * e, __ATOMIC_RELAXED, __HIP_MEMORY_SCOPE_AGENT), nt = (cnt + 255) >> 8;
            int incl = nt;
#pragma unroll
            for (int o = 1; o < 32; o <<= 1) { const int v = __shfl_up(incl, o, 32); if ((F.lane & 31) >= o) incl += v; }
            if (F.tid < 32) { const int t0 = incl - nt; for (int j = 0; j < nt; ++j) { tl_e[t0 + j] = e; tl_base[t0 + j] = e * ECAP + 256 * j; tl_nv[t0 + j] = min(256, cnt - 256 * j); } if (e == 31) tl_n[0] = incl; } }
        __syncthreads();
        const int ntiles = __builtin_amdgcn_readfirstlane(tl_n[0]);
        pg8::MoeOrder S{(const LAS unsigned*)tl_e, ntiles, F.G, (int)blockIdx.x, F.ROW_TOK, F.XN, F.ACT, F.WguT, F.WdnT, F.ctl + CW_READY, F.ctl + CW_TMO, tl_base, tl_nv};
        pg8::Gemm g{F.XN, F.WguT, ntiles * 256, NE * 2048, D / 2};
        pg8::EpiMoe E{{F.ACT, F.b_gate_up, 1.0f / 32.0f}, {F.YBUF, F.b_down, F.ROW_TOK, F.ROW_W, 1.0f / 32.0f, tl_base, tl_nv}};
        pg8::gemm_phase<pg8::EpiMoe, pg8::MoeOrder, true, true, true, true, true>(F.lds, g, S, E);
    }
#else
    if (IN(10)) REPS(10) {
        const int ntiles = (int)F.ctl[CW_NTILES];
#if FAST_MOE
        pg8::GroupedOrder S{F.ctl + CW_TILEE, ntiles, 8, F.G, (int)blockIdx.x, F.ROW_TOK};
#if MOE_FP8
        pg8::Gemm g{F.XN, F.WguT, ntiles * 256, NE * 2048, D / 2}; pg8::EpiSwiGLU<true> E{F.ACT, F.b_gate_up, 1.0f / 32.0f};
        pg8::gemm_phase<pg8::EpiSwiGLU<true>, pg8::GroupedOrder, true, true, true, true>(F.lds, g, S, E);
#else
        pg8::Gemm g{F.XS, F.WguT, ntiles * 256, NE * 2048, D}; pg8::EpiSwiGLU<false> E{F.ACT, F.b_gate_up, 1.0f};
        pg8::gemm_phase<pg8::EpiSwiGLU<false>, pg8::GroupedOrder, true, true, false>(F.lds, g, S, E);
#endif
#else
        naive_p8(F, ntiles);
#endif
    }
    SEAM(10);
    if (IN(11)) REPS(11) {
        const int ntiles = (int)F.ctl[CW_NTILES];
#if FAST_MOE
        pg8::GroupedOrder S{F.ctl + CW_TILEE, ntiles, 4, F.G, (int)blockIdx.x, F.ROW_TOK};
#if MOE_FP8
        pg8::Gemm g{F.ACT, F.WdnT, ntiles * 256, NE * D, D / 2}; pg8::EpiDown E{F.YBUF, F.b_down, F.ROW_TOK, F.ROW_W, 1.0f / 32.0f};
        pg8::gemm_phase<pg8::EpiDown, pg8::GroupedOrder, true, true, true>(F.lds, g, S, E);
#else
        pg8::Gemm g{F.ACT, F.WdnT, ntiles * 256, NE * D, D}; pg8::EpiDown E{F.YBUF, F.b_down, F.ROW_TOK, F.ROW_W, 1.0f};
        pg8::gemm_phase<pg8::EpiDown, pg8::GroupedOrder, true, true, false>(F.lds, g, S, E);
#endif
#else
        naive_p9(F, ntiles);
#endif
    }
#endif
    SEAM(11);
    if (IN(12)) REPS(12) p10_final(F);
#undef IN
#undef SEAM
}

extern "C" void kernel_launch(void* const* d_in, const int* in_sizes, int n_in, void* d_out, int out_size, void* d_ws, size_t ws_size, hipStream_t stream) {
    static int grid = 0;
    if (grid == 0) {
        if (n_in != 18 || out_size != T * D || ws_size < WS_END) { fprintf(stderr, "kernel_launch: unexpected shapes (n_in %d, out %d, ws %zu)\n", n_in, out_size, ws_size); grid = -1; return; }
        int dev = 0, cus = 0;
        if (hipGetDevice(&dev) != hipSuccess || hipDeviceGetAttribute(&cus, hipDeviceAttributeMultiprocessorCount, dev) != hipSuccess) { grid = -1; return; }
        if (hipFuncSetAttribute((const void*)mega_fwd, hipFuncAttributeMaxDynamicSharedMemorySize, LDS_BYTES) != hipSuccess) { fprintf(stderr, "kernel_launch: hipFuncSetAttribute failed\n"); grid = -1; return; }
        int per_cu = 0;
        if (hipOccupancyMaxActiveBlocksPerMultiprocessor(&per_cu, (const void*)mega_fwd, NTHREADS, LDS_BYTES) != hipSuccess || per_cu < 1) { fprintf(stderr, "kernel_launch: occupancy query says %d blocks per CU\n", per_cu); (void)hipGetLastError(); grid = -1; return; }
        grid = cus;
    }
    if (grid < 0) return;
    (void)hipMemsetAsync((char*)d_ws + WS_CTL, 0, CTL_ZERO_BYTES, stream);
    Args a{};
    for (int i = 0; i < 18; ++i) a.in[i] = d_in[i];
    a.out = (float*)d_out; a.ws = (unsigned char*)d_ws;
#if defined(MK_MULTI)
    for (int p = 0; p < N_PHASES; ++p) {
        a.ph_lo = p; a.ph_hi = p + 1;
        hipLaunchKernelGGL(mega_fwd, dim3(grid), dim3(NTHREADS), LDS_BYTES, stream, a);
    }
#else
#if defined(PROBE_HI)
    a.ph_lo = 0; a.ph_hi = PROBE_HI;
    hipLaunchKernelGGL(mega_fwd, dim3(grid), dim3(NTHREADS), LDS_BYTES, stream, a);
    (void)hipMemsetAsync((char*)d_ws + WS_CTL, 0, CTL_ZERO_BYTES, stream);
#endif
    a.ph_lo = 0; a.ph_hi = N_PHASES;
    hipLaunchKernelGGL(mega_fwd, dim3(grid), dim3(NTHREADS), LDS_BYTES, stream, a);
#endif
}
```

```cpp
#include <hip/hip_runtime.h>
#include <cstdio>
#include <cstdint>

#define LAS __attribute__((address_space(3)))
#define GAS __attribute__((address_space(1)))
typedef unsigned short bf16;
typedef float f32x4 __attribute__((ext_vector_type(4)));
typedef float f32x2 __attribute__((ext_vector_type(2)));
typedef unsigned u32x4 __attribute__((ext_vector_type(4)));
typedef unsigned u32x2 __attribute__((ext_vector_type(2)));
typedef short bf16x8 __attribute__((ext_vector_type(8)));

#ifndef FAST_P1
#define FAST_P1 1
#endif
#ifndef FAST_P4
#define FAST_P4 1
#endif
#ifndef FAST_P5
#define FAST_P5 1
#endif
#ifndef FAST_MOE
#define FAST_MOE 1
#endif
#ifndef MOE_FP8
#define MOE_FP8 1
#endif
#ifndef P1_FP8
#define P1_FP8 1
#endif
#ifndef STEAL
#define STEAL 1
#endif
#ifndef ROUTER_MFMA
#define ROUTER_MFMA 1
#endif
#ifndef P1_HI
#define P1_HI 30
#endif
#ifndef MOE_STREAM
#define MOE_STREAM 1
#endif
#ifndef ATT_QUEUE
#define ATT_QUEUE 1
#endif
#ifndef ROWMETA_FUSED
#define ROWMETA_FUSED 1
#endif
#ifndef H_BF16
#define H_BF16 1
#endif
#define RM_FUSED (ROWMETA_FUSED && MOE_FP8 && MOE_STREAM && FAST_MOE && ROUTER_MFMA)
#ifndef FAST_ATTN
#define FAST_ATTN 1
#endif
#ifndef FAST_MLSTM
#define FAST_MLSTM 1
#endif

constexpr int T = 16384, D = 1024, SEQ = 2048, NB = 8;
constexpr int DIN = 10760, NP = 10752;
constexpr int C_AQ = 0, C_AK = 1536, C_AV = 3072, C_MQ = 4608, C_MK = 5632, C_MV = 6656, C_MO = 7680, C_GA = 8704, C_GM = 9728;
constexpr int NE = 32, TOPK = 4, NA = T * TOPK, MAXTILES = NA / 256 + NE, XS_ROWS = MAXTILES * 256, ECAP = T;
constexpr float QSCALE = 0.08838834764831845f * 1.4426950408889634f;
constexpr float RMS_EPS = 1e-5f, LN_EPS = 1e-5f;

constexpr size_t MiB = 1u << 20;
constexpr size_t WS_CTL = 0, CTL_ZERO_BYTES = 1 * MiB;
constexpr size_t WS_WIN = 2 * MiB, WS_WAM = 23 * MiB, WS_WO = 26 * MiB, WS_WGU = 28 * MiB, WS_WDN = 156 * MiB;
constexpr size_t WS_XN = 220 * MiB, WS_GATES = 252 * MiB, WS_ROPE = 253 * MiB, WS_ROUTE = 255 * MiB;
constexpr size_t WS_H = 256 * MiB, WS_MERGED = 320 * MiB;
constexpr size_t WS_OG = 352 * MiB, WS_LSE = 400 * MiB, WS_HT = 401 * MiB, WS_AM = 433 * MiB;
constexpr int AMLD = 2560;
#ifndef MIX_STREAM
#define MIX_STREAM 0
#endif
constexpr size_t WS_YBUF = 352 * MiB;
constexpr size_t WS_PROJ = 513 * MiB;
constexpr size_t WS_XS = 513 * MiB, WS_ACT = 657 * MiB;
constexpr size_t WS_ROWMETA = 801 * MiB;
constexpr size_t WS_QC = 849 * MiB, WS_KC = 913 * MiB, WS_XN8 = 916 * MiB, WS_END = 977 * MiB;
constexpr int CW_TMO = 0, CW_BAR = 4096, CW_CNT = 8192  , CW_NTILES = 12288, CW_TILEE = 12352, CW_QCTR = 16384, CW_ACTR = 16448  , CW_READY = 32768  , CW_READY2 = 65536  ;

constexpr int RING_BYTES = 131072, LDS_BYTES = 147456, LDSCTL_OFF = LDS_BYTES - 256, MISC_OFF = LDSCTL_OFF;
constexpr int NWAVES = 8, NTHREADS = 512;

__device__ __forceinline__ unsigned f2bf(float f) { unsigned u = __builtin_bit_cast(unsigned, f); return (u + 0x7fffu + ((u >> 16) & 1u)) >> 16; }
__device__ __forceinline__ unsigned pk2(float lo, float hi) { unsigned r; asm("v_cvt_pk_bf16_f32 %0, %1, %2" : "=v"(r) : "v"(lo), "v"(hi)); return r; }
__device__ __forceinline__ unsigned pk4_fp8(float a, float b, float c, float d) { int w = __builtin_amdgcn_cvt_pk_fp8_f32(a, b, 0, false); w = __builtin_amdgcn_cvt_pk_fp8_f32(c, d, w, true); return (unsigned)w; }
__device__ __forceinline__ float frcp(float x) { return __builtin_amdgcn_rcpf(x); }
__device__ __forceinline__ float bf2f(unsigned b) { return __builtin_bit_cast(float, b << 16); }
__device__ __forceinline__ float bflo(unsigned w) { return __builtin_bit_cast(float, w << 16); }
__device__ __forceinline__ float bfhi(unsigned w) { return __builtin_bit_cast(float, w & 0xffff0000u); }
__device__ __forceinline__ float wave_sum(float v) {
#pragma unroll
    for (int o = 1; o < 64; o <<= 1) v += __shfl_xor(v, o);
    return v;
}
__device__ __forceinline__ float wave_max(float v) {
#pragma unroll
    for (int o = 1; o < 64; o <<= 1) v = fmaxf(v, __shfl_xor(v, o));
    return v;
}
__device__ __forceinline__ float sigmoidf_(float x) { return frcp(1.0f + __expf(-x)); }

__host__ __device__ __forceinline__ int win_logical_col(int c) {
    if (c < C_AV) { const int p = c & 127; if (p < 32) { const int a = p >> 3, n = (p >> 2) & 1, j = p & 3; return (c - p) + 16 * n + 4 * a + j; } return c; }
    return c < C_GA ? c : c + 8;
}
__host__ __device__ __forceinline__ int wgu_logical_col(int c) { const int pn = c >> 8, bj = (c >> 7) & 1, jl = c & 127; return 2 * (128 * pn + jl) + bj; }
namespace pg8 {
#define PG8_LAS __attribute__((address_space(3)))
typedef unsigned short bf16_t;
typedef short bf16x8 __attribute__((ext_vector_type(8)));
typedef float f32x4 __attribute__((ext_vector_type(4)));
typedef unsigned u32x4 __attribute__((ext_vector_type(4)));
constexpr int BM = 256, BK = 64, HALF = 128, HTB = HALF * BK * 2  , STAGE_BYTES = 8 * HTB, NXCD = 8, WGM = 8;

__host__ __device__ __forceinline__ int lds_byte(int r, int c) { const int st = (r >> 4) * 2 + (c >> 5), rr = r & 15, cc = c & 31, ob = rr * 64 + cc * 2; return st * 1024 + (ob ^ (((ob >> 9) & 1) << 5)); }
__host__ __device__ __forceinline__ void stage_rc(int b, int& R, int& C) { const int st = b / 1024, sb = b % 1024, swz = sb ^ (((sb >> 9) & 1) << 5); R = (st >> 1) * 16 + swz / 64; C = (st & 1) * 32 + (swz % 64) / 2; }
__host__ __device__ __forceinline__ int perm32(int rho) { const int n = rho >> 4, i = rho & 15; return 8 * (i >> 2) + 4 * n + (i & 3); }

typedef int i32x4 __attribute__((ext_vector_type(4)));
typedef int i32x8 __attribute__((ext_vector_type(8)));
template <bool FP8> struct FragT { typedef bf16x8 type; };
template <> struct FragT<true> { typedef i32x8 type; };
__device__ __forceinline__ f32x4 mma16(bf16x8 a, bf16x8 b, f32x4 c) { return __builtin_amdgcn_mfma_f32_16x16x32_bf16(a, b, c, 0, 0, 0); }
__device__ __forceinline__ f32x4 mma16(i32x8, i32x8, f32x4 c) { return c; }
__device__ __forceinline__ f32x4 mma8(i32x8 a, i32x8 b, f32x4 c) { const int one = 0x7F7F7F7F;
    asm volatile("v_mfma_scale_f32_16x16x128_f8f6f4 %0, %1, %2, %0, %3, %3 op_sel_hi:[0,0,0]" : "+v"(c) : "v"(a), "v"(b), "v"(one)); return c; }
__device__ __forceinline__ f32x4 mma8(bf16x8, bf16x8, f32x4 c) { return c; }
struct Unit { int pm, pn, part; };
struct Gemm { const bf16_t* A; const bf16_t* Bt; int M, N, K; };

struct StaticOrder {
    int nM, nN, nwg, G, c;
    __host__ __device__ void init(int M, int N, int G_, int c_) { nM = M / BM; nN = N / BM; nwg = nM * nN; G = G_; c = c_; }
    __host__ __device__ bool next(int i, Unit& u) const { return at((long)i * G + c, u); }
    __host__ __device__ bool at(long L, Unit& u) const {
        if (L >= nwg) return false;
        int wgid = (int)L; { const int q = nwg / NXCD, r = nwg % NXCD, xcd = wgid % NXCD, off = wgid / NXCD; wgid = (xcd < r ? xcd * (q + 1) : r * (q + 1) + (xcd - r) * q) + off; }
        const int nig = WGM * nN, gid = wgid / nig, fm = gid * WGM, gsz = (nM - fm) < WGM ? (nM - fm) : WGM;
        u.pm = fm + ((wgid % nig) % gsz); u.pn = (wgid % nig) / gsz; u.part = 0; return true;
    }
    __device__ __forceinline__ int kt0(const Unit&) const { return 0; }
    __device__ __forceinline__ int nkt(const Unit&, int full) const { return full; }
    __device__ __forceinline__ int rowsel(const Unit&, int r) const { return r; }
    __device__ __forceinline__ const void* abase(const Unit&) const { return nullptr; }
    __device__ __forceinline__ const void* bbase(const Unit&) const { return nullptr; }
    __device__ __forceinline__ void a_ready(const Unit&) const {}
    __device__ __forceinline__ void done(const Unit&) const {}
};


__device__ __forceinline__ unsigned cvt_pk_bf16(float lo, float hi) { unsigned r; asm volatile("v_cvt_pk_bf16_f32 %0, %1, %2" : "=v"(r) : "v"(lo), "v"(hi)); return r; }
__device__ __forceinline__ u32x4 pack8(const f32x4 v0, const f32x4 v1) { u32x4 w; w.x = cvt_pk_bf16(v0[0], v0[1]); w.y = cvt_pk_bf16(v0[2], v0[3]); w.z = cvt_pk_bf16(v1[0], v1[1]); w.w = cvt_pk_bf16(v1[2], v1[3]); return w; }
__device__ __forceinline__ void unpack8(const u32x4 w, f32x4& v0, f32x4& v1) {
    v0[0] = __builtin_bit_cast(float, w.x << 16); v0[1] = __builtin_bit_cast(float, w.x & 0xffff0000u); v0[2] = __builtin_bit_cast(float, w.y << 16); v0[3] = __builtin_bit_cast(float, w.y & 0xffff0000u);
    v1[0] = __builtin_bit_cast(float, w.z << 16); v1[1] = __builtin_bit_cast(float, w.z & 0xffff0000u); v1[2] = __builtin_bit_cast(float, w.w << 16); v1[3] = __builtin_bit_cast(float, w.w & 0xffff0000u);
}
__device__ __forceinline__ f32x4 sig4(const f32x4 x) { f32x4 r; r[0] = frcp(1.0f + __expf(-x[0])); r[1] = frcp(1.0f + __expf(-x[1])); r[2] = frcp(1.0f + __expf(-x[2])); r[3] = frcp(1.0f + __expf(-x[3])); return r; }

struct GroupedOrder {
    const unsigned* tile_e; int ntiles, nN, G, c; const int* rowidx;
    __device__ __forceinline__ int kt0(const Unit&) const { return 0; }
    __device__ __forceinline__ int nkt(const Unit&, int full) const { return full; }
    __device__ __forceinline__ int rowsel(const Unit&, int r) const { const int v = rowidx[r]; return (v < 0 ? 0 : v) >> 2; }
    __device__ __forceinline__ const void* abase(const Unit&) const { return nullptr; }
    __device__ __forceinline__ const void* bbase(const Unit&) const { return nullptr; }
    __device__ bool next(int i, Unit& u) const {
        const long L = (long)i * G + c; if (L >= (long)ntiles * nN) return false;
        u.pm = (int)(L / nN); const int e = (int)tile_e[u.pm]; u.pn = e * nN + (int)(L % nN); u.part = 0; return true;
    }
    __device__ __forceinline__ void a_ready(const Unit&) const {}
    __device__ __forceinline__ void done(const Unit&) const {}
};

template <int MODE> struct EpiProj {
    static constexpr bool PERM = true, AFTER_DRAIN = false, HAS_MID = false;
    bf16_t* O; const float* rope;
    __device__ __forceinline__ bool keep(const Unit&) const { return false; }
    __device__ __forceinline__ void operator()(f32x4 (&acc)[2][2][4][2], const Unit& u, int wr, int wc, int fr, int fq) const {
        const int pnp = (MODE == 0) ? u.pn : (MODE == 1) ? (u.pn < 18 ? u.pn : u.pn + (P1_HI - 18)) : u.pn + 18;
        const int row0 = u.pm * BM + wr * 64 + fr, col0 = pnp * BM + wc * 32 + 8 * fq;
        const float sc = ((pnp < 6) ? QSCALE : 1.0f) * ((MODE == 1) ? (1.0f / 32.0f) : 1.0f);
        const bool dorope = (pnp < 12) && (wc == 0);
#pragma unroll
        for (int ai = 0; ai < 2; ++ai)
#pragma unroll
            for (int m = 0; m < 4; ++m) {
                const int row = row0 + ai * HALF + m * 16; bf16_t* rowp = O + (size_t)row * NP + col0;
                f32x4 cs = (f32x4){1.f, 1.f, 1.f, 1.f}, sn = (f32x4){0.f, 0.f, 0.f, 0.f};
                if (dorope) { cs = *(const f32x4*)(rope + (size_t)row * 32 + 4 * fq); sn = *(const f32x4*)(rope + (size_t)row * 32 + 16 + 4 * fq); }
#pragma unroll
                for (int bj = 0; bj < 2; ++bj) {
                    f32x4 v0 = acc[ai][bj][m][0], v1 = acc[ai][bj][m][1];
                    if (dorope) { const f32x4 t0 = v0 * cs - v1 * sn, t1 = v1 * cs + v0 * sn; v0 = t0; v1 = t1; }
                    v0 = v0 * sc; v1 = v1 * sc;
                    *(u32x4*)(rowp + bj * HALF) = pack8(v0, v1);
                }
            }
    }
};

struct SplitOrder {
    StaticOrder base; int nA, nB;
    __device__ bool next(int i, Unit& u) const {
        const int c = base.c;
        if (base.G != 256 || nA < 0) return base.next(i, u);
        if (c < 128) { if (i >= nA) return false; return base.at((long)i * 128 + c, u); }
        if (i >= nB) return false; return base.at((long)128 * nA + (long)i * 128 + (c - 128), u);
    }
    __device__ __forceinline__ int kt0(const Unit&) const { return 0; }
    __device__ __forceinline__ int nkt(const Unit&, int full) const { return full; }
    __device__ __forceinline__ int rowsel(const Unit&, int r) const { return r; }
    __device__ __forceinline__ const void* abase(const Unit&) const { return nullptr; }
    __device__ __forceinline__ const void* bbase(const Unit&) const { return nullptr; }
    __device__ __forceinline__ void a_ready(const Unit&) const {}
    __device__ __forceinline__ void done(const Unit&) const {}
};
struct MergedOrder {
    StaticOrder base; int nparts; unsigned* ready; unsigned* tmo;
    bool pub;
    __device__ bool next(int i, Unit& u) const { if (!base.next(i / nparts, u)) return false; u.part = (nparts == 1) ? 2 : (i % nparts); return true; }
    __device__ __forceinline__ int kt0(const Unit& u) const { return u.part == 0 ? 0 : (u.part == 1 ? 8 : 24); }
    __device__ __forceinline__ int nkt(const Unit& u, int) const { return u.part == 0 ? 8 : 16; }
    __device__ __forceinline__ int rowsel(const Unit&, int r) const { return r; }
    __device__ __forceinline__ const void* abase(const Unit&) const { return nullptr; }
    __device__ __forceinline__ const void* bbase(const Unit&) const { return nullptr; }
    __device__ __forceinline__ void a_ready(const Unit& u) const {
        if (u.part != 2 || !pub) return;
        if (threadIdx.x < 64) {
            unsigned spins = 0;
            while ((unsigned)__builtin_amdgcn_readfirstlane(__hip_atomic_load(ready + 64 * u.pm, __ATOMIC_RELAXED, __HIP_MEMORY_SCOPE_AGENT)) < 32u) {
                __builtin_amdgcn_s_sleep(2);
                if (++spins > (1u << 22)) { if (threadIdx.x == 0) __hip_atomic_store(tmo, 1u, __ATOMIC_RELAXED, __HIP_MEMORY_SCOPE_AGENT); break; } }
            __builtin_amdgcn_fence(__ATOMIC_ACQUIRE, "agent");
            asm volatile("s_waitcnt vmcnt(0)" ::: "memory");
        }
        asm volatile("" ::: "memory"); __builtin_amdgcn_s_barrier(); asm volatile("" ::: "memory");
    }
    __device__ __forceinline__ void done(const Unit& u) const {
        if (!pub || u.part != 1) return;
        asm volatile("s_waitcnt vmcnt(0)" ::: "memory");
        __builtin_amdgcn_s_barrier(); asm volatile("" ::: "memory");
        if (threadIdx.x == 0) { __builtin_amdgcn_fence(__ATOMIC_RELEASE, "agent"); asm volatile("s_waitcnt vmcnt(0)" ::: "memory");
                                __hip_atomic_fetch_add(ready + 64 * u.pm, 8u, __ATOMIC_RELAXED, __HIP_MEMORY_SCOPE_AGENT); }
    }
};
struct EpiMerged {
    static constexpr bool PERM = true, AFTER_DRAIN = false, HAS_MID = false;
    bf16_t* O; const bf16_t* proj; const float* x; float* h; bool wt;
    __device__ __forceinline__ bool keep(const Unit& u) const { return u.part == 0; }
    __device__ __forceinline__ void operator()(f32x4 (&acc)[2][2][4][2], const Unit& u, int wr, int wc, int fr, int fq) const {
        const int row0 = u.pm * BM + wr * 64 + fr, col0 = u.pn * BM + wc * 32 + 8 * fq;
        if (u.part == 0) {
#pragma unroll
            for (int ai = 0; ai < 2; ++ai)
#pragma unroll
                for (int m = 0; m < 4; ++m) {
                    const bf16_t* rowp = proj + (size_t)(row0 + ai * HALF + m * 16) * NP + col0;
#pragma unroll
                    for (int bj = 0; bj < 2; ++bj) {
                        const u32x4 ga = *(const u32x4*)(rowp + C_GA + bj * HALF), gm = *(const u32x4*)(rowp + C_GM + bj * HALF);
                        f32x4 a0, a1, m0, m1; unpack8(ga, a0, a1); unpack8(gm, m0, m1);
                        f32x4 r0, r1;
#pragma unroll
                        for (int j = 0; j < 4; ++j) { r0[j] = (1.0f + __expf(-m0[j])) * frcp(1.0f + __expf(-a0[j])); r1[j] = (1.0f + __expf(-m1[j])) * frcp(1.0f + __expf(-a1[j])); }
                        acc[ai][bj][m][0] *= r0; acc[ai][bj][m][1] *= r1;
                    }
                    if (m & 1) asm volatile("" ::: "memory");
                }
        } else if (u.part == 1) {
#pragma unroll
            for (int ai = 0; ai < 2; ++ai)
#pragma unroll
                for (int m = 0; m < 4; ++m) {
                    const int row = row0 + ai * HALF + m * 16;
#pragma unroll
                    for (int bj = 0; bj < 2; ++bj) {
                        const u32x4 gm = *(const u32x4*)(proj + (size_t)row * NP + C_GM + col0 + bj * HALF);
                        f32x4 m0, m1; unpack8(gm, m0, m1);
                        const f32x4 v0 = acc[ai][bj][m][0] * sig4(m0), v1 = acc[ai][bj][m][1] * sig4(m1);
                        const u32x4 pw = pack8(v0, v1); bf16_t* dst = O + (size_t)row * AMLD + col0 + bj * HALF;
                        if (wt) { __hip_atomic_store((unsigned long long*)dst, (unsigned long long)pw.x | ((unsigned long long)pw.y << 32), __ATOMIC_RELAXED, __HIP_MEMORY_SCOPE_AGENT);
                                  __hip_atomic_store((unsigned long long*)dst + 1, (unsigned long long)pw.z | ((unsigned long long)pw.w << 32), __ATOMIC_RELAXED, __HIP_MEMORY_SCOPE_AGENT); }
                        else *(u32x4*)dst = pw;
                    }
                }
        } else {
#pragma unroll
            for (int ai = 0; ai < 2; ++ai)
#pragma unroll
                for (int m = 0; m < 4; ++m) {
                    const size_t off = (size_t)(row0 + ai * HALF + m * 16) * D + col0;
#if H_BF16
#pragma unroll
                    for (int bj = 0; bj < 2; ++bj) { const f32x4 v0 = *(const f32x4*)(x + off + bj * HALF) + acc[ai][bj][m][0], v1 = *(const f32x4*)(x + off + bj * HALF + 4) + acc[ai][bj][m][1];
                        *(u32x4*)((bf16_t*)h + off + bj * HALF) = pack8(v0, v1); }
#else
#pragma unroll
                    for (int bj = 0; bj < 2; ++bj)
#pragma unroll
                        for (int n = 0; n < 2; ++n) *(f32x4*)(h + off + bj * HALF + 4 * n) = *(const f32x4*)(x + off + bj * HALF + 4 * n) + acc[ai][bj][m][n];
#endif
                }
        }
    }
};

struct EpiResid {
    static constexpr bool PERM = false, AFTER_DRAIN = false, HAS_MID = false;
    const float* x; float* h;
    __device__ __forceinline__ bool keep(const Unit&) const { return false; }
    __device__ __forceinline__ void operator()(f32x4 (&acc)[2][2][4][2], const Unit& u, int wr, int wc, int fr, int fq) const {
        const int row0 = u.pm * BM + wr * 64 + fr, col0 = u.pn * BM + wc * 32 + 4 * fq;
#pragma unroll
        for (int ai = 0; ai < 2; ++ai)
#pragma unroll
            for (int m = 0; m < 4; ++m) {
                const size_t off = (size_t)(row0 + ai * HALF + m * 16) * D + col0;
#pragma unroll
                for (int bj = 0; bj < 2; ++bj)
#pragma unroll
                    for (int n = 0; n < 2; ++n) *(f32x4*)(h + off + bj * HALF + n * 16) = *(const f32x4*)(x + off + bj * HALF + n * 16) + acc[ai][bj][m][n];
            }
    }
};

template <bool OUT8> struct EpiSwiGLU {
    static constexpr bool PERM = true, AFTER_DRAIN = false, HAS_MID = false;
    bf16_t* act; const float* bgu; float sc;
    __device__ __forceinline__ bool keep(const Unit&) const { return false; }
    __device__ __forceinline__ void operator()(f32x4 (&acc)[2][2][4][2], const Unit& u, int wr, int wc, int fr, int fq) const {
        const int e = u.pn >> 3, pnl = u.pn & 7, row0 = u.pm * BM + wr * 64 + fr, j0 = 128 * pnl + 32 * wc + 8 * fq;
        const float* bp = bgu + (size_t)e * 2048 + 2 * j0;
        const f32x4 b0 = *(const f32x4*)(bp), b1 = *(const f32x4*)(bp + 4), b2 = *(const f32x4*)(bp + 8), b3 = *(const f32x4*)(bp + 12);
        const f32x4 bg0 = (f32x4){b0[0], b0[2], b1[0], b1[2]}, bu0 = (f32x4){b0[1], b0[3], b1[1], b1[3]}, bg1 = (f32x4){b2[0], b2[2], b3[0], b3[2]}, bu1 = (f32x4){b2[1], b2[3], b3[1], b3[3]};
#pragma unroll
        for (int ai = 0; ai < 2; ++ai)
#pragma unroll
            for (int m = 0; m < 4; ++m) {
                const int row = row0 + ai * HALF + m * 16;
                f32x4 o[2]; const float lim = 7.0f, nlim = -7.0f;
#pragma unroll
                for (int n = 0; n < 2; ++n) {
                    const f32x4 g = acc[ai][0][m][n] * sc + (n ? bg1 : bg0), up = acc[ai][1][m][n] * sc + (n ? bu1 : bu0);
#pragma unroll
                    for (int j = 0; j < 4; ++j) { float gg, uu;
                        asm("v_min_f32 %0, %2, %1" : "=v"(gg) : "v"(g[j]), "v"(lim)); asm("v_med3_f32 %0, %1, %2, %3" : "=v"(uu) : "v"(up[j]), "v"(nlim), "v"(lim));
                        const float sg = frcp(1.0f + __builtin_amdgcn_exp2f(gg * (-1.702f * 1.4426950408889634f)));
                        o[n][j] = __builtin_fmaf(uu, gg, gg) * sg; }
                }
                if constexpr (OUT8) { u32x2 w8; w8.x = pk4_fp8(o[0][0], o[0][1], o[0][2], o[0][3]); w8.y = pk4_fp8(o[1][0], o[1][1], o[1][2], o[1][3]); __hip_atomic_store((unsigned long long*)((unsigned char*)act + (size_t)row * D + j0), (unsigned long long)w8.x | ((unsigned long long)w8.y << 32), __ATOMIC_RELAXED, __HIP_MEMORY_SCOPE_AGENT); }
                else *(u32x4*)(act + (size_t)row * D + j0) = pack8(o[0], o[1]);
            }
    }
};

struct EpiDown {
    static constexpr bool PERM = true, AFTER_DRAIN = false, HAS_MID = false;
    bf16_t* ybuf; const float* bdn; const int* row_tok; const float* row_w; float sc;
    const LAS int* tbase; const LAS int* tnv;
    __device__ __forceinline__ bool keep(const Unit&) const { return false; }
    __device__ __forceinline__ void operator()(f32x4 (&acc)[2][2][4][2], const Unit& u, int wr, int wc, int fr, int fq) const {
        const int e = u.pn >> 2, pnl = u.pn & 3, col0 = 256 * pnl + 32 * wc + 8 * fq;
#if RM_FUSED
        const int row0 = tbase[u.pm] + wr * 64 + fr, nvr = tnv[u.pm] - (wr * 64 + fr);
#else
        const int row0 = u.pm * BM + wr * 64 + fr;
#endif
        f32x4 bv[2][2];
#pragma unroll
        for (int bj = 0; bj < 2; ++bj)
#pragma unroll
            for (int n = 0; n < 2; ++n) bv[bj][n] = *(const f32x4*)(bdn + (size_t)e * D + col0 + bj * HALF + 4 * n);
        int tks[8]; float ws[8];
#pragma unroll
#if RM_FUSED
        for (int i = 0; i < 8; ++i) { const int o = (i >> 2) * HALF + (i & 3) * 16; const bool ok = o < nvr; const int row = ok ? row0 + o : 0; tks[i] = row_tok[row]; ws[i] = row_w[row]; if (!ok) tks[i] = -1; }
#else
        for (int i = 0; i < 8; ++i) { const int row = row0 + (i >> 2) * HALF + (i & 3) * 16; tks[i] = row_tok[row]; ws[i] = row_w[row]; }
#endif
#pragma unroll
        for (int ai = 0; ai < 2; ++ai)
#pragma unroll
            for (int m = 0; m < 4; ++m) {
                const int tk = tks[ai * 4 + m]; const float w = ws[ai * 4 + m];
                if (tk >= 0) {
#pragma unroll
                    for (int bj = 0; bj < 2; ++bj) {
                        const f32x4 v0 = (acc[ai][bj][m][0] * sc + bv[bj][0]) * w, v1 = (acc[ai][bj][m][1] * sc + bv[bj][1]) * w;
                        *(u32x4*)(ybuf + (size_t)tk * D + col0 + bj * HALF) = pack8(v0, v1);
                    }
                }
            }
    }
};

struct MoeOrder {
    const LAS unsigned* tile_e; int ntiles, G, c; const int* rowidx; const void *a0, *a1, *b0, *b1; unsigned* ready; unsigned* tmo;
    const LAS int* tbase; const LAS int* tnv;
    __device__ __forceinline__ int kt0(const Unit&) const { return 0; }
    __device__ __forceinline__ int nkt(const Unit&, int full) const { return full; }
#if RM_FUSED
    __device__ __forceinline__ int rowsel(const Unit& u, int r) const { if (u.part) return r; const int lr = r - u.pm * BM; return (lr < tnv[u.pm]) ? (rowidx[tbase[u.pm] + lr] >> 2) : 0; }
#else
    __device__ __forceinline__ int rowsel(const Unit& u, int r) const { if (u.part) return r; const int v = rowidx[r]; return (v < 0 ? 0 : v) >> 2; }
#endif
    __device__ __forceinline__ const void* abase(const Unit& u) const { return u.part ? a1 : a0; }
    __device__ __forceinline__ const void* bbase(const Unit& u) const { return u.part ? b1 : b0; }
    __device__ bool next(int i, Unit& u) const {
        long L = (long)i * G + c; const long n1 = (long)ntiles * 8;
        if (L < n1) { u.pm = (int)(L >> 3); u.pn = (int)tile_e[u.pm] * 8 + (int)(L & 7); u.part = 0; return true; }
        L -= n1; if (L >= (long)ntiles * 4) return false;
        u.pm = (int)(L >> 2); u.pn = (int)tile_e[u.pm] * 4 + (int)(L & 3); u.part = 1; return true;
    }
    __device__ __forceinline__ void a_ready(const Unit& u) const {
        if (u.part == 0) return;
        if (threadIdx.x < 64) {
            unsigned spins = 0;
            while ((unsigned)__builtin_amdgcn_readfirstlane(__hip_atomic_load(ready + 64 * u.pm, __ATOMIC_RELAXED, __HIP_MEMORY_SCOPE_AGENT)) < 64u) {
                __builtin_amdgcn_s_sleep(2);
                if (++spins > (1u << 22)) { if (threadIdx.x == 0) __hip_atomic_store(tmo, 1u, __ATOMIC_RELAXED, __HIP_MEMORY_SCOPE_AGENT); break; } }
            __builtin_amdgcn_fence(__ATOMIC_ACQUIRE, "agent");
            asm volatile("s_waitcnt vmcnt(0)" ::: "memory");
        }
        asm volatile("" ::: "memory"); __builtin_amdgcn_s_barrier(); asm volatile("" ::: "memory");
    }
    __device__ __forceinline__ void done(const Unit& u) const {
        if (u.part != 0) return;
        asm volatile("s_waitcnt vmcnt(0)" ::: "memory");
        if ((threadIdx.x & 63) == 0) __hip_atomic_fetch_add(ready + 64 * u.pm, 1u, __ATOMIC_RELAXED, __HIP_MEMORY_SCOPE_AGENT);
    }
};
struct EpiMoe {
    static constexpr bool PERM = true, AFTER_DRAIN = false, HAS_MID = false;
    EpiSwiGLU<true> e0; EpiDown e1;
    __device__ __forceinline__ bool keep(const Unit&) const { return false; }
    __device__ __forceinline__ void operator()(f32x4 (&acc)[2][2][4][2], const Unit& u, int wr, int wc, int fr, int fq) const {
        if (u.part == 0) e0(acc, u, wr, wc, fr, fq); else e1(acc, u, wr, wc, fr, fq);
    }
};
template <class Epi, class Sched, bool ALIGN_EPI = false, bool SP2 = false, bool FP8 = false, bool GATHER = false, bool MULTI = false>
__device__ __forceinline__ void gemm_phase(PG8_LAS unsigned char* lds, const Gemm g, const Sched& S, const Epi& E) {
    typedef typename FragT<FP8>::type frag_t;
    const int tid = threadIdx.x, wid = __builtin_amdgcn_readfirstlane(tid >> 6), lane = tid & 63, wr = wid >> 2, wc = wid & 3, fr = lane & 15, fq = lane >> 4;
    int K_ = g.K; asm volatile("" : "+s"(K_));
    const int K = K_, ntfull = K / BK;
    unsigned voffA[2], voffB[2];
#pragma unroll
    for (int i = 0; i < 2; ++i) { int R, C; stage_rc(tid * 16 + i * 8192, R, C); const int Rb = Epi::PERM ? ((R & ~31) + perm32(R & 31)) : R;
        voffA[i] = (unsigned)(R * K + C) * 2u; voffB[i] = (unsigned)(Rb * K + C) * 2u; }
    const size_t kstep = (size_t)(BK * 2);
    const size_t hstep = (size_t)HALF * K * 2;
    const size_t tstep = 2 * hstep;
    const unsigned ldsw = (unsigned)wid * 1024u;
    const int aoff = lds_byte(wr * 64 + fr, fq * (FP8 ? 16 : 8)), boff = lds_byte(wc * 32 + fr, fq * (FP8 ? 16 : 8));
    constexpr int NKF = FP8 ? 1 : 2;
#define PG8_SA(b, h) (((b) * 2 + (h)) * HTB)
#define PG8_SB(b, h) ((4 + (b) * 2 + (h)) * HTB)
#define PG8_STAGE(bufoff, gbase, voff) do { _Pragma("unroll") for (int _i = 0; _i < 2; ++_i) \
        __builtin_amdgcn_global_load_lds((const unsigned*)((const char*)(gbase) + (voff)[_i]), (PG8_LAS unsigned*)(lds + (bufoff) + ldsw + _i * 8192), 16, 0, 0); } while (0)
#define PG8_STAGEA(bufoff, gbase, half, isnext) do { if constexpr (GATHER) { unsigned vs_[2]; vs_[0] = (isnext) ? voffAn[half][0] : voffAc[half][0]; vs_[1] = (isnext) ? voffAn[half][1] : voffAc[half][1]; PG8_STAGE(bufoff, gbase, vs_); } \
        else { PG8_STAGE(bufoff, (gbase) + (half) * hstep, voffA); } } while (0)
#define PG8_LDA(dst, b, h) do { _Pragma("unroll") for (int m = 0; m < 4; ++m) _Pragma("unroll") for (int k = 0; k < NKF; ++k) dst[m][k] = *(const PG8_LAS frag_t*)(lds + PG8_SA(b, h) + aoff + m * 2048 + k * 1024); } while (0)
#define PG8_LDB(dst, b, h) do { _Pragma("unroll") for (int n = 0; n < 2; ++n) _Pragma("unroll") for (int k = 0; k < NKF; ++k) dst[n][k] = *(const PG8_LAS frag_t*)(lds + PG8_SB(b, h) + boff + n * 2048 + k * 1024); } while (0)
#define PG8_MMA(ai, bj, At, Bt) do { __builtin_amdgcn_s_setprio(1); \
        if constexpr (FP8) { _Pragma("unroll") for (int m = 0; m < 4; ++m) _Pragma("unroll") for (int n = 0; n < 2; ++n) \
            acc[ai][bj][m][n] = mma8(Bt[n][0], At[m][0], acc[ai][bj][m][n]); } \
        else { _Pragma("unroll") for (int m = 0; m < 4; ++m) _Pragma("unroll") for (int n = 0; n < 2; ++n) _Pragma("unroll") for (int k = 0; k < 2; ++k) \
            acc[ai][bj][m][n] = mma16(Bt[n][k], At[m][k], acc[ai][bj][m][n]); } \
        __builtin_amdgcn_s_setprio(0); } while (0)
#define PG8_WAIT_V(n) asm volatile("s_waitcnt vmcnt(" #n ")" ::: "memory")
#define PG8_WAIT_L(n) asm volatile("s_waitcnt lgkmcnt(" #n ")" ::: "memory")
#define PG8_BAR __builtin_amdgcn_s_barrier()
#define PG8_SCHED __builtin_amdgcn_sched_barrier(0)
    Unit cur, nxt; int ui = 0;
    if (!S.next(0, cur)) return;
    unsigned voffAc[2][2], voffAn[2][2];
#define PG8_GROWS(dst, u_) do { if constexpr (GATHER) { _Pragma("unroll") for (int h_ = 0; h_ < 2; ++h_) _Pragma("unroll") for (int i_ = 0; i_ < 2; ++i_) { int R_, C_; stage_rc(tid * 16 + i_ * 8192, R_, C_); \
        const int ri_ = S.rowsel((u_), (u_).pm * BM + h_ * HALF + R_); dst[h_][i_] = (unsigned)ri_ * (unsigned)(K * 2) + (unsigned)(C_ * 2); } } } while (0)
    PG8_GROWS(voffAc, cur);
    f32x4 acc[2][2][4][2];
#pragma unroll
    for (int a = 0; a < 2; ++a)
#pragma unroll
        for (int b = 0; b < 2; ++b)
#pragma unroll
            for (int m = 0; m < 4; ++m)
#pragma unroll
                for (int n = 0; n < 2; ++n) acc[a][b][m][n] = (f32x4){0.f, 0.f, 0.f, 0.f};
    frag_t At[4][NKF], B0[2][NKF], B1[2][NKF];
    const char* cA = (MULTI ? (const char*)S.abase(cur) : (const char*)g.A) + (GATHER ? (size_t)0 : (size_t)cur.pm * tstep) + (size_t)S.kt0(cur) * kstep; const char* cB = (MULTI ? (const char*)S.bbase(cur) : (const char*)g.Bt) + (size_t)cur.pn * tstep + (size_t)S.kt0(cur) * kstep;
    S.a_ready(cur);
    if constexpr (SP2) {
        PG8_STAGE(PG8_SB(0, 0), cB, voffB); PG8_STAGE(PG8_SB(0, 1), cB + hstep, voffB); PG8_STAGEA(PG8_SA(0, 0), cA, 0, false); PG8_STAGEA(PG8_SA(0, 1), cA, 1, false);
        if (wr == 1) PG8_BAR;
        PG8_WAIT_V(2); PG8_BAR;
        PG8_STAGE(PG8_SB(1, 0), cB + kstep, voffB); PG8_STAGEA(PG8_SA(1, 0), cA + kstep, 0, false); PG8_STAGE(PG8_SB(1, 1), cB + hstep + kstep, voffB);
        PG8_WAIT_V(6); PG8_BAR;
    } else {
        PG8_STAGE(PG8_SB(0, 0), cB, voffB); PG8_STAGEA(PG8_SA(0, 0), cA, 0, false); PG8_STAGE(PG8_SB(0, 1), cB + hstep, voffB); PG8_STAGEA(PG8_SA(0, 1), cA, 1, false);
        if (wr == 1) PG8_BAR;
        PG8_WAIT_V(4); PG8_BAR;
        PG8_STAGE(PG8_SB(1, 0), cB + kstep, voffB); PG8_STAGEA(PG8_SA(1, 0), cA + kstep, 0, false); PG8_STAGE(PG8_SB(1, 1), cB + hstep + kstep, voffB);
        PG8_WAIT_V(6); PG8_BAR;
    }
    for (;;) {
        const bool has_next = S.next(ui + 1, nxt);
        if (has_next) PG8_GROWS(voffAn, nxt);
        else if constexpr (GATHER) { _Pragma("unroll") for (int h_ = 0; h_ < 2; ++h_) _Pragma("unroll") for (int i_ = 0; i_ < 2; ++i_) voffAn[h_][i_] = voffAc[h_][i_]; }
        const char* nA = has_next ? (MULTI ? (const char*)S.abase(nxt) : (const char*)g.A) + (GATHER ? (size_t)0 : (size_t)nxt.pm * tstep) + (size_t)S.kt0(nxt) * kstep : cA; const char* nB = has_next ? (MULTI ? (const char*)S.bbase(nxt) : (const char*)g.Bt) + (size_t)nxt.pn * tstep + (size_t)S.kt0(nxt) * kstep : cB;
        const int nt = S.nkt(cur, ntfull);
        for (int t = 0; t < nt; t += 2) {
            const bool last = (t == nt - 2);
            const char* a1 = cA + (size_t)(t + 1) * kstep;
            const char* a2 = last ? nA : cA + (size_t)(t + 2) * kstep; const char* b2 = last ? nB : cB + (size_t)(t + 2) * kstep;
            const char* a3 = a2 + kstep; const char* b3 = b2 + kstep;
            if (last && has_next) S.a_ready(nxt);
            if constexpr (SP2) {
            PG8_LDB(B0, 0, 0); PG8_LDB(B1, 0, 1); PG8_SCHED; PG8_LDA(At, 0, 0); PG8_STAGEA(PG8_SA(1, 1), a1, 1, false);
            PG8_WAIT_V(8); PG8_WAIT_L(0); PG8_BAR; PG8_MMA(0, 0, At, B0); PG8_MMA(0, 1, At, B1); PG8_BAR; PG8_SCHED;
            PG8_LDA(At, 0, 1); PG8_STAGE(PG8_SB(0, 0), b2, voffB); PG8_STAGE(PG8_SB(0, 1), b2 + hstep, voffB); PG8_STAGEA(PG8_SA(0, 0), a2, 0, last);
            PG8_WAIT_V(8); PG8_WAIT_L(0); PG8_BAR; PG8_MMA(1, 0, At, B0); PG8_MMA(1, 1, At, B1); PG8_BAR; PG8_SCHED;
            PG8_LDB(B0, 1, 0); PG8_LDB(B1, 1, 1); PG8_SCHED; PG8_LDA(At, 1, 0); PG8_STAGEA(PG8_SA(0, 1), a2, 1, last);
            PG8_WAIT_V(8); PG8_WAIT_L(0); PG8_BAR; PG8_MMA(0, 0, At, B0); PG8_MMA(0, 1, At, B1); PG8_BAR; PG8_SCHED;
            PG8_LDA(At, 1, 1); PG8_STAGE(PG8_SB(1, 0), b3, voffB); PG8_STAGE(PG8_SB(1, 1), b3 + hstep, voffB); PG8_STAGEA(PG8_SA(1, 0), a3, 0, last);
            PG8_WAIT_V(8); PG8_WAIT_L(0); PG8_BAR; PG8_MMA(1, 0, At, B0); PG8_MMA(1, 1, At, B1); PG8_BAR; PG8_SCHED;
            } else {
            PG8_LDB(B0, 0, 0); PG8_SCHED; PG8_LDA(At, 0, 0); PG8_STAGEA(PG8_SA(1, 1), a1, 1, false);
            PG8_WAIT_L(8); PG8_BAR; PG8_WAIT_L(0); PG8_MMA(0, 0, At, B0); PG8_BAR; PG8_SCHED;
            PG8_LDB(B1, 0, 1); PG8_STAGE(PG8_SB(0, 0), b2, voffB);
            PG8_BAR; PG8_WAIT_L(0); PG8_MMA(0, 1, At, B1); PG8_BAR;
            PG8_LDA(At, 0, 1); PG8_STAGEA(PG8_SA(0, 0), a2, 0, last);
            PG8_BAR; PG8_WAIT_L(0); PG8_MMA(1, 0, At, B0); PG8_BAR; PG8_SCHED;
            PG8_STAGE(PG8_SB(0, 1), b2 + hstep, voffB);
            PG8_WAIT_V(6); PG8_BAR; PG8_MMA(1, 1, At, B1); PG8_BAR;
            PG8_LDB(B0, 1, 0); PG8_SCHED; PG8_LDA(At, 1, 0); PG8_STAGEA(PG8_SA(0, 1), a2, 1, last);
            PG8_WAIT_L(8); PG8_BAR; PG8_WAIT_L(0); PG8_MMA(0, 0, At, B0); PG8_BAR; PG8_SCHED;
            PG8_LDB(B1, 1, 1); PG8_STAGE(PG8_SB(1, 0), b3, voffB);
            PG8_BAR; PG8_WAIT_L(0); PG8_MMA(0, 1, At, B1); PG8_BAR;
            PG8_LDA(At, 1, 1); PG8_STAGEA(PG8_SA(1, 0), a3, 0, last);
            PG8_BAR; PG8_WAIT_L(0); PG8_MMA(1, 0, At, B0); PG8_BAR; PG8_SCHED;
            PG8_STAGE(PG8_SB(1, 1), b3 + hstep, voffB);
            PG8_WAIT_V(6); PG8_BAR; PG8_MMA(1, 1, At, B1); PG8_BAR;
            }
        }
        if constexpr (FP8) asm volatile("s_nop 15\n\ts_nop 15" ::: "memory");
        if constexpr (ALIGN_EPI) { if (wr == 0) PG8_BAR; }
        if constexpr (!Epi::AFTER_DRAIN) { E(acc, cur, wr, wc, fr, fq); S.done(cur); }
        if (!has_next) break;
        if (!E.keep(cur)) {
#pragma unroll
        for (int a = 0; a < 2; ++a)
#pragma unroll
            for (int b = 0; b < 2; ++b)
#pragma unroll
                for (int m = 0; m < 4; ++m)
#pragma unroll
                    for (int n = 0; n < 2; ++n) acc[a][b][m][n] = (f32x4){0.f, 0.f, 0.f, 0.f};
        }
        cur = nxt; cA = nA; cB = nB; ++ui;
        if constexpr (GATHER) { _Pragma("unroll") for (int h_ = 0; h_ < 2; ++h_) _Pragma("unroll") for (int i_ = 0; i_ < 2; ++i_) voffAc[h_][i_] = voffAn[h_][i_]; }
        if constexpr (ALIGN_EPI) { if (wr == 1) PG8_BAR; }
    }
    PG8_WAIT_V(0);
    if constexpr (!ALIGN_EPI) { if (wr == 0) PG8_BAR; }
    PG8_BAR;
    if constexpr (Epi::AFTER_DRAIN) { E.fused(acc, cur, wr, wc, fr, fq, lds, wid, lane); S.done(cur); }
#undef PG8_SA
#undef PG8_SB
#undef PG8_STAGE
#undef PG8_LDA
#undef PG8_STAGEA
#undef PG8_GROWS
#undef PG8_LDB
#undef PG8_MMA
#undef PG8_WAIT_V
#undef PG8_WAIT_L
#undef PG8_BAR
#undef PG8_SCHED
}
}
#define XB_TMO      128
#define XB_XCNT(j)  (256  + 64 * (j))
#define XB_XSUB(j)  (1280 + 64 * (j))
#define XB_XGEN(j)  (2304 + 64 * (j))
#define XB_TOP      3328
#define XB_TOPGEN   3392
#define XCD_BAR_WORDS 3456
#define XB_SPIN_CAP (1u << 24)

__device__ __forceinline__ unsigned xb_ld(unsigned* p)              { return __hip_atomic_load(p, __ATOMIC_RELAXED, __HIP_MEMORY_SCOPE_AGENT); }
__device__ __forceinline__ unsigned xb_add(unsigned* p, unsigned v) { return __hip_atomic_fetch_add(p, v, __ATOMIC_RELAXED, __HIP_MEMORY_SCOPE_AGENT); }
__device__ __forceinline__ unsigned xb_xcc_id() { return (unsigned)__builtin_amdgcn_s_getreg((3 << 11) | 20) & 0xFu; }
#define XB_SPIN(cond, bar) do { unsigned _sp = 0; while (cond) { __builtin_amdgcn_s_sleep(1); \
    if ((++_sp & 255u) == 0u) { if (xb_ld(&(bar)[XB_TMO])) break; if (_sp > XB_SPIN_CAP) { atomicAdd(&(bar)[XB_TMO], 1u); break; } } } } while (0)

struct XcdBarrier {
    unsigned* bar; unsigned x;
    volatile LAS unsigned* st;
};

__device__ __forceinline__ XcdBarrier xcd_barrier_post(unsigned* bar, volatile LAS unsigned* st) {
    XcdBarrier b; b.bar = bar; b.x = xb_xcc_id(); b.st = st;
    if (threadIdx.x == 0) (void)xb_add(&bar[XB_XCNT(b.x)], 1u);
    return b;
}
__device__ __forceinline__ void xcd_barrier_complete(unsigned* bar, unsigned x, unsigned& nloc, unsigned& nx) {
    const unsigned G = gridDim.x * gridDim.y * gridDim.z;
    unsigned sum, cnt, mine, sp = 0u;
    for (;;) {
        sum = 0u; cnt = 0u; mine = 0u;
#pragma unroll
        for (unsigned j = 0; j < 16; ++j) { const unsigned c = xb_ld(&bar[XB_XCNT(j)]); sum += c; cnt += (c > 0u) ? 1u : 0u; mine = (j == x) ? c : mine; }
        if (sum == G) break;
        __builtin_amdgcn_s_sleep(1);
        if ((++sp & 255u) == 0u) { if (xb_ld(&bar[XB_TMO])) break; if (sp > XB_SPIN_CAP) { atomicAdd(&bar[XB_TMO], 1u); break; } }
    }
    nloc = mine > 0u ? mine : 1u; nx = cnt > 0u ? cnt : 1u;
}

__device__ __forceinline__ void xcd_barrier(const XcdBarrier& b) {
    asm volatile("s_waitcnt vmcnt(0)" ::: "memory");
    __syncthreads();
    if (threadIdx.x == 0) {
        unsigned* bar = b.bar;
        __builtin_amdgcn_s_waitcnt(0);
        unsigned nloc = b.st[0], nx = b.st[1];
        if (nloc == 0u) { xcd_barrier_complete(bar, b.x, nloc, nx); b.st[0] = nloc; b.st[1] = nx; }
        const unsigned old = xb_add(&bar[XB_XSUB(b.x)], 1u);
        const unsigned gen = old / nloc;
        if (old + 1u == (gen + 1u) * nloc) {
            __builtin_amdgcn_fence(__ATOMIC_RELEASE, "agent");
            asm volatile("s_waitcnt vmcnt(0)" ::: "memory");
            const unsigned og = xb_add(&bar[XB_TOP], 1u);
            const unsigned tg = og / nx;
            if (og + 1u == (tg + 1u) * nx) xb_add(&bar[XB_TOPGEN], 1u);
            else XB_SPIN(xb_ld(&bar[XB_TOPGEN]) == tg, bar);
            __builtin_amdgcn_fence(__ATOMIC_ACQUIRE, "agent");
            xb_add(&bar[XB_XGEN(b.x)], 1u);
            asm volatile("s_waitcnt vmcnt(0)" ::: "memory");
        } else {
            XB_SPIN(xb_ld(&bar[XB_XGEN(b.x)]) == gen, bar);
            __builtin_amdgcn_fence(__ATOMIC_ACQUIRE, "agent");
            asm volatile("s_waitcnt vmcnt(0)" ::: "memory");
        }
    }
    __syncthreads();
}

struct Frame {
    LAS unsigned char* lds;
    unsigned* ctl;
    int tid, lane, wave, vcu, G, gw, NGW;
    const float *x, *g_mix, *w_in, *conv_qk, *b_if, *g_mnorm, *w_attn_out, *w_mlstm_out, *w_mix_out, *g_ffn, *w_router, *b_router, *w_gate_up, *b_gate_up, *w_down, *b_down, *g_final;
    const int* positions;
    float* out;
    bf16 *WinT, *WamT, *WoT, *WguT, *WdnT, *XN, *PROJ, *OG, *AM, *MERGED, *XS, *ACT, *YBUF;
    float *GATES, *ROPE, *LSE, *HT, *H, *QC, *KC, *ROW_W, *TOK_W;
    int *TOK_E, *TOK_SLOT, *ROW_TOK;
};

__constant__ double ROPE_REV[16] = {
    1.59154943091895346e-01, 7.00865215877985032e-02, 3.08637634047012298e-02, 1.35913706361939050e-02, 5.98518571271370540e-03, 2.63567589866741401e-03, 1.16066364124006098e-03, 5.11117504537543857e-04,
    2.25079079039276525e-04, 9.91173093690193548e-05, 4.36479527928028909e-05, 1.92211006849448627e-05, 8.46433080824140138e-06, 3.72740860191535193e-06, 1.64142626279503449e-06, 7.22829306883286479e-07};

template <int MAP>
__device__ __forceinline__ void transpose_item(const float* W, int Nsrc, bf16* WT, int ldk, int kofs, int nblk, LAS float* scr, int item, int lane) {
    const int kb = item / nblk, nb = item % nblk, k0 = 64 * kb, n0 = 32 * nb;
    const int np = n0 + (lane & 31);
    const int sc = (MAP == 1) ? win_logical_col(np) : (MAP == 2) ? wgu_logical_col(np) : np;
    float tv[32];
#pragma unroll
    for (int i = 0; i < 32; ++i) tv[i] = W[(size_t)(k0 + 2 * i + (lane >> 5)) * Nsrc + sc];
#pragma unroll
    for (int i = 0; i < 32; ++i) scr[(2 * i + (lane >> 5)) * 33 + (lane & 31)] = tv[i];
    asm volatile("s_waitcnt lgkmcnt(0)" ::: "memory");
    const int c = lane & 7;
#pragma unroll
    for (int j = 0; j < 4; ++j) { const int n = (lane >> 3) + 8 * j; const LAS float* s = scr + (8 * c) * 33 + n;
        u32x4 o; o.x = pk2(s[0 * 33], s[1 * 33]); o.y = pk2(s[2 * 33], s[3 * 33]); o.z = pk2(s[4 * 33], s[5 * 33]); o.w = pk2(s[6 * 33], s[7 * 33]);
        *(u32x4*)(WT + (size_t)(n0 + n) * ldk + kofs + k0 + 8 * c) = o; }
    asm volatile("s_waitcnt lgkmcnt(0)" ::: "memory");
}

template <int MAP>
__device__ __forceinline__ void transpose_item_fp8(const float* W, int Nsrc, unsigned char* WT, int ldk, int nblk, LAS float* scr, int item, int lane, float scale) {
    const int kb = item / nblk, nb = item % nblk, k0 = 64 * kb, n0 = 32 * nb;
    const int np = n0 + (lane & 31);
    const int sc = (MAP == 1) ? win_logical_col(np) : (MAP == 2) ? wgu_logical_col(np) : np;
    float tv[32];
#pragma unroll
    for (int i = 0; i < 32; ++i) tv[i] = W[(size_t)(k0 + 2 * i + (lane >> 5)) * Nsrc + sc];
#pragma unroll
    for (int i = 0; i < 32; ++i) scr[(2 * i + (lane >> 5)) * 33 + (lane & 31)] = tv[i] * scale;
    asm volatile("s_waitcnt lgkmcnt(0)" ::: "memory");
    const int n = lane >> 1, c = lane & 1;
#pragma unroll
    for (int q = 0; q < 2; ++q) { const LAS float* s = scr + (32 * c + 16 * q) * 33 + n;
        u32x4 o; o.x = pk4_fp8(s[0 * 33], s[1 * 33], s[2 * 33], s[3 * 33]); o.y = pk4_fp8(s[4 * 33], s[5 * 33], s[6 * 33], s[7 * 33]);
        o.z = pk4_fp8(s[8 * 33], s[9 * 33], s[10 * 33], s[11 * 33]); o.w = pk4_fp8(s[12 * 33], s[13 * 33], s[14 * 33], s[15 * 33]);
        *(u32x4*)(WT + (size_t)(n0 + n) * ldk + k0 + 32 * c + 16 * q) = o; }
    asm volatile("s_waitcnt lgkmcnt(0)" ::: "memory");
}

template <int MAP>
__device__ __forceinline__ void tr8_load(const float* W, int Nsrc, int nblk, int item, int lane, float (&tv)[32]) {
    const int kb = item / nblk, nb = item % nblk, k0 = 64 * kb, np = 32 * nb + (lane & 31);
    const int sc = (MAP == 1) ? win_logical_col(np) : (MAP == 2) ? wgu_logical_col(np) : np;
#pragma unroll
    for (int i = 0; i < 32; ++i) tv[i] = W[(size_t)(k0 + 2 * i + (lane >> 5)) * Nsrc + sc];
}
__device__ __forceinline__ void tr8_store(const float (&tv)[32], unsigned char* WT, int ldk, int nblk, LAS float* scr, int item, int lane, float scale) {
    const int kb = item / nblk, nb = item % nblk, k0 = 64 * kb, n0 = 32 * nb;
#pragma unroll
    for (int i = 0; i < 32; ++i) scr[(2 * i + (lane >> 5)) * 33 + (lane & 31)] = tv[i] * scale;
    asm volatile("s_waitcnt lgkmcnt(0)" ::: "memory");
    const int n = lane >> 1, c = lane & 1;
#pragma unroll
    for (int q = 0; q < 2; ++q) { const LAS float* s = scr + (32 * c + 16 * q) * 33 + n;
        u32x4 o; o.x = pk4_fp8(s[0 * 33], s[1 * 33], s[2 * 33], s[3 * 33]); o.y = pk4_fp8(s[4 * 33], s[5 * 33], s[6 * 33], s[7 * 33]);
        o.z = pk4_fp8(s[8 * 33], s[9 * 33], s[10 * 33], s[11 * 33]); o.w = pk4_fp8(s[12 * 33], s[13 * 33], s[14 * 33], s[15 * 33]);
        *(u32x4*)(WT + (size_t)(n0 + n) * ldk + k0 + 32 * c + 16 * q) = o; }
    asm volatile("s_waitcnt lgkmcnt(0)" ::: "memory");
}

__device__ __forceinline__ void p0_weights(Frame& F) {
    LAS float* scr = (LAS float*)(F.lds + F.wave * 16384);
    constexpr int I_IN = (D / 64) * (NP / 32), I_A = (512 / 64) * (D / 32), I_M = (D / 64) * (D / 32), I_O = I_M;
    constexpr int I_GU1 = (D / 64) * (2048 / 32), I_DN1 = (D / 64) * (D / 32);
    constexpr int NITEMS = I_IN + I_A + I_M + I_O + ((MOE_FP8 && STEAL) ? 0 : NE * I_GU1 + NE * I_DN1);
    for (int it = F.gw; it < NITEMS; it += F.NGW) {
        int r = it;
#if P1_FP8
        if (r < I_IN) { const int pn = (r % (NP / 32)) >> 3;
            if (pn < 18 || pn >= P1_HI) transpose_item_fp8<1>(F.w_in, DIN, (unsigned char*)F.WinT - (pn >= P1_HI ? (size_t)(P1_HI - 18) * 256 * D : (size_t)0), D, NP / 32, scr, r, F.lane, 32.0f);
            else transpose_item<1>(F.w_in, DIN, F.WinT, D, 0, NP / 32, scr, r, F.lane);
            continue; } r -= I_IN;
#else
        if (r < I_IN) { transpose_item<1>(F.w_in, DIN, F.WinT, D, 0, NP / 32, scr, r, F.lane); continue; } r -= I_IN;
#endif
        if (r < I_A) { transpose_item<0>(F.w_attn_out, D, F.WamT, AMLD, 0, D / 32, scr, r, F.lane); continue; } r -= I_A;
        if (r < I_M) { transpose_item<0>(F.w_mlstm_out, D, F.WamT, AMLD, 512, D / 32, scr, r, F.lane); continue; } r -= I_M;
        if (r < I_O) { transpose_item<0>(F.w_mix_out, D, F.WamT, AMLD, 1536, D / 32, scr, r, F.lane); continue; } r -= I_O;
#if MOE_FP8 && STEAL
        (void)r;
#elif MOE_FP8
        if (r < NE * I_GU1) { const int e = r / I_GU1; transpose_item_fp8<2>(F.w_gate_up + (size_t)e * D * 2048, 2048, (unsigned char*)F.WguT + (size_t)e * 2048 * D, D, 2048 / 32, scr, r % I_GU1, F.lane, 32.0f); continue; } r -= NE * I_GU1;
        { const int e = r / I_DN1; transpose_item_fp8<0>(F.w_down + (size_t)e * D * D, D, (unsigned char*)F.WdnT + (size_t)e * D * D, D, D / 32, scr, r % I_DN1, F.lane, 32.0f); }
#else
        if (r < NE * I_GU1) { const int e = r / I_GU1; transpose_item<2>(F.w_gate_up + (size_t)e * D * 2048, 2048, F.WguT + (size_t)e * 2048 * D, D, 0, 2048 / 32, scr, r % I_GU1, F.lane); continue; } r -= NE * I_GU1;
        { const int e = r / I_DN1; transpose_item<0>(F.w_down + (size_t)e * D * D, D, F.WdnT + (size_t)e * D * D, D, 0, D / 32, scr, r % I_DN1, F.lane); }
#endif
    }
}

__device__ __forceinline__ void p0_rows(Frame& F) {
    LAS float* w8t = (LAS float*)(F.lds);
    __syncthreads();
    { float w8v[16];
#pragma unroll
      for (int j = 0; j < 16; ++j) { const int i = F.tid + j * NTHREADS; w8v[j] = F.w_in[(size_t)(i >> 3) * DIN + 8704 + (i & 7)]; }
#pragma unroll
      for (int j = 0; j < 16; ++j) { const int i = F.tid + j * NTHREADS; w8t[(i & 7) * 1024 + (i >> 3)] = w8v[j]; } }
    __syncthreads();
    f32x4 vnx[4];
    if (F.gw < T) { const f32x4* xr = (const f32x4*)(F.x + (size_t)F.gw * D) + F.lane;
#pragma unroll
        for (int j = 0; j < 4; ++j) vnx[j] = xr[64 * j]; }
    for (int row = F.gw; row < T; row += F.NGW) {
        f32x4 v[4]; float s = 0.f;
#pragma unroll
        for (int j = 0; j < 4; ++j) { v[j] = vnx[j]; s += (v[j].x * v[j].x + v[j].y * v[j].y) + (v[j].z * v[j].z + v[j].w * v[j].w); }
        if (row + F.NGW < T) { const f32x4* xr = (const f32x4*)(F.x + (size_t)(row + F.NGW) * D) + F.lane;
#pragma unroll
            for (int j = 0; j < 4; ++j) vnx[j] = xr[64 * j]; }
        const float rstd = 1.0f / sqrtf(wave_sum(s) * (1.0f / D) + RMS_EPS);
        float ga[8];
#pragma unroll
        for (int o = 0; o < 8; ++o) ga[o] = 0.f;
        unsigned long long* o8 = (unsigned long long*)(F.XN + (size_t)row * D) + F.lane;
#pragma unroll
        for (int j = 0; j < 4; ++j) {
            const f32x4 g = *((const f32x4*)F.g_mix + F.lane + 64 * j);
            v[j] = v[j] * rstd * g;
            o8[64 * j] = (unsigned long long)pk2(v[j].x, v[j].y) | ((unsigned long long)pk2(v[j].z, v[j].w) << 32);
#if P1_FP8
            ((unsigned*)((unsigned char*)F.ctl + WS_XN8 + (size_t)row * D))[F.lane + 64 * j] = pk4_fp8(v[j].x, v[j].y, v[j].z, v[j].w);
#endif
#pragma unroll
            for (int o = 0; o < 8; ++o) { const f32x4 w = *((const LAS f32x4*)(w8t + o * 1024) + F.lane + 64 * j); ga[o] += (v[j].x * w.x + v[j].y * w.y) + (v[j].z * w.z + v[j].w * w.w); }
        }
#pragma unroll
        for (int o = 0; o < 8; ++o) ga[o] = wave_sum(ga[o]);
        if (F.lane < 8) { float gv = ga[0];
#pragma unroll
            for (int o = 1; o < 8; ++o) gv = (F.lane == o) ? ga[o] : gv;
            F.GATES[(size_t)row * 8 + F.lane] = gv + F.b_if[F.lane]; }
        if (F.lane < 16) {
            const int pos = F.positions[row];
            double rev = (double)pos * ROPE_REV[F.lane]; rev -= floor(rev);
            const float fr = (float)rev;
            F.ROPE[(size_t)row * 32 + F.lane] = __builtin_amdgcn_cosf(fr);
            F.ROPE[(size_t)row * 32 + 16 + F.lane] = __builtin_amdgcn_sinf(fr);
        }
    }
}

template <int RT, class AF, class BF, class EP>
__device__ __forceinline__ void naive_gemm(Frame& F, int M, int N, int K, AF af, BF bf, EP ep) {
    const long gthreads = (long)F.G * NTHREADS, gtid = (long)blockIdx.x * NTHREADS + F.tid;
    for (long it = gtid; it < (long)(M / RT) * N; it += gthreads) {
        const int col = (int)(it % N), r0 = (int)(it / N) * RT;
        float acc[RT];
#pragma unroll
        for (int r = 0; r < RT; ++r) acc[r] = 0.f;
        for (int k = 0; k < K; ++k) { const float b = bf(k, col);
#pragma unroll
            for (int r = 0; r < RT; ++r) acc[r] += af(r0 + r, k) * b; }
#pragma unroll
        for (int r = 0; r < RT; ++r) ep(r0 + r, col, acc[r]);
    }
}

__device__ __forceinline__ void naive_p1(Frame& F) {
    const bf16* XN = F.XN; const float* W = F.w_in; bf16* P = F.PROJ;
    naive_gemm<8>(F, T, NP, D,
        [=](int r, int k) { return bf2f(XN[(size_t)r * D + k]); },
        [=](int k, int c) { return bf2f(f2bf(W[(size_t)k * DIN + win_logical_col(c)])); },
        [=](int r, int c, float a) { P[(size_t)r * NP + c] = (bf16)f2bf(a * (c < C_AK ? QSCALE : 1.0f)); });
}
__device__ __forceinline__ void naive_p1_rope(Frame& F) {
    const long gthreads = (long)F.G * NTHREADS, gtid = (long)blockIdx.x * NTHREADS + F.tid;
    for (long it = gtid; it < (long)T * 24 * 16; it += gthreads) {
        const int i = (int)(it & 15), hh = (int)((it >> 4) % 24), row = (int)(it / (24 * 16));
        const int a = i >> 2, j = i & 3; bf16* p = F.PROJ + (size_t)row * NP + hh * 128;
        const float x1 = bf2f(p[8 * a + j]), x2 = bf2f(p[8 * a + 4 + j]), cs = F.ROPE[(size_t)row * 32 + i], sn = F.ROPE[(size_t)row * 32 + 16 + i];
        p[8 * a + j] = (bf16)f2bf(x1 * cs - x2 * sn); p[8 * a + 4 + j] = (bf16)f2bf(x2 * cs + x1 * sn);
    }
}
__device__ __forceinline__ void naive_attn(Frame& F) {
    for (int it = F.gw; it < T * 12; it += F.NGW) {
        const int row = it / 12, gh = it % 12, g = gh >> 2, h = gh & 3, b = row / SEQ, t = row % SEQ, d = (g == 0) ? 1 : (g == 1) ? 4 : 16, i = t / d, r = t % d;
        const int hc = g * 512 + h * 128 + 2 * F.lane;
        const unsigned qw = *(const unsigned*)(F.PROJ + (size_t)row * NP + C_AQ + hc); const float q0 = bflo(qw), q1 = bfhi(qw);
        float m = -INFINITY, l = 0.f, o0 = 0.f, o1 = 0.f;
        for (int ii = (i > 128 ? i - 128 : 0); ii <= i; ++ii) {
            const size_t kr = (size_t)(b * SEQ + r + d * ii) * NP;
            const unsigned kw = *(const unsigned*)(F.PROJ + kr + C_AK + hc), vw = *(const unsigned*)(F.PROJ + kr + C_AV + hc);
            const float s = wave_sum(q0 * bflo(kw) + q1 * bfhi(kw));
            const float mn = fmaxf(m, s), al = exp2f(m - mn), p = exp2f(s - mn);
            l = l * al + p; o0 = o0 * al + p * bflo(vw); o1 = o1 * al + p * bfhi(vw); m = mn;
        }
        const float il = 1.0f / l;
        *(unsigned*)(F.OG + ((size_t)g * T + row) * 512 + h * 128 + 2 * F.lane) = pk2(o0 * il, o1 * il);
        if (F.lane == 0) F.LSE[((size_t)g * T + row) * 4 + h] = m + log2f(l);
    }
}
__device__ __forceinline__ void naive_conv(Frame& F) {
    const long gthreads = (long)F.G * NTHREADS, gtid = (long)blockIdx.x * NTHREADS + F.tid;
    for (long it = gtid; it < (long)T * 2048; it += gthreads) {
        const int c = (int)(it & 2047), row = (int)(it >> 11), t = row % SEQ;
        float a = 0.f;
#pragma unroll
        for (int j = 0; j < 4; ++j) if (t - 3 + j >= 0) a += F.conv_qk[j * 2048 + c] * bf2f(F.PROJ[(size_t)(row - 3 + j) * NP + C_MQ + c]);
        const float y = a / (1.0f + __expf(-a));
        if (c < 1024) F.QC[(size_t)row * 1024 + c] = y; else F.KC[(size_t)row * 1024 + c - 1024] = y * 0.0625f;
    }
}
__device__ __forceinline__ void naive_mlstm(Frame& F) {
    LAS float* sq = (LAS float*)F.lds; LAS float* sk = sq + 256; LAS float* red = sk + 256; LAS float* redn = red + 512;
    for (int item = blockIdx.x; item < NB * 4 * 8; item += F.G) {
        const int sl = item & 7, h = (item >> 3) & 3, b = item >> 5, dvl = F.tid & 31, dkp = F.tid >> 5;
        float c[16], n[16];
#pragma unroll
        for (int j = 0; j < 16; ++j) { c[j] = 0.f; n[j] = 0.f; }
        float m = 0.f;
        for (int t = 0; t < SEQ; ++t) {
            const size_t row = (size_t)b * SEQ + t;
            __syncthreads();
            if (F.tid < 256) sq[F.tid] = F.QC[row * 1024 + h * 256 + F.tid]; else sk[F.tid - 256] = F.KC[row * 1024 + h * 256 + F.tid - 256];
            const float v = bf2f(F.PROJ[row * NP + C_MV + h * 256 + sl * 32 + dvl]);
            const float ir = F.GATES[row * 8 + h], fr = F.GATES[row * 8 + 4 + h];
            const float logf = fminf(fr, 0.f) - log1pf(__expf(-fabsf(fr)));
            const float mn = fmaxf(logf + m, ir), fa = __expf(logf + m - mn), ia = __expf(ir - mn);
            m = mn;
            __syncthreads();
            float pn = 0.f, pd = 0.f;
#pragma unroll
            for (int j = 0; j < 16; ++j) { const float kk = sk[dkp * 16 + j], qq = sq[dkp * 16 + j]; c[j] = fa * c[j] + ia * kk * v; n[j] = fa * n[j] + ia * kk; pn += qq * c[j]; pd += qq * n[j]; }
            red[dkp * 32 + dvl] = pn; redn[dkp * 32 + dvl] = pd;
            __syncthreads();
            if (F.tid < 32) { float num = 0.f, den = 0.f;
#pragma unroll
                for (int p = 0; p < 16; ++p) { num += red[p * 32 + F.tid]; den += redn[p * 32 + F.tid]; }
                F.HT[row * 1024 + h * 256 + sl * 32 + F.tid] = num / fmaxf(fabsf(den), __expf(-mn)); }
        }
    }
}
__device__ __forceinline__ void naive_p4(Frame& F) {
    const bf16 *AM = F.AM, *PJ = F.PROJ; const float *WA = F.w_attn_out, *WM = F.w_mlstm_out; bf16* O = F.AM + 1536;
    float* tmp = F.QC;
    naive_gemm<8>(F, T, D, 512, [=](int r, int k) { return bf2f(AM[(size_t)r * AMLD + k]); }, [=](int k, int c) { return bf2f(f2bf(WA[(size_t)k * D + c])); },
        [=](int r, int c, float a) { tmp[(size_t)r * D + c] = a * sigmoidf_(bf2f(PJ[(size_t)r * NP + C_GA + c])); });
    __threadfence();
    naive_gemm<8>(F, T, D, D, [=](int r, int k) { return bf2f(AM[(size_t)r * AMLD + 512 + k]); }, [=](int k, int c) { return bf2f(f2bf(WM[(size_t)k * D + c])); },
        [=](int r, int c, float a) { O[(size_t)r * AMLD + c] = (bf16)f2bf(tmp[(size_t)r * D + c] + a * sigmoidf_(bf2f(PJ[(size_t)r * NP + C_GM + c]))); });
}
__device__ __forceinline__ void naive_p5(Frame& F) {
    const bf16* MG = F.AM + 1536; const float *WO = F.w_mix_out, *X = F.x; float* H = F.H;
    naive_gemm<8>(F, T, D, D, [=](int r, int k) { return bf2f(MG[(size_t)r * AMLD + k]); }, [=](int k, int c) { return bf2f(f2bf(WO[(size_t)k * D + c])); },
        [=](int r, int c, float a) { H[(size_t)r * D + c] = X[(size_t)r * D + c] + a; });
}
__device__ __forceinline__ void naive_p8(Frame& F, int ntiles) {
    const long gthreads = (long)F.G * NTHREADS, gtid = (long)blockIdx.x * NTHREADS + F.tid;
    const unsigned* tile_e = F.ctl + CW_TILEE;
    for (long it = gtid; it < (long)ntiles * 256 * D; it += gthreads) {
        const int j = (int)(it & 1023), row = (int)(it >> 10), e = (int)tile_e[row >> 8];
        if (F.ROW_TOK[row] < 0) { F.ACT[(size_t)row * D + j] = 0; continue; }
        const float* W = F.w_gate_up + (size_t)e * D * 2048; float g = 0.f, u = 0.f;
        for (int k = 0; k < D; ++k) { const float a = bf2f(F.XS[(size_t)row * D + k]); g += a * bf2f(f2bf(W[(size_t)k * 2048 + 2 * j])); u += a * bf2f(f2bf(W[(size_t)k * 2048 + 2 * j + 1])); }
        g += F.b_gate_up[e * 2048 + 2 * j]; u += F.b_gate_up[e * 2048 + 2 * j + 1];
        const float gg = fminf(g, 7.0f), uu = fminf(fmaxf(u, -7.0f), 7.0f);
        F.ACT[(size_t)row * D + j] = (bf16)f2bf((uu + 1.0f) * gg / (1.0f + __expf(-1.702f * gg)));
    }
}
__device__ __forceinline__ void naive_p9(Frame& F, int ntiles) {
    const long gthreads = (long)F.G * NTHREADS, gtid = (long)blockIdx.x * NTHREADS + F.tid;
    const unsigned* tile_e = F.ctl + CW_TILEE;
    for (long it = gtid; it < (long)ntiles * 256 * D; it += gthreads) {
        const int c = (int)(it & 1023), row = (int)(it >> 10), e = (int)tile_e[row >> 8], tk = F.ROW_TOK[row];
        if (tk < 0) continue;
        const float* W = F.w_down + (size_t)e * D * D; float y = 0.f;
        for (int k = 0; k < D; ++k) y += bf2f(F.ACT[(size_t)row * D + k]) * bf2f(f2bf(W[(size_t)k * D + c]));
        F.YBUF[(size_t)tk * D + c] = (bf16)f2bf((y + F.b_down[e * D + c]) * F.ROW_W[row]);
    }
}

__device__ __forceinline__ void p3_post_mixer(Frame& F) {
    for (int row = F.gw; row < T; row += F.NGW) {
        { const int h = F.lane >> 4; float l0 = F.LSE[((size_t)0 * T + row) * 4 + h], l1 = F.LSE[((size_t)1 * T + row) * 4 + h], l2 = F.LSE[((size_t)2 * T + row) * 4 + h];
          const float mx = fmaxf(l0, fmaxf(l1, l2)); float w0 = exp2f(l0 - mx), w1 = exp2f(l1 - mx), w2 = exp2f(l2 - mx); const float inv = 1.0f / (w0 + w1 + w2); w0 *= inv; w1 *= inv; w2 *= inv;
          const u32x4 a = *(const u32x4*)(F.OG + ((size_t)0 * T + row) * 512 + 8 * F.lane), b = *(const u32x4*)(F.OG + ((size_t)1 * T + row) * 512 + 8 * F.lane), c = *(const u32x4*)(F.OG + ((size_t)2 * T + row) * 512 + 8 * F.lane);
          f32x4 a0, a1, b0, b1, c0, c1; pg8::unpack8(a, a0, a1); pg8::unpack8(b, b0, b1); pg8::unpack8(c, c0, c1);
          const f32x4 o0 = a0 * w0 + b0 * w1 + c0 * w2, o1 = a1 * w0 + b1 * w1 + c1 * w2;
          u32x4 w; w.x = pk2(o0[0], o0[1]); w.y = pk2(o0[2], o0[3]); w.z = pk2(o1[0], o1[1]); w.w = pk2(o1[2], o1[3]);
          *(u32x4*)(F.AM + (size_t)row * AMLD + 8 * F.lane) = w; }
        { f32x4 v[4]; float s = 0.f;
#if FAST_MLSTM
          { const bf16* hp = (const bf16*)F.HT + (size_t)row * D + 16 * F.lane; const u32x4 w0 = *(const u32x4*)hp, w1 = *(const u32x4*)(hp + 8); pg8::unpack8(w0, v[0], v[1]); pg8::unpack8(w1, v[2], v[3]); }
#else
          { const float* hp = F.HT + (size_t)row * D + 16 * F.lane;
#pragma unroll
            for (int j = 0; j < 4; ++j) v[j] = *(const f32x4*)(hp + 4 * j); }
#endif
#pragma unroll
          for (int j = 0; j < 4; ++j) s += (v[j].x + v[j].y) + (v[j].z + v[j].w);
          s += __shfl_xor(s, 1); s += __shfl_xor(s, 2); s += __shfl_xor(s, 4); s += __shfl_xor(s, 8);
          const float mu = s * (1.0f / 256.0f); float q = 0.f;
#pragma unroll
          for (int j = 0; j < 4; ++j) { v[j] = v[j] - mu; q += (v[j].x * v[j].x + v[j].y * v[j].y) + (v[j].z * v[j].z + v[j].w * v[j].w); }
          q += __shfl_xor(q, 1); q += __shfl_xor(q, 2); q += __shfl_xor(q, 4); q += __shfl_xor(q, 8);
          const float rstd = 1.0f / sqrtf(q * (1.0f / 256.0f) + LN_EPS);
          const bf16* mo = F.PROJ + (size_t)row * NP + C_MO + 16 * F.lane; bf16* op = F.AM + (size_t)row * AMLD + 512 + 16 * F.lane;
#pragma unroll
          for (int jj = 0; jj < 2; ++jj) { const u32x4 mw = *(const u32x4*)(mo + 8 * jj); f32x4 m0, m1; pg8::unpack8(mw, m0, m1);
              const f32x4 g0 = *(const f32x4*)(F.g_mnorm + 16 * F.lane + 8 * jj), g1 = *(const f32x4*)(F.g_mnorm + 16 * F.lane + 8 * jj + 4);
              const f32x4 o0 = v[2 * jj] * rstd * g0 * pg8::sig4(m0), o1 = v[2 * jj + 1] * rstd * g1 * pg8::sig4(m1);
              u32x4 w; w.x = pk2(o0[0], o0[1]); w.y = pk2(o0[2], o0[3]); w.z = pk2(o1[0], o1[1]); w.w = pk2(o1[2], o1[3]);
              *(u32x4*)(op + 8 * jj) = w; } }
    }
}

constexpr int RT_WS = 1028;
constexpr int RT_TAB = NE * RT_WS * 4, RT_CNT = RT_TAB + 64 * 4 * 12;
static_assert(RT_CNT + 256 <= LDSCTL_OFF, "router LDS map");
__device__ __forceinline__ void p6_router(Frame& F) {
    LAS float* wt = (LAS float*)F.lds;
    LAS int* tab = (LAS int*)(F.lds + RT_TAB); LAS int* cntl = (LAS int*)(F.lds + RT_CNT); LAS int* basel = cntl + 32;
    const int lane = F.lane;
    for (int r0 = 0; r0 < T; r0 += F.NGW * 8) {
        __syncthreads();
        if (r0 == 0) for (int i = F.tid; i < D * NE; i += NTHREADS) wt[(i & 31) * RT_WS + (i >> 5)] = F.w_router[i];
        if (F.tid < 32) cntl[F.tid] = 0;
        __syncthreads();
        f32x4 vn[4];
        { const int row = r0 + F.gw; if (row < T) { const f32x4* hr = (const f32x4*)(F.H + (size_t)row * D) + lane;
#pragma unroll
            for (int j = 0; j < 4; ++j) vn[j] = hr[64 * j]; } }
        for (int ri = 0; ri < 8; ++ri) {
            const int row = r0 + ri * F.NGW + F.gw; if (row >= T) break;
            f32x4 v[4]; float s = 0.f;
#pragma unroll
            for (int j = 0; j < 4; ++j) { v[j] = vn[j]; s += (v[j].x * v[j].x + v[j].y * v[j].y) + (v[j].z * v[j].z + v[j].w * v[j].w); }
            { const int rown = row + F.NGW; if (ri + 1 < 8 && rown < T) { const f32x4* hr = (const f32x4*)(F.H + (size_t)rown * D) + lane;
#pragma unroll
                for (int j = 0; j < 4; ++j) vn[j] = hr[64 * j]; } }
            const float rstd = 1.0f / sqrtf(wave_sum(s) * (1.0f / D) + RMS_EPS);
            unsigned long long* o8 = (unsigned long long*)(F.XN + (size_t)row * D) + lane;
#pragma unroll
            for (int j = 0; j < 4; ++j) { const f32x4 g = *((const f32x4*)F.g_ffn + lane + 64 * j); v[j] = v[j] * rstd * g;
#if MOE_FP8
                ((unsigned*)((unsigned char*)F.XN + (size_t)row * D))[lane + 64 * j] = pk4_fp8(v[j].x, v[j].y, v[j].z, v[j].w); }
#else
                o8[64 * j] = (unsigned long long)pk2(v[j].x, v[j].y) | ((unsigned long long)pk2(v[j].z, v[j].w) << 32); }
#endif
            float lg[32];
#pragma unroll
            for (int e = 0; e < 32; ++e) { float a = 0.f;
#pragma unroll
                for (int j = 0; j < 4; ++j) { const f32x4 w = *((const LAS f32x4*)(wt + e * RT_WS) + lane + 64 * j); a += (v[j].x * w.x + v[j].y * w.y) + (v[j].z * w.z + v[j].w * w.w); }
                lg[e] = a; if ((e & 3) == 3) asm volatile("" ::: "memory"); }
#define RT_BF(N_, O_) do { const bool up = (lane & (O_)) != 0; _Pragma("unroll") for (int i = 0; i < (N_); ++i) { const float send = up ? lg[i] : lg[i + (N_)]; const float keep = up ? lg[i + (N_)] : lg[i]; lg[i] = keep + __shfl_xor(send, (O_)); } } while (0)
            RT_BF(16, 32); RT_BF(8, 16); RT_BF(4, 8); RT_BF(2, 4); RT_BF(1, 2);
#undef RT_BF
            float lgt = lg[0] + __shfl_xor(lg[0], 1);
            const int e = (lane >> 1) & 31;
            lgt += F.b_router[e];
            float tv[4]; int ti[4]; float cur = lgt;
#pragma unroll
            for (int r = 0; r < 4; ++r) { float bv = cur; int bi = e;
#pragma unroll
                for (int o = 2; o < 64; o <<= 1) { const float ov = __shfl_xor(bv, o); const int oi = __shfl_xor(bi, o); if (ov > bv || (ov == bv && oi < bi)) { bv = ov; bi = oi; } }
                tv[r] = bv; ti[r] = bi; if (e == bi) cur = -INFINITY; }
            const float e1 = __expf(tv[1] - tv[0]), e2 = __expf(tv[2] - tv[0]), e3 = __expf(tv[3] - tv[0]), inv = 1.0f / (1.0f + e1 + e2 + e3);
            if (lane < 4) {
                const int ee = (lane == 0) ? ti[0] : (lane == 1) ? ti[1] : (lane == 2) ? ti[2] : ti[3];
                const float ww = ((lane == 0) ? 1.0f : (lane == 1) ? e1 : (lane == 2) ? e2 : e3) * inv;
                const int loc = __hip_atomic_fetch_add(cntl + ee, 1, __ATOMIC_RELAXED, __HIP_MEMORY_SCOPE_WORKGROUP);
                LAS int* tp = tab + ((ri * 8 + F.wave) * 4 + lane) * 3; tp[0] = ee; tp[1] = loc; tp[2] = __float_as_int(ww);
            }
        }
        __syncthreads();
        if (F.tid < 32) basel[F.tid] = (int)atomicAdd(F.ctl + CW_CNT + 64 * F.tid, (unsigned)cntl[F.tid]);
        __syncthreads();
        if (lane < 4) for (int ri = 0; ri < 8; ++ri) {
            const int row = r0 + ri * F.NGW + F.gw; if (row >= T) break;
            const LAS int* tp = tab + ((ri * 8 + F.wave) * 4 + lane) * 3; const int ee = tp[0];
            F.TOK_E[row * 4 + lane] = ee; F.TOK_SLOT[row * 4 + lane] = basel[ee] + tp[1]; F.TOK_W[row * 4 + lane] = __int_as_float(tp[2]);
        }
    }
}

constexpr int RM_WS = 2064;
constexpr int RM_HI = 0, RM_LO = NE * RM_WS, RM_RSTD = 2 * NE * RM_WS, RM_TAB = RM_RSTD + 256, RM_CNT = RM_TAB + 64 * 4 * 12;
static_assert(RM_CNT + 256 <= LDSCTL_OFF, "router LDS map");
__device__ __forceinline__ void p6_router_mfma(Frame& F) {
    LAS unsigned char* L = F.lds;
    LAS float* rstdl = (LAS float*)(L + RM_RSTD); LAS int* tab = (LAS int*)(L + RM_TAB); LAS int* cntl = (LAS int*)(L + RM_CNT); LAS int* basel = cntl + 32;
    const int lane = F.lane, fr = lane & 15, fq = lane >> 4, w = F.wave;
    __syncthreads();
    for (int i0 = F.tid; i0 < D * NE; i0 += 16 * NTHREADS) {
        float wv[16], gv[16];
#pragma unroll
        for (int j = 0; j < 16; ++j) { const int i = i0 + j * NTHREADS; wv[j] = F.w_router[i]; gv[j] = F.g_ffn[i >> 5]; }
#pragma unroll
        for (int j = 0; j < 16; ++j) { const int i = i0 + j * NTHREADS, k = i >> 5, e = i & 31; const float w = wv[j] * gv[j];
            const unsigned hi = f2bf(w), lo = f2bf(w - bf2f(hi));
            *(LAS bf16*)(L + RM_HI + e * RM_WS + 2 * k) = (bf16)hi; *(LAS bf16*)(L + RM_LO + e * RM_WS + 2 * k) = (bf16)lo; } }
    const float br0 = F.b_router[fr], br1 = F.b_router[16 + fr];
    for (int rg = F.vcu; rg < T / 64; rg += F.G) {
        __syncthreads();
        if (F.tid < 32) cntl[F.tid] = 0;
        __syncthreads();
        if (w < 4) {
            const int row0 = rg * 64 + 16 * w;
#if H_BF16
            const bf16* hp = (const bf16*)F.H + (size_t)(row0 + fr) * D + 8 * fq;
#else
            const float* hp = F.H + (size_t)(row0 + fr) * D + 8 * fq;
#endif
            const LAS unsigned char* bh = L + RM_HI + fr * RM_WS + 16 * fq; const LAS unsigned char* bl = L + RM_LO + fr * RM_WS + 16 * fq;
            f32x4 acc[2] = {(f32x4){0.f, 0.f, 0.f, 0.f}, (f32x4){0.f, 0.f, 0.f, 0.f}}; float ss = 0.f;
#pragma unroll 4
            for (int ks = 0; ks < 32; ++ks) {
#if H_BF16
                const u32x4 hw = *(const u32x4*)(hp + 32 * ks);
                { const float q0 = bflo(hw.x), q1 = bfhi(hw.x), q2 = bflo(hw.y), q3 = bfhi(hw.y), q4 = bflo(hw.z), q5 = bfhi(hw.z), q6 = bflo(hw.w), q7 = bfhi(hw.w);
                  ss += (q0 * q0 + q1 * q1) + (q2 * q2 + q3 * q3) + (q4 * q4 + q5 * q5) + (q6 * q6 + q7 * q7); }
                const bf16x8 ahi = __builtin_bit_cast(bf16x8, hw);
#pragma unroll
                for (int nt = 0; nt < 2; ++nt) { const bf16x8 bhi = *(const LAS bf16x8*)(bh + 16 * nt * RM_WS + 64 * ks), blo = *(const LAS bf16x8*)(bl + 16 * nt * RM_WS + 64 * ks);
                    acc[nt] = __builtin_amdgcn_mfma_f32_16x16x32_bf16(ahi, bhi, acc[nt], 0, 0, 0);
                    acc[nt] = __builtin_amdgcn_mfma_f32_16x16x32_bf16(ahi, blo, acc[nt], 0, 0, 0); }
                continue;
#else
                const f32x4 a0 = *(const f32x4*)(hp + 32 * ks), a1 = *(const f32x4*)(hp + 32 * ks + 4);
                ss += (a0.x * a0.x + a0.y * a0.y) + (a0.z * a0.z + a0.w * a0.w) + (a1.x * a1.x + a1.y * a1.y) + (a1.z * a1.z + a1.w * a1.w);
                u32x4 hw; hw.x = pk2(a0.x, a0.y); hw.y = pk2(a0.z, a0.w); hw.z = pk2(a1.x, a1.y); hw.w = pk2(a1.z, a1.w);
                u32x4 lw; lw.x = pk2(a0.x - bflo(hw.x), a0.y - bfhi(hw.x)); lw.y = pk2(a0.z - bflo(hw.y), a0.w - bfhi(hw.y));
                lw.z = pk2(a1.x - bflo(hw.z), a1.y - bfhi(hw.z)); lw.w = pk2(a1.z - bflo(hw.w), a1.w - bfhi(hw.w));
                const bf16x8 ahi = __builtin_bit_cast(bf16x8, hw), alo = __builtin_bit_cast(bf16x8, lw);
#pragma unroll
                for (int nt = 0; nt < 2; ++nt) { const bf16x8 bhi = *(const LAS bf16x8*)(bh + 16 * nt * RM_WS + 64 * ks), blo = *(const LAS bf16x8*)(bl + 16 * nt * RM_WS + 64 * ks);
                    acc[nt] = __builtin_amdgcn_mfma_f32_16x16x32_bf16(ahi, bhi, acc[nt], 0, 0, 0);
                    acc[nt] = __builtin_amdgcn_mfma_f32_16x16x32_bf16(ahi, blo, acc[nt], 0, 0, 0);
                    acc[nt] = __builtin_amdgcn_mfma_f32_16x16x32_bf16(alo, bhi, acc[nt], 0, 0, 0); }
#endif
            }
            ss += __shfl_xor(ss, 16); ss += __shfl_xor(ss, 32);
            const float rstd = 1.0f / sqrtf(ss * (1.0f / D) + RMS_EPS);
            if (fq == 0) rstdl[16 * w + fr] = rstd;
#pragma unroll
            for (int reg = 0; reg < 4; ++reg) {
                const float rs = __shfl(rstd, 4 * fq + reg);
                float c0 = acc[0][reg] * rs + br0, c1 = acc[1][reg] * rs + br1;
                float tv[4]; int ti[4];
#pragma unroll
                for (int r = 0; r < 4; ++r) { float bv = (c0 >= c1) ? c0 : c1; int bi = (c0 >= c1) ? fr : 16 + fr;
#pragma unroll
                    for (int o = 1; o < 16; o <<= 1) { const float ov = __shfl_xor(bv, o); const int oi = __shfl_xor(bi, o); if (ov > bv || (ov == bv && oi < bi)) { bv = ov; bi = oi; } }
                    tv[r] = bv; ti[r] = bi; if (bi == fr) c0 = -INFINITY; if (bi == 16 + fr) c1 = -INFINITY; }
                const float e1 = __expf(tv[1] - tv[0]), e2 = __expf(tv[2] - tv[0]), e3 = __expf(tv[3] - tv[0]), inv = 1.0f / (1.0f + e1 + e2 + e3);
                if (fr < 4) {
                    const int ee = (fr == 0) ? ti[0] : (fr == 1) ? ti[1] : (fr == 2) ? ti[2] : ti[3];
                    const float ww = ((fr == 0) ? 1.0f : (fr == 1) ? e1 : (fr == 2) ? e2 : e3) * inv;
                    const int loc = __hip_atomic_fetch_add(cntl + ee, 1, __ATOMIC_RELAXED, __HIP_MEMORY_SCOPE_WORKGROUP);
                    LAS int* tp = tab + ((16 * w + 4 * fq + reg) * 4 + fr) * 3; tp[0] = ee; tp[1] = loc; tp[2] = __float_as_int(ww);
                }
            }
        }
        __syncthreads();
        if (F.tid < 32) basel[F.tid] = (int)atomicAdd(F.ctl + CW_CNT + 64 * F.tid, (unsigned)cntl[F.tid]);
#pragma unroll 2
        for (int i = 0; i < 8; ++i) { const int rl = 8 * w + i, row = rg * 64 + rl; const float rs = rstdl[rl];
#if H_BF16
            const u32x4* hr = (const u32x4*)((const bf16*)F.H + (size_t)row * D) + lane;
#pragma unroll
            for (int j = 0; j < 2; ++j) { const f32x4 g0 = *((const f32x4*)F.g_ffn + 2 * (lane + 64 * j)), g1 = *((const f32x4*)F.g_ffn + 2 * (lane + 64 * j) + 1); const u32x4 hw = hr[64 * j];
                u32x2 o; o.x = pk4_fp8(bflo(hw.x) * rs * g0.x, bfhi(hw.x) * rs * g0.y, bflo(hw.y) * rs * g0.z, bfhi(hw.y) * rs * g0.w);
                o.y = pk4_fp8(bflo(hw.z) * rs * g1.x, bfhi(hw.z) * rs * g1.y, bflo(hw.w) * rs * g1.z, bfhi(hw.w) * rs * g1.w);
                ((u32x2*)((unsigned char*)F.XN + (size_t)row * D))[lane + 64 * j] = o; } }
#else
            const f32x4* hr = (const f32x4*)(F.H + (size_t)row * D) + lane;
#pragma unroll
            for (int j = 0; j < 4; ++j) { const f32x4 g = *((const f32x4*)F.g_ffn + lane + 64 * j); const f32x4 v = hr[64 * j] * rs * g;
                ((unsigned*)((unsigned char*)F.XN + (size_t)row * D))[lane + 64 * j] = pk4_fp8(v.x, v.y, v.z, v.w); } }
#endif
        __syncthreads();
        if (F.tid < 256) { const int rl = F.tid >> 2, k = F.tid & 3, row = rg * 64 + rl; const LAS int* tp = tab + (rl * 4 + k) * 3; const int ee = tp[0];
#if RM_FUSED
            const int dst = ee * ECAP + basel[ee] + tp[1]; F.ROW_TOK[dst] = row * 4 + k; F.ROW_W[dst] = __int_as_float(tp[2]); }
#else
            F.TOK_E[row * 4 + k] = ee; F.TOK_SLOT[row * 4 + k] = basel[ee] + tp[1]; F.TOK_W[row * 4 + k] = __int_as_float(tp[2]); }
#endif
    }
}

__device__ __forceinline__ void p7_gather(Frame& F) {
    LAS int* pst = (LAS int*)F.lds;
    LAS int* cntl = pst + 64;
    int tid = (int)threadIdx.x; asm volatile("" : "+v"(tid));
    __syncthreads();
    if (tid < NE) cntl[tid] = (int)F.ctl[CW_CNT + 64 * tid];
    __syncthreads();
    if (tid == 0) { int acc = 0; for (int e = 0; e < NE; ++e) { pst[e] = acc; acc += (cntl[e] + 255) & ~255; } pst[NE] = acc; }
    __syncthreads();
    if (blockIdx.x == 0) {
        if (tid == 0) F.ctl[CW_NTILES] = (unsigned)(pst[NE] >> 8);
        if (tid < NE) { const int t0 = pst[tid] >> 8, t1 = pst[tid + 1] >> 8; for (int k = t0; k < t1; ++k) F.ctl[CW_TILEE + k] = (unsigned)tid; }
    }
#if MOE_FP8
    { const int gthreads = F.G * NTHREADS, gtid = F.vcu * NTHREADS + F.tid;
      for (int a = gtid; a < NA; a += gthreads) { const int e = F.TOK_E[a], dest = pst[e] + F.TOK_SLOT[a]; F.ROW_TOK[dest] = a; F.ROW_W[dest] = F.TOK_W[a]; }
      for (int e = 0; e < NE; ++e) { const int c = cntl[e], pe = (c + 255) & ~255;
          for (int r = c + gtid; r < pe; r += gthreads) { F.ROW_TOK[pst[e] + r] = -1; F.ROW_W[pst[e] + r] = 0.f; } } }
#else
    for (int a = F.gw; a < NA; a += F.NGW) {
        const int e = F.TOK_E[a], dest = pst[e] + F.TOK_SLOT[a];
        { const u32x4* src = (const u32x4*)(F.XN + (size_t)(a >> 2) * D) + F.lane; u32x4* dst = (u32x4*)(F.XS + (size_t)dest * D) + F.lane;
        const u32x4 v0 = src[0], v1 = src[64]; dst[0] = v0; dst[64] = v1; }
        if (F.lane == 0) { F.ROW_TOK[dest] = a; F.ROW_W[dest] = F.TOK_W[a]; }
    }
    for (int e = 0; e < NE; ++e) { const int c = cntl[e], pe = (c + 255) & ~255;
        for (int r = c + F.gw; r < pe; r += F.NGW) { const int dest = pst[e] + r; const u32x4 z = (u32x4){0u, 0u, 0u, 0u};
            { u32x4* dst = (u32x4*)(F.XS + (size_t)dest * D) + F.lane; dst[0] = z; dst[64] = z; }
            if (F.lane == 0) { F.ROW_TOK[dest] = -1; F.ROW_W[dest] = 0.f; } } }
#endif
}

__device__ __forceinline__ void p10_final(Frame& F) {
#if H_BF16
    u32x2 hn[4]; u32x2 yn[4][4];
#define P10_LOAD(r_) do { const u32x2* hr_ = (const u32x2*)((const bf16*)F.H + (size_t)(r_) * D) + F.lane; \
        _Pragma("unroll") for (int j = 0; j < 4; ++j) { hn[j] = hr_[64 * j]; _Pragma("unroll") for (int k = 0; k < 4; ++k) yn[j][k] = *((const u32x2*)(F.YBUF + ((size_t)(r_) * 4 + k) * D) + F.lane + 64 * j); } } while (0)
#define P10_H(j_) ((f32x4){bflo(hn[j_].x), bfhi(hn[j_].x), bflo(hn[j_].y), bfhi(hn[j_].y)})
#else
#define P10_H(j_) hn[j_]
    f32x4 hn[4]; u32x2 yn[4][4];
#define P10_LOAD(r_) do { const f32x4* hr_ = (const f32x4*)(F.H + (size_t)(r_) * D) + F.lane; \
        _Pragma("unroll") for (int j = 0; j < 4; ++j) { hn[j] = hr_[64 * j]; _Pragma("unroll") for (int k = 0; k < 4; ++k) yn[j][k] = *((const u32x2*)(F.YBUF + ((size_t)(r_) * 4 + k) * D) + F.lane + 64 * j); } } while (0)
#endif
    if (F.gw < T) P10_LOAD(F.gw);
    for (int row = F.gw; row < T; row += F.NGW) {
        f32x4 v[4]; float s = 0.f;
#pragma unroll
        for (int j = 0; j < 4; ++j) { v[j] = P10_H(j);
#pragma unroll
            for (int k = 0; k < 4; ++k) { const u32x2 w = yn[j][k]; v[j].x += bflo(w.x); v[j].y += bfhi(w.x); v[j].z += bflo(w.y); v[j].w += bfhi(w.y); }
            s += (v[j].x * v[j].x + v[j].y * v[j].y) + (v[j].z * v[j].z + v[j].w * v[j].w); }
        if (row + F.NGW < T) P10_LOAD(row + F.NGW);
        const float rstd = 1.0f / sqrtf(wave_sum(s) * (1.0f / D) + RMS_EPS);
        f32x4* orow = (f32x4*)(F.out + (size_t)row * D) + F.lane;
#pragma unroll
        for (int j = 0; j < 4; ++j) { const f32x4 g = *((const f32x4*)F.g_final + F.lane + 64 * j); orow[64 * j] = v[j] * rstd * g; }
    }
#undef P10_LOAD
#undef P10_H
}

typedef float f32x16 __attribute__((ext_vector_type(16)));
typedef short s16x4 __attribute__((ext_vector_type(4)));
constexpr int ATT_SCR_OFF = RING_BYTES;
__device__ __forceinline__ int crow16(int r, int hi) { return (r & 3) + 8 * (r >> 2) + 4 * hi; }
__device__ __forceinline__ s16x4 lds_tr16(const LAS unsigned char* p) { return __builtin_bit_cast(s16x4, __builtin_amdgcn_ds_read_tr16_b64_v4i16((LAS s16x4*)p)); }

struct AttItem { int b, g, hd, r, n, d; };
__device__ __forceinline__ AttItem att_decode(int it) {
    AttItem a; const int i = it >> 8, c = it & 255; a.g = i % 3; const int idx = (i / 3) * 256 + c, rn = idx & 15; a.b = idx >> 6; a.hd = (idx >> 4) & 3;
    a.r = (a.g == 0) ? 0 : (a.g == 1) ? (rn >> 2) : rn; a.n = (a.g == 0) ? rn : (a.g == 1) ? (rn & 3) : 0; a.d = (a.g == 0) ? 1 : (a.g == 1) ? 4 : 16; return a;
}
__device__ __forceinline__ const bf16* att_base(Frame& F, const AttItem& a) { return F.PROJ + (size_t)(a.b * SEQ + a.r) * NP + a.g * 512 + a.hd * 128; }
#define ATT_LOADKV(dst, a_, coff_) do { const bf16* base_ = att_base(F, a_) + (coff_) + 8 * (F.tid & 15); const size_t rs_ = (size_t)(a_).d * NP; const int i0_ = 128 * ((a_).n - 1) + (F.tid >> 4); \
        _Pragma("unroll") for (int p_ = 0; p_ < 8; ++p_) { if ((a_).n == 0 && p_ < 4) continue; dst[p_] = *(const u32x4*)(base_ + (size_t)(i0_ + 32 * p_) * rs_); } } while (0)

__device__ __forceinline__ void attn_phase(Frame& F) {
    const int lane = F.lane, w = F.wave, fr = lane & 15, fq = lane >> 4;
    LAS unsigned char* Ks = F.lds; LAS unsigned char* Vs = F.lds + 65536;
    const int kc = F.tid & 15, kk0 = F.tid >> 4;
    u32x4 kreg[8], vreg[8]; bf16x8 qn[4];
#define ATT_LOADQ(dst, a_) do { const bf16* qrow_ = att_base(F, a_) + (size_t)(128 * (a_).n + 16 * w + fr) * ((size_t)(a_).d * NP) + C_AQ + 8 * fq; \
        _Pragma("unroll") for (int s_ = 0; s_ < 4; ++s_) dst[s_] = *(const bf16x8*)(qrow_ + 32 * s_); } while (0)
#if ATT_QUEUE
    LAS int* slot = (LAS int*)(F.lds + RING_BYTES);
    int pend = 0;
    __syncthreads();
    if (F.tid == 0) { const int g0 = (int)atomicAdd(F.ctl + CW_ACTR, 2u); slot[0] = g0; pend = g0 + 1; }
    __syncthreads();
    int it = __builtin_amdgcn_readfirstlane(slot[0]);
#else
    int it = F.vcu;
#endif
    if (it < 1536) { const AttItem a0 = att_decode(it); ATT_LOADKV(kreg, a0, C_AK); ATT_LOADKV(vreg, a0, C_AV); ATT_LOADQ(qn, a0); }
    while (it < 1536) {
        const AttItem a = att_decode(it); const int n = a.n, d = a.d;
        __syncthreads();
#if ATT_QUEUE
        if (F.tid == 0) { slot[0] = pend; pend = (int)atomicAdd(F.ctl + CW_ACTR, 1u); }
#endif
#pragma unroll
        for (int pass = 0; pass < 8; ++pass) { if (n == 0 && pass < 4) continue; const int key = pass * 32 + kk0;
            *(LAS u32x4*)(Ks + key * 256 + ((kc ^ (key & 15)) << 4)) = kreg[pass];
            *(LAS u32x4*)(Vs + key * 256 + ((((kc >> 2) ^ (key & 3)) << 6) | ((kc & 3) << 4))) = vreg[pass]; }
        bf16x8 qf[4];
#pragma unroll
        for (int s = 0; s < 4; ++s) qf[s] = qn[s];
        __syncthreads();
#if ATT_QUEUE
        const int itn = __builtin_amdgcn_readfirstlane(slot[0]);
#else
        const int itn = it + F.G;
#endif
        if (itn < 1536) { const AttItem an = att_decode(itn); ATT_LOADKV(kreg, an, C_AK); ATT_LOADKV(vreg, an, C_AV); ATT_LOADQ(qn, an); }
        f32x4 S[10];
#pragma unroll
        for (int i = 0; i < 9; ++i) {
            const int kt = w + i; const bool act = !(n == 0 && kt < 8);
            f32x4 acc = (f32x4){0.f, 0.f, 0.f, 0.f};
            if (act) {
                const LAS unsigned char* kp = Ks + (kt * 16 + fr) * 256;
#pragma unroll
                for (int s = 0; s < 4; ++s) { const bf16x8 kf = *(const LAS bf16x8*)(kp + (((4 * s + fq) ^ fr) << 4)); acc = __builtin_amdgcn_mfma_f32_16x16x32_bf16(kf, qf[s], acc, 0, 0, 0); }
                if (i == 0) {
#pragma unroll
                    for (int r = 0; r < 4; ++r) if (4 * fq + r < fr) acc[r] = -INFINITY; }
                if (i == 8) {
#pragma unroll
                    for (int r = 0; r < 4; ++r) if (4 * fq + r > fr) acc[r] = -INFINITY; }
            } else acc = (f32x4){-INFINITY, -INFINITY, -INFINITY, -INFINITY};
            S[i] = acc;
        }
        float m = -INFINITY;
#pragma unroll
        for (int i = 0; i < 9; ++i)
#pragma unroll
            for (int r = 0; r < 4; ++r) m = fmaxf(m, S[i][r]);
        m = fmaxf(m, __shfl_xor(m, 16)); m = fmaxf(m, __shfl_xor(m, 32));
        float l = 0.f;
#pragma unroll
        for (int i = 0; i < 9; ++i)
#pragma unroll
            for (int r = 0; r < 4; ++r) { const float p = __builtin_amdgcn_exp2f(S[i][r] - m); S[i][r] = p; l += p; }
        l += __shfl_xor(l, 16); l += __shfl_xor(l, 32);
        S[9] = (f32x4){0.f, 0.f, 0.f, 0.f};
        f32x4 O[8];
#pragma unroll
        for (int t = 0; t < 8; ++t) O[t] = (f32x4){0.f, 0.f, 0.f, 0.f};
        const int q4 = fr >> 2, p4 = lane & 3;
#pragma unroll
        for (int p = 0; p < 5; ++p) {
            const int kt0 = w + 2 * p, kt1 = kt0 + 1;
            const bool act0 = !(n == 0 && kt0 < 8), act1 = (2 * p + 1 < 9) && !(n == 0 && kt1 < 8);
            if (act0 || act1) {
                u32x4 pw; pw.x = pg8::cvt_pk_bf16(S[2 * p][0], S[2 * p][1]); pw.y = pg8::cvt_pk_bf16(S[2 * p][2], S[2 * p][3]);
                pw.z = pg8::cvt_pk_bf16(S[2 * p + 1][0], S[2 * p + 1][1]); pw.w = pg8::cvt_pk_bf16(S[2 * p + 1][2], S[2 * p + 1][3]);
                const bf16x8 pa = __builtin_bit_cast(bf16x8, pw);
                const int key0 = kt0 * 16 + 4 * fq + q4, key1 = kt1 * 16 + 4 * fq + q4;
#pragma unroll
                for (int t = 0; t < 8; ++t) {
                    const int col = 16 * t + 4 * p4;
                    const int coff = ((((col >> 5) ^ q4) << 6) | ((col & 31) << 1));
                    s16x4 lo = (s16x4){0, 0, 0, 0}, hi = (s16x4){0, 0, 0, 0};
                    if (act0) lo = lds_tr16(Vs + key0 * 256 + coff);
                    if (act1) hi = lds_tr16(Vs + key1 * 256 + coff);
                    const bf16x8 vb = (bf16x8){lo[0], lo[1], lo[2], lo[3], hi[0], hi[1], hi[2], hi[3]};
                    O[t] = __builtin_amdgcn_mfma_f32_16x16x32_bf16(pa, vb, O[t], 0, 0, 0);
                }
            }
        }
        const float linv = frcp(l);
        const size_t tok0 = (size_t)a.b * SEQ + a.r + (size_t)d * (128 * n + 16 * w);
        if (fq == 0) F.LSE[((size_t)a.g * T + tok0 + (size_t)d * fr) * 4 + a.hd] = m + __log2f(l);
#pragma unroll
        for (int r = 0; r < 4; ++r) {
            const int q = 4 * fq + r; const float rl = __shfl(linv, q);
            bf16* op = F.OG + ((size_t)a.g * T + tok0 + (size_t)d * q) * 512 + a.hd * 128 + fr;
#pragma unroll
            for (int t = 0; t < 8; ++t) op[16 * t] = (bf16)f2bf(O[t][r] * rl);
        }
        it = itn;
    }
    __syncthreads();
}
#undef ATT_LOADKV
#undef ATT_LOADQ

constexpr int ML_QS = 528, ML_AS = 144;
constexpr int ML_Q = 0, ML_K = 33792;
constexpr int SC_U = 0, SC_MX = 64, SC_EBD = 128, SC_WI = 192, SC_WK = 256, SC_DEC = 320;
__device__ __forceinline__ f32x4 mfma16(bf16x8 a, bf16x8 b, f32x4 c) { return __builtin_amdgcn_mfma_f32_16x16x32_bf16(a, b, c, 0, 0, 0); }


constexpr size_t WS_QK = WS_QC, WS_SCAL = WS_KC;
__device__ __forceinline__ void mlstm_prepass(Frame& F) {
    const int tid = F.tid, lane = F.lane;
    float* SCAL = (float*)((unsigned char*)F.ctl + WS_SCAL);
    bf16* QK = (bf16*)((unsigned char*)F.ctl + WS_QK);
    if (F.vcu < 32) {
        const int b = F.vcu >> 2, h = F.vcu & 3; const float* gbase = F.GATES + (size_t)(b * SEQ) * 8;
        LAS float* lu = (LAS float*)F.lds; LAS float* lpm = lu + 2048; LAS float* lbc = lpm + 2048; LAS float* lm = lbc + 2048;
        __syncthreads();
#pragma unroll
        for (int i = 0; i < 4; ++i) { const int c = 4 * F.wave + i;
            const float gi = gbase[(size_t)(64 * c + lane) * 8 + h], gf = gbase[(size_t)(64 * c + lane) * 8 + 4 + h];
            const float logf = fminf(gf, 0.f) - __logf(1.0f + __expf(-fabsf(gf)));
            float bc = logf;
#pragma unroll
            for (int o = 1; o < 64; o <<= 1) { const float v = __shfl_up(bc, o); if (lane >= o) bc += v; }
            const float u = gi - bc; float pm = u;
#pragma unroll
            for (int o = 1; o < 64; o <<= 1) { const float v = __shfl_up(pm, o); if (lane >= o) pm = fmaxf(pm, v); }
            lu[64 * c + lane] = u; lpm[64 * c + lane] = pm; lbc[64 * c + lane] = bc; }
        __syncthreads();
        if (tid == 0) { float m = 0.f; for (int c = 0; c < 32; ++c) { const float M63 = fmaxf(m, lpm[64 * c + 63]); lm[c] = m; lm[32 + c] = M63; m = lbc[64 * c + 63] + M63; } }
        __syncthreads();
#pragma unroll
        for (int i = 0; i < 4; ++i) { const int c = 4 * F.wave + i; const float m_carry = lm[c], M63 = lm[32 + c];
            const float u = lu[64 * c + lane], bc = lbc[64 * c + lane], Mx = fmaxf(m_carry, lpm[64 * c + lane]);
            float* sp = SCAL + ((size_t)F.vcu * 32 + c) * 384;
            sp[SC_U + lane] = u; sp[SC_MX + lane] = Mx; sp[SC_EBD + lane] = __expf(-(bc + Mx)); sp[SC_WI + lane] = __expf(m_carry - Mx); sp[SC_WK + lane] = __expf(u - M63);
            sp[SC_DEC + lane] = __expf(m_carry - M63); }
        __syncthreads();
    }
    const int rb = tid >> 8, half = (tid >> 7) & 1, cg = tid & 127;
    float cw[4][8];
#pragma unroll
    for (int j = 0; j < 4; ++j) { const float* p = F.conv_qk + j * 2048 + half * 1024 + 8 * cg; const f32x4 a = *(const f32x4*)p, c = *(const f32x4*)(p + 4);
        cw[j][0] = a[0]; cw[j][1] = a[1]; cw[j][2] = a[2]; cw[j][3] = a[3]; cw[j][4] = c[0]; cw[j][5] = c[1]; cw[j][6] = c[2]; cw[j][7] = c[3]; }
    const float oscale = half ? 0.0625f : 1.0f;
    for (int step = F.vcu; step < T / 16; step += F.G) {
        const int row0 = step * 16 + rb * 8, ts0 = row0 & (SEQ - 1);
        const bf16* src = F.PROJ + (size_t)row0 * NP + (half ? C_MK : C_MQ) + 8 * cg;
        u32x4 raw[11];
#pragma unroll
        for (int r = 0; r < 11; ++r) raw[r] = (ts0 - 3 + r >= 0) ? *(const u32x4*)(src + (ptrdiff_t)(r - 3) * NP) : (u32x4){0u, 0u, 0u, 0u};
        bf16* dst = QK + (size_t)row0 * 2048 + half * 1024 + 8 * cg;
        float xf[11][8];
#pragma unroll
        for (int r = 0; r < 11; ++r) { const u32x4 rw = raw[r]; xf[r][0] = bflo(rw.x); xf[r][1] = bfhi(rw.x); xf[r][2] = bflo(rw.y); xf[r][3] = bfhi(rw.y); xf[r][4] = bflo(rw.z); xf[r][5] = bfhi(rw.z); xf[r][6] = bflo(rw.w); xf[r][7] = bfhi(rw.w); }
#pragma unroll
        for (int o = 0; o < 8; ++o) {
            float y[8];
#pragma unroll
            for (int i = 0; i < 8; ++i) y[i] = (cw[0][i] * xf[o][i] + cw[1][i] * xf[o + 1][i]) + (cw[2][i] * xf[o + 2][i] + cw[3][i] * xf[o + 3][i]);
#pragma unroll
            for (int i = 0; i < 8; ++i) y[i] = y[i] * oscale * frcp(1.0f + __expf(-y[i]));
            u32x4 pw; pw.x = pk2(y[0], y[1]); pw.y = pk2(y[2], y[3]); pw.z = pk2(y[4], y[5]); pw.w = pk2(y[6], y[7]);
            *(u32x4*)(dst + (size_t)o * 2048) = pw; }
    }
}

template <int NDT> struct MLMap {
    static constexpr int VROWS = 16 * (NDT + 1), CT = ML_K + 64 * ML_QS, A = CT + VROWS * ML_QS, VT = A + 64 * ML_AS, VWT = VT + VROWS * ML_AS, SC = VWT + VROWS * ML_AS, END = SC + 4 * 384;
    static_assert(END <= LDSCTL_OFF, "mLSTM LDS map");
};
template <int NDT>
__device__ __forceinline__ void mlstm_item(Frame& F, int b, int h, int sl) {
    typedef MLMap<NDT> MP; constexpr int VROWS = MP::VROWS, PARTS = 2 * NDT, NT2 = NDT / 2, NB5 = NDT + 1;
    const int tid = F.tid, lane = F.lane, w = F.wave, fr = lane & 15, fq = lane >> 4;
    LAS unsigned char* L = F.lds; LAS float* SC = (LAS float*)(L + MP::SC);
    const bf16* qkbase = (const bf16*)((const unsigned char*)F.ctl + WS_QK) + (size_t)(b * SEQ) * 2048 + h * 256 + 8 * (tid & 31);
#ifndef VMAP
#define VMAP 1
#endif
    const bool vact = tid < 64 * PARTS; const int vs = VMAP ? (tid & 63) : (tid / PARTS), vpart = VMAP ? (tid >> 6) : (tid % PARTS);
    const bf16* vbase = F.PROJ + (size_t)(b * SEQ) * NP + C_MV + h * 256 + sl * (16 * NDT) + 8 * vpart;
    const float* scbase = (const float*)((const unsigned char*)F.ctl + WS_SCAL) + (size_t)((b * 4 + h) * 32) * 384 + (tid < 384 ? tid : 0);
    const float* wkbase = (const float*)((const unsigned char*)F.ctl + WS_SCAL) + (size_t)((b * 4 + h) * 32) * 384 + SC_WK + vs;
    __syncthreads();
    for (int i = tid; i < (MP::A - MP::CT) / 4; i += NTHREADS) ((LAS unsigned*)(L + MP::CT))[i] = 0u;
    for (int i = tid; i < (MP::SC - MP::VT) / 4; i += NTHREADS) ((LAS unsigned*)(L + MP::VT))[i] = 0u;
    __syncthreads();
    if (tid < 32) ((LAS unsigned*)(L + MP::VT + (16 * NDT) * ML_AS))[tid] = 0x3F803F80u;
    f32x4 C[2][NB5];
#pragma unroll
    for (int a = 0; a < 2; ++a)
#pragma unroll
        for (int bb = 0; bb < NB5; ++bb) C[a][bb] = (f32x4){0.f, 0.f, 0.f, 0.f};
    u32x4 qk[8]; u32x4 vraw = (u32x4){0u, 0u, 0u, 0u}; float scv = 0.f, wkv = 0.f;
    unsigned hpk[NT2][2];
#define ML_ISSUE(c_) do { const int t0_ = 64 * (c_); \
        _Pragma("unroll") for (int i_ = 0; i_ < 4; ++i_) { const bf16* p_ = qkbase + (size_t)(t0_ + (tid >> 5) + 16 * i_) * 2048; qk[i_] = *(const u32x4*)p_; qk[4 + i_] = *(const u32x4*)(p_ + 1024); } \
        if (vact) { vraw = *(const u32x4*)(vbase + (size_t)(t0_ + vs) * NP); wkv = wkbase[(size_t)(c_) * 384]; } \
        if (tid < 384) scv = scbase[(size_t)(c_) * 384]; } while (0)
    ML_ISSUE(0);
    for (int c = 0; c < 32; ++c) {
        { LAS unsigned char* dq = L + ML_Q + (tid >> 5) * ML_QS + 16 * (tid & 31);
#pragma unroll
          for (int i = 0; i < 4; ++i) { *(LAS u32x4*)(dq + 16 * i * ML_QS) = qk[i]; *(LAS u32x4*)(dq + (ML_K - ML_Q) + 16 * i * ML_QS) = qk[4 + i]; } }
        if (vact) { LAS bf16* vt = (LAS bf16*)(L + MP::VT) + vs; LAS bf16* vw = (LAS bf16*)(L + MP::VWT) + vs;
            const float vf[8] = {bflo(vraw.x), bfhi(vraw.x), bflo(vraw.y), bfhi(vraw.y), bflo(vraw.z), bfhi(vraw.z), bflo(vraw.w), bfhi(vraw.w)};
            const unsigned vr[4] = {vraw.x, vraw.y, vraw.z, vraw.w};
#pragma unroll
            for (int i = 0; i < 4; ++i) { const unsigned pw = pk2(vf[2 * i] * wkv, vf[2 * i + 1] * wkv);
                vt[(8 * vpart + 2 * i) * (ML_AS / 2)] = (bf16)(vr[i] & 0xffffu); vt[(8 * vpart + 2 * i + 1) * (ML_AS / 2)] = (bf16)(vr[i] >> 16);
                vw[(8 * vpart + 2 * i) * (ML_AS / 2)] = (bf16)(pw & 0xffffu); vw[(8 * vpart + 2 * i + 1) * (ML_AS / 2)] = (bf16)(pw >> 16); } }
        if (tid >= 256 && tid < 320) ((LAS bf16*)(L + MP::VWT))[(16 * NDT) * (ML_AS / 2) + tid - 256] = (bf16)f2bf(scv);
        if (tid < 384) SC[tid] = scv;
        __syncthreads();
        if (c > 0) { bf16* hpp = (bf16*)F.HT + (size_t)(b * SEQ + 64 * (c - 1) + 16 * (w & 3) + 4 * fq) * D + h * 256 + sl * (16 * NDT) + 16 * ((w >> 2) * NT2) + fr;
#pragma unroll
            for (int j = 0; j < NT2; ++j) { hpp[16 * j] = (bf16)(hpk[j][0] & 0xffffu); hpp[(size_t)D + 16 * j] = (bf16)(hpk[j][0] >> 16); hpp[(size_t)2 * D + 16 * j] = (bf16)(hpk[j][1] & 0xffffu); hpp[(size_t)3 * D + 16 * j] = (bf16)(hpk[j][1] >> 16); } }
        if (c + 1 < 32) ML_ISSUE(c + 1);
        const int ti = w & 3;
#ifndef DUP_B
#define DUP_B 1
#endif
        for (int dupb = 0; dupb < DUP_B; ++dupb)
        { const int si0 = (w >> 2) * 2;
          const LAS unsigned char* qp = L + ML_Q + (16 * ti + fr) * ML_QS + 16 * fq;
          const LAS unsigned char* kp = L + ML_K + (16 * si0 + fr) * ML_QS + 16 * fq;
          f32x4 sacc[2] = {(f32x4){0.f, 0.f, 0.f, 0.f}, (f32x4){0.f, 0.f, 0.f, 0.f}};
#pragma unroll
          for (int hb = 0; hb < 2; ++hb) {
              bf16x8 qa[4], k0[4], k1[4];
#pragma unroll
              for (int kk = 0; kk < 4; ++kk) { qa[kk] = *(const LAS bf16x8*)(qp + 64 * (4 * hb + kk)); k0[kk] = *(const LAS bf16x8*)(kp + 64 * (4 * hb + kk)); k1[kk] = *(const LAS bf16x8*)(kp + 16 * ML_QS + 64 * (4 * hb + kk)); }
              __builtin_amdgcn_sched_barrier(0);
#pragma unroll
              for (int kk = 0; kk < 4; ++kk) { sacc[0] = mfma16(k0[kk], qa[kk], sacc[0]); sacc[1] = mfma16(k1[kk], qa[kk], sacc[1]); }
          }
          { const int t = 16 * ti + fr; const float mxt = SC[SC_MX + t];
#pragma unroll
            for (int si = 0; si < 2; ++si) { const int s0 = 16 * (si0 + si) + 4 * fq; const f32x4 us = *(const LAS f32x4*)(SC + SC_U + s0); float val[4];
#pragma unroll
                for (int r = 0; r < 4; ++r) val[r] = (s0 + r <= t) ? sacc[si][r] * __expf(us[r] - mxt) : 0.f;
                u32x2 pw; pw.x = pk2(val[0], val[1]); pw.y = pk2(val[2], val[3]);
                *(LAS u32x2*)(L + MP::A + t * ML_AS + 2 * s0) = pw; } } }
        __syncthreads();
        { const int dj0 = (w >> 2) * NT2;
          const LAS unsigned char* ap = L + MP::A + (16 * ti + fr) * ML_AS + 16 * fq;
          const LAS unsigned char* vp = L + MP::VT + (16 * dj0 + fr) * ML_AS + 16 * fq; const LAS unsigned char* ep = L + MP::VT + (16 * NDT + fr) * ML_AS + 16 * fq;
          const LAS unsigned char* cp = L + MP::CT + (16 * dj0 + fr) * ML_QS + 16 * fq; const LAS unsigned char* cep = L + MP::CT + (16 * NDT + fr) * ML_QS + 16 * fq;
          bf16x8 aa[2], vv[NT2][2], ee[2], afr[2][2], bw[2][NB5];
#pragma unroll
          for (int ks = 0; ks < 2; ++ks) { aa[ks] = *(const LAS bf16x8*)(ap + 64 * ks); ee[ks] = *(const LAS bf16x8*)(ep + 64 * ks);
#pragma unroll
              for (int j = 0; j < NT2; ++j) vv[j][ks] = *(const LAS bf16x8*)(vp + 16 * j * ML_AS + 64 * ks); }
          const int q4 = fr >> 2, p4 = lane & 3;
#pragma unroll
          for (int ks = 0; ks < 2; ++ks) {
#pragma unroll
              for (int a = 0; a < 2; ++a) { const LAS unsigned char* kp = L + ML_K + (32 * ks + 8 * fq + q4) * ML_QS + (16 * (2 * w + a) + 4 * p4) * 2;
                  const s16x4 lo = lds_tr16(kp), hi = lds_tr16(kp + 4 * ML_QS); afr[ks][a] = (bf16x8){lo[0], lo[1], lo[2], lo[3], hi[0], hi[1], hi[2], hi[3]}; }
#pragma unroll
              for (int bb = 0; bb < NB5; ++bb) bw[ks][bb] = *(const LAS bf16x8*)(L + MP::VWT + (16 * bb + fr) * ML_AS + 16 * fq + 64 * ks); }
          const float dec = SC[SC_DEC];
          f32x4 wi4, eb4;
#pragma unroll
          for (int r = 0; r < 4; ++r) { wi4[r] = SC[SC_WI + 16 * ti + 4 * fq + r]; eb4[r] = SC[SC_EBD + 16 * ti + 4 * fq + r]; }
          __builtin_amdgcn_sched_barrier(0);
          f32x4 av[NT2], av2[NT2], ae = (f32x4){0.f, 0.f, 0.f, 0.f}, ae2 = ae;
#pragma unroll
          for (int j = 0; j < NT2; ++j) { av[j] = (f32x4){0.f, 0.f, 0.f, 0.f}; av2[j] = av[j]; }
#pragma unroll
          for (int a = 0; a < 2; ++a)
#pragma unroll
              for (int bb = 0; bb < NB5; ++bb) C[a][bb] *= dec;
#pragma unroll
          for (int ks = 0; ks < 2; ++ks) { ae = mfma16(aa[ks], ee[ks], ae);
#pragma unroll
              for (int j = 0; j < NT2; ++j) av[j] = mfma16(aa[ks], vv[j][ks], av[j]); }
#pragma unroll
          for (int ks = 0; ks < 2; ++ks)
#pragma unroll
              for (int bb = 0; bb < NB5; ++bb) { C[0][bb] = mfma16(afr[ks][0], bw[ks][bb], C[0][bb]); C[1][bb] = mfma16(afr[ks][1], bw[ks][bb], C[1][bb]); }
          __builtin_amdgcn_sched_barrier(0);
          { const LAS unsigned char* qp = L + ML_Q + (16 * ti + fr) * ML_QS + 16 * fq;
#pragma unroll
            for (int hb = 0; hb < 2; ++hb) {
                bf16x8 qa[4], cc[NT2][4], ce[4];
#pragma unroll
                for (int kk = 0; kk < 4; ++kk) { qa[kk] = *(const LAS bf16x8*)(qp + 64 * (4 * hb + kk)); ce[kk] = *(const LAS bf16x8*)(cep + 64 * (4 * hb + kk));
#pragma unroll
                    for (int j = 0; j < NT2; ++j) cc[j][kk] = *(const LAS bf16x8*)(cp + 16 * j * ML_QS + 64 * (4 * hb + kk)); }
                __builtin_amdgcn_sched_barrier(0);
#pragma unroll
                for (int kk = 0; kk < 4; ++kk) { ae2 = mfma16(qa[kk], ce[kk], ae2);
#pragma unroll
                    for (int j = 0; j < NT2; ++j) av2[j] = mfma16(qa[kk], cc[j][kk], av2[j]); }
            } }
          float rd[4];
#pragma unroll
          for (int r = 0; r < 4; ++r) { float dn = ae[r] + wi4[r] * ae2[r]; dn = __shfl(dn, lane & 48); rd[r] = frcp(fmaxf(fabsf(dn), eb4[r])); }
#pragma unroll
          for (int j = 0; j < NT2; ++j) { hpk[j][0] = pk2((av[j][0] + wi4[0] * av2[j][0]) * rd[0], (av[j][1] + wi4[1] * av2[j][1]) * rd[1]);
              hpk[j][1] = pk2((av[j][2] + wi4[2] * av2[j][2]) * rd[2], (av[j][3] + wi4[3] * av2[j][3]) * rd[3]); } }
        __syncthreads();
#pragma unroll
        for (int a = 0; a < 2; ++a)
#pragma unroll
            for (int bb = 0; bb < NB5; ++bb) { u32x2 pw; pw.x = pk2(C[a][bb][0], C[a][bb][1]); pw.y = pk2(C[a][bb][2], C[a][bb][3]);
                *(LAS u32x2*)(L + MP::CT + (16 * bb + fr) * ML_QS + (16 * (2 * w + a) + 4 * fq) * 2) = pw; }
    }
#undef ML_ISSUE
    { bf16* hpp = (bf16*)F.HT + (size_t)(b * SEQ + 64 * 31 + 16 * (w & 3) + 4 * fq) * D + h * 256 + sl * (16 * NDT) + 16 * ((w >> 2) * NT2) + fr;
#pragma unroll
      for (int j = 0; j < NT2; ++j) { hpp[16 * j] = (bf16)(hpk[j][0] & 0xffffu); hpp[(size_t)D + 16 * j] = (bf16)(hpk[j][0] >> 16); hpp[(size_t)2 * D + 16 * j] = (bf16)(hpk[j][1] & 0xffffu); hpp[(size_t)3 * D + 16 * j] = (bf16)(hpk[j][1] >> 16); } }
    __syncthreads();
}

constexpr int CQ_TS = 144, CQ_SCR = 2 * 32 * CQ_TS;
struct CqItem { const float* W; unsigned char* WT; int Nsrc, c0, k0, row0, row1, rstep; };
__device__ __forceinline__ CqItem cq_decode(Frame& F, int r) {
    constexpr int I_GU1 = (D / 128) * (2048 / 64), I_DN1 = (D / 128) * (D / 64);
    CqItem it;
    if (r < NE * I_GU1) { const int e = r / I_GU1, q = r % I_GU1, kb = q / 32, cb = q % 32, j0 = 32 * cb;
        it.W = F.w_gate_up + (size_t)e * D * 2048; it.WT = (unsigned char*)F.WguT + (size_t)e * 2048 * D; it.Nsrc = 2048; it.c0 = 2 * j0; it.k0 = 128 * kb;
        it.row0 = (j0 >> 7) * 256 + (j0 & 127); it.row1 = it.row0 + 128; it.rstep = 1; }
    else { r -= NE * I_GU1; const int e = r / I_DN1, q = r % I_DN1, kb = q / 16, cb = q % 16;
        it.W = F.w_down + (size_t)e * D * D; it.WT = (unsigned char*)F.WdnT + (size_t)e * D * D; it.Nsrc = D; it.c0 = 64 * cb; it.k0 = 128 * kb;
        it.row0 = 64 * cb; it.row1 = 64 * cb + 1; it.rstep = 2; }
    return it;
}
__device__ __forceinline__ void cq_load(const CqItem& it, int half, int lane, f32x4 (&v)[16]) {
    const float* p = it.W + (size_t)(it.k0 + 64 * half + 4 * (lane >> 4)) * it.Nsrc + it.c0 + 4 * (lane & 15);
#pragma unroll
    for (int pp = 0; pp < 4; ++pp)
#pragma unroll
        for (int i = 0; i < 4; ++i) v[4 * pp + i] = *(const f32x4*)(p + (size_t)(16 * pp + i) * it.Nsrc);
}
__device__ __forceinline__ void cq_pack(const f32x4 (&v)[16], int half, int lane, LAS unsigned char* scr, float sc) {
    LAS unsigned char* t0 = scr + (2 * (lane & 15)) * CQ_TS + 4 * (16 * half + (lane >> 4));
#pragma unroll
    for (int pp = 0; pp < 4; ++pp)
#pragma unroll
        for (int c = 0; c < 4; ++c)
            *(LAS unsigned*)(t0 + (c & 1) * 32 * CQ_TS + (c >> 1) * CQ_TS + 16 * pp) = pk4_fp8(v[4 * pp][c] * sc, v[4 * pp + 1][c] * sc, v[4 * pp + 2][c] * sc, v[4 * pp + 3][c] * sc);
}
__device__ __forceinline__ void cq_store(const CqItem& it, int lane, LAS unsigned char* scr) {
    asm volatile("s_waitcnt lgkmcnt(0)" ::: "memory");
    const int r = lane >> 1, hf = lane & 1;
#pragma unroll
    for (int t = 0; t < 2; ++t) { const LAS unsigned char* s = scr + t * 32 * CQ_TS + r * CQ_TS + 64 * hf;
        unsigned char* d = it.WT + (size_t)((t ? it.row1 : it.row0) + r * it.rstep) * D + it.k0 + 64 * hf;
#pragma unroll
        for (int j = 0; j < 4; ++j) *(u32x4*)(d + 16 * j) = *(const LAS u32x4*)(s + 16 * j); }
    asm volatile("s_waitcnt lgkmcnt(0)" ::: "memory");
}
constexpr int CS_GRAB = 8;
__device__ __forceinline__ void convert_steal(Frame& F) {
    constexpr int I_GU1 = (D / 128) * (2048 / 64), I_DN1 = (D / 128) * (D / 64), NIT = NE * (I_GU1 + I_DN1);
    static_assert(NIT % CS_GRAB == 0, "conversion items per grab");
    LAS unsigned char* scr = F.lds + F.wave * CQ_SCR; LAS int* slot = (LAS int*)(F.lds + 8 * CQ_SCR);
    int nxt = 0;
    __syncthreads();
    if (F.tid == 0) nxt = (int)atomicAdd(F.ctl + CW_QCTR, (unsigned)CS_GRAB);
    for (;;) {
        if (F.tid == 0) slot[0] = nxt;
        __syncthreads();
        const int base = slot[0]; if (base >= NIT) break;
        if (F.tid == 0) nxt = (int)atomicAdd(F.ctl + CW_QCTR, (unsigned)CS_GRAB);
        const CqItem it = cq_decode(F, base + F.wave);
        f32x4 va[16], vb[16];
        cq_load(it, 0, F.lane, va);
        cq_load(it, 1, F.lane, vb);
        cq_pack(va, 0, F.lane, scr, 32.0f);
        cq_pack(vb, 1, F.lane, scr, 32.0f);
        cq_store(it, F.lane, scr);
        __syncthreads();
    }
}

#ifndef ML_NDT
#define ML_NDT 4
#endif
__device__ __forceinline__ void mlstm_phase(Frame& F) {
    constexpr int SLICES = 16 / ML_NDT, NITEMS = NB * 4 * SLICES;
    for (int item = F.vcu; item < NITEMS; item += F.G) mlstm_item<ML_NDT>(F, item / (4 * SLICES), (item / SLICES) & 3, item % SLICES);
#if FAST_ATTN && ATT_QUEUE
    attn_phase(F);
#endif
#if MOE_FP8 && STEAL
#if defined(PROBE_NOSTEAL)
    if (F.vcu >= NITEMS)
#endif
#if defined(PROBE_CONV64)
    if (F.vcu < NITEMS || F.vcu >= 192)
#endif
    convert_steal(F);
#endif
}

constexpr int N_PHASES = 13;
struct Args { const void* in[18]; float* out; unsigned char* ws; int ph_lo, ph_hi; };

__device__ __forceinline__ int opaque_int(int v) { asm volatile("" : "+s"(v)); return v; }
__global__ void __launch_bounds__(NTHREADS, 2) mega_fwd(Args args) {
    extern __shared__ __attribute__((aligned(16))) unsigned char lds[];
    Frame F;
    F.lds = (LAS unsigned char*)lds;
    F.tid = threadIdx.x; F.lane = F.tid & 63; F.wave = __builtin_amdgcn_readfirstlane(F.tid >> 6);
    F.G = gridDim.x; { const int bx = blockIdx.x; F.vcu = (F.G % 8 == 0) ? (bx % 8) * (F.G / 8) + bx / 8 : bx; }
    F.gw = F.vcu * NWAVES + F.wave; F.NGW = F.G * NWAVES;
    unsigned char* ws = args.ws;
    F.ctl = (unsigned*)(ws + WS_CTL);
    F.x = (const float*)args.in[0]; F.positions = (const int*)args.in[1]; F.g_mix = (const float*)args.in[2]; F.w_in = (const float*)args.in[3]; F.conv_qk = (const float*)args.in[4];
    F.b_if = (const float*)args.in[5]; F.g_mnorm = (const float*)args.in[6]; F.w_attn_out = (const float*)args.in[7]; F.w_mlstm_out = (const float*)args.in[8]; F.w_mix_out = (const float*)args.in[9];
    F.g_ffn = (const float*)args.in[10]; F.w_router = (const float*)args.in[11]; F.b_router = (const float*)args.in[12]; F.w_gate_up = (const float*)args.in[13]; F.b_gate_up = (const float*)args.in[14];
    F.w_down = (const float*)args.in[15]; F.b_down = (const float*)args.in[16]; F.g_final = (const float*)args.in[17]; F.out = args.out;
    F.WinT = (bf16*)(ws + WS_WIN); F.WamT = (bf16*)(ws + WS_WAM); F.WoT = (bf16*)(ws + WS_WO); F.WguT = (bf16*)(ws + WS_WGU); F.WdnT = (bf16*)(ws + WS_WDN);
    F.XN = (bf16*)(ws + WS_XN); F.PROJ = (bf16*)(ws + WS_PROJ); F.OG = (bf16*)(ws + WS_OG); F.AM = (bf16*)(ws + WS_AM); F.MERGED = (bf16*)(ws + WS_MERGED);
    F.XS = (bf16*)(ws + WS_XS); F.ACT = (bf16*)(ws + WS_ACT); F.YBUF = (bf16*)(ws + WS_YBUF);
    F.GATES = (float*)(ws + WS_GATES); F.ROPE = (float*)(ws + WS_ROPE); F.LSE = (float*)(ws + WS_LSE); F.HT = (float*)(ws + WS_HT); F.H = (float*)(ws + WS_H);
    F.QC = (float*)(ws + WS_QC); F.KC = (float*)(ws + WS_KC);
    F.TOK_E = (int*)(ws + WS_ROUTE); F.TOK_SLOT = F.TOK_E + NA; F.TOK_W = (float*)(F.TOK_SLOT + NA);
    F.ROW_TOK = (int*)(ws + WS_ROWMETA); F.ROW_W = (float*)(F.ROW_TOK + (RM_FUSED ? NE * ECAP : XS_ROWS));

    const int lo = args.ph_lo, hi = args.ph_hi;
    for (int u = F.tid; u < (LDS_BYTES - LDSCTL_OFF) / 4; u += NTHREADS) ((LAS unsigned*)(F.lds + LDSCTL_OFF))[u] = 0u;
    __syncthreads();
    XcdBarrier bar; bar.bar = F.ctl + CW_BAR; bar.x = 0; bar.st = nullptr;
    if (hi - lo > 1) bar = xcd_barrier_post(F.ctl + CW_BAR, (volatile LAS unsigned*)(F.lds + MISC_OFF) + 8);
#ifndef PH_MASK
#define PH_MASK 0xffffffffu
#endif
#ifndef REP_MASK
#define REP_MASK 0u
#endif
#define IN(k) (((PH_MASK >> (k)) & 1u) && lo <= (k) && (k) < hi)
#define REPS(k) for (int rep_ = 0, nrep_ = ((REP_MASK >> (k)) & 1u) ? opaque_int(2) : 1; rep_ < nrep_; ++rep_)
#define SEAM(k) do { if (IN(k) && IN((k) + 1)) { GRID_BAR(); } } while (0)
#define GRID_BAR() xcd_barrier(bar)

    if (IN(0)) REPS(0) { p0_weights(F); p0_rows(F); }
    SEAM(0);
    if (IN(1)) REPS(1) {
#if FAST_P1
#if P1_FP8
        constexpr int NF8 = 64 * (18 + 42 - P1_HI), NBF = 64 * (P1_HI - 18);
        constexpr bool SPLIT = (NF8 == 128 * 15 && NBF == 128 * 6);
        { pg8::Gemm g{(const bf16*)((const unsigned char*)F.ctl + WS_XN8), F.WinT, T, (18 + 42 - P1_HI) * 256, D / 2}; pg8::SplitOrder S; S.base.init(T, (18 + 42 - P1_HI) * 256, F.G, (int)blockIdx.x);
          S.nA = SPLIT ? 9 : -1; S.nB = SPLIT ? 6 : -1;
          pg8::EpiProj<1> E{F.PROJ, F.ROPE};
          pg8::gemm_phase<pg8::EpiProj<1>, pg8::SplitOrder, true, true, true>(F.lds, g, S, E); }
        { pg8::Gemm g{F.XN, F.WinT + (size_t)18 * 256 * D, T, (P1_HI - 18) * 256, D}; pg8::SplitOrder S; S.base.init(T, (P1_HI - 18) * 256, F.G, (int)blockIdx.x);
          S.nA = SPLIT ? 2 : -1; S.nB = SPLIT ? 4 : -1;
          pg8::EpiProj<2> E{F.PROJ, F.ROPE};
          pg8::gemm_phase<pg8::EpiProj<2>, pg8::SplitOrder, true, true>(F.lds, g, S, E); }
#else
        pg8::Gemm g{F.XN, F.WinT, T, NP, D}; pg8::StaticOrder S; S.init(T, NP, F.G, (int)blockIdx.x);
        pg8::EpiProj<0> E{F.PROJ, F.ROPE};
        pg8::gemm_phase<pg8::EpiProj<0>, pg8::StaticOrder, true, true>(F.lds, g, S, E);
#endif
#else
        naive_p1(F);
#endif
    }
    SEAM(1);
    if (IN(2)) REPS(2) {
#if !FAST_P1
        naive_p1_rope(F);
#endif
    }
#if !FAST_P1
    SEAM(2);
#endif
    if (IN(3)) REPS(3) {
#if !FAST_MLSTM
        naive_conv(F);
#endif
#if FAST_MLSTM
        mlstm_prepass(F);
#endif
#if FAST_ATTN && !(ATT_QUEUE && FAST_MLSTM)
        attn_phase(F);
#elif !FAST_ATTN
        naive_attn(F);
#endif
    }
    SEAM(3);
    if (IN(4)) REPS(4) {
#if FAST_MLSTM
        mlstm_phase(F);
#else
        naive_mlstm(F);
#endif
    }
    SEAM(4);
    if (IN(5)) REPS(5) p3_post_mixer(F);
    SEAM(5);
    if (IN(6)) REPS(6) {
#if FAST_P4
        constexpr bool STREAM = (MIX_STREAM && FAST_P5);
        pg8::Gemm g{F.AM, F.WamT, T, D, AMLD};
        { pg8::MergedOrder S; S.base.init(T, D, F.G, (int)blockIdx.x); S.nparts = 2; S.pub = STREAM; S.ready = F.ctl + CW_READY2; S.tmo = F.ctl + CW_TMO;
          pg8::EpiMerged E{F.AM + 1536, F.PROJ, F.x, F.H, false};
          pg8::gemm_phase<pg8::EpiMerged, pg8::MergedOrder, false, true>(F.lds, g, S, E); }
        if (STREAM) {
          pg8::MergedOrder S; S.base.init(T, D, F.G, (int)blockIdx.x); S.nparts = 1; S.pub = true; S.ready = F.ctl + CW_READY2; S.tmo = F.ctl + CW_TMO;
          pg8::EpiMerged E{F.AM + 1536, F.PROJ, F.x, F.H, false};
          pg8::gemm_phase<pg8::EpiMerged, pg8::MergedOrder, false, true>(F.lds, g, S, E); }
#else
        naive_p4(F);
#endif
    }
#if !(MIX_STREAM && FAST_P4 && FAST_P5)
    SEAM(6);
#endif
    if (IN(7)) REPS(7) {
#if FAST_P5
#if !(MIX_STREAM && FAST_P4)
        { pg8::Gemm g{F.AM, F.WamT, T, D, AMLD}; pg8::MergedOrder S; S.base.init(T, D, F.G, (int)blockIdx.x); S.nparts = 1; S.pub = false; S.ready = F.ctl + CW_READY2; S.tmo = F.ctl + CW_TMO;
          pg8::EpiMerged E{F.AM + 1536, F.PROJ, F.x, F.H, false};
          pg8::gemm_phase<pg8::EpiMerged, pg8::MergedOrder, false, true>(F.lds, g, S, E); }
#endif
#else
        naive_p5(F);
#endif
    }
    SEAM(7);
#if MOE_FP8 && ROUTER_MFMA
    if (IN(8)) REPS(8) p6_router_mfma(F);
#else
    if (IN(8)) REPS(8) p6_router(F);
#endif
    SEAM(8);
#if !RM_FUSED
    if (IN(9)) REPS(9) p7_gather(F);
    SEAM(9);
#endif
#if MOE_FP8 && MOE_STREAM && FAST_MOE
    if (IN(10)) REPS(10) {
        LAS int* tl_e = (LAS int*)(F.lds + RING_BYTES); LAS int* tl_base = tl_e + 320; LAS int* tl_nv = tl_base + 320; LAS int* tl_n = tl_nv + 320;
        __syncthreads();
        if (F.tid < 64) { const int e = F.lane & 31, cnt = (int)__hip_atomic_load(F.ctl + CW_CNT + 64 * e, __ATOMIC_RELAXED, __HIP_MEMORY_SCOPE_AGENT), nt = (cnt + 255) >> 8;
            int incl = nt;
#pragma unroll
            for (int o = 1; o < 32; o <<= 1) { const int v = __shfl_up(incl, o, 32); if ((F.lane & 31) >= o) incl += v; }
            if (F.tid < 32) { const int t0 = incl - nt; for (int j = 0; j < nt; ++j) { tl_e[t0 + j] = e; tl_base[t0 + j] = e * ECAP + 256 * j; tl_nv[t0 + j] = min(256, cnt - 256 * j); } if (e == 31) tl_n[0] = incl; } }
        __syncthreads();
        const int ntiles = __builtin_amdgcn_readfirstlane(tl_n[0]);
        pg8::MoeOrder S{(const LAS unsigned*)tl_e, ntiles, F.G, (int)blockIdx.x, F.ROW_TOK, F.XN, F.ACT, F.WguT, F.WdnT, F.ctl + CW_READY, F.ctl + CW_TMO, tl_base, tl_nv};
        pg8::Gemm g{F.XN, F.WguT, ntiles * 256, NE * 2048, D / 2};
        pg8::EpiMoe E{{F.ACT, F.b_gate_up, 1.0f / 32.0f}, {F.YBUF, F.b_down, F.ROW_TOK, F.ROW_W, 1.0f / 32.0f, tl_base, tl_nv}};
        pg8::gemm_phase<pg8::EpiMoe, pg8::MoeOrder, true, true, true, true, true>(F.lds, g, S, E);
    }
#else
    if (IN(10)) REPS(10) {
        const int ntiles = (int)F.ctl[CW_NTILES];
#if FAST_MOE
        pg8::GroupedOrder S{F.ctl + CW_TILEE, ntiles, 8, F.G, (int)blockIdx.x, F.ROW_TOK};
#if MOE_FP8
        pg8::Gemm g{F.XN, F.WguT, ntiles * 256, NE * 2048, D / 2}; pg8::EpiSwiGLU<true> E{F.ACT, F.b_gate_up, 1.0f / 32.0f};
        pg8::gemm_phase<pg8::EpiSwiGLU<true>, pg8::GroupedOrder, true, true, true, true>(F.lds, g, S, E);
#else
        pg8::Gemm g{F.XS, F.WguT, ntiles * 256, NE * 2048, D}; pg8::EpiSwiGLU<false> E{F.ACT, F.b_gate_up, 1.0f};
        pg8::gemm_phase<pg8::EpiSwiGLU<false>, pg8::GroupedOrder, true, true, false>(F.lds, g, S, E);
#endif
#else
        naive_p8(F, ntiles);
#endif
    }
    SEAM(10);
    if (IN(11)) REPS(11) {
        const int ntiles = (int)F.ctl[CW_NTILES];
#if FAST_MOE
        pg8::GroupedOrder S{F.ctl + CW_TILEE, ntiles, 4, F.G, (int)blockIdx.x, F.ROW_TOK};
#if MOE_FP8
        pg8::Gemm g{F.ACT, F.WdnT, ntiles * 256, NE * D, D / 2}; pg8::EpiDown E{F.YBUF, F.b_down, F.ROW_TOK, F.ROW_W, 1.0f / 32.0f};
        pg8::gemm_phase<pg8::EpiDown, pg8::GroupedOrder, true, true, true>(F.lds, g, S, E);
#else
        pg8::Gemm g{F.ACT, F.WdnT, ntiles * 256, NE * D, D}; pg8::EpiDown E{F.YBUF, F.b_down, F.ROW_TOK, F.ROW_W, 1.0f};
        pg8::gemm_phase<pg8::EpiDown, pg8::GroupedOrder, true, true, false>(F.lds, g, S, E);
#endif
#else
        naive_p9(F, ntiles);
#endif
    }
#endif
    SEAM(11);
    if (IN(12)) REPS(12) p10_final(F);
#undef IN
#undef SEAM
}

extern "C" void kernel_launch(void* const* d_in, const int* in_sizes, int n_in, void* d_out, int out_size, void* d_ws, size_t ws_size, hipStream_t stream) {
    static int grid = 0;
    if (grid == 0) {
        if (n_in != 18 || out_size != T * D || ws_size < WS_END) { fprintf(stderr, "kernel_launch: unexpected shapes (n_in %d, out %d, ws %zu)\n", n_in, out_size, ws_size); grid = -1; return; }
        int dev = 0, cus = 0;
        if (hipGetDevice(&dev) != hipSuccess || hipDeviceGetAttribute(&cus, hipDeviceAttributeMultiprocessorCount, dev) != hipSuccess) { grid = -1; return; }
        if (hipFuncSetAttribute((const void*)mega_fwd, hipFuncAttributeMaxDynamicSharedMemorySize, LDS_BYTES) != hipSuccess) { fprintf(stderr, "kernel_launch: hipFuncSetAttribute failed\n"); grid = -1; return; }
        int per_cu = 0;
        if (hipOccupancyMaxActiveBlocksPerMultiprocessor(&per_cu, (const void*)mega_fwd, NTHREADS, LDS_BYTES) != hipSuccess || per_cu < 1) { fprintf(stderr, "kernel_launch: occupancy query says %d blocks per CU\n", per_cu); (void)hipGetLastError(); grid = -1; return; }
        grid = cus;
    }
    if (grid < 0) return;
    (void)hipMemsetAsync((char*)d_ws + WS_CTL, 0, CTL_ZERO_BYTES, stream);
    Args a{};
    for (int i = 0; i < 18; ++i) a.in[i] = d_in[i];
    a.out = (float*)d_out; a.ws = (unsigned char*)d_ws;
#if defined(MK_MULTI)
    for (int p = 0; p < N_PHASES; ++p) {
        a.ph_lo = p; a.ph_hi = p + 1;
        hipLaunchKernelGGL(mega_fwd, dim3(grid), dim3(NTHREADS), LDS_BYTES, stream, a);
    }
#else
#if defined(PROBE_HI)
    a.ph_lo = 0; a.ph_hi = PROBE_HI;
    hipLaunchKernelGGL(mega_fwd, dim3(grid), dim3(NTHREADS), LDS_BYTES, stream, a);
    (void)hipMemsetAsync((char*)d_ws + WS_CTL, 0, CTL_ZERO_BYTES, stream);
#endif
    a.ph_lo = 0; a.ph_hi = N_PHASES;
    hipLaunchKernelGGL(mega_fwd, dim3(grid), dim3(NTHREADS), LDS_BYTES, stream, a);
#endif
}
```

```cpp
#include <hip/hip_runtime.h>
#include <cstdio>
#include <cstdint>

#define LAS __attribute__((address_space(3)))
#define GAS __attribute__((address_space(1)))
typedef unsigned short bf16;
typedef float f32x4 __attribute__((ext_vector_type(4)));
typedef float f32x2 __attribute__((ext_vector_type(2)));
typedef unsigned u32x4 __attribute__((ext_vector_type(4)));
typedef unsigned u32x2 __attribute__((ext_vector_type(2)));
typedef short bf16x8 __attribute__((ext_vector_type(8)));

#ifndef FAST_P1
#define FAST_P1 1
#endif
#ifndef FAST_P4
#define FAST_P4 1
#endif
#ifndef FAST_P5
#define FAST_P5 1
#endif
#ifndef FAST_MOE
#define FAST_MOE 1
#endif
#ifndef MOE_FP8
#define MOE_FP8 1
#endif
#ifndef P1_FP8
#define P1_FP8 1
#endif
#ifndef STEAL
#define STEAL 1
#endif
#ifndef ROUTER_MFMA
#define ROUTER_MFMA 1
#endif
#ifndef P1_HI
#define P1_HI 30
#endif
#ifndef MOE_STREAM
#define MOE_STREAM 1
#endif
#ifndef ATT_QUEUE
#define ATT_QUEUE 1
#endif
#ifndef ROWMETA_FUSED
#define ROWMETA_FUSED 1
#endif
#ifndef MERGE_FP8
#define MERGE_FP8 1
#endif
#ifndef H_BF16
#define H_BF16 1
#endif
#define RM_FUSED (ROWMETA_FUSED && MOE_FP8 && MOE_STREAM && FAST_MOE && ROUTER_MFMA)
#ifndef FAST_ATTN
#define FAST_ATTN 1
#endif
#ifndef FAST_MLSTM
#define FAST_MLSTM 1
#endif

constexpr int T = 16384, D = 1024, SEQ = 2048, NB = 8;
constexpr int DIN = 10760, NP = 10752;
constexpr int C_AQ = 0, C_AK = 1536, C_AV = 3072, C_MQ = 4608, C_MK = 5632, C_MV = 6656, C_MO = 7680, C_GA = 8704, C_GM = 9728;
constexpr int NE = 32, TOPK = 4, NA = T * TOPK, MAXTILES = NA / 256 + NE, XS_ROWS = MAXTILES * 256, ECAP = T;
constexpr float QSCALE = 0.08838834764831845f * 1.4426950408889634f;
constexpr float RMS_EPS = 1e-5f, LN_EPS = 1e-5f;

constexpr size_t MiB = 1u << 20;
constexpr size_t WS_CTL = 0, CTL_ZERO_BYTES = 1 * MiB;
constexpr size_t WS_WIN = 2 * MiB, WS_WAM = 23 * MiB, WS_WO = 26 * MiB, WS_WGU = 28 * MiB, WS_WDN = 156 * MiB;
constexpr size_t WS_XN = 220 * MiB, WS_GATES = 252 * MiB, WS_ROPE = 253 * MiB, WS_ROUTE = 255 * MiB;
constexpr size_t WS_H = 256 * MiB, WS_MERGED = 320 * MiB;
constexpr size_t WS_OG = 352 * MiB, WS_LSE = 400 * MiB, WS_HT = 401 * MiB, WS_AM = 433 * MiB;
constexpr int AMLD = 2560;
#ifndef MIX_STREAM
#define MIX_STREAM 0
#endif
constexpr size_t WS_YBUF = 352 * MiB;
constexpr size_t WS_PROJ = 513 * MiB;
constexpr size_t WS_XS = 513 * MiB, WS_ACT = 657 * MiB;
constexpr size_t WS_ROWMETA = 801 * MiB;
constexpr size_t WS_QC = 849 * MiB, WS_KC = 913 * MiB, WS_XN8 = 916 * MiB, WS_END = 977 * MiB;
constexpr int CW_TMO = 0, CW_BAR = 4096, CW_CNT = 8192  , CW_NTILES = 12288, CW_TILEE = 12352, CW_QCTR = 16384, CW_ACTR = 16448  , CW_READY = 32768  , CW_READY2 = 65536  ;

constexpr int RING_BYTES = 131072, LDS_BYTES = 147456, LDSCTL_OFF = LDS_BYTES - 256, MISC_OFF = LDSCTL_OFF;
constexpr int NWAVES = 8, NTHREADS = 512;

__device__ __forceinline__ unsigned f2bf(float f) { unsigned u = __builtin_bit_cast(unsigned, f); return (u + 0x7fffu + ((u >> 16) & 1u)) >> 16; }
__device__ __forceinline__ unsigned pk2(float lo, float hi) { unsigned r; asm("v_cvt_pk_bf16_f32 %0, %1, %2" : "=v"(r) : "v"(lo), "v"(hi)); return r; }
__device__ __forceinline__ unsigned pk4_fp8(float a, float b, float c, float d) { int w = __builtin_amdgcn_cvt_pk_fp8_f32(a, b, 0, false); w = __builtin_amdgcn_cvt_pk_fp8_f32(c, d, w, true); return (unsigned)w; }
__device__ __forceinline__ float frcp(float x) { return __builtin_amdgcn_rcpf(x); }
__device__ __forceinline__ float bf2f(unsigned b) { return __builtin_bit_cast(float, b << 16); }
__device__ __forceinline__ float bflo(unsigned w) { return __builtin_bit_cast(float, w << 16); }
__device__ __forceinline__ float bfhi(unsigned w) { return __builtin_bit_cast(float, w & 0xffff0000u); }
__device__ __forceinline__ float wave_sum(float v) {
#pragma unroll
    for (int o = 1; o < 64; o <<= 1) v += __shfl_xor(v, o);
    return v;
}
__device__ __forceinline__ float wave_max(float v) {
#pragma unroll
    for (int o = 1; o < 64; o <<= 1) v = fmaxf(v, __shfl_xor(v, o));
    return v;
}
__device__ __forceinline__ float sigmoidf_(float x) { return frcp(1.0f + __expf(-x)); }

__host__ __device__ __forceinline__ int win_logical_col(int c) {
    if (c < C_AV) { const int p = c & 127; if (p < 32) { const int a = p >> 3, n = (p >> 2) & 1, j = p & 3; return (c - p) + 16 * n + 4 * a + j; } return c; }
    return c < C_GA ? c : c + 8;
}
__host__ __device__ __forceinline__ int wgu_logical_col(int c) { const int pn = c >> 8, bj = (c >> 7) & 1, jl = c & 127; return 2 * (128 * pn + jl) + bj; }
namespace pg8 {
#define PG8_LAS __attribute__((address_space(3)))
typedef unsigned short bf16_t;
typedef short bf16x8 __attribute__((ext_vector_type(8)));
typedef float f32x4 __attribute__((ext_vector_type(4)));
typedef unsigned u32x4 __attribute__((ext_vector_type(4)));
constexpr int BM = 256, BK = 64, HALF = 128, HTB = HALF * BK * 2  , STAGE_BYTES = 8 * HTB, NXCD = 8, WGM = 8;

__host__ __device__ __forceinline__ int lds_byte(int r, int c) { const int st = (r >> 4) * 2 + (c >> 5), rr = r & 15, cc = c & 31, ob = rr * 64 + cc * 2; return st * 1024 + (ob ^ (((ob >> 9) & 1) << 5)); }
__host__ __device__ __forceinline__ void stage_rc(int b, int& R, int& C) { const int st = b / 1024, sb = b % 1024, swz = sb ^ (((sb >> 9) & 1) << 5); R = (st >> 1) * 16 + swz / 64; C = (st & 1) * 32 + (swz % 64) / 2; }
__host__ __device__ __forceinline__ int perm32(int rho) { const int n = rho >> 4, i = rho & 15; return 8 * (i >> 2) + 4 * n + (i & 3); }

typedef int i32x4 __attribute__((ext_vector_type(4)));
typedef int i32x8 __attribute__((ext_vector_type(8)));
template <bool FP8> struct FragT { typedef bf16x8 type; };
template <> struct FragT<true> { typedef i32x8 type; };
__device__ __forceinline__ f32x4 mma16(bf16x8 a, bf16x8 b, f32x4 c) { return __builtin_amdgcn_mfma_f32_16x16x32_bf16(a, b, c, 0, 0, 0); }
__device__ __forceinline__ f32x4 mma16(i32x8, i32x8, f32x4 c) { return c; }
__device__ __forceinline__ f32x4 mma8(i32x8 a, i32x8 b, f32x4 c) { const int one = 0x7F7F7F7F;
    asm volatile("v_mfma_scale_f32_16x16x128_f8f6f4 %0, %1, %2, %0, %3, %3 op_sel_hi:[0,0,0]" : "+v"(c) : "v"(a), "v"(b), "v"(one)); return c; }
__device__ __forceinline__ f32x4 mma8(bf16x8, bf16x8, f32x4 c) { return c; }
struct Unit { int pm, pn, part; };
struct Gemm { const bf16_t* A; const bf16_t* Bt; int M, N, K; };

struct StaticOrder {
    int nM, nN, nwg, G, c;
    __host__ __device__ void init(int M, int N, int G_, int c_) { nM = M / BM; nN = N / BM; nwg = nM * nN; G = G_; c = c_; }
    __host__ __device__ bool next(int i, Unit& u) const { return at((long)i * G + c, u); }
    __host__ __device__ bool at(long L, Unit& u) const {
        if (L >= nwg) return false;
        int wgid = (int)L; { const int q = nwg / NXCD, r = nwg % NXCD, xcd = wgid % NXCD, off = wgid / NXCD; wgid = (xcd < r ? xcd * (q + 1) : r * (q + 1) + (xcd - r) * q) + off; }
        const int nig = WGM * nN, gid = wgid / nig, fm = gid * WGM, gsz = (nM - fm) < WGM ? (nM - fm) : WGM;
        u.pm = fm + ((wgid % nig) % gsz); u.pn = (wgid % nig) / gsz; u.part = 0; return true;
    }
    __device__ __forceinline__ int kt0(const Unit&) const { return 0; }
    __device__ __forceinline__ int nkt(const Unit&, int full) const { return full; }
    __device__ __forceinline__ int rowsel(const Unit&, int r) const { return r; }
    __device__ __forceinline__ const void* abase(const Unit&) const { return nullptr; }
    __device__ __forceinline__ const void* bbase(const Unit&) const { return nullptr; }
    __device__ __forceinline__ void a_ready(const Unit&) const {}
    __device__ __forceinline__ void done(const Unit&) const {}
};


__device__ __forceinline__ unsigned cvt_pk_bf16(float lo, float hi) { unsigned r; asm volatile("v_cvt_pk_bf16_f32 %0, %1, %2" : "=v"(r) : "v"(lo), "v"(hi)); return r; }
__device__ __forceinline__ u32x4 pack8(const f32x4 v0, const f32x4 v1) { u32x4 w; w.x = cvt_pk_bf16(v0[0], v0[1]); w.y = cvt_pk_bf16(v0[2], v0[3]); w.z = cvt_pk_bf16(v1[0], v1[1]); w.w = cvt_pk_bf16(v1[2], v1[3]); return w; }
__device__ __forceinline__ void unpack8(const u32x4 w, f32x4& v0, f32x4& v1) {
    v0[0] = __builtin_bit_cast(float, w.x << 16); v0[1] = __builtin_bit_cast(float, w.x & 0xffff0000u); v0[2] = __builtin_bit_cast(float, w.y << 16); v0[3] = __builtin_bit_cast(float, w.y & 0xffff0000u);
    v1[0] = __builtin_bit_cast(float, w.z << 16); v1[1] = __builtin_bit_cast(float, w.z & 0xffff0000u); v1[2] = __builtin_bit_cast(float, w.w << 16); v1[3] = __builtin_bit_cast(float, w.w & 0xffff0000u);
}
__device__ __forceinline__ f32x4 sig4(const f32x4 x) { f32x4 r; r[0] = frcp(1.0f + __expf(-x[0])); r[1] = frcp(1.0f + __expf(-x[1])); r[2] = frcp(1.0f + __expf(-x[2])); r[3] = frcp(1.0f + __expf(-x[3])); return r; }

struct GroupedOrder {
    const unsigned* tile_e; int ntiles, nN, G, c; const int* rowidx;
    __device__ __forceinline__ int kt0(const Unit&) const { return 0; }
    __device__ __forceinline__ int nkt(const Unit&, int full) const { return full; }
    __device__ __forceinline__ int rowsel(const Unit&, int r) const { const int v = rowidx[r]; return (v < 0 ? 0 : v) >> 2; }
    __device__ __forceinline__ const void* abase(const Unit&) const { return nullptr; }
    __device__ __forceinline__ const void* bbase(const Unit&) const { return nullptr; }
    __device__ bool next(int i, Unit& u) const {
        const long L = (long)i * G + c; if (L >= (long)ntiles * nN) return false;
        u.pm = (int)(L / nN); const int e = (int)tile_e[u.pm]; u.pn = e * nN + (int)(L % nN); u.part = 0; return true;
    }
    __device__ __forceinline__ void a_ready(const Unit&) const {}
    __device__ __forceinline__ void done(const Unit&) const {}
};

template <int MODE> struct EpiProj {
    static constexpr bool PERM = true, AFTER_DRAIN = false, HAS_MID = false;
    bf16_t* O; const float* rope;
    __device__ __forceinline__ bool keep(const Unit&) const { return false; }
    __device__ __forceinline__ void operator()(f32x4 (&acc)[2][2][4][2], const Unit& u, int wr, int wc, int fr, int fq) const {
        const int pnp = (MODE == 0) ? u.pn : (MODE == 1) ? (u.pn < 18 ? u.pn : u.pn + (P1_HI - 18)) : u.pn + 18;
        const int row0 = u.pm * BM + wr * 64 + fr, col0 = pnp * BM + wc * 32 + 8 * fq;
        const float sc = ((pnp < 6) ? QSCALE : 1.0f) * ((MODE == 1) ? (1.0f / 32.0f) : 1.0f);
        const bool dorope = (pnp < 12) && (wc == 0);
#pragma unroll
        for (int ai = 0; ai < 2; ++ai)
#pragma unroll
            for (int m = 0; m < 4; ++m) {
                const int row = row0 + ai * HALF + m * 16; bf16_t* rowp = O + (size_t)row * NP + col0;
                f32x4 cs = (f32x4){1.f, 1.f, 1.f, 1.f}, sn = (f32x4){0.f, 0.f, 0.f, 0.f};
                if (dorope) { cs = *(const f32x4*)(rope + (size_t)row * 32 + 4 * fq); sn = *(const f32x4*)(rope + (size_t)row * 32 + 16 + 4 * fq); }
#pragma unroll
                for (int bj = 0; bj < 2; ++bj) {
                    f32x4 v0 = acc[ai][bj][m][0], v1 = acc[ai][bj][m][1];
                    if (dorope) { const f32x4 t0 = v0 * cs - v1 * sn, t1 = v1 * cs + v0 * sn; v0 = t0; v1 = t1; }
                    v0 = v0 * sc; v1 = v1 * sc;
                    *(u32x4*)(rowp + bj * HALF) = pack8(v0, v1);
                }
            }
    }
};

struct SplitOrder {
    StaticOrder base; int nA, nB;
    __device__ bool next(int i, Unit& u) const {
        const int c = base.c;
        if (base.G != 256 || nA < 0) return base.next(i, u);
        if (c < 128) { if (i >= nA) return false; return base.at((long)i * 128 + c, u); }
        if (i >= nB) return false; return base.at((long)128 * nA + (long)i * 128 + (c - 128), u);
    }
    __device__ __forceinline__ int kt0(const Unit&) const { return 0; }
    __device__ __forceinline__ int nkt(const Unit&, int full) const { return full; }
    __device__ __forceinline__ int rowsel(const Unit&, int r) const { return r; }
    __device__ __forceinline__ const void* abase(const Unit&) const { return nullptr; }
    __device__ __forceinline__ const void* bbase(const Unit&) const { return nullptr; }
    __device__ __forceinline__ void a_ready(const Unit&) const {}
    __device__ __forceinline__ void done(const Unit&) const {}
};
struct MergedOrder {
    StaticOrder base; int nparts; unsigned* ready; unsigned* tmo;
    bool pub;
    __device__ bool next(int i, Unit& u) const { if (!base.next(i / nparts, u)) return false; u.part = (nparts == 1) ? 2 : (i % nparts); return true; }
#if MERGE_FP8
    __device__ __forceinline__ int kt0(const Unit& u) const { return u.part == 0 ? 0 : (u.part == 1 ? 4 : 12); }
    __device__ __forceinline__ int nkt(const Unit& u, int) const { return u.part == 0 ? 4 : 8; }
#else
    __device__ __forceinline__ int kt0(const Unit& u) const { return u.part == 0 ? 0 : (u.part == 1 ? 8 : 24); }
    __device__ __forceinline__ int nkt(const Unit& u, int) const { return u.part == 0 ? 8 : 16; }
#endif
    __device__ __forceinline__ int rowsel(const Unit&, int r) const { return r; }
    __device__ __forceinline__ const void* abase(const Unit&) const { return nullptr; }
    __device__ __forceinline__ const void* bbase(const Unit&) const { return nullptr; }
    __device__ __forceinline__ void a_ready(const Unit& u) const {
        if (u.part != 2 || !pub) return;
        if (threadIdx.x < 64) {
            unsigned spins = 0;
            while ((unsigned)__builtin_amdgcn_readfirstlane(__hip_atomic_load(ready + 64 * u.pm, __ATOMIC_RELAXED, __HIP_MEMORY_SCOPE_AGENT)) < 32u) {
                __builtin_amdgcn_s_sleep(2);
                if (++spins > (1u << 22)) { if (threadIdx.x == 0) __hip_atomic_store(tmo, 1u, __ATOMIC_RELAXED, __HIP_MEMORY_SCOPE_AGENT); break; } }
            __builtin_amdgcn_fence(__ATOMIC_ACQUIRE, "agent");
            asm volatile("s_waitcnt vmcnt(0)" ::: "memory");
        }
        asm volatile("" ::: "memory"); __builtin_amdgcn_s_barrier(); asm volatile("" ::: "memory");
    }
    __device__ __forceinline__ void done(const Unit& u) const {
        if (!pub || u.part != 1) return;
        asm volatile("s_waitcnt vmcnt(0)" ::: "memory");
        __builtin_amdgcn_s_barrier(); asm volatile("" ::: "memory");
        if (threadIdx.x == 0) { __builtin_amdgcn_fence(__ATOMIC_RELEASE, "agent"); asm volatile("s_waitcnt vmcnt(0)" ::: "memory");
                                __hip_atomic_fetch_add(ready + 64 * u.pm, 8u, __ATOMIC_RELAXED, __HIP_MEMORY_SCOPE_AGENT); }
    }
};
struct EpiMerged {
    static constexpr bool PERM = true, AFTER_DRAIN = false, HAS_MID = false;
    bf16_t* O; const bf16_t* proj; const float* x; float* h; bool wt;
    __device__ __forceinline__ bool keep(const Unit& u) const { return u.part == 0; }
    __device__ __forceinline__ void operator()(f32x4 (&acc)[2][2][4][2], const Unit& u, int wr, int wc, int fr, int fq) const {
        const int row0 = u.pm * BM + wr * 64 + fr, col0 = u.pn * BM + wc * 32 + 8 * fq;
        if (u.part == 0) {
#pragma unroll
            for (int ai = 0; ai < 2; ++ai)
#pragma unroll
                for (int m = 0; m < 4; ++m) {
                    const bf16_t* rowp = proj + (size_t)(row0 + ai * HALF + m * 16) * NP + col0;
#pragma unroll
                    for (int bj = 0; bj < 2; ++bj) {
                        const u32x4 ga = *(const u32x4*)(rowp + C_GA + bj * HALF), gm = *(const u32x4*)(rowp + C_GM + bj * HALF);
                        f32x4 a0, a1, m0, m1; unpack8(ga, a0, a1); unpack8(gm, m0, m1);
                        f32x4 r0, r1;
#pragma unroll
                        for (int j = 0; j < 4; ++j) { r0[j] = (1.0f + __expf(-m0[j])) * frcp(1.0f + __expf(-a0[j])); r1[j] = (1.0f + __expf(-m1[j])) * frcp(1.0f + __expf(-a1[j])); }
                        acc[ai][bj][m][0] *= r0; acc[ai][bj][m][1] *= r1;
                    }
                    if (m & 1) asm volatile("" ::: "memory");
                }
        } else if (u.part == 1) {
#pragma unroll
            for (int ai = 0; ai < 2; ++ai)
#pragma unroll
                for (int m = 0; m < 4; ++m) {
                    const int row = row0 + ai * HALF + m * 16;
#pragma unroll
                    for (int bj = 0; bj < 2; ++bj) {
                        const u32x4 gm = *(const u32x4*)(proj + (size_t)row * NP + C_GM + col0 + bj * HALF);
                        f32x4 m0, m1; unpack8(gm, m0, m1);
#if MERGE_FP8
                        const f32x4 v0 = acc[ai][bj][m][0] * sig4(m0) * (1.0f / 32.0f), v1 = acc[ai][bj][m][1] * sig4(m1) * (1.0f / 32.0f);
                        u32x2 p8; p8.x = pk4_fp8(v0[0], v0[1], v0[2], v0[3]); p8.y = pk4_fp8(v1[0], v1[1], v1[2], v1[3]);
                        *(u32x2*)((unsigned char*)O + (size_t)row * AMLD + col0 + bj * HALF) = p8;
#else
                        const f32x4 v0 = acc[ai][bj][m][0] * sig4(m0), v1 = acc[ai][bj][m][1] * sig4(m1);
                        const u32x4 pw = pack8(v0, v1); bf16_t* dst = O + (size_t)row * AMLD + col0 + bj * HALF;
                        if (wt) { __hip_atomic_store((unsigned long long*)dst, (unsigned long long)pw.x | ((unsigned long long)pw.y << 32), __ATOMIC_RELAXED, __HIP_MEMORY_SCOPE_AGENT);
                                  __hip_atomic_store((unsigned long long*)dst + 1, (unsigned long long)pw.z | ((unsigned long long)pw.w << 32), __ATOMIC_RELAXED, __HIP_MEMORY_SCOPE_AGENT); }
                        else *(u32x4*)dst = pw;
#endif
                    }
                }
        } else {
#pragma unroll
            for (int ai = 0; ai < 2; ++ai)
#pragma unroll
                for (int m = 0; m < 4; ++m) {
                    const size_t off = (size_t)(row0 + ai * HALF + m * 16) * D + col0;
#if H_BF16
#pragma unroll
                    for (int bj = 0; bj < 2; ++bj) { const float osc = MERGE_FP8 ? (1.0f / 256.0f) : 1.0f;
                        const f32x4 v0 = *(const f32x4*)(x + off + bj * HALF) + acc[ai][bj][m][0] * osc, v1 = *(const f32x4*)(x + off + bj * HALF + 4) + acc[ai][bj][m][1] * osc;
                        *(u32x4*)((bf16_t*)h + off + bj * HALF) = pack8(v0, v1); }
#else
#pragma unroll
                    for (int bj = 0; bj < 2; ++bj)
#pragma unroll
                        for (int n = 0; n < 2; ++n) *(f32x4*)(h + off + bj * HALF + 4 * n) = *(const f32x4*)(x + off + bj * HALF + 4 * n) + acc[ai][bj][m][n];
#endif
                }
        }
    }
};

struct EpiResid {
    static constexpr bool PERM = false, AFTER_DRAIN = false, HAS_MID = false;
    const float* x; float* h;
    __device__ __forceinline__ bool keep(const Unit&) const { return false; }
    __device__ __forceinline__ void operator()(f32x4 (&acc)[2][2][4][2], const Unit& u, int wr, int wc, int fr, int fq) const {
        const int row0 = u.pm * BM + wr * 64 + fr, col0 = u.pn * BM + wc * 32 + 4 * fq;
#pragma unroll
        for (int ai = 0; ai < 2; ++ai)
#pragma unroll
            for (int m = 0; m < 4; ++m) {
                const size_t off = (size_t)(row0 + ai * HALF + m * 16) * D + col0;
#pragma unroll
                for (int bj = 0; bj < 2; ++bj)
#pragma unroll
                    for (int n = 0; n < 2; ++n) *(f32x4*)(h + off + bj * HALF + n * 16) = *(const f32x4*)(x + off + bj * HALF + n * 16) + acc[ai][bj][m][n];
            }
    }
};

template <bool OUT8> struct EpiSwiGLU {
    static constexpr bool PERM = true, AFTER_DRAIN = false, HAS_MID = false;
    bf16_t* act; const float* bgu; float sc;
    __device__ __forceinline__ bool keep(const Unit&) const { return false; }
    __device__ __forceinline__ void operator()(f32x4 (&acc)[2][2][4][2], const Unit& u, int wr, int wc, int fr, int fq) const {
        const int e = u.pn >> 3, pnl = u.pn & 7, row0 = u.pm * BM + wr * 64 + fr, j0 = 128 * pnl + 32 * wc + 8 * fq;
        const float* bp = bgu + (size_t)e * 2048 + 2 * j0;
        const f32x4 b0 = *(const f32x4*)(bp), b1 = *(const f32x4*)(bp + 4), b2 = *(const f32x4*)(bp + 8), b3 = *(const f32x4*)(bp + 12);
        const f32x4 bg0 = (f32x4){b0[0], b0[2], b1[0], b1[2]}, bu0 = (f32x4){b0[1], b0[3], b1[1], b1[3]}, bg1 = (f32x4){b2[0], b2[2], b3[0], b3[2]}, bu1 = (f32x4){b2[1], b2[3], b3[1], b3[3]};
#pragma unroll
        for (int ai = 0; ai < 2; ++ai)
#pragma unroll
            for (int m = 0; m < 4; ++m) {
                const int row = row0 + ai * HALF + m * 16;
                f32x4 o[2]; const float lim = 7.0f, nlim = -7.0f;
#pragma unroll
                for (int n = 0; n < 2; ++n) {
                    const f32x4 g = acc[ai][0][m][n] * sc + (n ? bg1 : bg0), up = acc[ai][1][m][n] * sc + (n ? bu1 : bu0);
#pragma unroll
                    for (int j = 0; j < 4; ++j) { float gg, uu;
                        asm("v_min_f32 %0, %2, %1" : "=v"(gg) : "v"(g[j]), "v"(lim)); asm("v_med3_f32 %0, %1, %2, %3" : "=v"(uu) : "v"(up[j]), "v"(nlim), "v"(lim));
                        const float sg = frcp(1.0f + __builtin_amdgcn_exp2f(gg * (-1.702f * 1.4426950408889634f)));
                        o[n][j] = __builtin_fmaf(uu, gg, gg) * sg; }
                }
                if constexpr (OUT8) { u32x2 w8; w8.x = pk4_fp8(o[0][0], o[0][1], o[0][2], o[0][3]); w8.y = pk4_fp8(o[1][0], o[1][1], o[1][2], o[1][3]); __hip_atomic_store((unsigned long long*)((unsigned char*)act + (size_t)row * D + j0), (unsigned long long)w8.x | ((unsigned long long)w8.y << 32), __ATOMIC_RELAXED, __HIP_MEMORY_SCOPE_AGENT); }
                else *(u32x4*)(act + (size_t)row * D + j0) = pack8(o[0], o[1]);
            }
    }
};

struct EpiDown {
    static constexpr bool PERM = true, AFTER_DRAIN = false, HAS_MID = false;
    bf16_t* ybuf; const float* bdn; const int* row_tok; const float* row_w; float sc;
    const LAS int* tbase; const LAS int* tnv;
    __device__ __forceinline__ bool keep(const Unit&) const { return false; }
    __device__ __forceinline__ void operator()(f32x4 (&acc)[2][2][4][2], const Unit& u, int wr, int wc, int fr, int fq) const {
        const int e = u.pn >> 2, pnl = u.pn & 3, col0 = 256 * pnl + 32 * wc + 8 * fq;
#if RM_FUSED
        const int row0 = tbase[u.pm] + wr * 64 + fr, nvr = tnv[u.pm] - (wr * 64 + fr);
#else
        const int row0 = u.pm * BM + wr * 64 + fr;
#endif
        f32x4 bv[2][2];
#pragma unroll
        for (int bj = 0; bj < 2; ++bj)
#pragma unroll
            for (int n = 0; n < 2; ++n) bv[bj][n] = *(const f32x4*)(bdn + (size_t)e * D + col0 + bj * HALF + 4 * n);
        int tks[8]; float ws[8];
#pragma unroll
#if RM_FUSED
        for (int i = 0; i < 8; ++i) { const int o = (i >> 2) * HALF + (i & 3) * 16; const bool ok = o < nvr; const int row = ok ? row0 + o : 0; tks[i] = row_tok[row]; ws[i] = row_w[row]; if (!ok) tks[i] = -1; }
#else
        for (int i = 0; i < 8; ++i) { const int row = row0 + (i >> 2) * HALF + (i & 3) * 16; tks[i] = row_tok[row]; ws[i] = row_w[row]; }
#endif
#pragma unroll
        for (int ai = 0; ai < 2; ++ai)
#pragma unroll
            for (int m = 0; m < 4; ++m) {
                const int tk = tks[ai * 4 + m]; const float w = ws[ai * 4 + m];
                if (tk >= 0) {
#pragma unroll
                    for (int bj = 0; bj < 2; ++bj) {
                        const f32x4 v0 = (acc[ai][bj][m][0] * sc + bv[bj][0]) * w, v1 = (acc[ai][bj][m][1] * sc + bv[bj][1]) * w;
                        *(u32x4*)(ybuf + (size_t)tk * D + col0 + bj * HALF) = pack8(v0, v1);
                    }
                }
            }
    }
};

struct MoeOrder {
    const LAS unsigned* tile_e; int ntiles, G, c; const int* rowidx; const void *a0, *a1, *b0, *b1; unsigned* ready; unsigned* tmo;
    const LAS int* tbase; const LAS int* tnv;
    __device__ __forceinline__ int kt0(const Unit&) const { return 0; }
    __device__ __forceinline__ int nkt(const Unit&, int full) const { return full; }
#if RM_FUSED
    __device__ __forceinline__ int rowsel(const Unit& u, int r) const { if (u.part) return r; const int lr = r - u.pm * BM; return (lr < tnv[u.pm]) ? (rowidx[tbase[u.pm] + lr] >> 2) : 0; }
#else
    __device__ __forceinline__ int rowsel(const Unit& u, int r) const { if (u.part) return r; const int v = rowidx[r]; return (v < 0 ? 0 : v) >> 2; }
#endif
    __device__ __forceinline__ const void* abase(const Unit& u) const { return u.part ? a1 : a0; }
    __device__ __forceinline__ const void* bbase(const Unit& u) const { return u.part ? b1 : b0; }
    __device__ bool next(int i, Unit& u) const {
        long L = (long)i * G + c; const long n1 = (long)ntiles * 8;
        if (L < n1) { u.pm = (int)(L >> 3); u.pn = (int)tile_e[u.pm] * 8 + (int)(L & 7); u.part = 0; return true; }
        L -= n1; if (L >= (long)ntiles * 4) return false;
        u.pm = (int)(L >> 2); u.pn = (int)tile_e[u.pm] * 4 + (int)(L & 3); u.part = 1; return true;
    }
    __device__ __forceinline__ void a_ready(const Unit& u) const {
        if (u.part == 0) return;
        if (threadIdx.x < 64) {
            unsigned spins = 0;
            while ((unsigned)__builtin_amdgcn_readfirstlane(__hip_atomic_load(ready + 64 * u.pm, __ATOMIC_RELAXED, __HIP_MEMORY_SCOPE_AGENT)) < 64u) {
                __builtin_amdgcn_s_sleep(2);
                if (++spins > (1u << 22)) { if (threadIdx.x == 0) __hip_atomic_store(tmo, 1u, __ATOMIC_RELAXED, __HIP_MEMORY_SCOPE_AGENT); break; } }
            __builtin_amdgcn_fence(__ATOMIC_ACQUIRE, "agent");
            asm volatile("s_waitcnt vmcnt(0)" ::: "memory");
        }
        asm volatile("" ::: "memory"); __builtin_amdgcn_s_barrier(); asm volatile("" ::: "memory");
    }
    __device__ __forceinline__ void done(const Unit& u) const {
        if (u.part != 0) return;
        asm volatile("s_waitcnt vmcnt(0)" ::: "memory");
        if ((threadIdx.x & 63) == 0) __hip_atomic_fetch_add(ready + 64 * u.pm, 1u, __ATOMIC_RELAXED, __HIP_MEMORY_SCOPE_AGENT);
    }
};
struct EpiMoe {
    static constexpr bool PERM = true, AFTER_DRAIN = false, HAS_MID = false;
    EpiSwiGLU<true> e0; EpiDown e1;
    __device__ __forceinline__ bool keep(const Unit&) const { return false; }
    __device__ __forceinline__ void operator()(f32x4 (&acc)[2][2][4][2], const Unit& u, int wr, int wc, int fr, int fq) const {
        if (u.part == 0) e0(acc, u, wr, wc, fr, fq); else e1(acc, u, wr, wc, fr, fq);
    }
};
template <class Epi, class Sched, bool ALIGN_EPI = false, bool SP2 = false, bool FP8 = false, bool GATHER = false, bool MULTI = false>
__device__ __forceinline__ void gemm_phase(PG8_LAS unsigned char* lds, const Gemm g, const Sched& S, const Epi& E) {
    typedef typename FragT<FP8>::type frag_t;
    const int tid = threadIdx.x, wid = __builtin_amdgcn_readfirstlane(tid >> 6), lane = tid & 63, wr = wid >> 2, wc = wid & 3, fr = lane & 15, fq = lane >> 4;
    int K_ = g.K; asm volatile("" : "+s"(K_));
    const int K = K_, ntfull = K / BK;
    unsigned voffA[2], voffB[2];
#pragma unroll
    for (int i = 0; i < 2; ++i) { int R, C; stage_rc(tid * 16 + i * 8192, R, C); const int Rb = Epi::PERM ? ((R & ~31) + perm32(R & 31)) : R;
        voffA[i] = (unsigned)(R * K + C) * 2u; voffB[i] = (unsigned)(Rb * K + C) * 2u; }
    const size_t kstep = (size_t)(BK * 2);
    const size_t hstep = (size_t)HALF * K * 2;
    const size_t tstep = 2 * hstep;
    const unsigned ldsw = (unsigned)wid * 1024u;
    const int aoff = lds_byte(wr * 64 + fr, fq * (FP8 ? 16 : 8)), boff = lds_byte(wc * 32 + fr, fq * (FP8 ? 16 : 8));
    constexpr int NKF = FP8 ? 1 : 2;
#define PG8_SA(b, h) (((b) * 2 + (h)) * HTB)
#define PG8_SB(b, h) ((4 + (b) * 2 + (h)) * HTB)
#define PG8_STAGE(bufoff, gbase, voff) do { _Pragma("unroll") for (int _i = 0; _i < 2; ++_i) \
        __builtin_amdgcn_global_load_lds((const unsigned*)((const char*)(gbase) + (voff)[_i]), (PG8_LAS unsigned*)(lds + (bufoff) + ldsw + _i * 8192), 16, 0, 0); } while (0)
#define PG8_STAGEA(bufoff, gbase, half, isnext) do { if constexpr (GATHER) { unsigned vs_[2]; vs_[0] = (isnext) ? voffAn[half][0] : voffAc[half][0]; vs_[1] = (isnext) ? voffAn[half][1] : voffAc[half][1]; PG8_STAGE(bufoff, gbase, vs_); } \
        else { PG8_STAGE(bufoff, (gbase) + (half) * hstep, voffA); } } while (0)
#define PG8_LDA(dst, b, h) do { _Pragma("unroll") for (int m = 0; m < 4; ++m) _Pragma("unroll") for (int k = 0; k < NKF; ++k) dst[m][k] = *(const PG8_LAS frag_t*)(lds + PG8_SA(b, h) + aoff + m * 2048 + k * 1024); } while (0)
#define PG8_LDB(dst, b, h) do { _Pragma("unroll") for (int n = 0; n < 2; ++n) _Pragma("unroll") for (int k = 0; k < NKF; ++k) dst[n][k] = *(const PG8_LAS frag_t*)(lds + PG8_SB(b, h) + boff + n * 2048 + k * 1024); } while (0)
#define PG8_MMA(ai, bj, At, Bt) do { __builtin_amdgcn_s_setprio(1); \
        if constexpr (FP8) { _Pragma("unroll") for (int m = 0; m < 4; ++m) _Pragma("unroll") for (int n = 0; n < 2; ++n) \
            acc[ai][bj][m][n] = mma8(Bt[n][0], At[m][0], acc[ai][bj][m][n]); } \
        else { _Pragma("unroll") for (int m = 0; m < 4; ++m) _Pragma("unroll") for (int n = 0; n < 2; ++n) _Pragma("unroll") for (int k = 0; k < 2; ++k) \
            acc[ai][bj][m][n] = mma16(Bt[n][k], At[m][k], acc[ai][bj][m][n]); } \
        __builtin_amdgcn_s_setprio(0); } while (0)
#define PG8_WAIT_V(n) asm volatile("s_waitcnt vmcnt(" #n ")" ::: "memory")
#define PG8_WAIT_L(n) asm volatile("s_waitcnt lgkmcnt(" #n ")" ::: "memory")
#define PG8_BAR __builtin_amdgcn_s_barrier()
#define PG8_SCHED __builtin_amdgcn_sched_barrier(0)
    Unit cur, nxt; int ui = 0;
    if (!S.next(0, cur)) return;
    unsigned voffAc[2][2], voffAn[2][2];
#define PG8_GROWS(dst, u_) do { if constexpr (GATHER) { _Pragma("unroll") for (int h_ = 0; h_ < 2; ++h_) _Pragma("unroll") for (int i_ = 0; i_ < 2; ++i_) { int R_, C_; stage_rc(tid * 16 + i_ * 8192, R_, C_); \
        const int ri_ = S.rowsel((u_), (u_).pm * BM + h_ * HALF + R_); dst[h_][i_] = (unsigned)ri_ * (unsigned)(K * 2) + (unsigned)(C_ * 2); } } } while (0)
    PG8_GROWS(voffAc, cur);
    f32x4 acc[2][2][4][2];
#pragma unroll
    for (int a = 0; a < 2; ++a)
#pragma unroll
        for (int b = 0; b < 2; ++b)
#pragma unroll
            for (int m = 0; m < 4; ++m)
#pragma unroll
                for (int n = 0; n < 2; ++n) acc[a][b][m][n] = (f32x4){0.f, 0.f, 0.f, 0.f};
    frag_t At[4][NKF], B0[2][NKF], B1[2][NKF];
    const char* cA = (MULTI ? (const char*)S.abase(cur) : (const char*)g.A) + (GATHER ? (size_t)0 : (size_t)cur.pm * tstep) + (size_t)S.kt0(cur) * kstep; const char* cB = (MULTI ? (const char*)S.bbase(cur) : (const char*)g.Bt) + (size_t)cur.pn * tstep + (size_t)S.kt0(cur) * kstep;
    S.a_ready(cur);
    if constexpr (SP2) {
        PG8_STAGE(PG8_SB(0, 0), cB, voffB); PG8_STAGE(PG8_SB(0, 1), cB + hstep, voffB); PG8_STAGEA(PG8_SA(0, 0), cA, 0, false); PG8_STAGEA(PG8_SA(0, 1), cA, 1, false);
        if (wr == 1) PG8_BAR;
        PG8_WAIT_V(2); PG8_BAR;
        PG8_STAGE(PG8_SB(1, 0), cB + kstep, voffB); PG8_STAGEA(PG8_SA(1, 0), cA + kstep, 0, false); PG8_STAGE(PG8_SB(1, 1), cB + hstep + kstep, voffB);
        PG8_WAIT_V(6); PG8_BAR;
    } else {
        PG8_STAGE(PG8_SB(0, 0), cB, voffB); PG8_STAGEA(PG8_SA(0, 0), cA, 0, false); PG8_STAGE(PG8_SB(0, 1), cB + hstep, voffB); PG8_STAGEA(PG8_SA(0, 1), cA, 1, false);
        if (wr == 1) PG8_BAR;
        PG8_WAIT_V(4); PG8_BAR;
        PG8_STAGE(PG8_SB(1, 0), cB + kstep, voffB); PG8_STAGEA(PG8_SA(1, 0), cA + kstep, 0, false); PG8_STAGE(PG8_SB(1, 1), cB + hstep + kstep, voffB);
        PG8_WAIT_V(6); PG8_BAR;
    }
    for (;;) {
        const bool has_next = S.next(ui + 1, nxt);
        if (has_next) PG8_GROWS(voffAn, nxt);
        else if constexpr (GATHER) { _Pragma("unroll") for (int h_ = 0; h_ < 2; ++h_) _Pragma("unroll") for (int i_ = 0; i_ < 2; ++i_) voffAn[h_][i_] = voffAc[h_][i_]; }
        const char* nA = has_next ? (MULTI ? (const char*)S.abase(nxt) : (const char*)g.A) + (GATHER ? (size_t)0 : (size_t)nxt.pm * tstep) + (size_t)S.kt0(nxt) * kstep : cA; const char* nB = has_next ? (MULTI ? (const char*)S.bbase(nxt) : (const char*)g.Bt) + (size_t)nxt.pn * tstep + (size_t)S.kt0(nxt) * kstep : cB;
        const int nt = S.nkt(cur, ntfull);
        for (int t = 0; t < nt; t += 2) {
            const bool last = (t == nt - 2);
            const char* a1 = cA + (size_t)(t + 1) * kstep;
            const char* a2 = last ? nA : cA + (size_t)(t + 2) * kstep; const char* b2 = last ? nB : cB + (size_t)(t + 2) * kstep;
            const char* a3 = a2 + kstep; const char* b3 = b2 + kstep;
            if (last && has_next) S.a_ready(nxt);
            if constexpr (SP2) {
            PG8_LDB(B0, 0, 0); PG8_LDB(B1, 0, 1); PG8_SCHED; PG8_LDA(At, 0, 0); PG8_STAGEA(PG8_SA(1, 1), a1, 1, false);
            PG8_WAIT_V(8); PG8_WAIT_L(0); PG8_BAR; PG8_MMA(0, 0, At, B0); PG8_MMA(0, 1, At, B1); PG8_BAR; PG8_SCHED;
            PG8_LDA(At, 0, 1); PG8_STAGE(PG8_SB(0, 0), b2, voffB); PG8_STAGE(PG8_SB(0, 1), b2 + hstep, voffB); PG8_STAGEA(PG8_SA(0, 0), a2, 0, last);
            PG8_WAIT_V(8); PG8_WAIT_L(0); PG8_BAR; PG8_MMA(1, 0, At, B0); PG8_MMA(1, 1, At, B1); PG8_BAR; PG8_SCHED;
            PG8_LDB(B0, 1, 0); PG8_LDB(B1, 1, 1); PG8_SCHED; PG8_LDA(At, 1, 0); PG8_STAGEA(PG8_SA(0, 1), a2, 1, last);
            PG8_WAIT_V(8); PG8_WAIT_L(0); PG8_BAR; PG8_MMA(0, 0, At, B0); PG8_MMA(0, 1, At, B1); PG8_BAR; PG8_SCHED;
            PG8_LDA(At, 1, 1); PG8_STAGE(PG8_SB(1, 0), b3, voffB); PG8_STAGE(PG8_SB(1, 1), b3 + hstep, voffB); PG8_STAGEA(PG8_SA(1, 0), a3, 0, last);
            PG8_WAIT_V(8); PG8_WAIT_L(0); PG8_BAR; PG8_MMA(1, 0, At, B0); PG8_MMA(1, 1, At, B1); PG8_BAR; PG8_SCHED;
            } else {
            PG8_LDB(B0, 0, 0); PG8_SCHED; PG8_LDA(At, 0, 0); PG8_STAGEA(PG8_SA(1, 1), a1, 1, false);
            PG8_WAIT_L(8); PG8_BAR; PG8_WAIT_L(0); PG8_MMA(0, 0, At, B0); PG8_BAR; PG8_SCHED;
            PG8_LDB(B1, 0, 1); PG8_STAGE(PG8_SB(0, 0), b2, voffB);
            PG8_BAR; PG8_WAIT_L(0); PG8_MMA(0, 1, At, B1); PG8_BAR;
            PG8_LDA(At, 0, 1); PG8_STAGEA(PG8_SA(0, 0), a2, 0, last);
            PG8_BAR; PG8_WAIT_L(0); PG8_MMA(1, 0, At, B0); PG8_BAR; PG8_SCHED;
            PG8_STAGE(PG8_SB(0, 1), b2 + hstep, voffB);
            PG8_WAIT_V(6); PG8_BAR; PG8_MMA(1, 1, At, B1); PG8_BAR;
            PG8_LDB(B0, 1, 0); PG8_SCHED; PG8_LDA(At, 1, 0); PG8_STAGEA(PG8_SA(0, 1), a2, 1, last);
            PG8_WAIT_L(8); PG8_BAR; PG8_WAIT_L(0); PG8_MMA(0, 0, At, B0); PG8_BAR; PG8_SCHED;
            PG8_LDB(B1, 1, 1); PG8_STAGE(PG8_SB(1, 0), b3, voffB);
            PG8_BAR; PG8_WAIT_L(0); PG8_MMA(0, 1, At, B1); PG8_BAR;
            PG8_LDA(At, 1, 1); PG8_STAGEA(PG8_SA(1, 0), a3, 0, last);
            PG8_BAR; PG8_WAIT_L(0); PG8_MMA(1, 0, At, B0); PG8_BAR; PG8_SCHED;
            PG8_STAGE(PG8_SB(1, 1), b3 + hstep, voffB);
            PG8_WAIT_V(6); PG8_BAR; PG8_MMA(1, 1, At, B1); PG8_BAR;
            }
        }
        if constexpr (FP8) asm volatile("s_nop 15\n\ts_nop 15" ::: "memory");
        if constexpr (ALIGN_EPI) { if (wr == 0) PG8_BAR; }
        if constexpr (!Epi::AFTER_DRAIN) { E(acc, cur, wr, wc, fr, fq); S.done(cur); }
        if (!has_next) break;
        if (!E.keep(cur)) {
#pragma unroll
        for (int a = 0; a < 2; ++a)
#pragma unroll
            for (int b = 0; b < 2; ++b)
#pragma unroll
                for (int m = 0; m < 4; ++m)
#pragma unroll
                    for (int n = 0; n < 2; ++n) acc[a][b][m][n] = (f32x4){0.f, 0.f, 0.f, 0.f};
        }
        cur = nxt; cA = nA; cB = nB; ++ui;
        if constexpr (GATHER) { _Pragma("unroll") for (int h_ = 0; h_ < 2; ++h_) _Pragma("unroll") for (int i_ = 0; i_ < 2; ++i_) voffAc[h_][i_] = voffAn[h_][i_]; }
        if constexpr (ALIGN_EPI) { if (wr == 1) PG8_BAR; }
    }
    PG8_WAIT_V(0);
    if constexpr (!ALIGN_EPI) { if (wr == 0) PG8_BAR; }
    PG8_BAR;
    if constexpr (Epi::AFTER_DRAIN) { E.fused(acc, cur, wr, wc, fr, fq, lds, wid, lane); S.done(cur); }
#undef PG8_SA
#undef PG8_SB
#undef PG8_STAGE
#undef PG8_LDA
#undef PG8_STAGEA
#undef PG8_GROWS
#undef PG8_LDB
#undef PG8_MMA
#undef PG8_WAIT_V
#undef PG8_WAIT_L
#undef PG8_BAR
#undef PG8_SCHED
}
}
#define XB_TMO      128
#define XB_XCNT(j)  (256  + 64 * (j))
#define XB_XSUB(j)  (1280 + 64 * (j))
#define XB_XGEN(j)  (2304 + 64 * (j))
#define XB_TOP      3328
#define XB_TOPGEN   3392
#define XCD_BAR_WORDS 3456
#define XB_SPIN_CAP (1u << 24)

__device__ __forceinline__ unsigned xb_ld(unsigned* p)              { return __hip_atomic_load(p, __ATOMIC_RELAXED, __HIP_MEMORY_SCOPE_AGENT); }
__device__ __forceinline__ unsigned xb_add(unsigned* p, unsigned v) { return __hip_atomic_fetch_add(p, v, __ATOMIC_RELAXED, __HIP_MEMORY_SCOPE_AGENT); }
__device__ __forceinline__ unsigned xb_xcc_id() { return (unsigned)__builtin_amdgcn_s_getreg((3 << 11) | 20) & 0xFu; }
#define XB_SPIN(cond, bar) do { unsigned _sp = 0; while (cond) { __builtin_amdgcn_s_sleep(1); \
    if ((++_sp & 255u) == 0u) { if (xb_ld(&(bar)[XB_TMO])) break; if (_sp > XB_SPIN_CAP) { atomicAdd(&(bar)[XB_TMO], 1u); break; } } } } while (0)

struct XcdBarrier {
    unsigned* bar; unsigned x;
    volatile LAS unsigned* st;
};

__device__ __forceinline__ XcdBarrier xcd_barrier_post(unsigned* bar, volatile LAS unsigned* st) {
    XcdBarrier b; b.bar = bar; b.x = xb_xcc_id(); b.st = st;
    if (threadIdx.x == 0) (void)xb_add(&bar[XB_XCNT(b.x)], 1u);
    return b;
}
__device__ __forceinline__ void xcd_barrier_complete(unsigned* bar, unsigned x, unsigned& nloc, unsigned& nx) {
    const unsigned G = gridDim.x * gridDim.y * gridDim.z;
    unsigned sum, cnt, mine, sp = 0u;
    for (;;) {
        sum = 0u; cnt = 0u; mine = 0u;
#pragma unroll
        for (unsigned j = 0; j < 16; ++j) { const unsigned c = xb_ld(&bar[XB_XCNT(j)]); sum += c; cnt += (c > 0u) ? 1u : 0u; mine = (j == x) ? c : mine; }
        if (sum == G) break;
        __builtin_amdgcn_s_sleep(1);
        if ((++sp & 255u) == 0u) { if (xb_ld(&bar[XB_TMO])) break; if (sp > XB_SPIN_CAP) { atomicAdd(&bar[XB_TMO], 1u); break; } }
    }
    nloc = mine > 0u ? mine : 1u; nx = cnt > 0u ? cnt : 1u;
}

__device__ __forceinline__ void xcd_barrier(const XcdBarrier& b) {
    asm volatile("s_waitcnt vmcnt(0)" ::: "memory");
    __syncthreads();
    if (threadIdx.x == 0) {
        unsigned* bar = b.bar;
        __builtin_amdgcn_s_waitcnt(0);
        unsigned nloc = b.st[0], nx = b.st[1];
        if (nloc == 0u) { xcd_barrier_complete(bar, b.x, nloc, nx); b.st[0] = nloc; b.st[1] = nx; }
        const unsigned old = xb_add(&bar[XB_XSUB(b.x)], 1u);
        const unsigned gen = old / nloc;
        if (old + 1u == (gen + 1u) * nloc) {
            __builtin_amdgcn_fence(__ATOMIC_RELEASE, "agent");
            asm volatile("s_waitcnt vmcnt(0)" ::: "memory");
            const unsigned og = xb_add(&bar[XB_TOP], 1u);
            const unsigned tg = og / nx;
            if (og + 1u == (tg + 1u) * nx) xb_add(&bar[XB_TOPGEN], 1u);
            else XB_SPIN(xb_ld(&bar[XB_TOPGEN]) == tg, bar);
            __builtin_amdgcn_fence(__ATOMIC_ACQUIRE, "agent");
            xb_add(&bar[XB_XGEN(b.x)], 1u);
            asm volatile("s_waitcnt vmcnt(0)" ::: "memory");
        } else {
            XB_SPIN(xb_ld(&bar[XB_XGEN(b.x)]) == gen, bar);
            __builtin_amdgcn_fence(__ATOMIC_ACQUIRE, "agent");
            asm volatile("s_waitcnt vmcnt(0)" ::: "memory");
        }
    }
    __syncthreads();
}

struct Frame {
    LAS unsigned char* lds;
    unsigned* ctl;
    int tid, lane, wave, vcu, G, gw, NGW;
    const float *x, *g_mix, *w_in, *conv_qk, *b_if, *g_mnorm, *w_attn_out, *w_mlstm_out, *w_mix_out, *g_ffn, *w_router, *b_router, *w_gate_up, *b_gate_up, *w_down, *b_down, *g_final;
    const int* positions;
    float* out;
    bf16 *WinT, *WamT, *WoT, *WguT, *WdnT, *XN, *PROJ, *OG, *AM, *MERGED, *XS, *ACT, *YBUF;
    float *GATES, *ROPE, *LSE, *HT, *H, *QC, *KC, *ROW_W, *TOK_W;
    int *TOK_E, *TOK_SLOT, *ROW_TOK;
};

__constant__ double ROPE_REV[16] = {
    1.59154943091895346e-01, 7.00865215877985032e-02, 3.08637634047012298e-02, 1.35913706361939050e-02, 5.98518571271370540e-03, 2.63567589866741401e-03, 1.16066364124006098e-03, 5.11117504537543857e-04,
    2.25079079039276525e-04, 9.91173093690193548e-05, 4.36479527928028909e-05, 1.92211006849448627e-05, 8.46433080824140138e-06, 3.72740860191535193e-06, 1.64142626279503449e-06, 7.22829306883286479e-07};

template <int MAP>
__device__ __forceinline__ void transpose_item(const float* W, int Nsrc, bf16* WT, int ldk, int kofs, int nblk, LAS float* scr, int item, int lane) {
    const int kb = item / nblk, nb = item % nblk, k0 = 64 * kb, n0 = 32 * nb;
    const int np = n0 + (lane & 31);
    const int sc = (MAP == 1) ? win_logical_col(np) : (MAP == 2) ? wgu_logical_col(np) : np;
    float tv[32];
#pragma unroll
    for (int i = 0; i < 32; ++i) tv[i] = W[(size_t)(k0 + 2 * i + (lane >> 5)) * Nsrc + sc];
#pragma unroll
    for (int i = 0; i < 32; ++i) scr[(2 * i + (lane >> 5)) * 33 + (lane & 31)] = tv[i];
    asm volatile("s_waitcnt lgkmcnt(0)" ::: "memory");
    const int c = lane & 7;
#pragma unroll
    for (int j = 0; j < 4; ++j) { const int n = (lane >> 3) + 8 * j; const LAS float* s = scr + (8 * c) * 33 + n;
        u32x4 o; o.x = pk2(s[0 * 33], s[1 * 33]); o.y = pk2(s[2 * 33], s[3 * 33]); o.z = pk2(s[4 * 33], s[5 * 33]); o.w = pk2(s[6 * 33], s[7 * 33]);
        *(u32x4*)(WT + (size_t)(n0 + n) * ldk + kofs + k0 + 8 * c) = o; }
    asm volatile("s_waitcnt lgkmcnt(0)" ::: "memory");
}

template <int MAP>
__device__ __forceinline__ void transpose_item_fp8(const float* W, int Nsrc, unsigned char* WT, int ldk, int nblk, LAS float* scr, int item, int lane, float scale) {
    const int kb = item / nblk, nb = item % nblk, k0 = 64 * kb, n0 = 32 * nb;
    const int np = n0 + (lane & 31);
    const int sc = (MAP == 1) ? win_logical_col(np) : (MAP == 2) ? wgu_logical_col(np) : np;
    float tv[32];
#pragma unroll
    for (int i = 0; i < 32; ++i) tv[i] = W[(size_t)(k0 + 2 * i + (lane >> 5)) * Nsrc + sc];
#pragma unroll
    for (int i = 0; i < 32; ++i) scr[(2 * i + (lane >> 5)) * 33 + (lane & 31)] = tv[i] * scale;
    asm volatile("s_waitcnt lgkmcnt(0)" ::: "memory");
    const int n = lane >> 1, c = lane & 1;
#pragma unroll
    for (int q = 0; q < 2; ++q) { const LAS float* s = scr + (32 * c + 16 * q) * 33 + n;
        u32x4 o; o.x = pk4_fp8(s[0 * 33], s[1 * 33], s[2 * 33], s[3 * 33]); o.y = pk4_fp8(s[4 * 33], s[5 * 33], s[6 * 33], s[7 * 33]);
        o.z = pk4_fp8(s[8 * 33], s[9 * 33], s[10 * 33], s[11 * 33]); o.w = pk4_fp8(s[12 * 33], s[13 * 33], s[14 * 33], s[15 * 33]);
        *(u32x4*)(WT + (size_t)(n0 + n) * ldk + k0 + 32 * c + 16 * q) = o; }
    asm volatile("s_waitcnt lgkmcnt(0)" ::: "memory");
}

template <int MAP>
__device__ __forceinline__ void tr8_load(const float* W, int Nsrc, int nblk, int item, int lane, float (&tv)[32]) {
    const int kb = item / nblk, nb = item % nblk, k0 = 64 * kb, np = 32 * nb + (lane & 31);
    const int sc = (MAP == 1) ? win_logical_col(np) : (MAP == 2) ? wgu_logical_col(np) : np;
#pragma unroll
    for (int i = 0; i < 32; ++i) tv[i] = W[(size_t)(k0 + 2 * i + (lane >> 5)) * Nsrc + sc];
}
__device__ __forceinline__ void tr8_store(const float (&tv)[32], unsigned char* WT, int ldk, int nblk, LAS float* scr, int item, int lane, float scale) {
    const int kb = item / nblk, nb = item % nblk, k0 = 64 * kb, n0 = 32 * nb;
#pragma unroll
    for (int i = 0; i < 32; ++i) scr[(2 * i + (lane >> 5)) * 33 + (lane & 31)] = tv[i] * scale;
    asm volatile("s_waitcnt lgkmcnt(0)" ::: "memory");
    const int n = lane >> 1, c = lane & 1;
#pragma unroll
    for (int q = 0; q < 2; ++q) { const LAS float* s = scr + (32 * c + 16 * q) * 33 + n;
        u32x4 o; o.x = pk4_fp8(s[0 * 33], s[1 * 33], s[2 * 33], s[3 * 33]); o.y = pk4_fp8(s[4 * 33], s[5 * 33], s[6 * 33], s[7 * 33]);
        o.z = pk4_fp8(s[8 * 33], s[9 * 33], s[10 * 33], s[11 * 33]); o.w = pk4_fp8(s[12 * 33], s[13 * 33], s[14 * 33], s[15 * 33]);
        *(u32x4*)(WT + (size_t)(n0 + n) * ldk + k0 + 32 * c + 16 * q) = o; }
    asm volatile("s_waitcnt lgkmcnt(0)" ::: "memory");
}

__device__ __forceinline__ void p0_weights(Frame& F) {
    LAS float* scr = (LAS float*)(F.lds + F.wave * 16384);
    constexpr int I_IN = (D / 64) * (NP / 32), I_A = (512 / 64) * (D / 32), I_M = (D / 64) * (D / 32), I_O = I_M;
    constexpr int I_GU1 = (D / 64) * (2048 / 32), I_DN1 = (D / 64) * (D / 32);
    constexpr int NITEMS = I_IN + I_A + I_M + I_O + ((MOE_FP8 && STEAL) ? 0 : NE * I_GU1 + NE * I_DN1);
    for (int it = F.gw; it < NITEMS; it += F.NGW) {
        int r = it;
#if P1_FP8
        if (r < I_IN) { const int pn = (r % (NP / 32)) >> 3;
            if (pn < 18 || pn >= P1_HI) transpose_item_fp8<1>(F.w_in, DIN, (unsigned char*)F.WinT - (pn >= P1_HI ? (size_t)(P1_HI - 18) * 256 * D : (size_t)0), D, NP / 32, scr, r, F.lane, 32.0f);
            else transpose_item<1>(F.w_in, DIN, F.WinT, D, 0, NP / 32, scr, r, F.lane);
            continue; } r -= I_IN;
#else
        if (r < I_IN) { transpose_item<1>(F.w_in, DIN, F.WinT, D, 0, NP / 32, scr, r, F.lane); continue; } r -= I_IN;
#endif
#if MERGE_FP8
        if (r < I_A) { transpose_item_fp8<0>(F.w_attn_out, D, (unsigned char*)F.WamT, AMLD, D / 32, scr, r, F.lane, 32.0f); continue; } r -= I_A;
        if (r < I_M) { transpose_item_fp8<0>(F.w_mlstm_out, D, (unsigned char*)F.WamT + 512, AMLD, D / 32, scr, r, F.lane, 32.0f); continue; } r -= I_M;
        if (r < I_O) { transpose_item_fp8<0>(F.w_mix_out, D, (unsigned char*)F.WamT + 1536, AMLD, D / 32, scr, r, F.lane, 32.0f); continue; } r -= I_O;
#else
        if (r < I_A) { transpose_item<0>(F.w_attn_out, D, F.WamT, AMLD, 0, D / 32, scr, r, F.lane); continue; } r -= I_A;
        if (r < I_M) { transpose_item<0>(F.w_mlstm_out, D, F.WamT, AMLD, 512, D / 32, scr, r, F.lane); continue; } r -= I_M;
        if (r < I_O) { transpose_item<0>(F.w_mix_out, D, F.WamT, AMLD, 1536, D / 32, scr, r, F.lane); continue; } r -= I_O;
#endif
#if MOE_FP8 && STEAL
        (void)r;
#elif MOE_FP8
        if (r < NE * I_GU1) { const int e = r / I_GU1; transpose_item_fp8<2>(F.w_gate_up + (size_t)e * D * 2048, 2048, (unsigned char*)F.WguT + (size_t)e * 2048 * D, D, 2048 / 32, scr, r % I_GU1, F.lane, 32.0f); continue; } r -= NE * I_GU1;
        { const int e = r / I_DN1; transpose_item_fp8<0>(F.w_down + (size_t)e * D * D, D, (unsigned char*)F.WdnT + (size_t)e * D * D, D, D / 32, scr, r % I_DN1, F.lane, 32.0f); }
#else
        if (r < NE * I_GU1) { const int e = r / I_GU1; transpose_item<2>(F.w_gate_up + (size_t)e * D * 2048, 2048, F.WguT + (size_t)e * 2048 * D, D, 0, 2048 / 32, scr, r % I_GU1, F.lane); continue; } r -= NE * I_GU1;
        { const int e = r / I_DN1; transpose_item<0>(F.w_down + (size_t)e * D * D, D, F.WdnT + (size_t)e * D * D, D, 0, D / 32, scr, r % I_DN1, F.lane); }
#endif
    }
}

__device__ __forceinline__ void p0_rows(Frame& F) {
    LAS float* w8t = (LAS float*)(F.lds);
    __syncthreads();
    { float w8v[16];
#pragma unroll
      for (int j = 0; j < 16; ++j) { const int i = F.tid + j * NTHREADS; w8v[j] = F.w_in[(size_t)(i >> 3) * DIN + 8704 + (i & 7)]; }
#pragma unroll
      for (int j = 0; j < 16; ++j) { const int i = F.tid + j * NTHREADS; w8t[(i & 7) * 1024 + (i >> 3)] = w8v[j]; } }
    __syncthreads();
    f32x4 vnx[4];
    if (F.gw < T) { const f32x4* xr = (const f32x4*)(F.x + (size_t)F.gw * D) + F.lane;
#pragma unroll
        for (int j = 0; j < 4; ++j) vnx[j] = xr[64 * j]; }
    for (int row = F.gw; row < T; row += F.NGW) {
        f32x4 v[4]; float s = 0.f;
#pragma unroll
        for (int j = 0; j < 4; ++j) { v[j] = vnx[j]; s += (v[j].x * v[j].x + v[j].y * v[j].y) + (v[j].z * v[j].z + v[j].w * v[j].w); }
        if (row + F.NGW < T) { const f32x4* xr = (const f32x4*)(F.x + (size_t)(row + F.NGW) * D) + F.lane;
#pragma unroll
            for (int j = 0; j < 4; ++j) vnx[j] = xr[64 * j]; }
        const float rstd = 1.0f / sqrtf(wave_sum(s) * (1.0f / D) + RMS_EPS);
        float ga[8];
#pragma unroll
        for (int o = 0; o < 8; ++o) ga[o] = 0.f;
        unsigned long long* o8 = (unsigned long long*)(F.XN + (size_t)row * D) + F.lane;
#pragma unroll
        for (int j = 0; j < 4; ++j) {
            const f32x4 g = *((const f32x4*)F.g_mix + F.lane + 64 * j);
            v[j] = v[j] * rstd * g;
            o8[64 * j] = (unsigned long long)pk2(v[j].x, v[j].y) | ((unsigned long long)pk2(v[j].z, v[j].w) << 32);
#if P1_FP8
            ((unsigned*)((unsigned char*)F.ctl + WS_XN8 + (size_t)row * D))[F.lane + 64 * j] = pk4_fp8(v[j].x, v[j].y, v[j].z, v[j].w);
#endif
#pragma unroll
            for (int o = 0; o < 8; ++o) { const f32x4 w = *((const LAS f32x4*)(w8t + o * 1024) + F.lane + 64 * j); ga[o] += (v[j].x * w.x + v[j].y * w.y) + (v[j].z * w.z + v[j].w * w.w); }
        }
#pragma unroll
        for (int o = 0; o < 8; ++o) ga[o] = wave_sum(ga[o]);
        if (F.lane < 8) { float gv = ga[0];
#pragma unroll
            for (int o = 1; o < 8; ++o) gv = (F.lane == o) ? ga[o] : gv;
            F.GATES[(size_t)row * 8 + F.lane] = gv + F.b_if[F.lane]; }
        if (F.lane < 16) {
            const int pos = F.positions[row];
            double rev = (double)pos * ROPE_REV[F.lane]; rev -= floor(rev);
            const float fr = (float)rev;
            F.ROPE[(size_t)row * 32 + F.lane] = __builtin_amdgcn_cosf(fr);
            F.ROPE[(size_t)row * 32 + 16 + F.lane] = __builtin_amdgcn_sinf(fr);
        }
    }
}

template <int RT, class AF, class BF, class EP>
__device__ __forceinline__ void naive_gemm(Frame& F, int M, int N, int K, AF af, BF bf, EP ep) {
    const long gthreads = (long)F.G * NTHREADS, gtid = (long)blockIdx.x * NTHREADS + F.tid;
    for (long it = gtid; it < (long)(M / RT) * N; it += gthreads) {
        const int col = (int)(it % N), r0 = (int)(it / N) * RT;
        float acc[RT];
#pragma unroll
        for (int r = 0; r < RT; ++r) acc[r] = 0.f;
        for (int k = 0; k < K; ++k) { const float b = bf(k, col);
#pragma unroll
            for (int r = 0; r < RT; ++r) acc[r] += af(r0 + r, k) * b; }
#pragma unroll
        for (int r = 0; r < RT; ++r) ep(r0 + r, col, acc[r]);
    }
}

__device__ __forceinline__ void naive_p1(Frame& F) {
    const bf16* XN = F.XN; const float* W = F.w_in; bf16* P = F.PROJ;
    naive_gemm<8>(F, T, NP, D,
        [=](int r, int k) { return bf2f(XN[(size_t)r * D + k]); },
        [=](int k, int c) { return bf2f(f2bf(W[(size_t)k * DIN + win_logical_col(c)])); },
        [=](int r, int c, float a) { P[(size_t)r * NP + c] = (bf16)f2bf(a * (c < C_AK ? QSCALE : 1.0f)); });
}
__device__ __forceinline__ void naive_p1_rope(Frame& F) {
    const long gthreads = (long)F.G * NTHREADS, gtid = (long)blockIdx.x * NTHREADS + F.tid;
    for (long it = gtid; it < (long)T * 24 * 16; it += gthreads) {
        const int i = (int)(it & 15), hh = (int)((it >> 4) % 24), row = (int)(it / (24 * 16));
        const int a = i >> 2, j = i & 3; bf16* p = F.PROJ + (size_t)row * NP + hh * 128;
        const float x1 = bf2f(p[8 * a + j]), x2 = bf2f(p[8 * a + 4 + j]), cs = F.ROPE[(size_t)row * 32 + i], sn = F.ROPE[(size_t)row * 32 + 16 + i];
        p[8 * a + j] = (bf16)f2bf(x1 * cs - x2 * sn); p[8 * a + 4 + j] = (bf16)f2bf(x2 * cs + x1 * sn);
    }
}
__device__ __forceinline__ void naive_attn(Frame& F) {
    for (int it = F.gw; it < T * 12; it += F.NGW) {
        const int row = it / 12, gh = it % 12, g = gh >> 2, h = gh & 3, b = row / SEQ, t = row % SEQ, d = (g == 0) ? 1 : (g == 1) ? 4 : 16, i = t / d, r = t % d;
        const int hc = g * 512 + h * 128 + 2 * F.lane;
        const unsigned qw = *(const unsigned*)(F.PROJ + (size_t)row * NP + C_AQ + hc); const float q0 = bflo(qw), q1 = bfhi(qw);
        float m = -INFINITY, l = 0.f, o0 = 0.f, o1 = 0.f;
        for (int ii = (i > 128 ? i - 128 : 0); ii <= i; ++ii) {
            const size_t kr = (size_t)(b * SEQ + r + d * ii) * NP;
            const unsigned kw = *(const unsigned*)(F.PROJ + kr + C_AK + hc), vw = *(const unsigned*)(F.PROJ + kr + C_AV + hc);
            const float s = wave_sum(q0 * bflo(kw) + q1 * bfhi(kw));
            const float mn = fmaxf(m, s), al = exp2f(m - mn), p = exp2f(s - mn);
            l = l * al + p; o0 = o0 * al + p * bflo(vw); o1 = o1 * al + p * bfhi(vw); m = mn;
        }
        const float il = 1.0f / l;
        *(unsigned*)(F.OG + ((size_t)g * T + row) * 512 + h * 128 + 2 * F.lane) = pk2(o0 * il, o1 * il);
        if (F.lane == 0) F.LSE[((size_t)g * T + row) * 4 + h] = m + log2f(l);
    }
}
__device__ __forceinline__ void naive_conv(Frame& F) {
    const long gthreads = (long)F.G * NTHREADS, gtid = (long)blockIdx.x * NTHREADS + F.tid;
    for (long it = gtid; it < (long)T * 2048; it += gthreads) {
        const int c = (int)(it & 2047), row = (int)(it >> 11), t = row % SEQ;
        float a = 0.f;
#pragma unroll
        for (int j = 0; j < 4; ++j) if (t - 3 + j >= 0) a += F.conv_qk[j * 2048 + c] * bf2f(F.PROJ[(size_t)(row - 3 + j) * NP + C_MQ + c]);
        const float y = a / (1.0f + __expf(-a));
        if (c < 1024) F.QC[(size_t)row * 1024 + c] = y; else F.KC[(size_t)row * 1024 + c - 1024] = y * 0.0625f;
    }
}
__device__ __forceinline__ void naive_mlstm(Frame& F) {
    LAS float* sq = (LAS float*)F.lds; LAS float* sk = sq + 256; LAS float* red = sk + 256; LAS float* redn = red + 512;
    for (int item = blockIdx.x; item < NB * 4 * 8; item += F.G) {
        const int sl = item & 7, h = (item >> 3) & 3, b = item >> 5, dvl = F.tid & 31, dkp = F.tid >> 5;
        float c[16], n[16];
#pragma unroll
        for (int j = 0; j < 16; ++j) { c[j] = 0.f; n[j] = 0.f; }
        float m = 0.f;
        for (int t = 0; t < SEQ; ++t) {
            const size_t row = (size_t)b * SEQ + t;
            __syncthreads();
            if (F.tid < 256) sq[F.tid] = F.QC[row * 1024 + h * 256 + F.tid]; else sk[F.tid - 256] = F.KC[row * 1024 + h * 256 + F.tid - 256];
            const float v = bf2f(F.PROJ[row * NP + C_MV + h * 256 + sl * 32 + dvl]);
            const float ir = F.GATES[row * 8 + h], fr = F.GATES[row * 8 + 4 + h];
            const float logf = fminf(fr, 0.f) - log1pf(__expf(-fabsf(fr)));
            const float mn = fmaxf(logf + m, ir), fa = __expf(logf + m - mn), ia = __expf(ir - mn);
            m = mn;
            __syncthreads();
            float pn = 0.f, pd = 0.f;
#pragma unroll
            for (int j = 0; j < 16; ++j) { const float kk = sk[dkp * 16 + j], qq = sq[dkp * 16 + j]; c[j] = fa * c[j] + ia * kk * v; n[j] = fa * n[j] + ia * kk; pn += qq * c[j]; pd += qq * n[j]; }
            red[dkp * 32 + dvl] = pn; redn[dkp * 32 + dvl] = pd;
            __syncthreads();
            if (F.tid < 32) { float num = 0.f, den = 0.f;
#pragma unroll
                for (int p = 0; p < 16; ++p) { num += red[p * 32 + F.tid]; den += redn[p * 32 + F.tid]; }
                F.HT[row * 1024 + h * 256 + sl * 32 + F.tid] = num / fmaxf(fabsf(den), __expf(-mn)); }
        }
    }
}
__device__ __forceinline__ void naive_p4(Frame& F) {
    const bf16 *AM = F.AM, *PJ = F.PROJ; const float *WA = F.w_attn_out, *WM = F.w_mlstm_out; bf16* O = F.AM + 1536;
    float* tmp = F.QC;
    naive_gemm<8>(F, T, D, 512, [=](int r, int k) { return bf2f(AM[(size_t)r * AMLD + k]); }, [=](int k, int c) { return bf2f(f2bf(WA[(size_t)k * D + c])); },
        [=](int r, int c, float a) { tmp[(size_t)r * D + c] = a * sigmoidf_(bf2f(PJ[(size_t)r * NP + C_GA + c])); });
    __threadfence();
    naive_gemm<8>(F, T, D, D, [=](int r, int k) { return bf2f(AM[(size_t)r * AMLD + 512 + k]); }, [=](int k, int c) { return bf2f(f2bf(WM[(size_t)k * D + c])); },
        [=](int r, int c, float a) { O[(size_t)r * AMLD + c] = (bf16)f2bf(tmp[(size_t)r * D + c] + a * sigmoidf_(bf2f(PJ[(size_t)r * NP + C_GM + c]))); });
}
__device__ __forceinline__ void naive_p5(Frame& F) {
    const bf16* MG = F.AM + 1536; const float *WO = F.w_mix_out, *X = F.x; float* H = F.H;
    naive_gemm<8>(F, T, D, D, [=](int r, int k) { return bf2f(MG[(size_t)r * AMLD + k]); }, [=](int k, int c) { return bf2f(f2bf(WO[(size_t)k * D + c])); },
        [=](int r, int c, float a) { H[(size_t)r * D + c] = X[(size_t)r * D + c] + a; });
}
__device__ __forceinline__ void naive_p8(Frame& F, int ntiles) {
    const long gthreads = (long)F.G * NTHREADS, gtid = (long)blockIdx.x * NTHREADS + F.tid;
    const unsigned* tile_e = F.ctl + CW_TILEE;
    for (long it = gtid; it < (long)ntiles * 256 * D; it += gthreads) {
        const int j = (int)(it & 1023), row = (int)(it >> 10), e = (int)tile_e[row >> 8];
        if (F.ROW_TOK[row] < 0) { F.ACT[(size_t)row * D + j] = 0; continue; }
        const float* W = F.w_gate_up + (size_t)e * D * 2048; float g = 0.f, u = 0.f;
        for (int k = 0; k < D; ++k) { const float a = bf2f(F.XS[(size_t)row * D + k]); g += a * bf2f(f2bf(W[(size_t)k * 2048 + 2 * j])); u += a * bf2f(f2bf(W[(size_t)k * 2048 + 2 * j + 1])); }
        g += F.b_gate_up[e * 2048 + 2 * j]; u += F.b_gate_up[e * 2048 + 2 * j + 1];
        const float gg = fminf(g, 7.0f), uu = fminf(fmaxf(u, -7.0f), 7.0f);
        F.ACT[(size_t)row * D + j] = (bf16)f2bf((uu + 1.0f) * gg / (1.0f + __expf(-1.702f * gg)));
    }
}
__device__ __forceinline__ void naive_p9(Frame& F, int ntiles) {
    const long gthreads = (long)F.G * NTHREADS, gtid = (long)blockIdx.x * NTHREADS + F.tid;
    const unsigned* tile_e = F.ctl + CW_TILEE;
    for (long it = gtid; it < (long)ntiles * 256 * D; it += gthreads) {
        const int c = (int)(it & 1023), row = (int)(it >> 10), e = (int)tile_e[row >> 8], tk = F.ROW_TOK[row];
        if (tk < 0) continue;
        const float* W = F.w_down + (size_t)e * D * D; float y = 0.f;
        for (int k = 0; k < D; ++k) y += bf2f(F.ACT[(size_t)row * D + k]) * bf2f(f2bf(W[(size_t)k * D + c]));
        F.YBUF[(size_t)tk * D + c] = (bf16)f2bf((y + F.b_down[e * D + c]) * F.ROW_W[row]);
    }
}

__device__ __forceinline__ void p3_post_mixer(Frame& F) {
    for (int row = F.gw; row < T; row += F.NGW) {
        { const int h = F.lane >> 4; float l0 = F.LSE[((size_t)0 * T + row) * 4 + h], l1 = F.LSE[((size_t)1 * T + row) * 4 + h], l2 = F.LSE[((size_t)2 * T + row) * 4 + h];
          const float mx = fmaxf(l0, fmaxf(l1, l2)); float w0 = exp2f(l0 - mx), w1 = exp2f(l1 - mx), w2 = exp2f(l2 - mx); const float inv = 1.0f / (w0 + w1 + w2); w0 *= inv; w1 *= inv; w2 *= inv;
          const u32x4 a = *(const u32x4*)(F.OG + ((size_t)0 * T + row) * 512 + 8 * F.lane), b = *(const u32x4*)(F.OG + ((size_t)1 * T + row) * 512 + 8 * F.lane), c = *(const u32x4*)(F.OG + ((size_t)2 * T + row) * 512 + 8 * F.lane);
          f32x4 a0, a1, b0, b1, c0, c1; pg8::unpack8(a, a0, a1); pg8::unpack8(b, b0, b1); pg8::unpack8(c, c0, c1);
          const f32x4 o0 = a0 * w0 + b0 * w1 + c0 * w2, o1 = a1 * w0 + b1 * w1 + c1 * w2;
#if MERGE_FP8
          u32x2 w; w.x = pk4_fp8(o0[0] * 8.f, o0[1] * 8.f, o0[2] * 8.f, o0[3] * 8.f); w.y = pk4_fp8(o1[0] * 8.f, o1[1] * 8.f, o1[2] * 8.f, o1[3] * 8.f);
          *(u32x2*)((unsigned char*)F.AM + (size_t)row * AMLD + 8 * F.lane) = w; }
#else
          u32x4 w; w.x = pk2(o0[0], o0[1]); w.y = pk2(o0[2], o0[3]); w.z = pk2(o1[0], o1[1]); w.w = pk2(o1[2], o1[3]);
          *(u32x4*)(F.AM + (size_t)row * AMLD + 8 * F.lane) = w; }
#endif
        { f32x4 v[4]; float s = 0.f;
#if FAST_MLSTM
          { const bf16* hp = (const bf16*)F.HT + (size_t)row * D + 16 * F.lane; const u32x4 w0 = *(const u32x4*)hp, w1 = *(const u32x4*)(hp + 8); pg8::unpack8(w0, v[0], v[1]); pg8::unpack8(w1, v[2], v[3]); }
#else
          { const float* hp = F.HT + (size_t)row * D + 16 * F.lane;
#pragma unroll
            for (int j = 0; j < 4; ++j) v[j] = *(const f32x4*)(hp + 4 * j); }
#endif
#pragma unroll
          for (int j = 0; j < 4; ++j) s += (v[j].x + v[j].y) + (v[j].z + v[j].w);
          s += __shfl_xor(s, 1); s += __shfl_xor(s, 2); s += __shfl_xor(s, 4); s += __shfl_xor(s, 8);
          const float mu = s * (1.0f / 256.0f); float q = 0.f;
#pragma unroll
          for (int j = 0; j < 4; ++j) { v[j] = v[j] - mu; q += (v[j].x * v[j].x + v[j].y * v[j].y) + (v[j].z * v[j].z + v[j].w * v[j].w); }
          q += __shfl_xor(q, 1); q += __shfl_xor(q, 2); q += __shfl_xor(q, 4); q += __shfl_xor(q, 8);
          const float rstd = 1.0f / sqrtf(q * (1.0f / 256.0f) + LN_EPS);
          const bf16* mo = F.PROJ + (size_t)row * NP + C_MO + 16 * F.lane; bf16* op = F.AM + (size_t)row * AMLD + 512 + 16 * F.lane;
#if MERGE_FP8
          u32x4 w8; const float rs8 = rstd * 8.f;
#endif
#pragma unroll
          for (int jj = 0; jj < 2; ++jj) { const u32x4 mw = *(const u32x4*)(mo + 8 * jj); f32x4 m0, m1; pg8::unpack8(mw, m0, m1);
              const f32x4 g0 = *(const f32x4*)(F.g_mnorm + 16 * F.lane + 8 * jj), g1 = *(const f32x4*)(F.g_mnorm + 16 * F.lane + 8 * jj + 4);
#if MERGE_FP8
              const f32x4 o0 = v[2 * jj] * rs8 * g0 * pg8::sig4(m0), o1 = v[2 * jj + 1] * rs8 * g1 * pg8::sig4(m1);
              w8[2 * jj] = pk4_fp8(o0[0], o0[1], o0[2], o0[3]); w8[2 * jj + 1] = pk4_fp8(o1[0], o1[1], o1[2], o1[3]); }
          (void)op; *(u32x4*)((unsigned char*)F.AM + (size_t)row * AMLD + 512 + 16 * F.lane) = w8; }
#else
              const f32x4 o0 = v[2 * jj] * rstd * g0 * pg8::sig4(m0), o1 = v[2 * jj + 1] * rstd * g1 * pg8::sig4(m1);
              u32x4 w; w.x = pk2(o0[0], o0[1]); w.y = pk2(o0[2], o0[3]); w.z = pk2(o1[0], o1[1]); w.w = pk2(o1[2], o1[3]);
              *(u32x4*)(op + 8 * jj) = w; } }
#endif
    }
}

constexpr int RT_WS = 1028;
constexpr int RT_TAB = NE * RT_WS * 4, RT_CNT = RT_TAB + 64 * 4 * 12;
static_assert(RT_CNT + 256 <= LDSCTL_OFF, "router LDS map");
__device__ __forceinline__ void p6_router(Frame& F) {
    LAS float* wt = (LAS float*)F.lds;
    LAS int* tab = (LAS int*)(F.lds + RT_TAB); LAS int* cntl = (LAS int*)(F.lds + RT_CNT); LAS int* basel = cntl + 32;
    const int lane = F.lane;
    for (int r0 = 0; r0 < T; r0 += F.NGW * 8) {
        __syncthreads();
        if (r0 == 0) for (int i = F.tid; i < D * NE; i += NTHREADS) wt[(i & 31) * RT_WS + (i >> 5)] = F.w_router[i];
        if (F.tid < 32) cntl[F.tid] = 0;
        __syncthreads();
        f32x4 vn[4];
        { const int row = r0 + F.gw; if (row < T) { const f32x4* hr = (const f32x4*)(F.H + (size_t)row * D) + lane;
#pragma unroll
            for (int j = 0; j < 4; ++j) vn[j] = hr[64 * j]; } }
        for (int ri = 0; ri < 8; ++ri) {
            const int row = r0 + ri * F.NGW + F.gw; if (row >= T) break;
            f32x4 v[4]; float s = 0.f;
#pragma unroll
            for (int j = 0; j < 4; ++j) { v[j] = vn[j]; s += (v[j].x * v[j].x + v[j].y * v[j].y) + (v[j].z * v[j].z + v[j].w * v[j].w); }
            { const int rown = row + F.NGW; if (ri + 1 < 8 && rown < T) { const f32x4* hr = (const f32x4*)(F.H + (size_t)rown * D) + lane;
#pragma unroll
                for (int j = 0; j < 4; ++j) vn[j] = hr[64 * j]; } }
            const float rstd = 1.0f / sqrtf(wave_sum(s) * (1.0f / D) + RMS_EPS);
            unsigned long long* o8 = (unsigned long long*)(F.XN + (size_t)row * D) + lane;
#pragma unroll
            for (int j = 0; j < 4; ++j) { const f32x4 g = *((const f32x4*)F.g_ffn + lane + 64 * j); v[j] = v[j] * rstd * g;
#if MOE_FP8
                ((unsigned*)((unsigned char*)F.XN + (size_t)row * D))[lane + 64 * j] = pk4_fp8(v[j].x, v[j].y, v[j].z, v[j].w); }
#else
                o8[64 * j] = (unsigned long long)pk2(v[j].x, v[j].y) | ((unsigned long long)pk2(v[j].z, v[j].w) << 32); }
#endif
            float lg[32];
#pragma unroll
            for (int e = 0; e < 32; ++e) { float a = 0.f;
#pragma unroll
                for (int j = 0; j < 4; ++j) { const f32x4 w = *((const LAS f32x4*)(wt + e * RT_WS) + lane + 64 * j); a += (v[j].x * w.x + v[j].y * w.y) + (v[j].z * w.z + v[j].w * w.w); }
                lg[e] = a; if ((e & 3) == 3) asm volatile("" ::: "memory"); }
#define RT_BF(N_, O_) do { const bool up = (lane & (O_)) != 0; _Pragma("unroll") for (int i = 0; i < (N_); ++i) { const float send = up ? lg[i] : lg[i + (N_)]; const float keep = up ? lg[i + (N_)] : lg[i]; lg[i] = keep + __shfl_xor(send, (O_)); } } while (0)
            RT_BF(16, 32); RT_BF(8, 16); RT_BF(4, 8); RT_BF(2, 4); RT_BF(1, 2);
#undef RT_BF
            float lgt = lg[0] + __shfl_xor(lg[0], 1);
            const int e = (lane >> 1) & 31;
            lgt += F.b_router[e];
            float tv[4]; int ti[4]; float cur = lgt;
#pragma unroll
            for (int r = 0; r < 4; ++r) { float bv = cur; int bi = e;
#pragma unroll
                for (int o = 2; o < 64; o <<= 1) { const float ov = __shfl_xor(bv, o); const int oi = __shfl_xor(bi, o); if (ov > bv || (ov == bv && oi < bi)) { bv = ov; bi = oi; } }
                tv[r] = bv; ti[r] = bi; if (e == bi) cur = -INFINITY; }
            const float e1 = __expf(tv[1] - tv[0]), e2 = __expf(tv[2] - tv[0]), e3 = __expf(tv[3] - tv[0]), inv = 1.0f / (1.0f + e1 + e2 + e3);
            if (lane < 4) {
                const int ee = (lane == 0) ? ti[0] : (lane == 1) ? ti[1] : (lane == 2) ? ti[2] : ti[3];
                const float ww = ((lane == 0) ? 1.0f : (lane == 1) ? e1 : (lane == 2) ? e2 : e3) * inv;
                const int loc = __hip_atomic_fetch_add(cntl + ee, 1, __ATOMIC_RELAXED, __HIP_MEMORY_SCOPE_WORKGROUP);
                LAS int* tp = tab + ((ri * 8 + F.wave) * 4 + lane) * 3; tp[0] = ee; tp[1] = loc; tp[2] = __float_as_int(ww);
            }
        }
        __syncthreads();
        if (F.tid < 32) basel[F.tid] = (int)atomicAdd(F.ctl + CW_CNT + 64 * F.tid, (unsigned)cntl[F.tid]);
        __syncthreads();
        if (lane < 4) for (int ri = 0; ri < 8; ++ri) {
            const int row = r0 + ri * F.NGW + F.gw; if (row >= T) break;
            const LAS int* tp = tab + ((ri * 8 + F.wave) * 4 + lane) * 3; const int ee = tp[0];
            F.TOK_E[row * 4 + lane] = ee; F.TOK_SLOT[row * 4 + lane] = basel[ee] + tp[1]; F.TOK_W[row * 4 + lane] = __int_as_float(tp[2]);
        }
    }
}

constexpr int RM_WS = 2064;
constexpr int RM_HI = 0, RM_LO = NE * RM_WS, RM_RSTD = 2 * NE * RM_WS, RM_TAB = RM_RSTD + 256, RM_CNT = RM_TAB + 64 * 4 * 12;
static_assert(RM_CNT + 256 <= LDSCTL_OFF, "router LDS map");
__device__ __forceinline__ void p6_router_mfma(Frame& F) {
    LAS unsigned char* L = F.lds;
    LAS float* rstdl = (LAS float*)(L + RM_RSTD); LAS int* tab = (LAS int*)(L + RM_TAB); LAS int* cntl = (LAS int*)(L + RM_CNT); LAS int* basel = cntl + 32;
    const int lane = F.lane, fr = lane & 15, fq = lane >> 4, w = F.wave;
    __syncthreads();
    for (int i0 = F.tid; i0 < D * NE; i0 += 16 * NTHREADS) {
        float wv[16], gv[16];
#pragma unroll
        for (int j = 0; j < 16; ++j) { const int i = i0 + j * NTHREADS; wv[j] = F.w_router[i]; gv[j] = F.g_ffn[i >> 5]; }
#pragma unroll
        for (int j = 0; j < 16; ++j) { const int i = i0 + j * NTHREADS, k = i >> 5, e = i & 31; const float w = wv[j] * gv[j];
            const unsigned hi = f2bf(w), lo = f2bf(w - bf2f(hi));
            *(LAS bf16*)(L + RM_HI + e * RM_WS + 2 * k) = (bf16)hi; *(LAS bf16*)(L + RM_LO + e * RM_WS + 2 * k) = (bf16)lo; } }
    const float br0 = F.b_router[fr], br1 = F.b_router[16 + fr];
    for (int rg = F.vcu; rg < T / 64; rg += F.G) {
        __syncthreads();
        if (F.tid < 32) cntl[F.tid] = 0;
        __syncthreads();
        if (w < 4) {
            const int row0 = rg * 64 + 16 * w;
#if H_BF16
            const bf16* hp = (const bf16*)F.H + (size_t)(row0 + fr) * D + 8 * fq;
#else
            const float* hp = F.H + (size_t)(row0 + fr) * D + 8 * fq;
#endif
            const LAS unsigned char* bh = L + RM_HI + fr * RM_WS + 16 * fq; const LAS unsigned char* bl = L + RM_LO + fr * RM_WS + 16 * fq;
            f32x4 acc[2] = {(f32x4){0.f, 0.f, 0.f, 0.f}, (f32x4){0.f, 0.f, 0.f, 0.f}}; float ss = 0.f;
#pragma unroll 4
            for (int ks = 0; ks < 32; ++ks) {
#if H_BF16
                const u32x4 hw = *(const u32x4*)(hp + 32 * ks);
                { const float q0 = bflo(hw.x), q1 = bfhi(hw.x), q2 = bflo(hw.y), q3 = bfhi(hw.y), q4 = bflo(hw.z), q5 = bfhi(hw.z), q6 = bflo(hw.w), q7 = bfhi(hw.w);
                  ss += (q0 * q0 + q1 * q1) + (q2 * q2 + q3 * q3) + (q4 * q4 + q5 * q5) + (q6 * q6 + q7 * q7); }
                const bf16x8 ahi = __builtin_bit_cast(bf16x8, hw);
#pragma unroll
                for (int nt = 0; nt < 2; ++nt) { const bf16x8 bhi = *(const LAS bf16x8*)(bh + 16 * nt * RM_WS + 64 * ks), blo = *(const LAS bf16x8*)(bl + 16 * nt * RM_WS + 64 * ks);
                    acc[nt] = __builtin_amdgcn_mfma_f32_16x16x32_bf16(ahi, bhi, acc[nt], 0, 0, 0);
                    acc[nt] = __builtin_amdgcn_mfma_f32_16x16x32_bf16(ahi, blo, acc[nt], 0, 0, 0); }
                continue;
#else
                const f32x4 a0 = *(const f32x4*)(hp + 32 * ks), a1 = *(const f32x4*)(hp + 32 * ks + 4);
                ss += (a0.x * a0.x + a0.y * a0.y) + (a0.z * a0.z + a0.w * a0.w) + (a1.x * a1.x + a1.y * a1.y) + (a1.z * a1.z + a1.w * a1.w);
                u32x4 hw; hw.x = pk2(a0.x, a0.y); hw.y = pk2(a0.z, a0.w); hw.z = pk2(a1.x, a1.y); hw.w = pk2(a1.z, a1.w);
                u32x4 lw; lw.x = pk2(a0.x - bflo(hw.x), a0.y - bfhi(hw.x)); lw.y = pk2(a0.z - bflo(hw.y), a0.w - bfhi(hw.y));
                lw.z = pk2(a1.x - bflo(hw.z), a1.y - bfhi(hw.z)); lw.w = pk2(a1.z - bflo(hw.w), a1.w - bfhi(hw.w));
                const bf16x8 ahi = __builtin_bit_cast(bf16x8, hw), alo = __builtin_bit_cast(bf16x8, lw);
#pragma unroll
                for (int nt = 0; nt < 2; ++nt) { const bf16x8 bhi = *(const LAS bf16x8*)(bh + 16 * nt * RM_WS + 64 * ks), blo = *(const LAS bf16x8*)(bl + 16 * nt * RM_WS + 64 * ks);
                    acc[nt] = __builtin_amdgcn_mfma_f32_16x16x32_bf16(ahi, bhi, acc[nt], 0, 0, 0);
                    acc[nt] = __builtin_amdgcn_mfma_f32_16x16x32_bf16(ahi, blo, acc[nt], 0, 0, 0);
                    acc[nt] = __builtin_amdgcn_mfma_f32_16x16x32_bf16(alo, bhi, acc[nt], 0, 0, 0); }
#endif
            }
            ss += __shfl_xor(ss, 16); ss += __shfl_xor(ss, 32);
            const float rstd = 1.0f / sqrtf(ss * (1.0f / D) + RMS_EPS);
            if (fq == 0) rstdl[16 * w + fr] = rstd;
#pragma unroll
            for (int reg = 0; reg < 4; ++reg) {
                const float rs = __shfl(rstd, 4 * fq + reg);
                float c0 = acc[0][reg] * rs + br0, c1 = acc[1][reg] * rs + br1;
                float tv[4]; int ti[4];
#pragma unroll
                for (int r = 0; r < 4; ++r) { float bv = (c0 >= c1) ? c0 : c1; int bi = (c0 >= c1) ? fr : 16 + fr;
#pragma unroll
                    for (int o = 1; o < 16; o <<= 1) { const float ov = __shfl_xor(bv, o); const int oi = __shfl_xor(bi, o); if (ov > bv || (ov == bv && oi < bi)) { bv = ov; bi = oi; } }
                    tv[r] = bv; ti[r] = bi; if (bi == fr) c0 = -INFINITY; if (bi == 16 + fr) c1 = -INFINITY; }
                const float e1 = __expf(tv[1] - tv[0]), e2 = __expf(tv[2] - tv[0]), e3 = __expf(tv[3] - tv[0]), inv = 1.0f / (1.0f + e1 + e2 + e3);
                if (fr < 4) {
                    const int ee = (fr == 0) ? ti[0] : (fr == 1) ? ti[1] : (fr == 2) ? ti[2] : ti[3];
                    const float ww = ((fr == 0) ? 1.0f : (fr == 1) ? e1 : (fr == 2) ? e2 : e3) * inv;
                    const int loc = __hip_atomic_fetch_add(cntl + ee, 1, __ATOMIC_RELAXED, __HIP_MEMORY_SCOPE_WORKGROUP);
                    LAS int* tp = tab + ((16 * w + 4 * fq + reg) * 4 + fr) * 3; tp[0] = ee; tp[1] = loc; tp[2] = __float_as_int(ww);
                }
            }
        }
        __syncthreads();
        if (F.tid < 32) basel[F.tid] = (int)atomicAdd(F.ctl + CW_CNT + 64 * F.tid, (unsigned)cntl[F.tid]);
#pragma unroll 2
        for (int i = 0; i < 8; ++i) { const int rl = 8 * w + i, row = rg * 64 + rl; const float rs = rstdl[rl];
#if H_BF16
            const u32x4* hr = (const u32x4*)((const bf16*)F.H + (size_t)row * D) + lane;
#pragma unroll
            for (int j = 0; j < 2; ++j) { const f32x4 g0 = *((const f32x4*)F.g_ffn + 2 * (lane + 64 * j)), g1 = *((const f32x4*)F.g_ffn + 2 * (lane + 64 * j) + 1); const u32x4 hw = hr[64 * j];
                u32x2 o; o.x = pk4_fp8(bflo(hw.x) * rs * g0.x, bfhi(hw.x) * rs * g0.y, bflo(hw.y) * rs * g0.z, bfhi(hw.y) * rs * g0.w);
                o.y = pk4_fp8(bflo(hw.z) * rs * g1.x, bfhi(hw.z) * rs * g1.y, bflo(hw.w) * rs * g1.z, bfhi(hw.w) * rs * g1.w);
                ((u32x2*)((unsigned char*)F.XN + (size_t)row * D))[lane + 64 * j] = o; } }
#else
            const f32x4* hr = (const f32x4*)(F.H + (size_t)row * D) + lane;
#pragma unroll
            for (int j = 0; j < 4; ++j) { const f32x4 g = *((const f32x4*)F.g_ffn + lane + 64 * j); const f32x4 v = hr[64 * j] * rs * g;
                ((unsigned*)((unsigned char*)F.XN + (size_t)row * D))[lane + 64 * j] = pk4_fp8(v.x, v.y, v.z, v.w); } }
#endif
        __syncthreads();
        if (F.tid < 256) { const int rl = F.tid >> 2, k = F.tid & 3, row = rg * 64 + rl; const LAS int* tp = tab + (rl * 4 + k) * 3; const int ee = tp[0];
#if RM_FUSED
            const int dst = ee * ECAP + basel[ee] + tp[1]; F.ROW_TOK[dst] = row * 4 + k; F.ROW_W[dst] = __int_as_float(tp[2]); }
#else
            F.TOK_E[row * 4 + k] = ee; F.TOK_SLOT[row * 4 + k] = basel[ee] + tp[1]; F.TOK_W[row * 4 + k] = __int_as_float(tp[2]); }
#endif
    }
}

__device__ __forceinline__ void p7_gather(Frame& F) {
    LAS int* pst = (LAS int*)F.lds;
    LAS int* cntl = pst + 64;
    int tid = (int)threadIdx.x; asm volatile("" : "+v"(tid));
    __syncthreads();
    if (tid < NE) cntl[tid] = (int)F.ctl[CW_CNT + 64 * tid];
    __syncthreads();
    if (tid == 0) { int acc = 0; for (int e = 0; e < NE; ++e) { pst[e] = acc; acc += (cntl[e] + 255) & ~255; } pst[NE] = acc; }
    __syncthreads();
    if (blockIdx.x == 0) {
        if (tid == 0) F.ctl[CW_NTILES] = (unsigned)(pst[NE] >> 8);
        if (tid < NE) { const int t0 = pst[tid] >> 8, t1 = pst[tid + 1] >> 8; for (int k = t0; k < t1; ++k) F.ctl[CW_TILEE + k] = (unsigned)tid; }
    }
#if MOE_FP8
    { const int gthreads = F.G * NTHREADS, gtid = F.vcu * NTHREADS + F.tid;
      for (int a = gtid; a < NA; a += gthreads) { const int e = F.TOK_E[a], dest = pst[e] + F.TOK_SLOT[a]; F.ROW_TOK[dest] = a; F.ROW_W[dest] = F.TOK_W[a]; }
      for (int e = 0; e < NE; ++e) { const int c = cntl[e], pe = (c + 255) & ~255;
          for (int r = c + gtid; r < pe; r += gthreads) { F.ROW_TOK[pst[e] + r] = -1; F.ROW_W[pst[e] + r] = 0.f; } } }
#else
    for (int a = F.gw; a < NA; a += F.NGW) {
        const int e = F.TOK_E[a], dest = pst[e] + F.TOK_SLOT[a];
        { const u32x4* src = (const u32x4*)(F.XN + (size_t)(a >> 2) * D) + F.lane; u32x4* dst = (u32x4*)(F.XS + (size_t)dest * D) + F.lane;
        const u32x4 v0 = src[0], v1 = src[64]; dst[0] = v0; dst[64] = v1; }
        if (F.lane == 0) { F.ROW_TOK[dest] = a; F.ROW_W[dest] = F.TOK_W[a]; }
    }
    for (int e = 0; e < NE; ++e) { const int c = cntl[e], pe = (c + 255) & ~255;
        for (int r = c + F.gw; r < pe; r += F.NGW) { const int dest = pst[e] + r; const u32x4 z = (u32x4){0u, 0u, 0u, 0u};
            { u32x4* dst = (u32x4*)(F.XS + (size_t)dest * D) + F.lane; dst[0] = z; dst[64] = z; }
            if (F.lane == 0) { F.ROW_TOK[dest] = -1; F.ROW_W[dest] = 0.f; } } }
#endif
}

__device__ __forceinline__ void p10_final(Frame& F) {
#if H_BF16
    u32x2 hn[4]; u32x2 yn[4][4];
#define P10_LOAD(r_) do { const u32x2* hr_ = (const u32x2*)((const bf16*)F.H + (size_t)(r_) * D) + F.lane; \
        _Pragma("unroll") for (int j = 0; j < 4; ++j) { hn[j] = hr_[64 * j]; _Pragma("unroll") for (int k = 0; k < 4; ++k) yn[j][k] = *((const u32x2*)(F.YBUF + ((size_t)(r_) * 4 + k) * D) + F.lane + 64 * j); } } while (0)
#define P10_H(j_) ((f32x4){bflo(hn[j_].x), bfhi(hn[j_].x), bflo(hn[j_].y), bfhi(hn[j_].y)})
#else
#define P10_H(j_) hn[j_]
    f32x4 hn[4]; u32x2 yn[4][4];
#define P10_LOAD(r_) do { const f32x4* hr_ = (const f32x4*)(F.H + (size_t)(r_) * D) + F.lane; \
        _Pragma("unroll") for (int j = 0; j < 4; ++j) { hn[j] = hr_[64 * j]; _Pragma("unroll") for (int k = 0; k < 4; ++k) yn[j][k] = *((const u32x2*)(F.YBUF + ((size_t)(r_) * 4 + k) * D) + F.lane + 64 * j); } } while (0)
#endif
    if (F.gw < T) P10_LOAD(F.gw);
    for (int row = F.gw; row < T; row += F.NGW) {
        f32x4 v[4]; float s = 0.f;
#pragma unroll
        for (int j = 0; j < 4; ++j) { v[j] = P10_H(j);
#pragma unroll
            for (int k = 0; k < 4; ++k) { const u32x2 w = yn[j][k]; v[j].x += bflo(w.x); v[j].y += bfhi(w.x); v[j].z += bflo(w.y); v[j].w += bfhi(w.y); }
            s += (v[j].x * v[j].x + v[j].y * v[j].y) + (v[j].z * v[j].z + v[j].w * v[j].w); }
        if (row + F.NGW < T) P10_LOAD(row + F.NGW);
        const float rstd = 1.0f / sqrtf(wave_sum(s) * (1.0f / D) + RMS_EPS);
        f32x4* orow = (f32x4*)(F.out + (size_t)row * D) + F.lane;
#pragma unroll
        for (int j = 0; j < 4; ++j) { const f32x4 g = *((const f32x4*)F.g_final + F.lane + 64 * j); orow[64 * j] = v[j] * rstd * g; }
    }
#undef P10_LOAD
#undef P10_H
}

typedef float f32x16 __attribute__((ext_vector_type(16)));
typedef short s16x4 __attribute__((ext_vector_type(4)));
constexpr int ATT_SCR_OFF = RING_BYTES;
__device__ __forceinline__ int crow16(int r, int hi) { return (r & 3) + 8 * (r >> 2) + 4 * hi; }
__device__ __forceinline__ s16x4 lds_tr16(const LAS unsigned char* p) { return __builtin_bit_cast(s16x4, __builtin_amdgcn_ds_read_tr16_b64_v4i16((LAS s16x4*)p)); }

struct AttItem { int b, g, hd, r, n, d; };
__device__ __forceinline__ AttItem att_decode(int it) {
    AttItem a; const int i = it >> 8, c = it & 255; a.g = i % 3; const int idx = (i / 3) * 256 + c, rn = idx & 15; a.b = idx >> 6; a.hd = (idx >> 4) & 3;
    a.r = (a.g == 0) ? 0 : (a.g == 1) ? (rn >> 2) : rn; a.n = (a.g == 0) ? rn : (a.g == 1) ? (rn & 3) : 0; a.d = (a.g == 0) ? 1 : (a.g == 1) ? 4 : 16; return a;
}
__device__ __forceinline__ const bf16* att_base(Frame& F, const AttItem& a) { return F.PROJ + (size_t)(a.b * SEQ + a.r) * NP + a.g * 512 + a.hd * 128; }
#define ATT_LOADKV(dst, a_, coff_) do { const bf16* base_ = att_base(F, a_) + (coff_) + 8 * (F.tid & 15); const size_t rs_ = (size_t)(a_).d * NP; const int i0_ = 128 * ((a_).n - 1) + (F.tid >> 4); \
        _Pragma("unroll") for (int p_ = 0; p_ < 8; ++p_) { if ((a_).n == 0 && p_ < 4) continue; dst[p_] = *(const u32x4*)(base_ + (size_t)(i0_ + 32 * p_) * rs_); } } while (0)

__device__ __forceinline__ void attn_phase(Frame& F) {
    const int lane = F.lane, w = F.wave, fr = lane & 15, fq = lane >> 4;
    LAS unsigned char* Ks = F.lds; LAS unsigned char* Vs = F.lds + 65536;
    const int kc = F.tid & 15, kk0 = F.tid >> 4;
    u32x4 kreg[8], vreg[8]; bf16x8 qn[4];
#define ATT_LOADQ(dst, a_) do { const bf16* qrow_ = att_base(F, a_) + (size_t)(128 * (a_).n + 16 * w + fr) * ((size_t)(a_).d * NP) + C_AQ + 8 * fq; \
        _Pragma("unroll") for (int s_ = 0; s_ < 4; ++s_) dst[s_] = *(const bf16x8*)(qrow_ + 32 * s_); } while (0)
#if ATT_QUEUE
    LAS int* slot = (LAS int*)(F.lds + RING_BYTES);
    int pend = 0;
    __syncthreads();
    if (F.tid == 0) { const int g0 = (int)atomicAdd(F.ctl + CW_ACTR, 2u); slot[0] = g0; pend = g0 + 1; }
    __syncthreads();
    int it = __builtin_amdgcn_readfirstlane(slot[0]);
#else
    int it = F.vcu;
#endif
    if (it < 1536) { const AttItem a0 = att_decode(it); ATT_LOADKV(kreg, a0, C_AK); ATT_LOADKV(vreg, a0, C_AV); ATT_LOADQ(qn, a0); }
    while (it < 1536) {
        const AttItem a = att_decode(it); const int n = a.n, d = a.d;
        __syncthreads();
#if ATT_QUEUE
        if (F.tid == 0) { slot[0] = pend; pend = (int)atomicAdd(F.ctl + CW_ACTR, 1u); }
#endif
#pragma unroll
        for (int pass = 0; pass < 8; ++pass) { if (n == 0 && pass < 4) continue; const int key = pass * 32 + kk0;
            *(LAS u32x4*)(Ks + key * 256 + ((kc ^ (key & 15)) << 4)) = kreg[pass];
            *(LAS u32x4*)(Vs + key * 256 + ((((kc >> 2) ^ (key & 3)) << 6) | ((kc & 3) << 4))) = vreg[pass]; }
        bf16x8 qf[4];
#pragma unroll
        for (int s = 0; s < 4; ++s) qf[s] = qn[s];
        __syncthreads();
#if ATT_QUEUE
        const int itn = __builtin_amdgcn_readfirstlane(slot[0]);
#else
        const int itn = it + F.G;
#endif
        if (itn < 1536) { const AttItem an = att_decode(itn); ATT_LOADKV(kreg, an, C_AK); ATT_LOADKV(vreg, an, C_AV); ATT_LOADQ(qn, an); }
        f32x4 S[10];
#pragma unroll
        for (int i = 0; i < 9; ++i) {
            const int kt = w + i; const bool act = !(n == 0 && kt < 8);
            f32x4 acc = (f32x4){0.f, 0.f, 0.f, 0.f};
            if (act) {
                const LAS unsigned char* kp = Ks + (kt * 16 + fr) * 256;
#pragma unroll
                for (int s = 0; s < 4; ++s) { const bf16x8 kf = *(const LAS bf16x8*)(kp + (((4 * s + fq) ^ fr) << 4)); acc = __builtin_amdgcn_mfma_f32_16x16x32_bf16(kf, qf[s], acc, 0, 0, 0); }
                if (i == 0) {
#pragma unroll
                    for (int r = 0; r < 4; ++r) if (4 * fq + r < fr) acc[r] = -INFINITY; }
                if (i == 8) {
#pragma unroll
                    for (int r = 0; r < 4; ++r) if (4 * fq + r > fr) acc[r] = -INFINITY; }
            } else acc = (f32x4){-INFINITY, -INFINITY, -INFINITY, -INFINITY};
            S[i] = acc;
        }
        float m = -INFINITY;
#pragma unroll
        for (int i = 0; i < 9; ++i)
#pragma unroll
            for (int r = 0; r < 4; ++r) m = fmaxf(m, S[i][r]);
        m = fmaxf(m, __shfl_xor(m, 16)); m = fmaxf(m, __shfl_xor(m, 32));
        float l = 0.f;
#pragma unroll
        for (int i = 0; i < 9; ++i)
#pragma unroll
            for (int r = 0; r < 4; ++r) { const float p = __builtin_amdgcn_exp2f(S[i][r] - m); S[i][r] = p; l += p; }
        l += __shfl_xor(l, 16); l += __shfl_xor(l, 32);
        S[9] = (f32x4){0.f, 0.f, 0.f, 0.f};
        f32x4 O[8];
#pragma unroll
        for (int t = 0; t < 8; ++t) O[t] = (f32x4){0.f, 0.f, 0.f, 0.f};
        const int q4 = fr >> 2, p4 = lane & 3;
#pragma unroll
        for (int p = 0; p < 5; ++p) {
            const int kt0 = w + 2 * p, kt1 = kt0 + 1;
            const bool act0 = !(n == 0 && kt0 < 8), act1 = (2 * p + 1 < 9) && !(n == 0 && kt1 < 8);
            if (act0 || act1) {
                u32x4 pw; pw.x = pg8::cvt_pk_bf16(S[2 * p][0], S[2 * p][1]); pw.y = pg8::cvt_pk_bf16(S[2 * p][2], S[2 * p][3]);
                pw.z = pg8::cvt_pk_bf16(S[2 * p + 1][0], S[2 * p + 1][1]); pw.w = pg8::cvt_pk_bf16(S[2 * p + 1][2], S[2 * p + 1][3]);
                const bf16x8 pa = __builtin_bit_cast(bf16x8, pw);
                const int key0 = kt0 * 16 + 4 * fq + q4, key1 = kt1 * 16 + 4 * fq + q4;
#pragma unroll
                for (int t = 0; t < 8; ++t) {
                    const int col = 16 * t + 4 * p4;
                    const int coff = ((((col >> 5) ^ q4) << 6) | ((col & 31) << 1));
                    s16x4 lo = (s16x4){0, 0, 0, 0}, hi = (s16x4){0, 0, 0, 0};
                    if (act0) lo = lds_tr16(Vs + key0 * 256 + coff);
                    if (act1) hi = lds_tr16(Vs + key1 * 256 + coff);
                    const bf16x8 vb = (bf16x8){lo[0], lo[1], lo[2], lo[3], hi[0], hi[1], hi[2], hi[3]};
                    O[t] = __builtin_amdgcn_mfma_f32_16x16x32_bf16(pa, vb, O[t], 0, 0, 0);
                }
            }
        }
        const float linv = frcp(l);
        const size_t tok0 = (size_t)a.b * SEQ + a.r + (size_t)d * (128 * n + 16 * w);
        if (fq == 0) F.LSE[((size_t)a.g * T + tok0 + (size_t)d * fr) * 4 + a.hd] = m + __log2f(l);
#pragma unroll
        for (int r = 0; r < 4; ++r) {
            const int q = 4 * fq + r; const float rl = __shfl(linv, q);
            bf16* op = F.OG + ((size_t)a.g * T + tok0 + (size_t)d * q) * 512 + a.hd * 128 + fr;
#pragma unroll
            for (int t = 0; t < 8; ++t) op[16 * t] = (bf16)f2bf(O[t][r] * rl);
        }
        it = itn;
    }
    __syncthreads();
}
#undef ATT_LOADKV
#undef ATT_LOADQ

constexpr int ML_QS = 528, ML_AS = 144;
constexpr int ML_Q = 0, ML_K = 33792;
constexpr int SC_U = 0, SC_MX = 64, SC_EBD = 128, SC_WI = 192, SC_WK = 256, SC_DEC = 320;
__device__ __forceinline__ f32x4 mfma16(bf16x8 a, bf16x8 b, f32x4 c) { return __builtin_amdgcn_mfma_f32_16x16x32_bf16(a, b, c, 0, 0, 0); }


constexpr size_t WS_QK = WS_QC, WS_SCAL = WS_KC;
__device__ __forceinline__ void mlstm_prepass(Frame& F) {
    const int tid = F.tid, lane = F.lane;
    float* SCAL = (float*)((unsigned char*)F.ctl + WS_SCAL);
    bf16* QK = (bf16*)((unsigned char*)F.ctl + WS_QK);
    if (F.vcu < 32) {
        const int b = F.vcu >> 2, h = F.vcu & 3; const float* gbase = F.GATES + (size_t)(b * SEQ) * 8;
        LAS float* lu = (LAS float*)F.lds; LAS float* lpm = lu + 2048; LAS float* lbc = lpm + 2048; LAS float* lm = lbc + 2048;
        __syncthreads();
#pragma unroll
        for (int i = 0; i < 4; ++i) { const int c = 4 * F.wave + i;
            const float gi = gbase[(size_t)(64 * c + lane) * 8 + h], gf = gbase[(size_t)(64 * c + lane) * 8 + 4 + h];
            const float logf = fminf(gf, 0.f) - __logf(1.0f + __expf(-fabsf(gf)));
            float bc = logf;
#pragma unroll
            for (int o = 1; o < 64; o <<= 1) { const float v = __shfl_up(bc, o); if (lane >= o) bc += v; }
            const float u = gi - bc; float pm = u;
#pragma unroll
            for (int o = 1; o < 64; o <<= 1) { const float v = __shfl_up(pm, o); if (lane >= o) pm = fmaxf(pm, v); }
            lu[64 * c + lane] = u; lpm[64 * c + lane] = pm; lbc[64 * c + lane] = bc; }
        __syncthreads();
        if (tid == 0) { float m = 0.f; for (int c = 0; c < 32; ++c) { const float M63 = fmaxf(m, lpm[64 * c + 63]); lm[c] = m; lm[32 + c] = M63; m = lbc[64 * c + 63] + M63; } }
        __syncthreads();
#pragma unroll
        for (int i = 0; i < 4; ++i) { const int c = 4 * F.wave + i; const float m_carry = lm[c], M63 = lm[32 + c];
            const float u = lu[64 * c + lane], bc = lbc[64 * c + lane], Mx = fmaxf(m_carry, lpm[64 * c + lane]);
            float* sp = SCAL + ((size_t)F.vcu * 32 + c) * 384;
            sp[SC_U + lane] = u; sp[SC_MX + lane] = Mx; sp[SC_EBD + lane] = __expf(-(bc + Mx)); sp[SC_WI + lane] = __expf(m_carry - Mx); sp[SC_WK + lane] = __expf(u - M63);
            sp[SC_DEC + lane] = __expf(m_carry - M63); }
        __syncthreads();
    }
    const int rb = tid >> 8, half = (tid >> 7) & 1, cg = tid & 127;
    float cw[4][8];
#pragma unroll
    for (int j = 0; j < 4; ++j) { const float* p = F.conv_qk + j * 2048 + half * 1024 + 8 * cg; const f32x4 a = *(const f32x4*)p, c = *(const f32x4*)(p + 4);
        cw[j][0] = a[0]; cw[j][1] = a[1]; cw[j][2] = a[2]; cw[j][3] = a[3]; cw[j][4] = c[0]; cw[j][5] = c[1]; cw[j][6] = c[2]; cw[j][7] = c[3]; }
    const float oscale = half ? 0.0625f : 1.0f;
    for (int step = F.vcu; step < T / 16; step += F.G) {
        const int row0 = step * 16 + rb * 8, ts0 = row0 & (SEQ - 1);
        const bf16* src = F.PROJ + (size_t)row0 * NP + (half ? C_MK : C_MQ) + 8 * cg;
        u32x4 raw[11];
#pragma unroll
        for (int r = 0; r < 11; ++r) raw[r] = (ts0 - 3 + r >= 0) ? *(const u32x4*)(src + (ptrdiff_t)(r - 3) * NP) : (u32x4){0u, 0u, 0u, 0u};
        bf16* dst = QK + (size_t)row0 * 2048 + half * 1024 + 8 * cg;
        float xf[11][8];
#pragma unroll
        for (int r = 0; r < 11; ++r) { const u32x4 rw = raw[r]; xf[r][0] = bflo(rw.x); xf[r][1] = bfhi(rw.x); xf[r][2] = bflo(rw.y); xf[r][3] = bfhi(rw.y); xf[r][4] = bflo(rw.z); xf[r][5] = bfhi(rw.z); xf[r][6] = bflo(rw.w); xf[r][7] = bfhi(rw.w); }
#pragma unroll
        for (int o = 0; o < 8; ++o) {
            float y[8];
#pragma unroll
            for (int i = 0; i < 8; ++i) y[i] = (cw[0][i] * xf[o][i] + cw[1][i] * xf[o + 1][i]) + (cw[2][i] * xf[o + 2][i] + cw[3][i] * xf[o + 3][i]);
#pragma unroll
            for (int i = 0; i < 8; ++i) y[i] = y[i] * oscale * frcp(1.0f + __expf(-y[i]));
            u32x4 pw; pw.x = pk2(y[0], y[1]); pw.y = pk2(y[2], y[3]); pw.z = pk2(y[4], y[5]); pw.w = pk2(y[6], y[7]);
            *(u32x4*)(dst + (size_t)o * 2048) = pw; }
    }
}

template <int NDT> struct MLMap {
    static constexpr int VROWS = 16 * (NDT + 1), CT = ML_K + 64 * ML_QS, A = CT + VROWS * ML_QS, VT = A + 64 * ML_AS, VWT = VT + VROWS * ML_AS, SC = VWT + VROWS * ML_AS, END = SC + 4 * 384;
    static_assert(END <= LDSCTL_OFF, "mLSTM LDS map");
};
template <int NDT>
__device__ __forceinline__ void mlstm_item(Frame& F, int b, int h, int sl) {
    typedef MLMap<NDT> MP; constexpr int VROWS = MP::VROWS, PARTS = 2 * NDT, NT2 = NDT / 2, NB5 = NDT + 1;
    const int tid = F.tid, lane = F.lane, w = F.wave, fr = lane & 15, fq = lane >> 4;
    LAS unsigned char* L = F.lds; LAS float* SC = (LAS float*)(L + MP::SC);
    const bf16* qkbase = (const bf16*)((const unsigned char*)F.ctl + WS_QK) + (size_t)(b * SEQ) * 2048 + h * 256 + 8 * (tid & 31);
#ifndef VMAP
#define VMAP 1
#endif
    const bool vact = tid < 64 * PARTS; const int vs = VMAP ? (tid & 63) : (tid / PARTS), vpart = VMAP ? (tid >> 6) : (tid % PARTS);
    const bf16* vbase = F.PROJ + (size_t)(b * SEQ) * NP + C_MV + h * 256 + sl * (16 * NDT) + 8 * vpart;
    const float* scbase = (const float*)((const unsigned char*)F.ctl + WS_SCAL) + (size_t)((b * 4 + h) * 32) * 384 + (tid < 384 ? tid : 0);
    const float* wkbase = (const float*)((const unsigned char*)F.ctl + WS_SCAL) + (size_t)((b * 4 + h) * 32) * 384 + SC_WK + vs;
    __syncthreads();
    for (int i = tid; i < (MP::A - MP::CT) / 4; i += NTHREADS) ((LAS unsigned*)(L + MP::CT))[i] = 0u;
    for (int i = tid; i < (MP::SC - MP::VT) / 4; i += NTHREADS) ((LAS unsigned*)(L + MP::VT))[i] = 0u;
    __syncthreads();
    if (tid < 32) ((LAS unsigned*)(L + MP::VT + (16 * NDT) * ML_AS))[tid] = 0x3F803F80u;
    f32x4 C[2][NB5];
#pragma unroll
    for (int a = 0; a < 2; ++a)
#pragma unroll
        for (int bb = 0; bb < NB5; ++bb) C[a][bb] = (f32x4){0.f, 0.f, 0.f, 0.f};
    u32x4 qk[8]; u32x4 vraw = (u32x4){0u, 0u, 0u, 0u}; float scv = 0.f, wkv = 0.f;
    unsigned hpk[NT2][2];
#define ML_ISSUE(c_) do { const int t0_ = 64 * (c_); \
        _Pragma("unroll") for (int i_ = 0; i_ < 4; ++i_) { const bf16* p_ = qkbase + (size_t)(t0_ + (tid >> 5) + 16 * i_) * 2048; qk[i_] = *(const u32x4*)p_; qk[4 + i_] = *(const u32x4*)(p_ + 1024); } \
        if (vact) { vraw = *(const u32x4*)(vbase + (size_t)(t0_ + vs) * NP); wkv = wkbase[(size_t)(c_) * 384]; } \
        if (tid < 384) scv = scbase[(size_t)(c_) * 384]; } while (0)
    ML_ISSUE(0);
    for (int c = 0; c < 32; ++c) {
        { LAS unsigned char* dq = L + ML_Q + (tid >> 5) * ML_QS + 16 * (tid & 31);
#pragma unroll
          for (int i = 0; i < 4; ++i) { *(LAS u32x4*)(dq + 16 * i * ML_QS) = qk[i]; *(LAS u32x4*)(dq + (ML_K - ML_Q) + 16 * i * ML_QS) = qk[4 + i]; } }
        if (vact) { LAS bf16* vt = (LAS bf16*)(L + MP::VT) + vs; LAS bf16* vw = (LAS bf16*)(L + MP::VWT) + vs;
            const float vf[8] = {bflo(vraw.x), bfhi(vraw.x), bflo(vraw.y), bfhi(vraw.y), bflo(vraw.z), bfhi(vraw.z), bflo(vraw.w), bfhi(vraw.w)};
            const unsigned vr[4] = {vraw.x, vraw.y, vraw.z, vraw.w};
#pragma unroll
            for (int i = 0; i < 4; ++i) { const unsigned pw = pk2(vf[2 * i] * wkv, vf[2 * i + 1] * wkv);
                vt[(8 * vpart + 2 * i) * (ML_AS / 2)] = (bf16)(vr[i] & 0xffffu); vt[(8 * vpart + 2 * i + 1) * (ML_AS / 2)] = (bf16)(vr[i] >> 16);
                vw[(8 * vpart + 2 * i) * (ML_AS / 2)] = (bf16)(pw & 0xffffu); vw[(8 * vpart + 2 * i + 1) * (ML_AS / 2)] = (bf16)(pw >> 16); } }
        if (tid >= 256 && tid < 320) ((LAS bf16*)(L + MP::VWT))[(16 * NDT) * (ML_AS / 2) + tid - 256] = (bf16)f2bf(scv);
        if (tid < 384) SC[tid] = scv;
        __syncthreads();
        if (c > 0) { bf16* hpp = (bf16*)F.HT + (size_t)(b * SEQ + 64 * (c - 1) + 16 * (w & 3) + 4 * fq) * D + h * 256 + sl * (16 * NDT) + 16 * ((w >> 2) * NT2) + fr;
#pragma unroll
            for (int j = 0; j < NT2; ++j) { hpp[16 * j] = (bf16)(hpk[j][0] & 0xffffu); hpp[(size_t)D + 16 * j] = (bf16)(hpk[j][0] >> 16); hpp[(size_t)2 * D + 16 * j] = (bf16)(hpk[j][1] & 0xffffu); hpp[(size_t)3 * D + 16 * j] = (bf16)(hpk[j][1] >> 16); } }
        if (c + 1 < 32) ML_ISSUE(c + 1);
        const int ti = w & 3;
#ifndef DUP_B
#define DUP_B 1
#endif
        for (int dupb = 0; dupb < DUP_B; ++dupb)
        { const int si0 = (w >> 2) * 2;
          const LAS unsigned char* qp = L + ML_Q + (16 * ti + fr) * ML_QS + 16 * fq;
          const LAS unsigned char* kp = L + ML_K + (16 * si0 + fr) * ML_QS + 16 * fq;
          f32x4 sacc[2] = {(f32x4){0.f, 0.f, 0.f, 0.f}, (f32x4){0.f, 0.f, 0.f, 0.f}};
#pragma unroll
          for (int hb = 0; hb < 2; ++hb) {
              bf16x8 qa[4], k0[4], k1[4];
#pragma unroll
              for (int kk = 0; kk < 4; ++kk) { qa[kk] = *(const LAS bf16x8*)(qp + 64 * (4 * hb + kk)); k0[kk] = *(const LAS bf16x8*)(kp + 64 * (4 * hb + kk)); k1[kk] = *(const LAS bf16x8*)(kp + 16 * ML_QS + 64 * (4 * hb + kk)); }
              __builtin_amdgcn_sched_barrier(0);
#pragma unroll
              for (int kk = 0; kk < 4; ++kk) { sacc[0] = mfma16(k0[kk], qa[kk], sacc[0]); sacc[1] = mfma16(k1[kk], qa[kk], sacc[1]); }
          }
          { const int t = 16 * ti + fr; const float mxt = SC[SC_MX + t];
#pragma unroll
            for (int si = 0; si < 2; ++si) { const int s0 = 16 * (si0 + si) + 4 * fq; const f32x4 us = *(const LAS f32x4*)(SC + SC_U + s0); float val[4];
#pragma unroll
                for (int r = 0; r < 4; ++r) val[r] = (s0 + r <= t) ? sacc[si][r] * __expf(us[r] - mxt) : 0.f;
                u32x2 pw; pw.x = pk2(val[0], val[1]); pw.y = pk2(val[2], val[3]);
                *(LAS u32x2*)(L + MP::A + t * ML_AS + 2 * s0) = pw; } } }
        __syncthreads();
        { const int dj0 = (w >> 2) * NT2;
          const LAS unsigned char* ap = L + MP::A + (16 * ti + fr) * ML_AS + 16 * fq;
          const LAS unsigned char* vp = L + MP::VT + (16 * dj0 + fr) * ML_AS + 16 * fq; const LAS unsigned char* ep = L + MP::VT + (16 * NDT + fr) * ML_AS + 16 * fq;
          const LAS unsigned char* cp = L + MP::CT + (16 * dj0 + fr) * ML_QS + 16 * fq; const LAS unsigned char* cep = L + MP::CT + (16 * NDT + fr) * ML_QS + 16 * fq;
          bf16x8 aa[2], vv[NT2][2], ee[2], afr[2][2], bw[2][NB5];
#pragma unroll
          for (int ks = 0; ks < 2; ++ks) { aa[ks] = *(const LAS bf16x8*)(ap + 64 * ks); ee[ks] = *(const LAS bf16x8*)(ep + 64 * ks);
#pragma unroll
              for (int j = 0; j < NT2; ++j) vv[j][ks] = *(const LAS bf16x8*)(vp + 16 * j * ML_AS + 64 * ks); }
          const int q4 = fr >> 2, p4 = lane & 3;
#pragma unroll
          for (int ks = 0; ks < 2; ++ks) {
#pragma unroll
              for (int a = 0; a < 2; ++a) { const LAS unsigned char* kp = L + ML_K + (32 * ks + 8 * fq + q4) * ML_QS + (16 * (2 * w + a) + 4 * p4) * 2;
                  const s16x4 lo = lds_tr16(kp), hi = lds_tr16(kp + 4 * ML_QS); afr[ks][a] = (bf16x8){lo[0], lo[1], lo[2], lo[3], hi[0], hi[1], hi[2], hi[3]}; }
#pragma unroll
              for (int bb = 0; bb < NB5; ++bb) bw[ks][bb] = *(const LAS bf16x8*)(L + MP::VWT + (16 * bb + fr) * ML_AS + 16 * fq + 64 * ks); }
          const float dec = SC[SC_DEC];
          f32x4 wi4, eb4;
#pragma unroll
          for (int r = 0; r < 4; ++r) { wi4[r] = SC[SC_WI + 16 * ti + 4 * fq + r]; eb4[r] = SC[SC_EBD + 16 * ti + 4 * fq + r]; }
          __builtin_amdgcn_sched_barrier(0);
          f32x4 av[NT2], av2[NT2], ae = (f32x4){0.f, 0.f, 0.f, 0.f}, ae2 = ae;
#pragma unroll
          for (int j = 0; j < NT2; ++j) { av[j] = (f32x4){0.f, 0.f, 0.f, 0.f}; av2[j] = av[j]; }
#pragma unroll
          for (int a = 0; a < 2; ++a)
#pragma unroll
              for (int bb = 0; bb < NB5; ++bb) C[a][bb] *= dec;
#pragma unroll
          for (int ks = 0; ks < 2; ++ks) { ae = mfma16(aa[ks], ee[ks], ae);
#pragma unroll
              for (int j = 0; j < NT2; ++j) av[j] = mfma16(aa[ks], vv[j][ks], av[j]); }
#pragma unroll
          for (int ks = 0; ks < 2; ++ks)
#pragma unroll
              for (int bb = 0; bb < NB5; ++bb) { C[0][bb] = mfma16(afr[ks][0], bw[ks][bb], C[0][bb]); C[1][bb] = mfma16(afr[ks][1], bw[ks][bb], C[1][bb]); }
          __builtin_amdgcn_sched_barrier(0);
          { const LAS unsigned char* qp = L + ML_Q + (16 * ti + fr) * ML_QS + 16 * fq;
#pragma unroll
            for (int hb = 0; hb < 2; ++hb) {
                bf16x8 qa[4], cc[NT2][4], ce[4];
#pragma unroll
                for (int kk = 0; kk < 4; ++kk) { qa[kk] = *(const LAS bf16x8*)(qp + 64 * (4 * hb + kk)); ce[kk] = *(const LAS bf16x8*)(cep + 64 * (4 * hb + kk));
#pragma unroll
                    for (int j = 0; j < NT2; ++j) cc[j][kk] = *(const LAS bf16x8*)(cp + 16 * j * ML_QS + 64 * (4 * hb + kk)); }
                __builtin_amdgcn_sched_barrier(0);
#pragma unroll
                for (int kk = 0; kk < 4; ++kk) { ae2 = mfma16(qa[kk], ce[kk], ae2);
#pragma unroll
                    for (int j = 0; j < NT2; ++j) av2[j] = mfma16(qa[kk], cc[j][kk], av2[j]); }
            } }
          float rd[4];
#pragma unroll
          for (int r = 0; r < 4; ++r) { float dn = ae[r] + wi4[r] * ae2[r]; dn = __shfl(dn, lane & 48); rd[r] = frcp(fmaxf(fabsf(dn), eb4[r])); }
#pragma unroll
          for (int j = 0; j < NT2; ++j) { hpk[j][0] = pk2((av[j][0] + wi4[0] * av2[j][0]) * rd[0], (av[j][1] + wi4[1] * av2[j][1]) * rd[1]);
              hpk[j][1] = pk2((av[j][2] + wi4[2] * av2[j][2]) * rd[2], (av[j][3] + wi4[3] * av2[j][3]) * rd[3]); } }
        __syncthreads();
#pragma unroll
        for (int a = 0; a < 2; ++a)
#pragma unroll
            for (int bb = 0; bb < NB5; ++bb) { u32x2 pw; pw.x = pk2(C[a][bb][0], C[a][bb][1]); pw.y = pk2(C[a][bb][2], C[a][bb][3]);
                *(LAS u32x2*)(L + MP::CT + (16 * bb + fr) * ML_QS + (16 * (2 * w + a) + 4 * fq) * 2) = pw; }
    }
#undef ML_ISSUE
    { bf16* hpp = (bf16*)F.HT + (size_t)(b * SEQ + 64 * 31 + 16 * (w & 3) + 4 * fq) * D + h * 256 + sl * (16 * NDT) + 16 * ((w >> 2) * NT2) + fr;
#pragma unroll
      for (int j = 0; j < NT2; ++j) { hpp[16 * j] = (bf16)(hpk[j][0] & 0xffffu); hpp[(size_t)D + 16 * j] = (bf16)(hpk[j][0] >> 16); hpp[(size_t)2 * D + 16 * j] = (bf16)(hpk[j][1] & 0xffffu); hpp[(size_t)3 * D + 16 * j] = (bf16)(hpk[j][1] >> 16); } }
    __syncthreads();
}

constexpr int CQ_TS = 144, CQ_SCR = 2 * 32 * CQ_TS;
struct CqItem { const float* W; unsigned char* WT; int Nsrc, c0, k0, row0, row1, rstep; };
__device__ __forceinline__ CqItem cq_decode(Frame& F, int r) {
    constexpr int I_GU1 = (D / 128) * (2048 / 64), I_DN1 = (D / 128) * (D / 64);
    CqItem it;
    if (r < NE * I_GU1) { const int e = r / I_GU1, q = r % I_GU1, kb = q / 32, cb = q % 32, j0 = 32 * cb;
        it.W = F.w_gate_up + (size_t)e * D * 2048; it.WT = (unsigned char*)F.WguT + (size_t)e * 2048 * D; it.Nsrc = 2048; it.c0 = 2 * j0; it.k0 = 128 * kb;
        it.row0 = (j0 >> 7) * 256 + (j0 & 127); it.row1 = it.row0 + 128; it.rstep = 1; }
    else { r -= NE * I_GU1; const int e = r / I_DN1, q = r % I_DN1, kb = q / 16, cb = q % 16;
        it.W = F.w_down + (size_t)e * D * D; it.WT = (unsigned char*)F.WdnT + (size_t)e * D * D; it.Nsrc = D; it.c0 = 64 * cb; it.k0 = 128 * kb;
        it.row0 = 64 * cb; it.row1 = 64 * cb + 1; it.rstep = 2; }
    return it;
}
__device__ __forceinline__ void cq_load(const CqItem& it, int half, int lane, f32x4 (&v)[16]) {
    const float* p = it.W + (size_t)(it.k0 + 64 * half + 4 * (lane >> 4)) * it.Nsrc + it.c0 + 4 * (lane & 15);
#pragma unroll
    for (int pp = 0; pp < 4; ++pp)
#pragma unroll
        for (int i = 0; i < 4; ++i) v[4 * pp + i] = *(const f32x4*)(p + (size_t)(16 * pp + i) * it.Nsrc);
}
__device__ __forceinline__ void cq_pack(const f32x4 (&v)[16], int half, int lane, LAS unsigned char* scr, float sc) {
    LAS unsigned char* t0 = scr + (2 * (lane & 15)) * CQ_TS + 4 * (16 * half + (lane >> 4));
#pragma unroll
    for (int pp = 0; pp < 4; ++pp)
#pragma unroll
        for (int c = 0; c < 4; ++c)
            *(LAS unsigned*)(t0 + (c & 1) * 32 * CQ_TS + (c >> 1) * CQ_TS + 16 * pp) = pk4_fp8(v[4 * pp][c] * sc, v[4 * pp + 1][c] * sc, v[4 * pp + 2][c] * sc, v[4 * pp + 3][c] * sc);
}
__device__ __forceinline__ void cq_store(const CqItem& it, int lane, LAS unsigned char* scr) {
    asm volatile("s_waitcnt lgkmcnt(0)" ::: "memory");
    const int r = lane >> 1, hf = lane & 1;
#pragma unroll
    for (int t = 0; t < 2; ++t) { const LAS unsigned char* s = scr + t * 32 * CQ_TS + r * CQ_TS + 64 * hf;
        unsigned char* d = it.WT + (size_t)((t ? it.row1 : it.row0) + r * it.rstep) * D + it.k0 + 64 * hf;
#pragma unroll
        for (int j = 0; j < 4; ++j) *(u32x4*)(d + 16 * j) = *(const LAS u32x4*)(s + 16 * j); }
    asm volatile("s_waitcnt lgkmcnt(0)" ::: "memory");
}
constexpr int CS_GRAB = 8;
__device__ __forceinline__ void convert_steal(Frame& F) {
    constexpr int I_GU1 = (D / 128) * (2048 / 64), I_DN1 = (D / 128) * (D / 64), NIT = NE * (I_GU1 + I_DN1);
    static_assert(NIT % CS_GRAB == 0, "conversion items per grab");
    LAS unsigned char* scr = F.lds + F.wave * CQ_SCR; LAS int* slot = (LAS int*)(F.lds + 8 * CQ_SCR);
    int nxt = 0;
    __syncthreads();
    if (F.tid == 0) nxt = (int)atomicAdd(F.ctl + CW_QCTR, (unsigned)CS_GRAB);
    for (;;) {
        if (F.tid == 0) slot[0] = nxt;
        __syncthreads();
        const int base = slot[0]; if (base >= NIT) break;
        if (F.tid == 0) nxt = (int)atomicAdd(F.ctl + CW_QCTR, (unsigned)CS_GRAB);
        const CqItem it = cq_decode(F, base + F.wave);
        f32x4 va[16], vb[16];
        cq_load(it, 0, F.lane, va);
        cq_load(it, 1, F.lane, vb);
        cq_pack(va, 0, F.lane, scr, 32.0f);
        cq_pack(vb, 1, F.lane, scr, 32.0f);
        cq_store(it, F.lane, scr);
        __syncthreads();
    }
}

#ifndef ML_NDT
#define ML_NDT 4
#endif
__device__ __forceinline__ void mlstm_phase(Frame& F) {
    constexpr int SLICES = 16 / ML_NDT, NITEMS = NB * 4 * SLICES;
    for (int item = F.vcu; item < NITEMS; item += F.G) mlstm_item<ML_NDT>(F, item / (4 * SLICES), (item / SLICES) & 3, item % SLICES);
#if FAST_ATTN && ATT_QUEUE
    attn_phase(F);
#endif
#if MOE_FP8 && STEAL
#if defined(PROBE_NOSTEAL)
    if (F.vcu >= NITEMS)
#endif
#if defined(PROBE_CONV64)
    if (F.vcu < NITEMS || F.vcu >= 192)
#endif
    convert_steal(F);
#endif
}

constexpr int N_PHASES = 13;
struct Args { const void* in[18]; float* out; unsigned char* ws; int ph_lo, ph_hi; };

__device__ __forceinline__ int opaque_int(int v) { asm volatile("" : "+s"(v)); return v; }
__global__ void __launch_bounds__(NTHREADS, 2) mega_fwd(Args args) {
    extern __shared__ __attribute__((aligned(16))) unsigned char lds[];
    Frame F;
    F.lds = (LAS unsigned char*)lds;
    F.tid = threadIdx.x; F.lane = F.tid & 63; F.wave = __builtin_amdgcn_readfirstlane(F.tid >> 6);
    F.G = gridDim.x; { const int bx = blockIdx.x; F.vcu = (F.G % 8 == 0) ? (bx % 8) * (F.G / 8) + bx / 8 : bx; }
    F.gw = F.vcu * NWAVES + F.wave; F.NGW = F.G * NWAVES;
    unsigned char* ws = args.ws;
    F.ctl = (unsigned*)(ws + WS_CTL);
    F.x = (const float*)args.in[0]; F.positions = (const int*)args.in[1]; F.g_mix = (const float*)args.in[2]; F.w_in = (const float*)args.in[3]; F.conv_qk = (const float*)args.in[4];
    F.b_if = (const float*)args.in[5]; F.g_mnorm = (const float*)args.in[6]; F.w_attn_out = (const float*)args.in[7]; F.w_mlstm_out = (const float*)args.in[8]; F.w_mix_out = (const float*)args.in[9];
    F.g_ffn = (const float*)args.in[10]; F.w_router = (const float*)args.in[11]; F.b_router = (const float*)args.in[12]; F.w_gate_up = (const float*)args.in[13]; F.b_gate_up = (const float*)args.in[14];
    F.w_down = (const float*)args.in[15]; F.b_down = (const float*)args.in[16]; F.g_final = (const float*)args.in[17]; F.out = args.out;
    F.WinT = (bf16*)(ws + WS_WIN); F.WamT = (bf16*)(ws + WS_WAM); F.WoT = (bf16*)(ws + WS_WO); F.WguT = (bf16*)(ws + WS_WGU); F.WdnT = (bf16*)(ws + WS_WDN);
    F.XN = (bf16*)(ws + WS_XN); F.PROJ = (bf16*)(ws + WS_PROJ); F.OG = (bf16*)(ws + WS_OG); F.AM = (bf16*)(ws + WS_AM); F.MERGED = (bf16*)(ws + WS_MERGED);
    F.XS = (bf16*)(ws + WS_XS); F.ACT = (bf16*)(ws + WS_ACT); F.YBUF = (bf16*)(ws + WS_YBUF);
    F.GATES = (float*)(ws + WS_GATES); F.ROPE = (float*)(ws + WS_ROPE); F.LSE = (float*)(ws + WS_LSE); F.HT = (float*)(ws + WS_HT); F.H = (float*)(ws + WS_H);
    F.QC = (float*)(ws + WS_QC); F.KC = (float*)(ws + WS_KC);
    F.TOK_E = (int*)(ws + WS_ROUTE); F.TOK_SLOT = F.TOK_E + NA; F.TOK_W = (float*)(F.TOK_SLOT + NA);
    F.ROW_TOK = (int*)(ws + WS_ROWMETA); F.ROW_W = (float*)(F.ROW_TOK + (RM_FUSED ? NE * ECAP : XS_ROWS));

    const int lo = args.ph_lo, hi = args.ph_hi;
    for (int u = F.tid; u < (LDS_BYTES - LDSCTL_OFF) / 4; u += NTHREADS) ((LAS unsigned*)(F.lds + LDSCTL_OFF))[u] = 0u;
    __syncthreads();
    XcdBarrier bar; bar.bar = F.ctl + CW_BAR; bar.x = 0; bar.st = nullptr;
    if (hi - lo > 1) bar = xcd_barrier_post(F.ctl + CW_BAR, (volatile LAS unsigned*)(F.lds + MISC_OFF) + 8);
#ifndef PH_MASK
#define PH_MASK 0xffffffffu
#endif
#ifndef REP_MASK
#define REP_MASK 0u
#endif
#define IN(k) (((PH_MASK >> (k)) & 1u) && lo <= (k) && (k) < hi)
#define REPS(k) for (int rep_ = 0, nrep_ = ((REP_MASK >> (k)) & 1u) ? opaque_int(2) : 1; rep_ < nrep_; ++rep_)
#define SEAM(k) do { if (IN(k) && IN((k) + 1)) { GRID_BAR(); } } while (0)
#define GRID_BAR() xcd_barrier(bar)

    if (IN(0)) REPS(0) { p0_weights(F); p0_rows(F); }
    SEAM(0);
    if (IN(1)) REPS(1) {
#if FAST_P1
#if P1_FP8
        constexpr int NF8 = 64 * (18 + 42 - P1_HI), NBF = 64 * (P1_HI - 18);
        constexpr bool SPLIT = (NF8 == 128 * 15 && NBF == 128 * 6);
        { pg8::Gemm g{(const bf16*)((const unsigned char*)F.ctl + WS_XN8), F.WinT, T, (18 + 42 - P1_HI) * 256, D / 2}; pg8::SplitOrder S; S.base.init(T, (18 + 42 - P1_HI) * 256, F.G, (int)blockIdx.x);
          S.nA = SPLIT ? 9 : -1; S.nB = SPLIT ? 6 : -1;
          pg8::EpiProj<1> E{F.PROJ, F.ROPE};
          pg8::gemm_phase<pg8::EpiProj<1>, pg8::SplitOrder, true, true, true>(F.lds, g, S, E); }
        { pg8::Gemm g{F.XN, F.WinT + (size_t)18 * 256 * D, T, (P1_HI - 18) * 256, D}; pg8::SplitOrder S; S.base.init(T, (P1_HI - 18) * 256, F.G, (int)blockIdx.x);
          S.nA = SPLIT ? 2 : -1; S.nB = SPLIT ? 4 : -1;
          pg8::EpiProj<2> E{F.PROJ, F.ROPE};
          pg8::gemm_phase<pg8::EpiProj<2>, pg8::SplitOrder, true, true>(F.lds, g, S, E); }
#else
        pg8::Gemm g{F.XN, F.WinT, T, NP, D}; pg8::StaticOrder S; S.init(T, NP, F.G, (int)blockIdx.x);
        pg8::EpiProj<0> E{F.PROJ, F.ROPE};
        pg8::gemm_phase<pg8::EpiProj<0>, pg8::StaticOrder, true, true>(F.lds, g, S, E);
#endif
#else
        naive_p1(F);
#endif
    }
    SEAM(1);
    if (IN(2)) REPS(2) {
#if !FAST_P1
        naive_p1_rope(F);
#endif
    }
#if !FAST_P1
    SEAM(2);
#endif
    if (IN(3)) REPS(3) {
#if !FAST_MLSTM
        naive_conv(F);
#endif
#if FAST_MLSTM
        mlstm_prepass(F);
#endif
#if FAST_ATTN && !(ATT_QUEUE && FAST_MLSTM)
        attn_phase(F);
#elif !FAST_ATTN
        naive_attn(F);
#endif
    }
    SEAM(3);
    if (IN(4)) REPS(4) {
#if FAST_MLSTM
        mlstm_phase(F);
#else
        naive_mlstm(F);
#endif
    }
    SEAM(4);
    if (IN(5)) REPS(5) p3_post_mixer(F);
    SEAM(5);
    if (IN(6)) REPS(6) {
#if FAST_P4
        constexpr bool STREAM = (MIX_STREAM && FAST_P5);
        pg8::Gemm g{F.AM, F.WamT, T, D, MERGE_FP8 ? AMLD / 2 : AMLD};
        { pg8::MergedOrder S; S.base.init(T, D, F.G, (int)blockIdx.x); S.nparts = 2; S.pub = STREAM; S.ready = F.ctl + CW_READY2; S.tmo = F.ctl + CW_TMO;
          pg8::EpiMerged E{MERGE_FP8 ? (bf16*)((unsigned char*)F.AM + 1536) : F.AM + 1536, F.PROJ, F.x, F.H, false};
          pg8::gemm_phase<pg8::EpiMerged, pg8::MergedOrder, false, true, (MERGE_FP8 != 0)>(F.lds, g, S, E); }
        if (STREAM) {
          pg8::MergedOrder S; S.base.init(T, D, F.G, (int)blockIdx.x); S.nparts = 1; S.pub = true; S.ready = F.ctl + CW_READY2; S.tmo = F.ctl + CW_TMO;
          pg8::EpiMerged E{MERGE_FP8 ? (bf16*)((unsigned char*)F.AM + 1536) : F.AM + 1536, F.PROJ, F.x, F.H, false};
          pg8::gemm_phase<pg8::EpiMerged, pg8::MergedOrder, false, true, (MERGE_FP8 != 0)>(F.lds, g, S, E); }
#else
        naive_p4(F);
#endif
    }
#if !(MIX_STREAM && FAST_P4 && FAST_P5)
    SEAM(6);
#endif
    if (IN(7)) REPS(7) {
#if FAST_P5
#if !(MIX_STREAM && FAST_P4)
        { pg8::Gemm g{F.AM, F.WamT, T, D, MERGE_FP8 ? AMLD / 2 : AMLD}; pg8::MergedOrder S; S.base.init(T, D, F.G, (int)blockIdx.x); S.nparts = 1; S.pub = false; S.ready = F.ctl + CW_READY2; S.tmo = F.ctl + CW_TMO;
          pg8::EpiMerged E{MERGE_FP8 ? (bf16*)((unsigned char*)F.AM + 1536) : F.AM + 1536, F.PROJ, F.x, F.H, false};
          pg8::gemm_phase<pg8::EpiMerged, pg8::MergedOrder, false, true, (MERGE_FP8 != 0)>(F.lds, g, S, E); }
#endif
#else
        naive_p5(F);
#endif
    }
    SEAM(7);
#if MOE_FP8 && ROUTER_MFMA
    if (IN(8)) REPS(8) p6_router_mfma(F);
#else
    if (IN(8)) REPS(8) p6_router(F);
#endif
    SEAM(8);
#if !RM_FUSED
    if (IN(9)) REPS(9) p7_gather(F);
    SEAM(9);
#endif
#if MOE_FP8 && MOE_STREAM && FAST_MOE
    if (IN(10)) REPS(10) {
        LAS int* tl_e = (LAS int*)(F.lds + RING_BYTES); LAS int* tl_base = tl_e + 320; LAS int* tl_nv = tl_base + 320; LAS int* tl_n = tl_nv + 320;
        __syncthreads();
        if (F.tid < 64) { const int e = F.lane & 31, cnt = (int)__hip_atomic_load(F.ctl + CW_CNT + 64 * e, __ATOMIC_RELAXED, __HIP_MEMORY_SCOPE_AGENT), nt = (cnt + 255) >> 8;
            int incl = nt;
#pragma unroll
            for (int o = 1; o < 32; o <<= 1) { const int v = __shfl_up(incl, o, 32); if ((F.lane & 31) >= o) incl += v; }
            if (F.tid < 32) { const int t0 = incl - nt; for (int j = 0; j < nt; ++j) { tl_e[t0 + j] = e; tl_base[t0 + j] = e * ECAP + 256 * j; tl_nv[t0 + j] = min(256, cnt - 256 * j); } if (e == 31) tl_n[0] = incl; } }
        __syncthreads();
        const int ntiles = __builtin_amdgcn_readfirstlane(tl_n[0]);
        pg8::MoeOrder S{(const LAS unsigned*)tl_e, ntiles, F.G, (int)blockIdx.x, F.ROW_TOK, F.XN, F.ACT, F.WguT, F.WdnT, F.ctl + CW_READY, F.ctl + CW_TMO, tl_base, tl_nv};
        pg8::Gemm g{F.XN, F.WguT, ntiles * 256, NE * 2048, D / 2};
        pg8::EpiMoe E{{F.ACT, F.b_gate_up, 1.0f / 32.0f}, {F.YBUF, F.b_down, F.ROW_TOK, F.ROW_W, 1.0f / 32.0f, tl_base, tl_nv}};
        pg8::gemm_phase<pg8::EpiMoe, pg8::MoeOrder, true, true, true, true, true>(F.lds, g, S, E);
    }
#else
    if (IN(10)) REPS(10) {
        const int ntiles = (int)F.ctl[CW_NTILES];
#if FAST_MOE
        pg8::GroupedOrder S{F.ctl + CW_TILEE, ntiles, 8, F.G, (int)blockIdx.x, F.ROW_TOK};
#if MOE_FP8
        pg8::Gemm g{F.XN, F.WguT, ntiles * 256, NE * 2048, D / 2}; pg8::EpiSwiGLU<true> E{F.ACT, F.b_gate_up, 1.0f / 32.0f};
        pg8::gemm_phase<pg8::EpiSwiGLU<true>, pg8::GroupedOrder, true, true, true, true>(F.lds, g, S, E);
#else
        pg8::Gemm g{F.XS, F.WguT, ntiles * 256, NE * 2048, D}; pg8::EpiSwiGLU<false> E{F.ACT, F.b_gate_up, 1.0f};
        pg8::gemm_phase<pg8::EpiSwiGLU<false>, pg8::GroupedOrder, true, true, false>(F.lds, g, S, E);
#endif
#else
        naive_p8(F, ntiles);
#endif
    }
    SEAM(10);
    if (IN(11)) REPS(11) {
        const int ntiles = (int)F.ctl[CW_NTILES];
#if FAST_MOE
        pg8::GroupedOrder S{F.ctl + CW_TILEE, ntiles, 4, F.G, (int)blockIdx.x, F.ROW_TOK};
#if MOE_FP8
        pg8::Gemm g{F.ACT, F.WdnT, ntiles * 256, NE * D, D / 2}; pg8::EpiDown E{F.YBUF, F.b_down, F.ROW_TOK, F.ROW_W, 1.0f / 32.0f};
        pg8::gemm_phase<pg8::EpiDown, pg8::GroupedOrder, true, true, true>(F.lds, g, S, E);
#else
        pg8::Gemm g{F.ACT, F.WdnT, ntiles * 256, NE * D, D}; pg8::EpiDown E{F.YBUF, F.b_down, F.ROW_TOK, F.ROW_W, 1.0f};
        pg8::gemm_phase<pg8::EpiDown, pg8::GroupedOrder, true, true, false>(F.lds, g, S, E);
#endif
#else
        naive_p9(F, ntiles);
#endif
    }
#endif
    SEAM(11);
    if (IN(12)) REPS(12) p10_final(F);
#undef IN
#undef SEAM
}

extern "C" void kernel_launch(void* const* d_in, const int* in_sizes, int n_in, void* d_out, int out_size, void* d_ws, size_t ws_size, hipStream_t stream) {
    static int grid = 0;
    if (grid == 0) {
        if (n_in != 18 || out_size != T * D || ws_size < WS_END) { fprintf(stderr, "kernel_launch: unexpected shapes (n_in %d, out %d, ws %zu)\n", n_in, out_size, ws_size); grid = -1; return; }
        int dev = 0, cus = 0;
        if (hipGetDevice(&dev) != hipSuccess || hipDeviceGetAttribute(&cus, hipDeviceAttributeMultiprocessorCount, dev) != hipSuccess) { grid = -1; return; }
        if (hipFuncSetAttribute((const void*)mega_fwd, hipFuncAttributeMaxDynamicSharedMemorySize, LDS_BYTES) != hipSuccess) { fprintf(stderr, "kernel_launch: hipFuncSetAttribute failed\n"); grid = -1; return; }
        int per_cu = 0;
        if (hipOccupancyMaxActiveBlocksPerMultiprocessor(&per_cu, (const void*)mega_fwd, NTHREADS, LDS_BYTES) != hipSuccess || per_cu < 1) { fprintf(stderr, "kernel_launch: occupancy query says %d blocks per CU\n", per_cu); (void)hipGetLastError(); grid = -1; return; }
        grid = cus;
    }
    if (grid < 0) return;
    (void)hipMemsetAsync((char*)d_ws + WS_CTL, 0, CTL_ZERO_BYTES, stream);
    Args a{};
    for (int i = 0; i < 18; ++i) a.in[i] = d_in[i];
    a.out = (float*)d_out; a.ws = (unsigned char*)d_ws;
#if defined(MK_MULTI)
    for (int p = 0; p < N_PHASES; ++p) {
        a.ph_lo = p; a.ph_hi = p + 1;
        hipLaunchKernelGGL(mega_fwd, dim3(grid), dim3(NTHREADS), LDS_BYTES, stream, a);
    }
#else
#if defined(PROBE_HI)
    a.ph_lo = 0; a.ph_hi = PROBE_HI;
    hipLaunchKernelGGL(mega_fwd, dim3(grid), dim3(NTHREADS), LDS_BYTES, stream, a);
    (void)hipMemsetAsync((char*)d_ws + WS_CTL, 0, CTL_ZERO_BYTES, stream);
#endif
    a.ph_lo = 0; a.ph_hi = N_PHASES;
    hipLaunchKernelGGL(mega_fwd, dim3(grid), dim3(NTHREADS), LDS_BYTES, stream, a);
#endif
}
```

```cpp
#include <hip/hip_runtime.h>
#include <cstdio>
#include <cstdint>

#define LAS __attribute__((address_space(3)))
#define GAS __attribute__((address_space(1)))
typedef unsigned short bf16;
typedef float f32x4 __attribute__((ext_vector_type(4)));
typedef float f32x2 __attribute__((ext_vector_type(2)));
typedef unsigned u32x4 __attribute__((ext_vector_type(4)));
typedef unsigned u32x2 __attribute__((ext_vector_type(2)));
typedef short bf16x8 __attribute__((ext_vector_type(8)));

#ifndef FAST_P1
#define FAST_P1 1
#endif
#ifndef FAST_P4
#define FAST_P4 1
#endif
#ifndef FAST_P5
#define FAST_P5 1
#endif
#ifndef FAST_MOE
#define FAST_MOE 1
#endif
#ifndef MOE_FP8
#define MOE_FP8 1
#endif
#ifndef P1_FP8
#define P1_FP8 1
#endif
#ifndef STEAL
#define STEAL 1
#endif
#ifndef ROUTER_MFMA
#define ROUTER_MFMA 1
#endif
#ifndef P1_HI
#define P1_HI 30
#endif
#ifndef MOE_STREAM
#define MOE_STREAM 1
#endif
#ifndef ATT_QUEUE
#define ATT_QUEUE 1
#endif
#ifndef ROWMETA_FUSED
#define ROWMETA_FUSED 1
#endif
#ifndef MERGE_FP8
#define MERGE_FP8 1
#endif
#ifndef H_BF16
#define H_BF16 1
#endif
#define RM_FUSED (ROWMETA_FUSED && MOE_FP8 && MOE_STREAM && FAST_MOE && ROUTER_MFMA)
#ifndef FAST_ATTN
#define FAST_ATTN 1
#endif
#ifndef FAST_MLSTM
#define FAST_MLSTM 1
#endif

constexpr int T = 16384, D = 1024, SEQ = 2048, NB = 8;
constexpr int DIN = 10760, NP = 10752;
constexpr int C_AQ = 0, C_AK = 1536, C_AV = 3072, C_MQ = 4608, C_MK = 5632, C_MV = 6656, C_MO = 7680, C_GA = 8704, C_GM = 9728;
constexpr int NE = 32, TOPK = 4, NA = T * TOPK, MAXTILES = NA / 256 + NE, XS_ROWS = MAXTILES * 256, ECAP = T;
constexpr float QSCALE = 0.08838834764831845f * 1.4426950408889634f;
constexpr float RMS_EPS = 1e-5f, LN_EPS = 1e-5f;

constexpr size_t MiB = 1u << 20;
constexpr size_t WS_CTL = 0, CTL_ZERO_BYTES = 1 * MiB;
constexpr size_t WS_WIN = 2 * MiB, WS_WAM = 23 * MiB, WS_WO = 26 * MiB, WS_WGU = 28 * MiB, WS_WDN = 156 * MiB;
constexpr size_t WS_XN = 220 * MiB, WS_GATES = 252 * MiB, WS_ROPE = 253 * MiB, WS_ROUTE = 255 * MiB;
constexpr size_t WS_H = 256 * MiB, WS_MERGED = 320 * MiB;
constexpr size_t WS_OG = 352 * MiB, WS_LSE = 400 * MiB, WS_HT = 401 * MiB, WS_AM = 433 * MiB;
constexpr int AMLD = 2560;
#ifndef MIX_STREAM
#define MIX_STREAM 0
#endif
constexpr size_t WS_YBUF = 352 * MiB;
constexpr size_t WS_PROJ = 513 * MiB;
constexpr size_t WS_XS = 513 * MiB, WS_ACT = 657 * MiB;
constexpr size_t WS_ROWMETA = 801 * MiB;
constexpr size_t WS_QC = 849 * MiB, WS_KC = 913 * MiB, WS_XN8 = 916 * MiB, WS_END = 977 * MiB;
constexpr int CW_TMO = 0, CW_BAR = 4096, CW_CNT = 8192  , CW_NTILES = 12288, CW_TILEE = 12352, CW_QCTR = 16384, CW_ACTR = 16448  , CW_READY = 32768  , CW_READY2 = 65536  ;

constexpr int RING_BYTES = 131072, LDS_BYTES = 147456, LDSCTL_OFF = LDS_BYTES - 256, MISC_OFF = LDSCTL_OFF;
constexpr int NWAVES = 8, NTHREADS = 512;

__device__ __forceinline__ unsigned f2bf(float f) { unsigned u = __builtin_bit_cast(unsigned, f); return (u + 0x7fffu + ((u >> 16) & 1u)) >> 16; }
__device__ __forceinline__ unsigned pk2(float lo, float hi) { unsigned r; asm("v_cvt_pk_bf16_f32 %0, %1, %2" : "=v"(r) : "v"(lo), "v"(hi)); return r; }
__device__ __forceinline__ unsigned pk4_fp8(float a, float b, float c, float d) { int w = __builtin_amdgcn_cvt_pk_fp8_f32(a, b, 0, false); w = __builtin_amdgcn_cvt_pk_fp8_f32(c, d, w, true); return (unsigned)w; }
__device__ __forceinline__ float frcp(float x) { return __builtin_amdgcn_rcpf(x); }
__device__ __forceinline__ float bf2f(unsigned b) { return __builtin_bit_cast(float, b << 16); }
__device__ __forceinline__ float bflo(unsigned w) { return __builtin_bit_cast(float, w << 16); }
__device__ __forceinline__ float bfhi(unsigned w) { return __builtin_bit_cast(float, w & 0xffff0000u); }
__device__ __forceinline__ float wave_sum(float v) {
#pragma unroll
    for (int o = 1; o < 64; o <<= 1) v += __shfl_xor(v, o);
    return v;
}
__device__ __forceinline__ float wave_max(float v) {
#pragma unroll
    for (int o = 1; o < 64; o <<= 1) v = fmaxf(v, __shfl_xor(v, o));
    return v;
}
__device__ __forceinline__ float sigmoidf_(float x) { return frcp(1.0f + __expf(-x)); }

__host__ __device__ __forceinline__ int win_logical_col(int c) {
    if (c < C_AV) { const int p = c & 127; if (p < 32) { const int a = p >> 3, n = (p >> 2) & 1, j = p & 3; return (c - p) + 16 * n + 4 * a + j; } return c; }
    return c < C_GA ? c : c + 8;
}
__host__ __device__ __forceinline__ int wgu_logical_col(int c) { const int pn = c >> 8, bj = (c >> 7) & 1, jl = c & 127; return 2 * (128 * pn + jl) + bj; }
namespace pg8 {
#define PG8_LAS __attribute__((address_space(3)))
typedef unsigned short bf16_t;
typedef short bf16x8 __attribute__((ext_vector_type(8)));
typedef float f32x4 __attribute__((ext_vector_type(4)));
typedef unsigned u32x4 __attribute__((ext_vector_type(4)));
constexpr int BM = 256, BK = 64, HALF = 128, HTB = HALF * BK * 2  , STAGE_BYTES = 8 * HTB, NXCD = 8, WGM = 8;

__host__ __device__ __forceinline__ int lds_byte(int r, int c) { const int st = (r >> 4) * 2 + (c >> 5), rr = r & 15, cc = c & 31, ob = rr * 64 + cc * 2; return st * 1024 + (ob ^ (((ob >> 9) & 1) << 5)); }
__host__ __device__ __forceinline__ void stage_rc(int b, int& R, int& C) { const int st = b / 1024, sb = b % 1024, swz = sb ^ (((sb >> 9) & 1) << 5); R = (st >> 1) * 16 + swz / 64; C = (st & 1) * 32 + (swz % 64) / 2; }
__host__ __device__ __forceinline__ int perm32(int rho) { const int n = rho >> 4, i = rho & 15; return 8 * (i >> 2) + 4 * n + (i & 3); }

typedef int i32x4 __attribute__((ext_vector_type(4)));
typedef int i32x8 __attribute__((ext_vector_type(8)));
template <bool FP8> struct FragT { typedef bf16x8 type; };
template <> struct FragT<true> { typedef i32x8 type; };
__device__ __forceinline__ f32x4 mma16(bf16x8 a, bf16x8 b, f32x4 c) { return __builtin_amdgcn_mfma_f32_16x16x32_bf16(a, b, c, 0, 0, 0); }
__device__ __forceinline__ f32x4 mma16(i32x8, i32x8, f32x4 c) { return c; }
__device__ __forceinline__ f32x4 mma8(i32x8 a, i32x8 b, f32x4 c) { const int one = 0x7F7F7F7F;
    asm volatile("v_mfma_scale_f32_16x16x128_f8f6f4 %0, %1, %2, %0, %3, %3 op_sel_hi:[0,0,0]" : "+v"(c) : "v"(a), "v"(b), "v"(one)); return c; }
__device__ __forceinline__ f32x4 mma8(bf16x8, bf16x8, f32x4 c) { return c; }
struct Unit { int pm, pn, part; };
struct Gemm { const bf16_t* A; const bf16_t* Bt; int M, N, K; };

struct StaticOrder {
    int nM, nN, nwg, G, c;
    __host__ __device__ void init(int M, int N, int G_, int c_) { nM = M / BM; nN = N / BM; nwg = nM * nN; G = G_; c = c_; }
    __host__ __device__ bool next(int i, Unit& u) const { return at((long)i * G + c, u); }
    __host__ __device__ bool at(long L, Unit& u) const {
        if (L >= nwg) return false;
        int wgid = (int)L; { const int q = nwg / NXCD, r = nwg % NXCD, xcd = wgid % NXCD, off = wgid / NXCD; wgid = (xcd < r ? xcd * (q + 1) : r * (q + 1) + (xcd - r) * q) + off; }
        const int nig = WGM * nN, gid = wgid / nig, fm = gid * WGM, gsz = (nM - fm) < WGM ? (nM - fm) : WGM;
        u.pm = fm + ((wgid % nig) % gsz); u.pn = (wgid % nig) / gsz; u.part = 0; return true;
    }
    __device__ __forceinline__ int kt0(const Unit&) const { return 0; }
    __device__ __forceinline__ int nkt(const Unit&, int full) const { return full; }
    __device__ __forceinline__ int rowsel(const Unit&, int r) const { return r; }
    __device__ __forceinline__ const void* abase(const Unit&) const { return nullptr; }
    __device__ __forceinline__ const void* bbase(const Unit&) const { return nullptr; }
    __device__ __forceinline__ void a_ready(const Unit&) const {}
    __device__ __forceinline__ void done(const Unit&) const {}
};


__device__ __forceinline__ unsigned cvt_pk_bf16(float lo, float hi) { unsigned r; asm volatile("v_cvt_pk_bf16_f32 %0, %1, %2" : "=v"(r) : "v"(lo), "v"(hi)); return r; }
__device__ __forceinline__ u32x4 pack8(const f32x4 v0, const f32x4 v1) { u32x4 w; w.x = cvt_pk_bf16(v0[0], v0[1]); w.y = cvt_pk_bf16(v0[2], v0[3]); w.z = cvt_pk_bf16(v1[0], v1[1]); w.w = cvt_pk_bf16(v1[2], v1[3]); return w; }
__device__ __forceinline__ void unpack8(const u32x4 w, f32x4& v0, f32x4& v1) {
    v0[0] = __builtin_bit_cast(float, w.x << 16); v0[1] = __builtin_bit_cast(float, w.x & 0xffff0000u); v0[2] = __builtin_bit_cast(float, w.y << 16); v0[3] = __builtin_bit_cast(float, w.y & 0xffff0000u);
    v1[0] = __builtin_bit_cast(float, w.z << 16); v1[1] = __builtin_bit_cast(float, w.z & 0xffff0000u); v1[2] = __builtin_bit_cast(float, w.w << 16); v1[3] = __builtin_bit_cast(float, w.w & 0xffff0000u);
}
__device__ __forceinline__ f32x4 sig4(const f32x4 x) { f32x4 r; r[0] = frcp(1.0f + __expf(-x[0])); r[1] = frcp(1.0f + __expf(-x[1])); r[2] = frcp(1.0f + __expf(-x[2])); r[3] = frcp(1.0f + __expf(-x[3])); return r; }

struct GroupedOrder {
    const unsigned* tile_e; int ntiles, nN, G, c; const int* rowidx;
    __device__ __forceinline__ int kt0(const Unit&) const { return 0; }
    __device__ __forceinline__ int nkt(const Unit&, int full) const { return full; }
    __device__ __forceinline__ int rowsel(const Unit&, int r) const { const int v = rowidx[r]; return (v < 0 ? 0 : v) >> 2; }
    __device__ __forceinline__ const void* abase(const Unit&) const { return nullptr; }
    __device__ __forceinline__ const void* bbase(const Unit&) const { return nullptr; }
    __device__ bool next(int i, Unit& u) const {
        const long L = (long)i * G + c; if (L >= (long)ntiles * nN) return false;
        u.pm = (int)(L / nN); const int e = (int)tile_e[u.pm]; u.pn = e * nN + (int)(L % nN); u.part = 0; return true;
    }
    __device__ __forceinline__ void a_ready(const Unit&) const {}
    __device__ __forceinline__ void done(const Unit&) const {}
};

template <int MODE> struct EpiProj {
    static constexpr bool PERM = true, AFTER_DRAIN = false, HAS_MID = false;
    bf16_t* O; const float* rope;
    __device__ __forceinline__ bool keep(const Unit&) const { return false; }
    __device__ __forceinline__ void operator()(f32x4 (&acc)[2][2][4][2], const Unit& u, int wr, int wc, int fr, int fq) const {
        const int pnp = (MODE == 0) ? u.pn : (MODE == 1) ? (u.pn < 18 ? u.pn : u.pn + (P1_HI - 18)) : u.pn + 18;
        const int row0 = u.pm * BM + wr * 64 + fr, col0 = pnp * BM + wc * 32 + 8 * fq;
        const float sc = ((pnp < 6) ? QSCALE : 1.0f) * ((MODE == 1) ? (1.0f / 32.0f) : 1.0f);
        const bool dorope = (pnp < 12) && (wc == 0);
#pragma unroll
        for (int ai = 0; ai < 2; ++ai)
#pragma unroll
            for (int m = 0; m < 4; ++m) {
                const int row = row0 + ai * HALF + m * 16; bf16_t* rowp = O + (size_t)row * NP + col0;
                f32x4 cs = (f32x4){1.f, 1.f, 1.f, 1.f}, sn = (f32x4){0.f, 0.f, 0.f, 0.f};
                if (dorope) { cs = *(const f32x4*)(rope + (size_t)row * 32 + 4 * fq); sn = *(const f32x4*)(rope + (size_t)row * 32 + 16 + 4 * fq); }
#pragma unroll
                for (int bj = 0; bj < 2; ++bj) {
                    f32x4 v0 = acc[ai][bj][m][0], v1 = acc[ai][bj][m][1];
                    if (dorope) { const f32x4 t0 = v0 * cs - v1 * sn, t1 = v1 * cs + v0 * sn; v0 = t0; v1 = t1; }
                    v0 = v0 * sc; v1 = v1 * sc;
                    *(u32x4*)(rowp + bj * HALF) = pack8(v0, v1);
                }
            }
    }
};

struct SplitOrder {
    StaticOrder base; int nA, nB;
    __device__ bool next(int i, Unit& u) const {
        const int c = base.c;
        if (base.G != 256 || nA < 0) return base.next(i, u);
        if (c < 128) { if (i >= nA) return false; return base.at((long)i * 128 + c, u); }
        if (i >= nB) return false; return base.at((long)128 * nA + (long)i * 128 + (c - 128), u);
    }
    __device__ __forceinline__ int kt0(const Unit&) const { return 0; }
    __device__ __forceinline__ int nkt(const Unit&, int full) const { return full; }
    __device__ __forceinline__ int rowsel(const Unit&, int r) const { return r; }
    __device__ __forceinline__ const void* abase(const Unit&) const { return nullptr; }
    __device__ __forceinline__ const void* bbase(const Unit&) const { return nullptr; }
    __device__ __forceinline__ void a_ready(const Unit&) const {}
    __device__ __forceinline__ void done(const Unit&) const {}
};
struct MergedOrder {
    StaticOrder base; int nparts; unsigned* ready; unsigned* tmo;
    bool pub;
    __device__ bool next(int i, Unit& u) const { if (!base.next(i / nparts, u)) return false; u.part = (nparts == 1) ? 2 : (i % nparts); return true; }
#if MERGE_FP8
    __device__ __forceinline__ int kt0(const Unit& u) const { return u.part == 0 ? 0 : (u.part == 1 ? 4 : 12); }
    __device__ __forceinline__ int nkt(const Unit& u, int) const { return u.part == 0 ? 4 : 8; }
#else
    __device__ __forceinline__ int kt0(const Unit& u) const { return u.part == 0 ? 0 : (u.part == 1 ? 8 : 24); }
    __device__ __forceinline__ int nkt(const Unit& u, int) const { return u.part == 0 ? 8 : 16; }
#endif
    __device__ __forceinline__ int rowsel(const Unit&, int r) const { return r; }
    __device__ __forceinline__ const void* abase(const Unit&) const { return nullptr; }
    __device__ __forceinline__ const void* bbase(const Unit&) const { return nullptr; }
    __device__ __forceinline__ void a_ready(const Unit& u) const {
        if (u.part != 2 || !pub) return;
        if (threadIdx.x < 64) {
            unsigned spins = 0;
            while ((unsigned)__builtin_amdgcn_readfirstlane(__hip_atomic_load(ready + 64 * u.pm, __ATOMIC_RELAXED, __HIP_MEMORY_SCOPE_AGENT)) < 32u) {
                __builtin_amdgcn_s_sleep(2);
                if (++spins > (1u << 22)) { if (threadIdx.x == 0) __hip_atomic_store(tmo, 1u, __ATOMIC_RELAXED, __HIP_MEMORY_SCOPE_AGENT); break; } }
            __builtin_amdgcn_fence(__ATOMIC_ACQUIRE, "agent");
            asm volatile("s_waitcnt vmcnt(0)" ::: "memory");
        }
        asm volatile("" ::: "memory"); __builtin_amdgcn_s_barrier(); asm volatile("" ::: "memory");
    }
    __device__ __forceinline__ void done(const Unit& u) const {
        if (!pub || u.part != 1) return;
        asm volatile("s_waitcnt vmcnt(0)" ::: "memory");
        __builtin_amdgcn_s_barrier(); asm volatile("" ::: "memory");
        if (threadIdx.x == 0) { __builtin_amdgcn_fence(__ATOMIC_RELEASE, "agent"); asm volatile("s_waitcnt vmcnt(0)" ::: "memory");
                                __hip_atomic_fetch_add(ready + 64 * u.pm, 8u, __ATOMIC_RELAXED, __HIP_MEMORY_SCOPE_AGENT); }
    }
};
struct EpiMerged {
    static constexpr bool PERM = true, AFTER_DRAIN = false, HAS_MID = false;
    bf16_t* O; const bf16_t* proj; const float* x; float* h; bool wt;
    __device__ __forceinline__ bool keep(const Unit& u) const { return u.part == 0; }
    __device__ __forceinline__ void operator()(f32x4 (&acc)[2][2][4][2], const Unit& u, int wr, int wc, int fr, int fq) const {
        const int row0 = u.pm * BM + wr * 64 + fr, col0 = u.pn * BM + wc * 32 + 8 * fq;
        if (u.part == 0) {
#pragma unroll
            for (int ai = 0; ai < 2; ++ai)
#pragma unroll
                for (int m = 0; m < 4; ++m) {
                    const bf16_t* rowp = proj + (size_t)(row0 + ai * HALF + m * 16) * NP + col0;
#pragma unroll
                    for (int bj = 0; bj < 2; ++bj) {
                        const u32x4 ga = *(const u32x4*)(rowp + C_GA + bj * HALF), gm = *(const u32x4*)(rowp + C_GM + bj * HALF);
                        f32x4 a0, a1, m0, m1; unpack8(ga, a0, a1); unpack8(gm, m0, m1);
                        f32x4 r0, r1;
#pragma unroll
                        for (int j = 0; j < 4; ++j) { r0[j] = (1.0f + __expf(-m0[j])) * frcp(1.0f + __expf(-a0[j])); r1[j] = (1.0f + __expf(-m1[j])) * frcp(1.0f + __expf(-a1[j])); }
                        acc[ai][bj][m][0] *= r0; acc[ai][bj][m][1] *= r1;
                    }
                    if (m & 1) asm volatile("" ::: "memory");
                }
        } else if (u.part == 1) {
#pragma unroll
            for (int ai = 0; ai < 2; ++ai)
#pragma unroll
                for (int m = 0; m < 4; ++m) {
                    const int row = row0 + ai * HALF + m * 16;
#pragma unroll
                    for (int bj = 0; bj < 2; ++bj) {
                        const u32x4 gm = *(const u32x4*)(proj + (size_t)row * NP + C_GM + col0 + bj * HALF);
                        f32x4 m0, m1; unpack8(gm, m0, m1);
#if MERGE_FP8
                        const f32x4 v0 = acc[ai][bj][m][0] * sig4(m0) * (1.0f / 32.0f), v1 = acc[ai][bj][m][1] * sig4(m1) * (1.0f / 32.0f);
                        u32x2 p8; p8.x = pk4_fp8(v0[0], v0[1], v0[2], v0[3]); p8.y = pk4_fp8(v1[0], v1[1], v1[2], v1[3]);
                        *(u32x2*)((unsigned char*)O + (size_t)row * AMLD + col0 + bj * HALF) = p8;
#else
                        const f32x4 v0 = acc[ai][bj][m][0] * sig4(m0), v1 = acc[ai][bj][m][1] * sig4(m1);
                        const u32x4 pw = pack8(v0, v1); bf16_t* dst = O + (size_t)row * AMLD + col0 + bj * HALF;
                        if (wt) { __hip_atomic_store((unsigned long long*)dst, (unsigned long long)pw.x | ((unsigned long long)pw.y << 32), __ATOMIC_RELAXED, __HIP_MEMORY_SCOPE_AGENT);
                                  __hip_atomic_store((unsigned long long*)dst + 1, (unsigned long long)pw.z | ((unsigned long long)pw.w << 32), __ATOMIC_RELAXED, __HIP_MEMORY_SCOPE_AGENT); }
                        else *(u32x4*)dst = pw;
#endif
                    }
                }
        } else {
#pragma unroll
            for (int ai = 0; ai < 2; ++ai)
#pragma unroll
                for (int m = 0; m < 4; ++m) {
                    const size_t off = (size_t)(row0 + ai * HALF + m * 16) * D + col0;
#if H_BF16
#pragma unroll
                    for (int bj = 0; bj < 2; ++bj) { const float osc = MERGE_FP8 ? (1.0f / 256.0f) : 1.0f;
                        const f32x4 v0 = *(const f32x4*)(x + off + bj * HALF) + acc[ai][bj][m][0] * osc, v1 = *(const f32x4*)(x + off + bj * HALF + 4) + acc[ai][bj][m][1] * osc;
                        *(u32x4*)((bf16_t*)h + off + bj * HALF) = pack8(v0, v1); }
#else
#pragma unroll
                    for (int bj = 0; bj < 2; ++bj)
#pragma unroll
                        for (int n = 0; n < 2; ++n) *(f32x4*)(h + off + bj * HALF + 4 * n) = *(const f32x4*)(x + off + bj * HALF + 4 * n) + acc[ai][bj][m][n];
#endif
                }
        }
    }
};

struct EpiResid {
    static constexpr bool PERM = false, AFTER_DRAIN = false, HAS_MID = false;
    const float* x; float* h;
    __device__ __forceinline__ bool keep(const Unit&) const { return false; }
    __device__ __forceinline__ void operator()(f32x4 (&acc)[2][2][4][2], const Unit& u, int wr, int wc, int fr, int fq) const {
        const int row0 = u.pm * BM + wr * 64 + fr, col0 = u.pn * BM + wc * 32 + 4 * fq;
#pragma unroll
        for (int ai = 0; ai < 2; ++ai)
#pragma unroll
            for (int m = 0; m < 4; ++m) {
                const size_t off = (size_t)(row0 + ai * HALF + m * 16) * D + col0;
#pragma unroll
                for (int bj = 0; bj < 2; ++bj)
#pragma unroll
                    for (int n = 0; n < 2; ++n) *(f32x4*)(h + off + bj * HALF + n * 16) = *(const f32x4*)(x + off + bj * HALF + n * 16) + acc[ai][bj][m][n];
            }
    }
};

template <bool OUT8> struct EpiSwiGLU {
    static constexpr bool PERM = true, AFTER_DRAIN = false, HAS_MID = false;
    bf16_t* act; const float* bgu; float sc;
    __device__ __forceinline__ bool keep(const Unit&) const { return false; }
    __device__ __forceinline__ void operator()(f32x4 (&acc)[2][2][4][2], const Unit& u, int wr, int wc, int fr, int fq) const {
        const int e = u.pn >> 3, pnl = u.pn & 7, row0 = u.pm * BM + wr * 64 + fr, j0 = 128 * pnl + 32 * wc + 8 * fq;
        const float* bp = bgu + (size_t)e * 2048 + 2 * j0;
        const f32x4 b0 = *(const f32x4*)(bp), b1 = *(const f32x4*)(bp + 4), b2 = *(const f32x4*)(bp + 8), b3 = *(const f32x4*)(bp + 12);
        const f32x4 bg0 = (f32x4){b0[0], b0[2], b1[0], b1[2]}, bu0 = (f32x4){b0[1], b0[3], b1[1], b1[3]}, bg1 = (f32x4){b2[0], b2[2], b3[0], b3[2]}, bu1 = (f32x4){b2[1], b2[3], b3[1], b3[3]};
#pragma unroll
        for (int ai = 0; ai < 2; ++ai)
#pragma unroll
            for (int m = 0; m < 4; ++m) {
                const int row = row0 + ai * HALF + m * 16;
                f32x4 o[2]; const float lim = 7.0f, nlim = -7.0f;
#pragma unroll
                for (int n = 0; n < 2; ++n) {
                    const f32x4 g = acc[ai][0][m][n] * sc + (n ? bg1 : bg0), up = acc[ai][1][m][n] * sc + (n ? bu1 : bu0);
#pragma unroll
                    for (int j = 0; j < 4; ++j) { float gg, uu;
                        asm("v_min_f32 %0, %2, %1" : "=v"(gg) : "v"(g[j]), "v"(lim)); asm("v_med3_f32 %0, %1, %2, %3" : "=v"(uu) : "v"(up[j]), "v"(nlim), "v"(lim));
                        const float sg = frcp(1.0f + __builtin_amdgcn_exp2f(gg * (-1.702f * 1.4426950408889634f)));
                        o[n][j] = __builtin_fmaf(uu, gg, gg) * sg; }
                }
                if constexpr (OUT8) { u32x2 w8; w8.x = pk4_fp8(o[0][0], o[0][1], o[0][2], o[0][3]); w8.y = pk4_fp8(o[1][0], o[1][1], o[1][2], o[1][3]); __hip_atomic_store((unsigned long long*)((unsigned char*)act + (size_t)row * D + j0), (unsigned long long)w8.x | ((unsigned long long)w8.y << 32), __ATOMIC_RELAXED, __HIP_MEMORY_SCOPE_AGENT); }
                else *(u32x4*)(act + (size_t)row * D + j0) = pack8(o[0], o[1]);
            }
    }
};

struct EpiDown {
    static constexpr bool PERM = true, AFTER_DRAIN = false, HAS_MID = false;
    bf16_t* ybuf; const float* bdn; const int* row_tok; const float* row_w; float sc;
    const LAS int* tbase; const LAS int* tnv;
    __device__ __forceinline__ bool keep(const Unit&) const { return false; }
    __device__ __forceinline__ void operator()(f32x4 (&acc)[2][2][4][2], const Unit& u, int wr, int wc, int fr, int fq) const {
        const int e = u.pn >> 2, pnl = u.pn & 3, col0 = 256 * pnl + 32 * wc + 8 * fq;
#if RM_FUSED
        const int row0 = tbase[u.pm] + wr * 64 + fr, nvr = tnv[u.pm] - (wr * 64 + fr);
#else
        const int row0 = u.pm * BM + wr * 64 + fr;
#endif
        f32x4 bv[2][2];
#pragma unroll
        for (int bj = 0; bj < 2; ++bj)
#pragma unroll
            for (int n = 0; n < 2; ++n) bv[bj][n] = *(const f32x4*)(bdn + (size_t)e * D + col0 + bj * HALF + 4 * n);
        int tks[8]; float ws[8];
#pragma unroll
#if RM_FUSED
        for (int i = 0; i < 8; ++i) { const int o = (i >> 2) * HALF + (i & 3) * 16; const bool ok = o < nvr; const int row = ok ? row0 + o : 0; tks[i] = row_tok[row]; ws[i] = row_w[row]; if (!ok) tks[i] = -1; }
#else
        for (int i = 0; i < 8; ++i) { const int row = row0 + (i >> 2) * HALF + (i & 3) * 16; tks[i] = row_tok[row]; ws[i] = row_w[row]; }
#endif
#pragma unroll
        for (int ai = 0; ai < 2; ++ai)
#pragma unroll
            for (int m = 0; m < 4; ++m) {
                const int tk = tks[ai * 4 + m]; const float w = ws[ai * 4 + m];
                if (tk >= 0) {
#pragma unroll
                    for (int bj = 0; bj < 2; ++bj) {
                        const f32x4 v0 = (acc[ai][bj][m][0] * sc + bv[bj][0]) * w, v1 = (acc[ai][bj][m][1] * sc + bv[bj][1]) * w;
                        *(u32x4*)(ybuf + (size_t)tk * D + col0 + bj * HALF) = pack8(v0, v1);
                    }
                }
            }
    }
};

struct MoeOrder {
    const LAS unsigned* tile_e; int ntiles, G, c; const int* rowidx; const void *a0, *a1, *b0, *b1; unsigned* ready; unsigned* tmo;
    const LAS int* tbase; const LAS int* tnv;
    __device__ __forceinline__ int kt0(const Unit&) const { return 0; }
    __device__ __forceinline__ int nkt(const Unit&, int full) const { return full; }
#if RM_FUSED
    __device__ __forceinline__ int rowsel(const Unit& u, int r) const { if (u.part) return r; const int lr = r - u.pm * BM; return (lr < tnv[u.pm]) ? (rowidx[tbase[u.pm] + lr] >> 2) : 0; }
#else
    __device__ __forceinline__ int rowsel(const Unit& u, int r) const { if (u.part) return r; const int v = rowidx[r]; return (v < 0 ? 0 : v) >> 2; }
#endif
    __device__ __forceinline__ const void* abase(const Unit& u) const { return u.part ? a1 : a0; }
    __device__ __forceinline__ const void* bbase(const Unit& u) const { return u.part ? b1 : b0; }
    __device__ bool next(int i, Unit& u) const {
        long L = (long)i * G + c; const long n1 = (long)ntiles * 8;
        if (L < n1) { u.pm = (int)(L >> 3); u.pn = (int)tile_e[u.pm] * 8 + (int)(L & 7); u.part = 0; return true; }
        L -= n1; if (L >= (long)ntiles * 4) return false;
        u.pm = (int)(L >> 2); u.pn = (int)tile_e[u.pm] * 4 + (int)(L & 3); u.part = 1; return true;
    }
    __device__ __forceinline__ void a_ready(const Unit& u) const {
        if (u.part == 0) return;
        if (threadIdx.x < 64) {
            unsigned spins = 0;
            while ((unsigned)__builtin_amdgcn_readfirstlane(__hip_atomic_load(ready + 64 * u.pm, __ATOMIC_RELAXED, __HIP_MEMORY_SCOPE_AGENT)) < 64u) {
                __builtin_amdgcn_s_sleep(2);
                if (++spins > (1u << 22)) { if (threadIdx.x == 0) __hip_atomic_store(tmo, 1u, __ATOMIC_RELAXED, __HIP_MEMORY_SCOPE_AGENT); break; } }
            __builtin_amdgcn_fence(__ATOMIC_ACQUIRE, "agent");
            asm volatile("s_waitcnt vmcnt(0)" ::: "memory");
        }
        asm volatile("" ::: "memory"); __builtin_amdgcn_s_barrier(); asm volatile("" ::: "memory");
    }
    __device__ __forceinline__ void done(const Unit& u) const {
        if (u.part != 0) return;
        asm volatile("s_waitcnt vmcnt(0)" ::: "memory");
        if ((threadIdx.x & 63) == 0) __hip_atomic_fetch_add(ready + 64 * u.pm, 1u, __ATOMIC_RELAXED, __HIP_MEMORY_SCOPE_AGENT);
    }
};
struct EpiMoe {
    static constexpr bool PERM = true, AFTER_DRAIN = false, HAS_MID = false;
    EpiSwiGLU<true> e0; EpiDown e1;
    __device__ __forceinline__ bool keep(const Unit&) const { return false; }
    __device__ __forceinline__ void operator()(f32x4 (&acc)[2][2][4][2], const Unit& u, int wr, int wc, int fr, int fq) const {
        if (u.part == 0) e0(acc, u, wr, wc, fr, fq); else e1(acc, u, wr, wc, fr, fq);
    }
};
template <class Epi, class Sched, bool ALIGN_EPI = false, bool SP2 = false, bool FP8 = false, bool GATHER = false, bool MULTI = false>
__device__ __forceinline__ void gemm_phase(PG8_LAS unsigned char* lds, const Gemm g, const Sched& S, const Epi& E) {
    typedef typename FragT<FP8>::type frag_t;
    const int tid = threadIdx.x, wid = __builtin_amdgcn_readfirstlane(tid >> 6), lane = tid & 63, wr = wid >> 2, wc = wid & 3, fr = lane & 15, fq = lane >> 4;
    int K_ = g.K; asm volatile("" : "+s"(K_));
    const int K = K_, ntfull = K / BK;
    unsigned voffA[2], voffB[2];
#pragma unroll
    for (int i = 0; i < 2; ++i) { int R, C; stage_rc(tid * 16 + i * 8192, R, C); const int Rb = Epi::PERM ? ((R & ~31) + perm32(R & 31)) : R;
        voffA[i] = (unsigned)(R * K + C) * 2u; voffB[i] = (unsigned)(Rb * K + C) * 2u; }
    const size_t kstep = (size_t)(BK * 2);
    const size_t hstep = (size_t)HALF * K * 2;
    const size_t tstep = 2 * hstep;
    const unsigned ldsw = (unsigned)wid * 1024u;
    const int aoff = lds_byte(wr * 64 + fr, fq * (FP8 ? 16 : 8)), boff = lds_byte(wc * 32 + fr, fq * (FP8 ? 16 : 8));
    constexpr int NKF = FP8 ? 1 : 2;
#define PG8_SA(b, h) (((b) * 2 + (h)) * HTB)
#define PG8_SB(b, h) ((4 + (b) * 2 + (h)) * HTB)
#define PG8_STAGE(bufoff, gbase, voff) do { _Pragma("unroll") for (int _i = 0; _i < 2; ++_i) \
        __builtin_amdgcn_global_load_lds((const unsigned*)((const char*)(gbase) + (voff)[_i]), (PG8_LAS unsigned*)(lds + (bufoff) + ldsw + _i * 8192), 16, 0, 0); } while (0)
#define PG8_STAGEA(bufoff, gbase, half, isnext) do { if constexpr (GATHER) { unsigned vs_[2]; vs_[0] = (isnext) ? voffAn[half][0] : voffAc[half][0]; vs_[1] = (isnext) ? voffAn[half][1] : voffAc[half][1]; PG8_STAGE(bufoff, gbase, vs_); } \
        else { PG8_STAGE(bufoff, (gbase) + (half) * hstep, voffA); } } while (0)
#define PG8_LDA(dst, b, h) do { _Pragma("unroll") for (int m = 0; m < 4; ++m) _Pragma("unroll") for (int k = 0; k < NKF; ++k) dst[m][k] = *(const PG8_LAS frag_t*)(lds + PG8_SA(b, h) + aoff + m * 2048 + k * 1024); } while (0)
#define PG8_LDB(dst, b, h) do { _Pragma("unroll") for (int n = 0; n < 2; ++n) _Pragma("unroll") for (int k = 0; k < NKF; ++k) dst[n][k] = *(const PG8_LAS frag_t*)(lds + PG8_SB(b, h) + boff + n * 2048 + k * 1024); } while (0)
#define PG8_MMA(ai, bj, At, Bt) do { __builtin_amdgcn_s_setprio(1); \
        if constexpr (FP8) { _Pragma("unroll") for (int m = 0; m < 4; ++m) _Pragma("unroll") for (int n = 0; n < 2; ++n) \
            acc[ai][bj][m][n] = mma8(Bt[n][0], At[m][0], acc[ai][bj][m][n]); } \
        else { _Pragma("unroll") for (int m = 0; m < 4; ++m) _Pragma("unroll") for (int n = 0; n < 2; ++n) _Pragma("unroll") for (int k = 0; k < 2; ++k) \
            acc[ai][bj][m][n] = mma16(Bt[n][k], At[m][k], acc[ai][bj][m][n]); } \
        __builtin_amdgcn_s_setprio(0); } while (0)
#define PG8_WAIT_V(n) asm volatile("s_waitcnt vmcnt(" #n ")" ::: "memory")
#define PG8_WAIT_L(n) asm volatile("s_waitcnt lgkmcnt(" #n ")" ::: "memory")
#define PG8_BAR __builtin_amdgcn_s_barrier()
#define PG8_SCHED __builtin_amdgcn_sched_barrier(0)
    Unit cur, nxt; int ui = 0;
    if (!S.next(0, cur)) return;
    unsigned voffAc[2][2], voffAn[2][2];
#define PG8_GROWS(dst, u_) do { if constexpr (GATHER) { _Pragma("unroll") for (int h_ = 0; h_ < 2; ++h_) _Pragma("unroll") for (int i_ = 0; i_ < 2; ++i_) { int R_, C_; stage_rc(tid * 16 + i_ * 8192, R_, C_); \
        const int ri_ = S.rowsel((u_), (u_).pm * BM + h_ * HALF + R_); dst[h_][i_] = (unsigned)ri_ * (unsigned)(K * 2) + (unsigned)(C_ * 2); } } } while (0)
    PG8_GROWS(voffAc, cur);
    f32x4 acc[2][2][4][2];
#pragma unroll
    for (int a = 0; a < 2; ++a)
#pragma unroll
        for (int b = 0; b < 2; ++b)
#pragma unroll
            for (int m = 0; m < 4; ++m)
#pragma unroll
                for (int n = 0; n < 2; ++n) acc[a][b][m][n] = (f32x4){0.f, 0.f, 0.f, 0.f};
    frag_t At[4][NKF], B0[2][NKF], B1[2][NKF];
    const char* cA = (MULTI ? (const char*)S.abase(cur) : (const char*)g.A) + (GATHER ? (size_t)0 : (size_t)cur.pm * tstep) + (size_t)S.kt0(cur) * kstep; const char* cB = (MULTI ? (const char*)S.bbase(cur) : (const char*)g.Bt) + (size_t)cur.pn * tstep + (size_t)S.kt0(cur) * kstep;
    S.a_ready(cur);
    if constexpr (SP2) {
        PG8_STAGE(PG8_SB(0, 0), cB, voffB); PG8_STAGE(PG8_SB(0, 1), cB + hstep, voffB); PG8_STAGEA(PG8_SA(0, 0), cA, 0, false); PG8_STAGEA(PG8_SA(0, 1), cA, 1, false);
        if (wr == 1) PG8_BAR;
        PG8_WAIT_V(2); PG8_BAR;
        PG8_STAGE(PG8_SB(1, 0), cB + kstep, voffB); PG8_STAGEA(PG8_SA(1, 0), cA + kstep, 0, false); PG8_STAGE(PG8_SB(1, 1), cB + hstep + kstep, voffB);
        PG8_WAIT_V(6); PG8_BAR;
    } else {
        PG8_STAGE(PG8_SB(0, 0), cB, voffB); PG8_STAGEA(PG8_SA(0, 0), cA, 0, false); PG8_STAGE(PG8_SB(0, 1), cB + hstep, voffB); PG8_STAGEA(PG8_SA(0, 1), cA, 1, false);
        if (wr == 1) PG8_BAR;
        PG8_WAIT_V(4); PG8_BAR;
        PG8_STAGE(PG8_SB(1, 0), cB + kstep, voffB); PG8_STAGEA(PG8_SA(1, 0), cA + kstep, 0, false); PG8_STAGE(PG8_SB(1, 1), cB + hstep + kstep, voffB);
        PG8_WAIT_V(6); PG8_BAR;
    }
    for (;;) {
        const bool has_next = S.next(ui + 1, nxt);
        if (has_next) PG8_GROWS(voffAn, nxt);
        else if constexpr (GATHER) { _Pragma("unroll") for (int h_ = 0; h_ < 2; ++h_) _Pragma("unroll") for (int i_ = 0; i_ < 2; ++i_) voffAn[h_][i_] = voffAc[h_][i_]; }
        const char* nA = has_next ? (MULTI ? (const char*)S.abase(nxt) : (const char*)g.A) + (GATHER ? (size_t)0 : (size_t)nxt.pm * tstep) + (size_t)S.kt0(nxt) * kstep : cA; const char* nB = has_next ? (MULTI ? (const char*)S.bbase(nxt) : (const char*)g.Bt) + (size_t)nxt.pn * tstep + (size_t)S.kt0(nxt) * kstep : cB;
        const int nt = S.nkt(cur, ntfull);
        for (int t = 0; t < nt; t += 2) {
            const bool last = (t == nt - 2);
            const char* a1 = cA + (size_t)(t + 1) * kstep;
            const char* a2 = last ? nA : cA + (size_t)(t + 2) * kstep; const char* b2 = last ? nB : cB + (size_t)(t + 2) * kstep;
            const char* a3 = a2 + kstep; const char* b3 = b2 + kstep;
            if (last && has_next) S.a_ready(nxt);
            if constexpr (SP2) {
            PG8_LDB(B0, 0, 0); PG8_LDB(B1, 0, 1); PG8_SCHED; PG8_LDA(At, 0, 0); PG8_STAGEA(PG8_SA(1, 1), a1, 1, false);
            PG8_WAIT_V(8); PG8_WAIT_L(0); PG8_BAR; PG8_MMA(0, 0, At, B0); PG8_MMA(0, 1, At, B1); PG8_BAR; PG8_SCHED;
            PG8_LDA(At, 0, 1); PG8_STAGE(PG8_SB(0, 0), b2, voffB); PG8_STAGE(PG8_SB(0, 1), b2 + hstep, voffB); PG8_STAGEA(PG8_SA(0, 0), a2, 0, last);
            PG8_WAIT_V(8); PG8_WAIT_L(0); PG8_BAR; PG8_MMA(1, 0, At, B0); PG8_MMA(1, 1, At, B1); PG8_BAR; PG8_SCHED;
            PG8_LDB(B0, 1, 0); PG8_LDB(B1, 1, 1); PG8_SCHED; PG8_LDA(At, 1, 0); PG8_STAGEA(PG8_SA(0, 1), a2, 1, last);
            PG8_WAIT_V(8); PG8_WAIT_L(0); PG8_BAR; PG8_MMA(0, 0, At, B0); PG8_MMA(0, 1, At, B1); PG8_BAR; PG8_SCHED;
            PG8_LDA(At, 1, 1); PG8_STAGE(PG8_SB(1, 0), b3, voffB); PG8_STAGE(PG8_SB(1, 1), b3 + hstep, voffB); PG8_STAGEA(PG8_SA(1, 0), a3, 0, last);
            PG8_WAIT_V(8); PG8_WAIT_L(0); PG8_BAR; PG8_MMA(1, 0, At, B0); PG8_MMA(1, 1, At, B1); PG8_BAR; PG8_SCHED;
            } else {
            PG8_LDB(B0, 0, 0); PG8_SCHED; PG8_LDA(At, 0, 0); PG8_STAGEA(PG8_SA(1, 1), a1, 1, false);
            PG8_WAIT_L(8); PG8_BAR; PG8_WAIT_L(0); PG8_MMA(0, 0, At, B0); PG8_BAR; PG8_SCHED;
            PG8_LDB(B1, 0, 1); PG8_STAGE(PG8_SB(0, 0), b2, voffB);
            PG8_BAR; PG8_WAIT_L(0); PG8_MMA(0, 1, At, B1); PG8_BAR;
            PG8_LDA(At, 0, 1); PG8_STAGEA(PG8_SA(0, 0), a2, 0, last);
            PG8_BAR; PG8_WAIT_L(0); PG8_MMA(1, 0, At, B0); PG8_BAR; PG8_SCHED;
            PG8_STAGE(PG8_SB(0, 1), b2 + hstep, voffB);
            PG8_WAIT_V(6); PG8_BAR; PG8_MMA(1, 1, At, B1); PG8_BAR;
            PG8_LDB(B0, 1, 0); PG8_SCHED; PG8_LDA(At, 1, 0); PG8_STAGEA(PG8_SA(0, 1), a2, 1, last);
            PG8_WAIT_L(8); PG8_BAR; PG8_WAIT_L(0); PG8_MMA(0, 0, At, B0); PG8_BAR; PG8_SCHED;
            PG8_LDB(B1, 1, 1); PG8_STAGE(PG8_SB(1, 0), b3, voffB);
            PG8_BAR; PG8_WAIT_L(0); PG8_MMA(0, 1, At, B1); PG8_BAR;
            PG8_LDA(At, 1, 1); PG8_STAGEA(PG8_SA(1, 0), a3, 0, last);
            PG8_BAR; PG8_WAIT_L(0); PG8_MMA(1, 0, At, B0); PG8_BAR; PG8_SCHED;
            PG8_STAGE(PG8_SB(1, 1), b3 + hstep, voffB);
            PG8_WAIT_V(6); PG8_BAR; PG8_MMA(1, 1, At, B1); PG8_BAR;
            }
        }
        if constexpr (FP8) asm volatile("s_nop 15\n\ts_nop 15" ::: "memory");
        if constexpr (ALIGN_EPI) { if (wr == 0) PG8_BAR; }
        if constexpr (!Epi::AFTER_DRAIN) { E(acc, cur, wr, wc, fr, fq); S.done(cur); }
        if (!has_next) break;
        if (!E.keep(cur)) {
#pragma unroll
        for (int a = 0; a < 2; ++a)
#pragma unroll
            for (int b = 0; b < 2; ++b)
#pragma unroll
                for (int m = 0; m < 4; ++m)
#pragma unroll
                    for (int n = 0; n < 2; ++n) acc[a][b][m][n] = (f32x4){0.f, 0.f, 0.f, 0.f};
        }
        cur = nxt; cA = nA; cB = nB; ++ui;
        if constexpr (GATHER) { _Pragma("unroll") for (int h_ = 0; h_ < 2; ++h_) _Pragma("unroll") for (int i_ = 0; i_ < 2; ++i_) voffAc[h_][i_] = voffAn[h_][i_]; }
        if constexpr (ALIGN_EPI) { if (wr == 1) PG8_BAR; }
    }
    PG8_WAIT_V(0);
    if constexpr (!ALIGN_EPI) { if (wr == 0) PG8_BAR; }
    PG8_BAR;
    if constexpr (Epi::AFTER_DRAIN) { E.fused(acc, cur, wr, wc, fr, fq, lds, wid, lane); S.done(cur); }
#undef PG8_SA
#undef PG8_SB
#undef PG8_STAGE
#undef PG8_LDA
#undef PG8_STAGEA
#undef PG8_GROWS
#undef PG8_LDB
#undef PG8_MMA
#undef PG8_WAIT_V
#undef PG8_WAIT_L
#undef PG8_BAR
#undef PG8_SCHED
}
}
#define XB_TMO      128
#define XB_XCNT(j)  (256  + 64 * (j))
#define XB_XSUB(j)  (1280 + 64 * (j))
#define XB_XGEN(j)  (2304 + 64 * (j))
#define XB_TOP      3328
#define XB_TOPGEN   3392
#define XCD_BAR_WORDS 3456
#define XB_SPIN_CAP (1u << 24)

__device__ __forceinline__ unsigned xb_ld(unsigned* p)              { return __hip_atomic_load(p, __ATOMIC_RELAXED, __HIP_MEMORY_SCOPE_AGENT); }
__device__ __forceinline__ unsigned xb_add(unsigned* p, unsigned v) { return __hip_atomic_fetch_add(p, v, __ATOMIC_RELAXED, __HIP_MEMORY_SCOPE_AGENT); }
__device__ __forceinline__ unsigned xb_xcc_id() { return (unsigned)__builtin_amdgcn_s_getreg((3 << 11) | 20) & 0xFu; }
#define XB_SPIN(cond, bar) do { unsigned _sp = 0; while (cond) { __builtin_amdgcn_s_sleep(1); \
    if ((++_sp & 255u) == 0u) { if (xb_ld(&(bar)[XB_TMO])) break; if (_sp > XB_SPIN_CAP) { atomicAdd(&(bar)[XB_TMO], 1u); break; } } } } while (0)

struct XcdBarrier {
    unsigned* bar; unsigned x;
    volatile LAS unsigned* st;
};

__device__ __forceinline__ XcdBarrier xcd_barrier_post(unsigned* bar, volatile LAS unsigned* st) {
    XcdBarrier b; b.bar = bar; b.x = xb_xcc_id(); b.st = st;
    if (threadIdx.x == 0) (void)xb_add(&bar[XB_XCNT(b.x)], 1u);
    return b;
}
__device__ __forceinline__ void xcd_barrier_complete(unsigned* bar, unsigned x, unsigned& nloc, unsigned& nx) {
    const unsigned G = gridDim.x * gridDim.y * gridDim.z;
    unsigned sum, cnt, mine, sp = 0u;
    for (;;) {
        sum = 0u; cnt = 0u; mine = 0u;
#pragma unroll
        for (unsigned j = 0; j < 16; ++j) { const unsigned c = xb_ld(&bar[XB_XCNT(j)]); sum += c; cnt += (c > 0u) ? 1u : 0u; mine = (j == x) ? c : mine; }
        if (sum == G) break;
        __builtin_amdgcn_s_sleep(1);
        if ((++sp & 255u) == 0u) { if (xb_ld(&bar[XB_TMO])) break; if (sp > XB_SPIN_CAP) { atomicAdd(&bar[XB_TMO], 1u); break; } }
    }
    nloc = mine > 0u ? mine : 1u; nx = cnt > 0u ? cnt : 1u;
}

__device__ __forceinline__ void xcd_barrier(const XcdBarrier& b) {
    asm volatile("s_waitcnt vmcnt(0)" ::: "memory");
    __syncthreads();
    if (threadIdx.x == 0) {
        unsigned* bar = b.bar;
        __builtin_amdgcn_s_waitcnt(0);
        unsigned nloc = b.st[0], nx = b.st[1];
        if (nloc == 0u) { xcd_barrier_complete(bar, b.x, nloc, nx); b.st[0] = nloc; b.st[1] = nx; }
        const unsigned old = xb_add(&bar[XB_XSUB(b.x)], 1u);
        const unsigned gen = old / nloc;
        if (old + 1u == (gen + 1u) * nloc) {
            __builtin_amdgcn_fence(__ATOMIC_RELEASE, "agent");
            asm volatile("s_waitcnt vmcnt(0)" ::: "memory");
            const unsigned og = xb_add(&bar[XB_TOP], 1u);
            const unsigned tg = og / nx;
            if (og + 1u == (tg + 1u) * nx) xb_add(&bar[XB_TOPGEN], 1u);
            else XB_SPIN(xb_ld(&bar[XB_TOPGEN]) == tg, bar);
            __builtin_amdgcn_fence(__ATOMIC_ACQUIRE, "agent");
            xb_add(&bar[XB_XGEN(b.x)], 1u);
            asm volatile("s_waitcnt vmcnt(0)" ::: "memory");
        } else {
            XB_SPIN(xb_ld(&bar[XB_XGEN(b.x)]) == gen, bar);
            __builtin_amdgcn_fence(__ATOMIC_ACQUIRE, "agent");
            asm volatile("s_waitcnt vmcnt(0)" ::: "memory");
        }
    }
    __syncthreads();
}

struct Frame {
    LAS unsigned char* lds;
    unsigned* ctl;
    int tid, lane, wave, vcu, G, gw, NGW;
    const float *x, *g_mix, *w_in, *conv_qk, *b_if, *g_mnorm, *w_attn_out, *w_mlstm_out, *w_mix_out, *g_ffn, *w_router, *b_router, *w_gate_up, *b_gate_up, *w_down, *b_down, *g_final;
    const int* positions;
    float* out;
    bf16 *WinT, *WamT, *WoT, *WguT, *WdnT, *XN, *PROJ, *OG, *AM, *MERGED, *XS, *ACT, *YBUF;
    float *GATES, *ROPE, *LSE, *HT, *H, *QC, *KC, *ROW_W, *TOK_W;
    int *TOK_E, *TOK_SLOT, *ROW_TOK;
};

__constant__ double ROPE_REV[16] = {
    1.59154943091895346e-01, 7.00865215877985032e-02, 3.08637634047012298e-02, 1.35913706361939050e-02, 5.98518571271370540e-03, 2.63567589866741401e-03, 1.16066364124006098e-03, 5.11117504537543857e-04,
    2.25079079039276525e-04, 9.91173093690193548e-05, 4.36479527928028909e-05, 1.92211006849448627e-05, 8.46433080824140138e-06, 3.72740860191535193e-06, 1.64142626279503449e-06, 7.22829306883286479e-07};

template <int MAP>
__device__ __forceinline__ void transpose_item(const float* W, int Nsrc, bf16* WT, int ldk, int kofs, int nblk, LAS float* scr, int item, int lane) {
    const int kb = item / nblk, nb = item % nblk, k0 = 64 * kb, n0 = 32 * nb;
    const int np = n0 + (lane & 31);
    const int sc = (MAP == 1) ? win_logical_col(np) : (MAP == 2) ? wgu_logical_col(np) : np;
    float tv[32];
#pragma unroll
    for (int i = 0; i < 32; ++i) tv[i] = W[(size_t)(k0 + 2 * i + (lane >> 5)) * Nsrc + sc];
#pragma unroll
    for (int i = 0; i < 32; ++i) scr[(2 * i + (lane >> 5)) * 33 + (lane & 31)] = tv[i];
    asm volatile("s_waitcnt lgkmcnt(0)" ::: "memory");
    const int c = lane & 7;
#pragma unroll
    for (int j = 0; j < 4; ++j) { const int n = (lane >> 3) + 8 * j; const LAS float* s = scr + (8 * c) * 33 + n;
        u32x4 o; o.x = pk2(s[0 * 33], s[1 * 33]); o.y = pk2(s[2 * 33], s[3 * 33]); o.z = pk2(s[4 * 33], s[5 * 33]); o.w = pk2(s[6 * 33], s[7 * 33]);
        *(u32x4*)(WT + (size_t)(n0 + n) * ldk + kofs + k0 + 8 * c) = o; }
    asm volatile("s_waitcnt lgkmcnt(0)" ::: "memory");
}

template <int MAP>
__device__ __forceinline__ void transpose_item_fp8(const float* W, int Nsrc, unsigned char* WT, int ldk, int nblk, LAS float* scr, int item, int lane, float scale) {
    const int kb = item / nblk, nb = item % nblk, k0 = 64 * kb, n0 = 32 * nb;
    const int np = n0 + (lane & 31);
    const int sc = (MAP == 1) ? win_logical_col(np) : (MAP == 2) ? wgu_logical_col(np) : np;
    float tv[32];
#pragma unroll
    for (int i = 0; i < 32; ++i) tv[i] = W[(size_t)(k0 + 2 * i + (lane >> 5)) * Nsrc + sc];
#pragma unroll
    for (int i = 0; i < 32; ++i) scr[(2 * i + (lane >> 5)) * 33 + (lane & 31)] = tv[i] * scale;
    asm volatile("s_waitcnt lgkmcnt(0)" ::: "memory");
    const int n = lane >> 1, c = lane & 1;
#pragma unroll
    for (int q = 0; q < 2; ++q) { const LAS float* s = scr + (32 * c + 16 * q) * 33 + n;
        u32x4 o; o.x = pk4_fp8(s[0 * 33], s[1 * 33], s[2 * 33], s[3 * 33]); o.y = pk4_fp8(s[4 * 33], s[5 * 33], s[6 * 33], s[7 * 33]);
        o.z = pk4_fp8(s[8 * 33], s[9 * 33], s[10 * 33], s[11 * 33]); o.w = pk4_fp8(s[12 * 33], s[13 * 33], s[14 * 33], s[15 * 33]);
        *(u32x4*)(WT + (size_t)(n0 + n) * ldk + k0 + 32 * c + 16 * q) = o; }
    asm volatile("s_waitcnt lgkmcnt(0)" ::: "memory");
}

template <int MAP>
__device__ __forceinline__ void tr8_load(const float* W, int Nsrc, int nblk, int item, int lane, float (&tv)[32]) {
    const int kb = item / nblk, nb = item % nblk, k0 = 64 * kb, np = 32 * nb + (lane & 31);
    const int sc = (MAP == 1) ? win_logical_col(np) : (MAP == 2) ? wgu_logical_col(np) : np;
#pragma unroll
    for (int i = 0; i < 32; ++i) tv[i] = W[(size_t)(k0 + 2 * i + (lane >> 5)) * Nsrc + sc];
}
__device__ __forceinline__ void tr8_store(const float (&tv)[32], unsigned char* WT, int ldk, int nblk, LAS float* scr, int item, int lane, float scale) {
    const int kb = item / nblk, nb = item % nblk, k0 = 64 * kb, n0 = 32 * nb;
#pragma unroll
    for (int i = 0; i < 32; ++i) scr[(2 * i + (lane >> 5)) * 33 + (lane & 31)] = tv[i] * scale;
    asm volatile("s_waitcnt lgkmcnt(0)" ::: "memory");
    const int n = lane >> 1, c = lane & 1;
#pragma unroll
    for (int q = 0; q < 2; ++q) { const LAS float* s = scr + (32 * c + 16 * q) * 33 + n;
        u32x4 o; o.x = pk4_fp8(s[0 * 33], s[1 * 33], s[2 * 33], s[3 * 33]); o.y = pk4_fp8(s[4 * 33], s[5 * 33], s[6 * 33], s[7 * 33]);
        o.z = pk4_fp8(s[8 * 33], s[9 * 33], s[10 * 33], s[11 * 33]); o.w = pk4_fp8(s[12 * 33], s[13 * 33], s[14 * 33], s[15 * 33]);
        *(u32x4*)(WT + (size_t)(n0 + n) * ldk + k0 + 32 * c + 16 * q) = o; }
    asm volatile("s_waitcnt lgkmcnt(0)" ::: "memory");
}

__device__ __forceinline__ void p0_weights(Frame& F) {
    LAS float* scr = (LAS float*)(F.lds + F.wave * 16384);
    constexpr int I_IN = (D / 64) * (NP / 32), I_A = (512 / 64) * (D / 32), I_M = (D / 64) * (D / 32), I_O = I_M;
    constexpr int I_GU1 = (D / 64) * (2048 / 32), I_DN1 = (D / 64) * (D / 32);
    constexpr int NITEMS = I_IN + I_A + I_M + I_O + ((MOE_FP8 && STEAL) ? 0 : NE * I_GU1 + NE * I_DN1);
    for (int it = F.gw; it < NITEMS; it += F.NGW) {
        int r = it;
#if P1_FP8
        if (r < I_IN) { const int pn = (r % (NP / 32)) >> 3;
            if (pn < 18 || pn >= P1_HI) transpose_item_fp8<1>(F.w_in, DIN, (unsigned char*)F.WinT - (pn >= P1_HI ? (size_t)(P1_HI - 18) * 256 * D : (size_t)0), D, NP / 32, scr, r, F.lane, 32.0f);
            else transpose_item<1>(F.w_in, DIN, F.WinT, D, 0, NP / 32, scr, r, F.lane);
            continue; } r -= I_IN;
#else
        if (r < I_IN) { transpose_item<1>(F.w_in, DIN, F.WinT, D, 0, NP / 32, scr, r, F.lane); continue; } r -= I_IN;
#endif
#if MERGE_FP8
        if (r < I_A) { transpose_item_fp8<0>(F.w_attn_out, D, (unsigned char*)F.WamT, AMLD, D / 32, scr, r, F.lane, 32.0f); continue; } r -= I_A;
        if (r < I_M) { transpose_item_fp8<0>(F.w_mlstm_out, D, (unsigned char*)F.WamT + 512, AMLD, D / 32, scr, r, F.lane, 32.0f); continue; } r -= I_M;
        if (r < I_O) { transpose_item_fp8<0>(F.w_mix_out, D, (unsigned char*)F.WamT + 1536, AMLD, D / 32, scr, r, F.lane, 32.0f); continue; } r -= I_O;
#else
        if (r < I_A) { transpose_item<0>(F.w_attn_out, D, F.WamT, AMLD, 0, D / 32, scr, r, F.lane); continue; } r -= I_A;
        if (r < I_M) { transpose_item<0>(F.w_mlstm_out, D, F.WamT, AMLD, 512, D / 32, scr, r, F.lane); continue; } r -= I_M;
        if (r < I_O) { transpose_item<0>(F.w_mix_out, D, F.WamT, AMLD, 1536, D / 32, scr, r, F.lane); continue; } r -= I_O;
#endif
#if MOE_FP8 && STEAL
        (void)r;
#elif MOE_FP8
        if (r < NE * I_GU1) { const int e = r / I_GU1; transpose_item_fp8<2>(F.w_gate_up + (size_t)e * D * 2048, 2048, (unsigned char*)F.WguT + (size_t)e * 2048 * D, D, 2048 / 32, scr, r % I_GU1, F.lane, 32.0f); continue; } r -= NE * I_GU1;
        { const int e = r / I_DN1; transpose_item_fp8<0>(F.w_down + (size_t)e * D * D, D, (unsigned char*)F.WdnT + (size_t)e * D * D, D, D / 32, scr, r % I_DN1, F.lane, 32.0f); }
#else
        if (r < NE * I_GU1) { const int e = r / I_GU1; transpose_item<2>(F.w_gate_up + (size_t)e * D * 2048, 2048, F.WguT + (size_t)e * 2048 * D, D, 0, 2048 / 32, scr, r % I_GU1, F.lane); continue; } r -= NE * I_GU1;
        { const int e = r / I_DN1; transpose_item<0>(F.w_down + (size_t)e * D * D, D, F.WdnT + (size_t)e * D * D, D, 0, D / 32, scr, r % I_DN1, F.lane); }
#endif
    }
}

__device__ __forceinline__ void p0_rows(Frame& F) {
    LAS float* w8t = (LAS float*)(F.lds);
    __syncthreads();
    { float w8v[16];
#pragma unroll
      for (int j = 0; j < 16; ++j) { const int i = F.tid + j * NTHREADS; w8v[j] = F.w_in[(size_t)(i >> 3) * DIN + 8704 + (i & 7)]; }
#pragma unroll
      for (int j = 0; j < 16; ++j) { const int i = F.tid + j * NTHREADS; w8t[(i & 7) * 1024 + (i >> 3)] = w8v[j]; } }
    __syncthreads();
    f32x4 vnx[4];
    if (F.gw < T) { const f32x4* xr = (const f32x4*)(F.x + (size_t)F.gw * D) + F.lane;
#pragma unroll
        for (int j = 0; j < 4; ++j) vnx[j] = xr[64 * j]; }
    for (int row = F.gw; row < T; row += F.NGW) {
        f32x4 v[4]; float s = 0.f;
#pragma unroll
        for (int j = 0; j < 4; ++j) { v[j] = vnx[j]; s += (v[j].x * v[j].x + v[j].y * v[j].y) + (v[j].z * v[j].z + v[j].w * v[j].w); }
        if (row + F.NGW < T) { const f32x4* xr = (const f32x4*)(F.x + (size_t)(row + F.NGW) * D) + F.lane;
#pragma unroll
            for (int j = 0; j < 4; ++j) vnx[j] = xr[64 * j]; }
        const float rstd = 1.0f / sqrtf(wave_sum(s) * (1.0f / D) + RMS_EPS);
        float ga[8];
#pragma unroll
        for (int o = 0; o < 8; ++o) ga[o] = 0.f;
        unsigned long long* o8 = (unsigned long long*)(F.XN + (size_t)row * D) + F.lane;
#pragma unroll
        for (int j = 0; j < 4; ++j) {
            const f32x4 g = *((const f32x4*)F.g_mix + F.lane + 64 * j);
            v[j] = v[j] * rstd * g;
            o8[64 * j] = (unsigned long long)pk2(v[j].x, v[j].y) | ((unsigned long long)pk2(v[j].z, v[j].w) << 32);
#if P1_FP8
            ((unsigned*)((unsigned char*)F.ctl + WS_XN8 + (size_t)row * D))[F.lane + 64 * j] = pk4_fp8(v[j].x, v[j].y, v[j].z, v[j].w);
#endif
#pragma unroll
            for (int o = 0; o < 8; ++o) { const f32x4 w = *((const LAS f32x4*)(w8t + o * 1024) + F.lane + 64 * j); ga[o] += (v[j].x * w.x + v[j].y * w.y) + (v[j].z * w.z + v[j].w * w.w); }
        }
#pragma unroll
        for (int o = 0; o < 8; ++o) ga[o] = wave_sum(ga[o]);
        if (F.lane < 8) { float gv = ga[0];
#pragma unroll
            for (int o = 1; o < 8; ++o) gv = (F.lane == o) ? ga[o] : gv;
            F.GATES[(size_t)row * 8 + F.lane] = gv + F.b_if[F.lane]; }
        if (F.lane < 16) {
            const int pos = F.positions[row];
            double rev = (double)pos * ROPE_REV[F.lane]; rev -= floor(rev);
            const float fr = (float)rev;
            F.ROPE[(size_t)row * 32 + F.lane] = __builtin_amdgcn_cosf(fr);
            F.ROPE[(size_t)row * 32 + 16 + F.lane] = __builtin_amdgcn_sinf(fr);
        }
    }
}

template <int RT, class AF, class BF, class EP>
__device__ __forceinline__ void naive_gemm(Frame& F, int M, int N, int K, AF af, BF bf, EP ep) {
    const long gthreads = (long)F.G * NTHREADS, gtid = (long)blockIdx.x * NTHREADS + F.tid;
    for (long it = gtid; it < (long)(M / RT) * N; it += gthreads) {
        const int col = (int)(it % N), r0 = (int)(it / N) * RT;
        float acc[RT];
#pragma unroll
        for (int r = 0; r < RT; ++r) acc[r] = 0.f;
        for (int k = 0; k < K; ++k) { const float b = bf(k, col);
#pragma unroll
            for (int r = 0; r < RT; ++r) acc[r] += af(r0 + r, k) * b; }
#pragma unroll
        for (int r = 0; r < RT; ++r) ep(r0 + r, col, acc[r]);
    }
}

__device__ __forceinline__ void naive_p1(Frame& F) {
    const bf16* XN = F.XN; const float* W = F.w_in; bf16* P = F.PROJ;
    naive_gemm<8>(F, T, NP, D,
        [=](int r, int k) { return bf2f(XN[(size_t)r * D + k]); },
        [=](int k, int c) { return bf2f(f2bf(W[(size_t)k * DIN + win_logical_col(c)])); },
        [=](int r, int c, float a) { P[(size_t)r * NP + c] = (bf16)f2bf(a * (c < C_AK ? QSCALE : 1.0f)); });
}
__device__ __forceinline__ void naive_p1_rope(Frame& F) {
    const long gthreads = (long)F.G * NTHREADS, gtid = (long)blockIdx.x * NTHREADS + F.tid;
    for (long it = gtid; it < (long)T * 24 * 16; it += gthreads) {
        const int i = (int)(it & 15), hh = (int)((it >> 4) % 24), row = (int)(it / (24 * 16));
        const int a = i >> 2, j = i & 3; bf16* p = F.PROJ + (size_t)row * NP + hh * 128;
        const float x1 = bf2f(p[8 * a + j]), x2 = bf2f(p[8 * a + 4 + j]), cs = F.ROPE[(size_t)row * 32 + i], sn = F.ROPE[(size_t)row * 32 + 16 + i];
        p[8 * a + j] = (bf16)f2bf(x1 * cs - x2 * sn); p[8 * a + 4 + j] = (bf16)f2bf(x2 * cs + x1 * sn);
    }
}
__device__ __forceinline__ void naive_attn(Frame& F) {
    for (int it = F.gw; it < T * 12; it += F.NGW) {
        const int row = it / 12, gh = it % 12, g = gh >> 2, h = gh & 3, b = row / SEQ, t = row % SEQ, d = (g == 0) ? 1 : (g == 1) ? 4 : 16, i = t / d, r = t % d;
        const int hc = g * 512 + h * 128 + 2 * F.lane;
        const unsigned qw = *(const unsigned*)(F.PROJ + (size_t)row * NP + C_AQ + hc); const float q0 = bflo(qw), q1 = bfhi(qw);
        float m = -INFINITY, l = 0.f, o0 = 0.f, o1 = 0.f;
        for (int ii = (i > 128 ? i - 128 : 0); ii <= i; ++ii) {
            const size_t kr = (size_t)(b * SEQ + r + d * ii) * NP;
            const unsigned kw = *(const unsigned*)(F.PROJ + kr + C_AK + hc), vw = *(const unsigned*)(F.PROJ + kr + C_AV + hc);
            const float s = wave_sum(q0 * bflo(kw) + q1 * bfhi(kw));
            const float mn = fmaxf(m, s), al = exp2f(m - mn), p = exp2f(s - mn);
            l = l * al + p; o0 = o0 * al + p * bflo(vw); o1 = o1 * al + p * bfhi(vw); m = mn;
        }
        const float il = 1.0f / l;
        *(unsigned*)(F.OG + ((size_t)g * T + row) * 512 + h * 128 + 2 * F.lane) = pk2(o0 * il, o1 * il);
        if (F.lane == 0) F.LSE[((size_t)g * T + row) * 4 + h] = m + log2f(l);
    }
}
__device__ __forceinline__ void naive_conv(Frame& F) {
    const long gthreads = (long)F.G * NTHREADS, gtid = (long)blockIdx.x * NTHREADS + F.tid;
    for (long it = gtid; it < (long)T * 2048; it += gthreads) {
        const int c = (int)(it & 2047), row = (int)(it >> 11), t = row % SEQ;
        float a = 0.f;
#pragma unroll
        for (int j = 0; j < 4; ++j) if (t - 3 + j >= 0) a += F.conv_qk[j * 2048 + c] * bf2f(F.PROJ[(size_t)(row - 3 + j) * NP + C_MQ + c]);
        const float y = a / (1.0f + __expf(-a));
        if (c < 1024) F.QC[(size_t)row * 1024 + c] = y; else F.KC[(size_t)row * 1024 + c - 1024] = y * 0.0625f;
    }
}
__device__ __forceinline__ void naive_mlstm(Frame& F) {
    LAS float* sq = (LAS float*)F.lds; LAS float* sk = sq + 256; LAS float* red = sk + 256; LAS float* redn = red + 512;
    for (int item = blockIdx.x; item < NB * 4 * 8; item += F.G) {
        const int sl = item & 7, h = (item >> 3) & 3, b = item >> 5, dvl = F.tid & 31, dkp = F.tid >> 5;
        float c[16], n[16];
#pragma unroll
        for (int j = 0; j < 16; ++j) { c[j] = 0.f; n[j] = 0.f; }
        float m = 0.f;
        for (int t = 0; t < SEQ; ++t) {
            const size_t row = (size_t)b * SEQ + t;
            __syncthreads();
            if (F.tid < 256) sq[F.tid] = F.QC[row * 1024 + h * 256 + F.tid]; else sk[F.tid - 256] = F.KC[row * 1024 + h * 256 + F.tid - 256];
            const float v = bf2f(F.PROJ[row * NP + C_MV + h * 256 + sl * 32 + dvl]);
            const float ir = F.GATES[row * 8 + h], fr = F.GATES[row * 8 + 4 + h];
            const float logf = fminf(fr, 0.f) - log1pf(__expf(-fabsf(fr)));
            const float mn = fmaxf(logf + m, ir), fa = __expf(logf + m - mn), ia = __expf(ir - mn);
            m = mn;
            __syncthreads();
            float pn = 0.f, pd = 0.f;
#pragma unroll
            for (int j = 0; j < 16; ++j) { const float kk = sk[dkp * 16 + j], qq = sq[dkp * 16 + j]; c[j] = fa * c[j] + ia * kk * v; n[j] = fa * n[j] + ia * kk; pn += qq * c[j]; pd += qq * n[j]; }
            red[dkp * 32 + dvl] = pn; redn[dkp * 32 + dvl] = pd;
            __syncthreads();
            if (F.tid < 32) { float num = 0.f, den = 0.f;
#pragma unroll
                for (int p = 0; p < 16; ++p) { num += red[p * 32 + F.tid]; den += redn[p * 32 + F.tid]; }
                F.HT[row * 1024 + h * 256 + sl * 32 + F.tid] = num / fmaxf(fabsf(den), __expf(-mn)); }
        }
    }
}
__device__ __forceinline__ void naive_p4(Frame& F) {
    const bf16 *AM = F.AM, *PJ = F.PROJ; const float *WA = F.w_attn_out, *WM = F.w_mlstm_out; bf16* O = F.AM + 1536;
    float* tmp = F.QC;
    naive_gemm<8>(F, T, D, 512, [=](int r, int k) { return bf2f(AM[(size_t)r * AMLD + k]); }, [=](int k, int c) { return bf2f(f2bf(WA[(size_t)k * D + c])); },
        [=](int r, int c, float a) { tmp[(size_t)r * D + c] = a * sigmoidf_(bf2f(PJ[(size_t)r * NP + C_GA + c])); });
    __threadfence();
    naive_gemm<8>(F, T, D, D, [=](int r, int k) { return bf2f(AM[(size_t)r * AMLD + 512 + k]); }, [=](int k, int c) { return bf2f(f2bf(WM[(size_t)k * D + c])); },
        [=](int r, int c, float a) { O[(size_t)r * AMLD + c] = (bf16)f2bf(tmp[(size_t)r * D + c] + a * sigmoidf_(bf2f(PJ[(size_t)r * NP + C_GM + c]))); });
}
__device__ __forceinline__ void naive_p5(Frame& F) {
    const bf16* MG = F.AM + 1536; const float *WO = F.w_mix_out, *X = F.x; float* H = F.H;
    naive_gemm<8>(F, T, D, D, [=](int r, int k) { return bf2f(MG[(size_t)r * AMLD + k]); }, [=](int k, int c) { return bf2f(f2bf(WO[(size_t)k * D + c])); },
        [=](int r, int c, float a) { H[(size_t)r * D + c] = X[(size_t)r * D + c] + a; });
}
__device__ __forceinline__ void naive_p8(Frame& F, int ntiles) {
    const long gthreads = (long)F.G * NTHREADS, gtid = (long)blockIdx.x * NTHREADS + F.tid;
    const unsigned* tile_e = F.ctl + CW_TILEE;
    for (long it = gtid; it < (long)ntiles * 256 * D; it += gthreads) {
        const int j = (int)(it & 1023), row = (int)(it >> 10), e = (int)tile_e[row >> 8];
        if (F.ROW_TOK[row] < 0) { F.ACT[(size_t)row * D + j] = 0; continue; }
        const float* W = F.w_gate_up + (size_t)e * D * 2048; float g = 0.f, u = 0.f;
        for (int k = 0; k < D; ++k) { const float a = bf2f(F.XS[(size_t)row * D + k]); g += a * bf2f(f2bf(W[(size_t)k * 2048 + 2 * j])); u += a * bf2f(f2bf(W[(size_t)k * 2048 + 2 * j + 1])); }
        g += F.b_gate_up[e * 2048 + 2 * j]; u += F.b_gate_up[e * 2048 + 2 * j + 1];
        const float gg = fminf(g, 7.0f), uu = fminf(fmaxf(u, -7.0f), 7.0f);
        F.ACT[(size_t)row * D + j] = (bf16)f2bf((uu + 1.0f) * gg / (1.0f + __expf(-1.702f * gg)));
    }
}
__device__ __forceinline__ void naive_p9(Frame& F, int ntiles) {
    const long gthreads = (long)F.G * NTHREADS, gtid = (long)blockIdx.x * NTHREADS + F.tid;
    const unsigned* tile_e = F.ctl + CW_TILEE;
    for (long it = gtid; it < (long)ntiles * 256 * D; it += gthreads) {
        const int c = (int)(it & 1023), row = (int)(it >> 10), e = (int)tile_e[row >> 8], tk = F.ROW_TOK[row];
        if (tk < 0) continue;
        const float* W = F.w_down + (size_t)e * D * D; float y = 0.f;
        for (int k = 0; k < D; ++k) y += bf2f(F.ACT[(size_t)row * D + k]) * bf2f(f2bf(W[(size_t)k * D + c]));
        F.YBUF[(size_t)tk * D + c] = (bf16)f2bf((y + F.b_down[e * D + c]) * F.ROW_W[row]);
    }
}

__device__ __forceinline__ void p3_post_mixer(Frame& F) {
    for (int row = F.gw; row < T; row += F.NGW) {
        { const int h = F.lane >> 4; float l0 = F.LSE[((size_t)0 * T + row) * 4 + h], l1 = F.LSE[((size_t)1 * T + row) * 4 + h], l2 = F.LSE[((size_t)2 * T + row) * 4 + h];
          const float mx = fmaxf(l0, fmaxf(l1, l2)); float w0 = exp2f(l0 - mx), w1 = exp2f(l1 - mx), w2 = exp2f(l2 - mx); const float inv = 1.0f / (w0 + w1 + w2); w0 *= inv; w1 *= inv; w2 *= inv;
          const u32x4 a = *(const u32x4*)(F.OG + ((size_t)0 * T + row) * 512 + 8 * F.lane), b = *(const u32x4*)(F.OG + ((size_t)1 * T + row) * 512 + 8 * F.lane), c = *(const u32x4*)(F.OG + ((size_t)2 * T + row) * 512 + 8 * F.lane);
          f32x4 a0, a1, b0, b1, c0, c1; pg8::unpack8(a, a0, a1); pg8::unpack8(b, b0, b1); pg8::unpack8(c, c0, c1);
          const f32x4 o0 = a0 * w0 + b0 * w1 + c0 * w2, o1 = a1 * w0 + b1 * w1 + c1 * w2;
#if MERGE_FP8
          u32x2 w; w.x = pk4_fp8(o0[0] * 8.f, o0[1] * 8.f, o0[2] * 8.f, o0[3] * 8.f); w.y = pk4_fp8(o1[0] * 8.f, o1[1] * 8.f, o1[2] * 8.f, o1[3] * 8.f);
          *(u32x2*)((unsigned char*)F.AM + (size_t)row * AMLD + 8 * F.lane) = w; }
#else
          u32x4 w; w.x = pk2(o0[0], o0[1]); w.y = pk2(o0[2], o0[3]); w.z = pk2(o1[0], o1[1]); w.w = pk2(o1[2], o1[3]);
          *(u32x4*)(F.AM + (size_t)row * AMLD + 8 * F.lane) = w; }
#endif
        { f32x4 v[4]; float s = 0.f;
#if FAST_MLSTM
          { const bf16* hp = (const bf16*)F.HT + (size_t)row * D + 16 * F.lane; const u32x4 w0 = *(const u32x4*)hp, w1 = *(const u32x4*)(hp + 8); pg8::unpack8(w0, v[0], v[1]); pg8::unpack8(w1, v[2], v[3]); }
#else
          { const float* hp = F.HT + (size_t)row * D + 16 * F.lane;
#pragma unroll
            for (int j = 0; j < 4; ++j) v[j] = *(const f32x4*)(hp + 4 * j); }
#endif
#pragma unroll
          for (int j = 0; j < 4; ++j) s += (v[j].x + v[j].y) + (v[j].z + v[j].w);
          s += __shfl_xor(s, 1); s += __shfl_xor(s, 2); s += __shfl_xor(s, 4); s += __shfl_xor(s, 8);
          const float mu = s * (1.0f / 256.0f); float q = 0.f;
#pragma unroll
          for (int j = 0; j < 4; ++j) { v[j] = v[j] - mu; q += (v[j].x * v[j].x + v[j].y * v[j].y) + (v[j].z * v[j].z + v[j].w * v[j].w); }
          q += __shfl_xor(q, 1); q += __shfl_xor(q, 2); q += __shfl_xor(q, 4); q += __shfl_xor(q, 8);
          const float rstd = 1.0f / sqrtf(q * (1.0f / 256.0f) + LN_EPS);
          const bf16* mo = F.PROJ + (size_t)row * NP + C_MO + 16 * F.lane; bf16* op = F.AM + (size_t)row * AMLD + 512 + 16 * F.lane;
#if MERGE_FP8
          u32x4 w8; const float rs8 = rstd * 8.f;
#endif
#pragma unroll
          for (int jj = 0; jj < 2; ++jj) { const u32x4 mw = *(const u32x4*)(mo + 8 * jj); f32x4 m0, m1; pg8::unpack8(mw, m0, m1);
              const f32x4 g0 = *(const f32x4*)(F.g_mnorm + 16 * F.lane + 8 * jj), g1 = *(const f32x4*)(F.g_mnorm + 16 * F.lane + 8 * jj + 4);
#if MERGE_FP8
              const f32x4 o0 = v[2 * jj] * rs8 * g0 * pg8::sig4(m0), o1 = v[2 * jj + 1] * rs8 * g1 * pg8::sig4(m1);
              w8[2 * jj] = pk4_fp8(o0[0], o0[1], o0[2], o0[3]); w8[2 * jj + 1] = pk4_fp8(o1[0], o1[1], o1[2], o1[3]); }
          (void)op; *(u32x4*)((unsigned char*)F.AM + (size_t)row * AMLD + 512 + 16 * F.lane) = w8; }
#else
              const f32x4 o0 = v[2 * jj] * rstd * g0 * pg8::sig4(m0), o1 = v[2 * jj + 1] * rstd * g1 * pg8::sig4(m1);
              u32x4 w; w.x = pk2(o0[0], o0[1]); w.y = pk2(o0[2], o0[3]); w.z = pk2(o1[0], o1[1]); w.w = pk2(o1[2], o1[3]);
              *(u32x4*)(op + 8 * jj) = w; } }
#endif
    }
}

constexpr int RT_WS = 1028;
constexpr int RT_TAB = NE * RT_WS * 4, RT_CNT = RT_TAB + 64 * 4 * 12;
static_assert(RT_CNT + 256 <= LDSCTL_OFF, "router LDS map");
__device__ __forceinline__ void p6_router(Frame& F) {
    LAS float* wt = (LAS float*)F.lds;
    LAS int* tab = (LAS int*)(F.lds + RT_TAB); LAS int* cntl = (LAS int*)(F.lds + RT_CNT); LAS int* basel = cntl + 32;
    const int lane = F.lane;
    for (int r0 = 0; r0 < T; r0 += F.NGW * 8) {
        __syncthreads();
        if (r0 == 0) for (int i = F.tid; i < D * NE; i += NTHREADS) wt[(i & 31) * RT_WS + (i >> 5)] = F.w_router[i];
        if (F.tid < 32) cntl[F.tid] = 0;
        __syncthreads();
        f32x4 vn[4];
        { const int row = r0 + F.gw; if (row < T) { const f32x4* hr = (const f32x4*)(F.H + (size_t)row * D) + lane;
#pragma unroll
            for (int j = 0; j < 4; ++j) vn[j] = hr[64 * j]; } }
        for (int ri = 0; ri < 8; ++ri) {
            const int row = r0 + ri * F.NGW + F.gw; if (row >= T) break;
            f32x4 v[4]; float s = 0.f;
#pragma unroll
            for (int j = 0; j < 4; ++j) { v[j] = vn[j]; s += (v[j].x * v[j].x + v[j].y * v[j].y) + (v[j].z * v[j].z + v[j].w * v[j].w); }
            { const int rown = row + F.NGW; if (ri + 1 < 8 && rown < T) { const f32x4* hr = (const f32x4*)(F.H + (size_t)rown * D) + lane;
#pragma unroll
                for (int j = 0; j < 4; ++j) vn[j] = hr[64 * j]; } }
            const float rstd = 1.0f / sqrtf(wave_sum(s) * (1.0f / D) + RMS_EPS);
            unsigned long long* o8 = (unsigned long long*)(F.XN + (size_t)row * D) + lane;
#pragma unroll
            for (int j = 0; j < 4; ++j) { const f32x4 g = *((const f32x4*)F.g_ffn + lane + 64 * j); v[j] = v[j] * rstd * g;
#if MOE_FP8
                ((unsigned*)((unsigned char*)F.XN + (size_t)row * D))[lane + 64 * j] = pk4_fp8(v[j].x, v[j].y, v[j].z, v[j].w); }
#else
                o8[64 * j] = (unsigned long long)pk2(v[j].x, v[j].y) | ((unsigned long long)pk2(v[j].z, v[j].w) << 32); }
#endif
            float lg[32];
#pragma unroll
            for (int e = 0; e < 32; ++e) { float a = 0.f;
#pragma unroll
                for (int j = 0; j < 4; ++j) { const f32x4 w = *((const LAS f32x4*)(wt + e * RT_WS) + lane + 64 * j); a += (v[j].x * w.x + v[j].y * w.y) + (v[j].z * w.z + v[j].w * w.w); }
                lg[e] = a; if ((e & 3) == 3) asm volatile("" ::: "memory"); }
#define RT_BF(N_, O_) do { const bool up = (lane & (O_)) != 0; _Pragma("unroll") for (int i = 0; i < (N_); ++i) { const float send = up ? lg[i] : lg[i + (N_)]; const float keep = up ? lg[i + (N_)] : lg[i]; lg[i] = keep + __shfl_xor(send, (O_)); } } while (0)
            RT_BF(16, 32); RT_BF(8, 16); RT_BF(4, 8); RT_BF(2, 4); RT_BF(1, 2);
#undef RT_BF
            float lgt = lg[0] + __shfl_xor(lg[0], 1);
            const int e = (lane >> 1) & 31;
            lgt += F.b_router[e];
            float tv[4]; int ti[4]; float cur = lgt;
#pragma unroll
            for (int r = 0; r < 4; ++r) { float bv = cur; int bi = e;
#pragma unroll
                for (int o = 2; o < 64; o <<= 1) { const float ov = __shfl_xor(bv, o); const int oi = __shfl_xor(bi, o); if (ov > bv || (ov == bv && oi < bi)) { bv = ov; bi = oi; } }
                tv[r] = bv; ti[r] = bi; if (e == bi) cur = -INFINITY; }
            const float e1 = __expf(tv[1] - tv[0]), e2 = __expf(tv[2] - tv[0]), e3 = __expf(tv[3] - tv[0]), inv = 1.0f / (1.0f + e1 + e2 + e3);
            if (lane < 4) {
                const int ee = (lane == 0) ? ti[0] : (lane == 1) ? ti[1] : (lane == 2) ? ti[2] : ti[3];
                const float ww = ((lane == 0) ? 1.0f : (lane == 1) ? e1 : (lane == 2) ? e2 : e3) * inv;
                const int loc = __hip_atomic_fetch_add(cntl + ee, 1, __ATOMIC_RELAXED, __HIP_MEMORY_SCOPE_WORKGROUP);
                LAS int* tp = tab + ((ri * 8 + F.wave) * 4 + lane) * 3; tp[0] = ee; tp[1] = loc; tp[2] = __float_as_int(ww);
            }
        }
        __syncthreads();
        if (F.tid < 32) basel[F.tid] = (int)atomicAdd(F.ctl + CW_CNT + 64 * F.tid, (unsigned)cntl[F.tid]);
        __syncthreads();
        if (lane < 4) for (int ri = 0; ri < 8; ++ri) {
            const int row = r0 + ri * F.NGW + F.gw; if (row >= T) break;
            const LAS int* tp = tab + ((ri * 8 + F.wave) * 4 + lane) * 3; const int ee = tp[0];
            F.TOK_E[row * 4 + lane] = ee; F.TOK_SLOT[row * 4 + lane] = basel[ee] + tp[1]; F.TOK_W[row * 4 + lane] = __int_as_float(tp[2]);
        }
    }
}

constexpr int RM_WS = 2064;
constexpr int RM_HI = 0, RM_LO = NE * RM_WS, RM_RSTD = 2 * NE * RM_WS, RM_TAB = RM_RSTD + 256, RM_CNT = RM_TAB + 64 * 4 * 12;
static_assert(RM_CNT + 256 <= LDSCTL_OFF, "router LDS map");
__device__ __forceinline__ void p6_router_mfma(Frame& F) {
    LAS unsigned char* L = F.lds;
    LAS float* rstdl = (LAS float*)(L + RM_RSTD); LAS int* tab = (LAS int*)(L + RM_TAB); LAS int* cntl = (LAS int*)(L + RM_CNT); LAS int* basel = cntl + 32;
    const int lane = F.lane, fr = lane & 15, fq = lane >> 4, w = F.wave;
    __syncthreads();
    for (int i0 = F.tid; i0 < D * NE; i0 += 16 * NTHREADS) {
        float wv[16], gv[16];
#pragma unroll
        for (int j = 0; j < 16; ++j) { const int i = i0 + j * NTHREADS; wv[j] = F.w_router[i]; gv[j] = F.g_ffn[i >> 5]; }
#pragma unroll
        for (int j = 0; j < 16; ++j) { const int i = i0 + j * NTHREADS, k = i >> 5, e = i & 31; const float w = wv[j] * gv[j];
            const unsigned hi = f2bf(w), lo = f2bf(w - bf2f(hi));
            *(LAS bf16*)(L + RM_HI + e * RM_WS + 2 * k) = (bf16)hi; *(LAS bf16*)(L + RM_LO + e * RM_WS + 2 * k) = (bf16)lo; } }
    const float br0 = F.b_router[fr], br1 = F.b_router[16 + fr];
    for (int rg = F.vcu; rg < T / 64; rg += F.G) {
        __syncthreads();
        if (F.tid < 32) cntl[F.tid] = 0;
        __syncthreads();
        if (w < 4) {
            const int row0 = rg * 64 + 16 * w;
#if H_BF16
            const bf16* hp = (const bf16*)F.H + (size_t)(row0 + fr) * D + 8 * fq;
#else
            const float* hp = F.H + (size_t)(row0 + fr) * D + 8 * fq;
#endif
            const LAS unsigned char* bh = L + RM_HI + fr * RM_WS + 16 * fq; const LAS unsigned char* bl = L + RM_LO + fr * RM_WS + 16 * fq;
            f32x4 acc[2] = {(f32x4){0.f, 0.f, 0.f, 0.f}, (f32x4){0.f, 0.f, 0.f, 0.f}}; float ss = 0.f;
#pragma unroll 4
            for (int ks = 0; ks < 32; ++ks) {
#if H_BF16
                const u32x4 hw = *(const u32x4*)(hp + 32 * ks);
                { const float q0 = bflo(hw.x), q1 = bfhi(hw.x), q2 = bflo(hw.y), q3 = bfhi(hw.y), q4 = bflo(hw.z), q5 = bfhi(hw.z), q6 = bflo(hw.w), q7 = bfhi(hw.w);
                  ss += (q0 * q0 + q1 * q1) + (q2 * q2 + q3 * q3) + (q4 * q4 + q5 * q5) + (q6 * q6 + q7 * q7); }
                const bf16x8 ahi = __builtin_bit_cast(bf16x8, hw);
#pragma unroll
                for (int nt = 0; nt < 2; ++nt) { const bf16x8 bhi = *(const LAS bf16x8*)(bh + 16 * nt * RM_WS + 64 * ks), blo = *(const LAS bf16x8*)(bl + 16 * nt * RM_WS + 64 * ks);
                    acc[nt] = __builtin_amdgcn_mfma_f32_16x16x32_bf16(ahi, bhi, acc[nt], 0, 0, 0);
                    acc[nt] = __builtin_amdgcn_mfma_f32_16x16x32_bf16(ahi, blo, acc[nt], 0, 0, 0); }
                continue;
#else
                const f32x4 a0 = *(const f32x4*)(hp + 32 * ks), a1 = *(const f32x4*)(hp + 32 * ks + 4);
                ss += (a0.x * a0.x + a0.y * a0.y) + (a0.z * a0.z + a0.w * a0.w) + (a1.x * a1.x + a1.y * a1.y) + (a1.z * a1.z + a1.w * a1.w);
                u32x4 hw; hw.x = pk2(a0.x, a0.y); hw.y = pk2(a0.z, a0.w); hw.z = pk2(a1.x, a1.y); hw.w = pk2(a1.z, a1.w);
                u32x4 lw; lw.x = pk2(a0.x - bflo(hw.x), a0.y - bfhi(hw.x)); lw.y = pk2(a0.z - bflo(hw.y), a0.w - bfhi(hw.y));
                lw.z = pk2(a1.x - bflo(hw.z), a1.y - bfhi(hw.z)); lw.w = pk2(a1.z - bflo(hw.w), a1.w - bfhi(hw.w));
                const bf16x8 ahi = __builtin_bit_cast(bf16x8, hw), alo = __builtin_bit_cast(bf16x8, lw);
#pragma unroll
                for (int nt = 0; nt < 2; ++nt) { const bf16x8 bhi = *(const LAS bf16x8*)(bh + 16 * nt * RM_WS + 64 * ks), blo = *(const LAS bf16x8*)(bl + 16 * nt * RM_WS + 64 * ks);
                    acc[nt] = __builtin_amdgcn_mfma_f32_16x16x32_bf16(ahi, bhi, acc[nt], 0, 0, 0);
                    acc[nt] = __builtin_amdgcn_mfma_f32_16x16x32_bf16(ahi, blo, acc[nt], 0, 0, 0);
                    acc[nt] = __builtin_amdgcn_mfma_f32_16x16x32_bf16(alo, bhi, acc[nt], 0, 0, 0); }
#endif
            }
            ss += __shfl_xor(ss, 16); ss += __shfl_xor(ss, 32);
            const float rstd = 1.0f / sqrtf(ss * (1.0f / D) + RMS_EPS);
            if (fq == 0) rstdl[16 * w + fr] = rstd;
#pragma unroll
            for (int reg = 0; reg < 4; ++reg) {
                const float rs = __shfl(rstd, 4 * fq + reg);
                float c0 = acc[0][reg] * rs + br0, c1 = acc[1][reg] * rs + br1;
                float tv[4]; int ti[4];
#pragma unroll
                for (int r = 0; r < 4; ++r) { float bv = (c0 >= c1) ? c0 : c1; int bi = (c0 >= c1) ? fr : 16 + fr;
#pragma unroll
                    for (int o = 1; o < 16; o <<= 1) { const float ov = __shfl_xor(bv, o); const int oi = __shfl_xor(bi, o); if (ov > bv || (ov == bv && oi < bi)) { bv = ov; bi = oi; } }
                    tv[r] = bv; ti[r] = bi; if (bi == fr) c0 = -INFINITY; if (bi == 16 + fr) c1 = -INFINITY; }
                const float e1 = __expf(tv[1] - tv[0]), e2 = __expf(tv[2] - tv[0]), e3 = __expf(tv[3] - tv[0]), inv = 1.0f / (1.0f + e1 + e2 + e3);
                if (fr < 4) {
                    const int ee = (fr == 0) ? ti[0] : (fr == 1) ? ti[1] : (fr == 2) ? ti[2] : ti[3];
                    const float ww = ((fr == 0) ? 1.0f : (fr == 1) ? e1 : (fr == 2) ? e2 : e3) * inv;
                    const int loc = __hip_atomic_fetch_add(cntl + ee, 1, __ATOMIC_RELAXED, __HIP_MEMORY_SCOPE_WORKGROUP);
                    LAS int* tp = tab + ((16 * w + 4 * fq + reg) * 4 + fr) * 3; tp[0] = ee; tp[1] = loc; tp[2] = __float_as_int(ww);
                }
            }
        }
        __syncthreads();
        if (F.tid < 32) basel[F.tid] = (int)atomicAdd(F.ctl + CW_CNT + 64 * F.tid, (unsigned)cntl[F.tid]);
#pragma unroll 2
        for (int i = 0; i < 8; ++i) { const int rl = 8 * w + i, row = rg * 64 + rl; const float rs = rstdl[rl];
#if H_BF16
            const u32x4* hr = (const u32x4*)((const bf16*)F.H + (size_t)row * D) + lane;
#pragma unroll
            for (int j = 0; j < 2; ++j) { const f32x4 g0 = *((const f32x4*)F.g_ffn + 2 * (lane + 64 * j)), g1 = *((const f32x4*)F.g_ffn + 2 * (lane + 64 * j) + 1); const u32x4 hw = hr[64 * j];
                u32x2 o; o.x = pk4_fp8(bflo(hw.x) * rs * g0.x, bfhi(hw.x) * rs * g0.y, bflo(hw.y) * rs * g0.z, bfhi(hw.y) * rs * g0.w);
                o.y = pk4_fp8(bflo(hw.z) * rs * g1.x, bfhi(hw.z) * rs * g1.y, bflo(hw.w) * rs * g1.z, bfhi(hw.w) * rs * g1.w);
                ((u32x2*)((unsigned char*)F.XN + (size_t)row * D))[lane + 64 * j] = o; } }
#else
            const f32x4* hr = (const f32x4*)(F.H + (size_t)row * D) + lane;
#pragma unroll
            for (int j = 0; j < 4; ++j) { const f32x4 g = *((const f32x4*)F.g_ffn + lane + 64 * j); const f32x4 v = hr[64 * j] * rs * g;
                ((unsigned*)((unsigned char*)F.XN + (size_t)row * D))[lane + 64 * j] = pk4_fp8(v.x, v.y, v.z, v.w); } }
#endif
        __syncthreads();
        if (F.tid < 256) { const int rl = F.tid >> 2, k = F.tid & 3, row = rg * 64 + rl; const LAS int* tp = tab + (rl * 4 + k) * 3; const int ee = tp[0];
#if RM_FUSED
            const int dst = ee * ECAP + basel[ee] + tp[1]; F.ROW_TOK[dst] = row * 4 + k; F.ROW_W[dst] = __int_as_float(tp[2]); }
#else
            F.TOK_E[row * 4 + k] = ee; F.TOK_SLOT[row * 4 + k] = basel[ee] + tp[1]; F.TOK_W[row * 4 + k] = __int_as_float(tp[2]); }
#endif
    }
}

__device__ __forceinline__ void p7_gather(Frame& F) {
    LAS int* pst = (LAS int*)F.lds;
    LAS int* cntl = pst + 64;
    int tid = (int)threadIdx.x; asm volatile("" : "+v"(tid));
    __syncthreads();
    if (tid < NE) cntl[tid] = (int)F.ctl[CW_CNT + 64 * tid];
    __syncthreads();
    if (tid == 0) { int acc = 0; for (int e = 0; e < NE; ++e) { pst[e] = acc; acc += (cntl[e] + 255) & ~255; } pst[NE] = acc; }
    __syncthreads();
    if (blockIdx.x == 0) {
        if (tid == 0) F.ctl[CW_NTILES] = (unsigned)(pst[NE] >> 8);
        if (tid < NE) { const int t0 = pst[tid] >> 8, t1 = pst[tid + 1] >> 8; for (int k = t0; k < t1; ++k) F.ctl[CW_TILEE + k] = (unsigned)tid; }
    }
#if MOE_FP8
    { const int gthreads = F.G * NTHREADS, gtid = F.vcu * NTHREADS + F.tid;
      for (int a = gtid; a < NA; a += gthreads) { const int e = F.TOK_E[a], dest = pst[e] + F.TOK_SLOT[a]; F.ROW_TOK[dest] = a; F.ROW_W[dest] = F.TOK_W[a]; }
      for (int e = 0; e < NE; ++e) { const int c = cntl[e], pe = (c + 255) & ~255;
          for (int r = c + gtid; r < pe; r += gthreads) { F.ROW_TOK[pst[e] + r] = -1; F.ROW_W[pst[e] + r] = 0.f; } } }
#else
    for (int a = F.gw; a < NA; a += F.NGW) {
        const int e = F.TOK_E[a], dest = pst[e] + F.TOK_SLOT[a];
        { const u32x4* src = (const u32x4*)(F.XN + (size_t)(a >> 2) * D) + F.lane; u32x4* dst = (u32x4*)(F.XS + (size_t)dest * D) + F.lane;
        const u32x4 v0 = src[0], v1 = src[64]; dst[0] = v0; dst[64] = v1; }
        if (F.lane == 0) { F.ROW_TOK[dest] = a; F.ROW_W[dest] = F.TOK_W[a]; }
    }
    for (int e = 0; e < NE; ++e) { const int c = cntl[e], pe = (c + 255) & ~255;
        for (int r = c + F.gw; r < pe; r += F.NGW) { const int dest = pst[e] + r; const u32x4 z = (u32x4){0u, 0u, 0u, 0u};
            { u32x4* dst = (u32x4*)(F.XS + (size_t)dest * D) + F.lane; dst[0] = z; dst[64] = z; }
            if (F.lane == 0) { F.ROW_TOK[dest] = -1; F.ROW_W[dest] = 0.f; } } }
#endif
}

__device__ __forceinline__ void p10_final(Frame& F) {
#if H_BF16
    u32x2 hn[4]; u32x2 yn[4][4];
#define P10_LOAD(r_) do { const u32x2* hr_ = (const u32x2*)((const bf16*)F.H + (size_t)(r_) * D) + F.lane; \
        _Pragma("unroll") for (int j = 0; j < 4; ++j) { hn[j] = hr_[64 * j]; _Pragma("unroll") for (int k = 0; k < 4; ++k) yn[j][k] = *((const u32x2*)(F.YBUF + ((size_t)(r_) * 4 + k) * D) + F.lane + 64 * j); } } while (0)
#define P10_H(j_) ((f32x4){bflo(hn[j_].x), bfhi(hn[j_].x), bflo(hn[j_].y), bfhi(hn[j_].y)})
#else
#define P10_H(j_) hn[j_]
    f32x4 hn[4]; u32x2 yn[4][4];
#define P10_LOAD(r_) do { const f32x4* hr_ = (const f32x4*)(F.H + (size_t)(r_) * D) + F.lane; \
        _Pragma("unroll") for (int j = 0; j < 4; ++j) { hn[j] = hr_[64 * j]; _Pragma("unroll") for (int k = 0; k < 4; ++k) yn[j][k] = *((const u32x2*)(F.YBUF + ((size_t)(r_) * 4 + k) * D) + F.lane + 64 * j); } } while (0)
#endif
    if (F.gw < T) P10_LOAD(F.gw);
    for (int row = F.gw; row < T; row += F.NGW) {
        f32x4 v[4]; float s = 0.f;
#pragma unroll
        for (int j = 0; j < 4; ++j) { v[j] = P10_H(j);
#pragma unroll
            for (int k = 0; k < 4; ++k) { const u32x2 w = yn[j][k]; v[j].x += bflo(w.x); v[j].y += bfhi(w.x); v[j].z += bflo(w.y); v[j].w += bfhi(w.y); }
            s += (v[j].x * v[j].x + v[j].y * v[j].y) + (v[j].z * v[j].z + v[j].w * v[j].w); }
        if (row + F.NGW < T) P10_LOAD(row + F.NGW);
        const float rstd = 1.0f / sqrtf(wave_sum(s) * (1.0f / D) + RMS_EPS);
        f32x4* orow = (f32x4*)(F.out + (size_t)row * D) + F.lane;
#pragma unroll
        for (int j = 0; j < 4; ++j) { const f32x4 g = *((const f32x4*)F.g_final + F.lane + 64 * j); orow[64 * j] = v[j] * rstd * g; }
    }
#undef P10_LOAD
#undef P10_H
}

typedef float f32x16 __attribute__((ext_vector_type(16)));
typedef short s16x4 __attribute__((ext_vector_type(4)));
constexpr int ATT_SCR_OFF = RING_BYTES;
__device__ __forceinline__ int crow16(int r, int hi) { return (r & 3) + 8 * (r >> 2) + 4 * hi; }
__device__ __forceinline__ s16x4 lds_tr16(const LAS unsigned char* p) { return __builtin_bit_cast(s16x4, __builtin_amdgcn_ds_read_tr16_b64_v4i16((LAS s16x4*)p)); }

struct AttItem { int b, g, hd, r, n, d, cont; };
__device__ __forceinline__ AttItem att_decode(int it) {
    AttItem a; const int G = it >> 2, j = it & 3;
    if (G < 128) { a.g = 0; a.b = G >> 4; a.hd = (G >> 2) & 3; a.r = 0; a.n = 4 * (G & 3) + j; a.d = 1; a.cont = j > 0; }
    else if (G < 256) { const int x = G - 128; a.g = 1; a.b = x >> 4; a.hd = (x >> 2) & 3; a.r = x & 3; a.n = j; a.d = 4; a.cont = j > 0; }
    else { const int q = 4 * (G - 256) + j; a.g = 2; a.b = q >> 6; a.hd = (q >> 4) & 3; a.r = q & 15; a.n = 0; a.d = 16; a.cont = 0; }
    return a;
}
__device__ __forceinline__ const bf16* att_base(Frame& F, const AttItem& a) { return F.PROJ + (size_t)(a.b * SEQ + a.r) * NP + a.g * 512 + a.hd * 128; }
#define ATT_LOADKV(dst, a_, coff_) do { const bf16* base_ = att_base(F, a_) + (coff_) + 8 * (F.tid & 15); const size_t rs_ = (size_t)(a_).d * NP; const int i0_ = 128 * ((a_).n - 1) + (F.tid >> 4); \
        const bool skp_ = ((a_).n == 0) || (a_).cont; \
        _Pragma("unroll") for (int p_ = 0; p_ < 8; ++p_) { if (skp_ && p_ < 4) continue; dst[p_] = *(const u32x4*)(base_ + (size_t)(i0_ + 32 * p_) * rs_); } } while (0)

__device__ __forceinline__ void attn_phase(Frame& F) {
    const int lane = F.lane, w = F.wave, fr = lane & 15, fq = lane >> 4;
    LAS unsigned char* Ks = F.lds; LAS unsigned char* Vs = F.lds + 65536;
    const int kc = F.tid & 15, kk0 = F.tid >> 4;
    u32x4 kreg[8], vreg[8]; bf16x8 qn[4];
#define ATT_LOADQ(dst, a_) do { const bf16* qrow_ = att_base(F, a_) + (size_t)(128 * (a_).n + 16 * w + fr) * ((size_t)(a_).d * NP) + C_AQ + 8 * fq; \
        _Pragma("unroll") for (int s_ = 0; s_ < 4; ++s_) dst[s_] = *(const bf16x8*)(qrow_ + 32 * s_); } while (0)
    LAS int* slot = (LAS int*)(F.lds + RING_BYTES);
    int pend = 0;
    __syncthreads();
    if (F.tid == 0) slot[0] = (int)atomicAdd(F.ctl + CW_ACTR, 1u);
    __syncthreads();
    int it = 4 * __builtin_amdgcn_readfirstlane(slot[0]), pofs = 0;
    if (it < 1536) { const AttItem a0 = att_decode(it); ATT_LOADKV(kreg, a0, C_AK); ATT_LOADKV(vreg, a0, C_AV); ATT_LOADQ(qn, a0); }
    while (it < 1536) {
        const AttItem a = att_decode(it); const int n = a.n, d = a.d; const bool skp = (n == 0) || a.cont;
        pofs = a.cont ? (pofs ^ 128) : 0;
        __syncthreads();
        if (F.tid == 0) { if ((it & 3) == 2) pend = (int)atomicAdd(F.ctl + CW_ACTR, 1u); if ((it & 3) == 3) slot[0] = pend; }
#pragma unroll
        for (int pass = 0; pass < 8; ++pass) { if (skp && pass < 4) continue; const int key = (pass * 32 + kk0) ^ pofs;
            *(LAS u32x4*)(Ks + key * 256 + ((kc ^ (key & 15)) << 4)) = kreg[pass];
            *(LAS u32x4*)(Vs + key * 256 + ((((kc >> 2) ^ (key & 3)) << 6) | ((kc & 3) << 4))) = vreg[pass]; }
        bf16x8 qf[4];
#pragma unroll
        for (int s = 0; s < 4; ++s) qf[s] = qn[s];
        __syncthreads();
        const int itn = ((it & 3) == 3) ? 4 * __builtin_amdgcn_readfirstlane(slot[0]) : it + 1;
        if (itn < 1536) { const AttItem an = att_decode(itn); ATT_LOADKV(kreg, an, C_AK); ATT_LOADKV(vreg, an, C_AV); ATT_LOADQ(qn, an); }
        f32x4 S[10];
#pragma unroll
        for (int i = 0; i < 9; ++i) {
            const int kt = w + i; const bool act = !(n == 0 && kt < 8);
            f32x4 acc = (f32x4){0.f, 0.f, 0.f, 0.f};
            if (act) {
                const LAS unsigned char* kp = Ks + ((kt * 16 + fr) ^ pofs) * 256;
#pragma unroll
                for (int s = 0; s < 4; ++s) { const bf16x8 kf = *(const LAS bf16x8*)(kp + (((4 * s + fq) ^ fr) << 4)); acc = __builtin_amdgcn_mfma_f32_16x16x32_bf16(kf, qf[s], acc, 0, 0, 0); }
                if (i == 0) {
#pragma unroll
                    for (int r = 0; r < 4; ++r) if (4 * fq + r < fr) acc[r] = -INFINITY; }
                if (i == 8) {
#pragma unroll
                    for (int r = 0; r < 4; ++r) if (4 * fq + r > fr) acc[r] = -INFINITY; }
            } else acc = (f32x4){-INFINITY, -INFINITY, -INFINITY, -INFINITY};
            S[i] = acc;
        }
        float m = -INFINITY;
#pragma unroll
        for (int i = 0; i < 9; ++i)
#pragma unroll
            for (int r = 0; r < 4; ++r) m = fmaxf(m, S[i][r]);
        m = fmaxf(m, __shfl_xor(m, 16)); m = fmaxf(m, __shfl_xor(m, 32));
        float l = 0.f;
#pragma unroll
        for (int i = 0; i < 9; ++i)
#pragma unroll
            for (int r = 0; r < 4; ++r) { const float p = __builtin_amdgcn_exp2f(S[i][r] - m); S[i][r] = p; l += p; }
        l += __shfl_xor(l, 16); l += __shfl_xor(l, 32);
        S[9] = (f32x4){0.f, 0.f, 0.f, 0.f};
        f32x4 O[8];
#pragma unroll
        for (int t = 0; t < 8; ++t) O[t] = (f32x4){0.f, 0.f, 0.f, 0.f};
        const int q4 = fr >> 2, p4 = lane & 3;
#pragma unroll
        for (int p = 0; p < 5; ++p) {
            const int kt0 = w + 2 * p, kt1 = kt0 + 1;
            const bool act0 = !(n == 0 && kt0 < 8), act1 = (2 * p + 1 < 9) && !(n == 0 && kt1 < 8);
            if (act0 || act1) {
                u32x4 pw; pw.x = pg8::cvt_pk_bf16(S[2 * p][0], S[2 * p][1]); pw.y = pg8::cvt_pk_bf16(S[2 * p][2], S[2 * p][3]);
                pw.z = pg8::cvt_pk_bf16(S[2 * p + 1][0], S[2 * p + 1][1]); pw.w = pg8::cvt_pk_bf16(S[2 * p + 1][2], S[2 * p + 1][3]);
                const bf16x8 pa = __builtin_bit_cast(bf16x8, pw);
                const int key0 = (kt0 * 16 + 4 * fq + q4) ^ pofs, key1 = (kt1 * 16 + 4 * fq + q4) ^ pofs;
#pragma unroll
                for (int t = 0; t < 8; ++t) {
                    const int col = 16 * t + 4 * p4;
                    const int coff = ((((col >> 5) ^ q4) << 6) | ((col & 31) << 1));
                    s16x4 lo = (s16x4){0, 0, 0, 0}, hi = (s16x4){0, 0, 0, 0};
                    if (act0) lo = lds_tr16(Vs + key0 * 256 + coff);
                    if (act1) hi = lds_tr16(Vs + key1 * 256 + coff);
                    const bf16x8 vb = (bf16x8){lo[0], lo[1], lo[2], lo[3], hi[0], hi[1], hi[2], hi[3]};
                    O[t] = __builtin_amdgcn_mfma_f32_16x16x32_bf16(vb, pa, O[t], 0, 0, 0);
                }
            }
        }
        const float linv = frcp(l);
        const size_t tok0 = (size_t)a.b * SEQ + a.r + (size_t)d * (128 * n + 16 * w);
        if (fq == 0) F.LSE[((size_t)a.g * T + tok0 + (size_t)d * fr) * 4 + a.hd] = m + __log2f(l);
        { bf16* op = F.OG + ((size_t)a.g * T + tok0 + (size_t)d * fr) * 512 + a.hd * 128 + 4 * fq;
#pragma unroll
          for (int t = 0; t < 8; ++t) { u32x2 ow; ow.x = pk2(O[t][0] * linv, O[t][1] * linv); ow.y = pk2(O[t][2] * linv, O[t][3] * linv); *(u32x2*)(op + 16 * t) = ow; } }
        it = itn;
    }
    __syncthreads();
}
#undef ATT_LOADKV
#undef ATT_LOADQ

constexpr int ML_QS = 528, ML_AS = 144;
constexpr int ML_Q = 0, ML_K = 33792;
constexpr int SC_U = 0, SC_MX = 64, SC_EBD = 128, SC_WI = 192, SC_WK = 256, SC_DEC = 320;
__device__ __forceinline__ f32x4 mfma16(bf16x8 a, bf16x8 b, f32x4 c) { return __builtin_amdgcn_mfma_f32_16x16x32_bf16(a, b, c, 0, 0, 0); }


constexpr size_t WS_QK = WS_QC, WS_SCAL = WS_KC;
__device__ __forceinline__ void mlstm_prepass(Frame& F) {
    const int tid = F.tid, lane = F.lane;
    float* SCAL = (float*)((unsigned char*)F.ctl + WS_SCAL);
    bf16* QK = (bf16*)((unsigned char*)F.ctl + WS_QK);
    if (F.vcu < 32) {
        const int b = F.vcu >> 2, h = F.vcu & 3; const float* gbase = F.GATES + (size_t)(b * SEQ) * 8;
        LAS float* lu = (LAS float*)F.lds; LAS float* lpm = lu + 2048; LAS float* lbc = lpm + 2048; LAS float* lm = lbc + 2048;
        __syncthreads();
#pragma unroll
        for (int i = 0; i < 4; ++i) { const int c = 4 * F.wave + i;
            const float gi = gbase[(size_t)(64 * c + lane) * 8 + h], gf = gbase[(size_t)(64 * c + lane) * 8 + 4 + h];
            const float logf = fminf(gf, 0.f) - __logf(1.0f + __expf(-fabsf(gf)));
            float bc = logf;
#pragma unroll
            for (int o = 1; o < 64; o <<= 1) { const float v = __shfl_up(bc, o); if (lane >= o) bc += v; }
            const float u = gi - bc; float pm = u;
#pragma unroll
            for (int o = 1; o < 64; o <<= 1) { const float v = __shfl_up(pm, o); if (lane >= o) pm = fmaxf(pm, v); }
            lu[64 * c + lane] = u; lpm[64 * c + lane] = pm; lbc[64 * c + lane] = bc; }
        __syncthreads();
        if (tid == 0) { float m = 0.f; for (int c = 0; c < 32; ++c) { const float M63 = fmaxf(m, lpm[64 * c + 63]); lm[c] = m; lm[32 + c] = M63; m = lbc[64 * c + 63] + M63; } }
        __syncthreads();
#pragma unroll
        for (int i = 0; i < 4; ++i) { const int c = 4 * F.wave + i; const float m_carry = lm[c], M63 = lm[32 + c];
            const float u = lu[64 * c + lane], bc = lbc[64 * c + lane], Mx = fmaxf(m_carry, lpm[64 * c + lane]);
            float* sp = SCAL + ((size_t)F.vcu * 32 + c) * 384;
            sp[SC_U + lane] = u; sp[SC_MX + lane] = Mx; sp[SC_EBD + lane] = __expf(-(bc + Mx)); sp[SC_WI + lane] = __expf(m_carry - Mx); sp[SC_WK + lane] = __expf(u - M63);
            sp[SC_DEC + lane] = __expf(m_carry - M63); }
        __syncthreads();
    }
    const int rb = tid >> 8, half = (tid >> 7) & 1, cg = tid & 127;
    float cw[4][8];
#pragma unroll
    for (int j = 0; j < 4; ++j) { const float* p = F.conv_qk + j * 2048 + half * 1024 + 8 * cg; const f32x4 a = *(const f32x4*)p, c = *(const f32x4*)(p + 4);
        cw[j][0] = a[0]; cw[j][1] = a[1]; cw[j][2] = a[2]; cw[j][3] = a[3]; cw[j][4] = c[0]; cw[j][5] = c[1]; cw[j][6] = c[2]; cw[j][7] = c[3]; }
    const float oscale = half ? 0.0625f : 1.0f;
    for (int step = F.vcu; step < T / 16; step += F.G) {
        const int row0 = step * 16 + rb * 8, ts0 = row0 & (SEQ - 1);
        const bf16* src = F.PROJ + (size_t)row0 * NP + (half ? C_MK : C_MQ) + 8 * cg;
        u32x4 raw[11];
#pragma unroll
        for (int r = 0; r < 11; ++r) raw[r] = (ts0 - 3 + r >= 0) ? *(const u32x4*)(src + (ptrdiff_t)(r - 3) * NP) : (u32x4){0u, 0u, 0u, 0u};
        bf16* dst = QK + (size_t)row0 * 2048 + half * 1024 + 8 * cg;
        float xf[11][8];
#pragma unroll
        for (int r = 0; r < 11; ++r) { const u32x4 rw = raw[r]; xf[r][0] = bflo(rw.x); xf[r][1] = bfhi(rw.x); xf[r][2] = bflo(rw.y); xf[r][3] = bfhi(rw.y); xf[r][4] = bflo(rw.z); xf[r][5] = bfhi(rw.z); xf[r][6] = bflo(rw.w); xf[r][7] = bfhi(rw.w); }
#pragma unroll
        for (int o = 0; o < 8; ++o) {
            float y[8];
#pragma unroll
            for (int i = 0; i < 8; ++i) y[i] = (cw[0][i] * xf[o][i] + cw[1][i] * xf[o + 1][i]) + (cw[2][i] * xf[o + 2][i] + cw[3][i] * xf[o + 3][i]);
#pragma unroll
            for (int i = 0; i < 8; ++i) y[i] = y[i] * oscale * frcp(1.0f + __expf(-y[i]));
            u32x4 pw; pw.x = pk2(y[0], y[1]); pw.y = pk2(y[2], y[3]); pw.z = pk2(y[4], y[5]); pw.w = pk2(y[6], y[7]);
            *(u32x4*)(dst + (size_t)o * 2048) = pw; }
    }
}

template <int NDT> struct MLMap {
    static constexpr int VROWS = 16 * (NDT + 1), CT = ML_K + 64 * ML_QS, A = CT + VROWS * ML_QS, VT = A + 64 * ML_AS, VWT = VT + VROWS * ML_AS, SC = VWT + VROWS * ML_AS, END = SC + 4 * 384;
    static_assert(END <= LDSCTL_OFF, "mLSTM LDS map");
};
template <int NDT>
__device__ __forceinline__ void mlstm_item(Frame& F, int b, int h, int sl) {
    typedef MLMap<NDT> MP; constexpr int VROWS = MP::VROWS, PARTS = 2 * NDT, NT2 = NDT / 2, NB5 = NDT + 1;
    const int tid = F.tid, lane = F.lane, w = F.wave, fr = lane & 15, fq = lane >> 4;
    LAS unsigned char* L = F.lds; LAS float* SC = (LAS float*)(L + MP::SC);
    const bf16* qkbase = (const bf16*)((const unsigned char*)F.ctl + WS_QK) + (size_t)(b * SEQ) * 2048 + h * 256 + 8 * (tid & 31);
#ifndef VMAP
#define VMAP 1
#endif
    const bool vact = tid < 64 * PARTS; const int vs = VMAP ? (tid & 63) : (tid / PARTS), vpart = VMAP ? (tid >> 6) : (tid % PARTS);
    const bf16* vbase = F.PROJ + (size_t)(b * SEQ) * NP + C_MV + h * 256 + sl * (16 * NDT) + 8 * vpart;
    const float* scbase = (const float*)((const unsigned char*)F.ctl + WS_SCAL) + (size_t)((b * 4 + h) * 32) * 384 + (tid < 384 ? tid : 0);
    const float* wkbase = (const float*)((const unsigned char*)F.ctl + WS_SCAL) + (size_t)((b * 4 + h) * 32) * 384 + SC_WK + vs;
    __syncthreads();
    for (int i = tid; i < (MP::A - MP::CT) / 4; i += NTHREADS) ((LAS unsigned*)(L + MP::CT))[i] = 0u;
    for (int i = tid; i < (MP::SC - MP::VT) / 4; i += NTHREADS) ((LAS unsigned*)(L + MP::VT))[i] = 0u;
    __syncthreads();
    if (tid < 32) ((LAS unsigned*)(L + MP::VT + (16 * NDT) * ML_AS))[tid] = 0x3F803F80u;
    f32x4 C[2][NB5];
#pragma unroll
    for (int a = 0; a < 2; ++a)
#pragma unroll
        for (int bb = 0; bb < NB5; ++bb) C[a][bb] = (f32x4){0.f, 0.f, 0.f, 0.f};
    u32x4 qk[8]; u32x4 vraw = (u32x4){0u, 0u, 0u, 0u}; float scv = 0.f, wkv = 0.f;
    unsigned hpk[NT2][2];
#define ML_ISSUE(c_) do { const int t0_ = 64 * (c_); \
        _Pragma("unroll") for (int i_ = 0; i_ < 4; ++i_) { const bf16* p_ = qkbase + (size_t)(t0_ + (tid >> 5) + 16 * i_) * 2048; qk[i_] = *(const u32x4*)p_; qk[4 + i_] = *(const u32x4*)(p_ + 1024); } \
        if (vact) { vraw = *(const u32x4*)(vbase + (size_t)(t0_ + vs) * NP); wkv = wkbase[(size_t)(c_) * 384]; } \
        if (tid < 384) scv = scbase[(size_t)(c_) * 384]; } while (0)
    ML_ISSUE(0);
    for (int c = 0; c < 32; ++c) {
        { LAS unsigned char* dq = L + ML_Q + (tid >> 5) * ML_QS + 16 * (tid & 31);
#pragma unroll
          for (int i = 0; i < 4; ++i) { *(LAS u32x4*)(dq + 16 * i * ML_QS) = qk[i]; *(LAS u32x4*)(dq + (ML_K - ML_Q) + 16 * i * ML_QS) = qk[4 + i]; } }
        if (vact) { LAS bf16* vt = (LAS bf16*)(L + MP::VT) + vs; LAS bf16* vw = (LAS bf16*)(L + MP::VWT) + vs;
            const float vf[8] = {bflo(vraw.x), bfhi(vraw.x), bflo(vraw.y), bfhi(vraw.y), bflo(vraw.z), bfhi(vraw.z), bflo(vraw.w), bfhi(vraw.w)};
            const unsigned vr[4] = {vraw.x, vraw.y, vraw.z, vraw.w};
#pragma unroll
            for (int i = 0; i < 4; ++i) { const unsigned pw = pk2(vf[2 * i] * wkv, vf[2 * i + 1] * wkv);
                vt[(8 * vpart + 2 * i) * (ML_AS / 2)] = (bf16)(vr[i] & 0xffffu); vt[(8 * vpart + 2 * i + 1) * (ML_AS / 2)] = (bf16)(vr[i] >> 16);
                vw[(8 * vpart + 2 * i) * (ML_AS / 2)] = (bf16)(pw & 0xffffu); vw[(8 * vpart + 2 * i + 1) * (ML_AS / 2)] = (bf16)(pw >> 16); } }
        if (tid >= 256 && tid < 320) ((LAS bf16*)(L + MP::VWT))[(16 * NDT) * (ML_AS / 2) + tid - 256] = (bf16)f2bf(scv);
        if (tid < 384) SC[tid] = scv;
        __syncthreads();
        if (c > 0) { bf16* hpp = (bf16*)F.HT + (size_t)(b * SEQ + 64 * (c - 1) + 16 * (w & 3) + 4 * fq) * D + h * 256 + sl * (16 * NDT) + 16 * ((w >> 2) * NT2) + fr;
#pragma unroll
            for (int j = 0; j < NT2; ++j) { hpp[16 * j] = (bf16)(hpk[j][0] & 0xffffu); hpp[(size_t)D + 16 * j] = (bf16)(hpk[j][0] >> 16); hpp[(size_t)2 * D + 16 * j] = (bf16)(hpk[j][1] & 0xffffu); hpp[(size_t)3 * D + 16 * j] = (bf16)(hpk[j][1] >> 16); } }
        if (c + 1 < 32) ML_ISSUE(c + 1);
        const int ti = w & 3;
#ifndef DUP_B
#define DUP_B 1
#endif
        for (int dupb = 0; dupb < DUP_B; ++dupb)
        { const int si0 = (w >> 2) * 2;
          const LAS unsigned char* qp = L + ML_Q + (16 * ti + fr) * ML_QS + 16 * fq;
          const LAS unsigned char* kp = L + ML_K + (16 * si0 + fr) * ML_QS + 16 * fq;
          f32x4 sacc[2] = {(f32x4){0.f, 0.f, 0.f, 0.f}, (f32x4){0.f, 0.f, 0.f, 0.f}};
#pragma unroll
          for (int hb = 0; hb < 2; ++hb) {
              bf16x8 qa[4], k0[4], k1[4];
#pragma unroll
              for (int kk = 0; kk < 4; ++kk) { qa[kk] = *(const LAS bf16x8*)(qp + 64 * (4 * hb + kk)); k0[kk] = *(const LAS bf16x8*)(kp + 64 * (4 * hb + kk)); k1[kk] = *(const LAS bf16x8*)(kp + 16 * ML_QS + 64 * (4 * hb + kk)); }
              __builtin_amdgcn_sched_barrier(0);
#pragma unroll
              for (int kk = 0; kk < 4; ++kk) { sacc[0] = mfma16(k0[kk], qa[kk], sacc[0]); sacc[1] = mfma16(k1[kk], qa[kk], sacc[1]); }
          }
          { const int t = 16 * ti + fr; const float mxt = SC[SC_MX + t];
#pragma unroll
            for (int si = 0; si < 2; ++si) { const int s0 = 16 * (si0 + si) + 4 * fq; const f32x4 us = *(const LAS f32x4*)(SC + SC_U + s0); float val[4];
#pragma unroll
                for (int r = 0; r < 4; ++r) val[r] = (s0 + r <= t) ? sacc[si][r] * __expf(us[r] - mxt) : 0.f;
                u32x2 pw; pw.x = pk2(val[0], val[1]); pw.y = pk2(val[2], val[3]);
                *(LAS u32x2*)(L + MP::A + t * ML_AS + 2 * s0) = pw; } } }
        __syncthreads();
        { const int dj0 = (w >> 2) * NT2;
          const LAS unsigned char* ap = L + MP::A + (16 * ti + fr) * ML_AS + 16 * fq;
          const LAS unsigned char* vp = L + MP::VT + (16 * dj0 + fr) * ML_AS + 16 * fq; const LAS unsigned char* ep = L + MP::VT + (16 * NDT + fr) * ML_AS + 16 * fq;
          const LAS unsigned char* cp = L + MP::CT + (16 * dj0 + fr) * ML_QS + 16 * fq; const LAS unsigned char* cep = L + MP::CT + (16 * NDT + fr) * ML_QS + 16 * fq;
          bf16x8 aa[2], vv[NT2][2], ee[2], afr[2][2], bw[2][NB5];
#pragma unroll
          for (int ks = 0; ks < 2; ++ks) { aa[ks] = *(const LAS bf16x8*)(ap + 64 * ks); ee[ks] = *(const LAS bf16x8*)(ep + 64 * ks);
#pragma unroll
              for (int j = 0; j < NT2; ++j) vv[j][ks] = *(const LAS bf16x8*)(vp + 16 * j * ML_AS + 64 * ks); }
          const int q4 = fr >> 2, p4 = lane & 3;
#pragma unroll
          for (int ks = 0; ks < 2; ++ks) {
#pragma unroll
              for (int a = 0; a < 2; ++a) { const LAS unsigned char* kp = L + ML_K + (32 * ks + 8 * fq + q4) * ML_QS + (16 * (2 * w + a) + 4 * p4) * 2;
                  const s16x4 lo = lds_tr16(kp), hi = lds_tr16(kp + 4 * ML_QS); afr[ks][a] = (bf16x8){lo[0], lo[1], lo[2], lo[3], hi[0], hi[1], hi[2], hi[3]}; }
#pragma unroll
              for (int bb = 0; bb < NB5; ++bb) bw[ks][bb] = *(const LAS bf16x8*)(L + MP::VWT + (16 * bb + fr) * ML_AS + 16 * fq + 64 * ks); }
          const float dec = SC[SC_DEC];
          f32x4 wi4, eb4;
#pragma unroll
          for (int r = 0; r < 4; ++r) { wi4[r] = SC[SC_WI + 16 * ti + 4 * fq + r]; eb4[r] = SC[SC_EBD + 16 * ti + 4 * fq + r]; }
          __builtin_amdgcn_sched_barrier(0);
          f32x4 av[NT2], av2[NT2], ae = (f32x4){0.f, 0.f, 0.f, 0.f}, ae2 = ae;
#pragma unroll
          for (int j = 0; j < NT2; ++j) { av[j] = (f32x4){0.f, 0.f, 0.f, 0.f}; av2[j] = av[j]; }
#pragma unroll
          for (int a = 0; a < 2; ++a)
#pragma unroll
              for (int bb = 0; bb < NB5; ++bb) C[a][bb] *= dec;
#pragma unroll
          for (int ks = 0; ks < 2; ++ks) { ae = mfma16(aa[ks], ee[ks], ae);
#pragma unroll
              for (int j = 0; j < NT2; ++j) av[j] = mfma16(aa[ks], vv[j][ks], av[j]); }
#pragma unroll
          for (int ks = 0; ks < 2; ++ks)
#pragma unroll
              for (int bb = 0; bb < NB5; ++bb) { C[0][bb] = mfma16(afr[ks][0], bw[ks][bb], C[0][bb]); C[1][bb] = mfma16(afr[ks][1], bw[ks][bb], C[1][bb]); }
          __builtin_amdgcn_sched_barrier(0);
          { const LAS unsigned char* qp = L + ML_Q + (16 * ti + fr) * ML_QS + 16 * fq;
#pragma unroll
            for (int hb = 0; hb < 2; ++hb) {
                bf16x8 qa[4], cc[NT2][4], ce[4];
#pragma unroll
                for (int kk = 0; kk < 4; ++kk) { qa[kk] = *(const LAS bf16x8*)(qp + 64 * (4 * hb + kk)); ce[kk] = *(const LAS bf16x8*)(cep + 64 * (4 * hb + kk));
#pragma unroll
                    for (int j = 0; j < NT2; ++j) cc[j][kk] = *(const LAS bf16x8*)(cp + 16 * j * ML_QS + 64 * (4 * hb + kk)); }
                __builtin_amdgcn_sched_barrier(0);
#pragma unroll
                for (int kk = 0; kk < 4; ++kk) { ae2 = mfma16(qa[kk], ce[kk], ae2);
#pragma unroll
                    for (int j = 0; j < NT2; ++j) av2[j] = mfma16(qa[kk], cc[j][kk], av2[j]); }
            } }
          float rd[4];
#pragma unroll
          for (int r = 0; r < 4; ++r) { float dn = ae[r] + wi4[r] * ae2[r]; dn = __shfl(dn, lane & 48); rd[r] = frcp(fmaxf(fabsf(dn), eb4[r])); }
#pragma unroll
          for (int j = 0; j < NT2; ++j) { hpk[j][0] = pk2((av[j][0] + wi4[0] * av2[j][0]) * rd[0], (av[j][1] + wi4[1] * av2[j][1]) * rd[1]);
              hpk[j][1] = pk2((av[j][2] + wi4[2] * av2[j][2]) * rd[2], (av[j][3] + wi4[3] * av2[j][3]) * rd[3]); } }
        __syncthreads();
#pragma unroll
        for (int a = 0; a < 2; ++a)
#pragma unroll
            for (int bb = 0; bb < NB5; ++bb) { u32x2 pw; pw.x = pk2(C[a][bb][0], C[a][bb][1]); pw.y = pk2(C[a][bb][2], C[a][bb][3]);
                *(LAS u32x2*)(L + MP::CT + (16 * bb + fr) * ML_QS + (16 * (2 * w + a) + 4 * fq) * 2) = pw; }
    }
#undef ML_ISSUE
    { bf16* hpp = (bf16*)F.HT + (size_t)(b * SEQ + 64 * 31 + 16 * (w & 3) + 4 * fq) * D + h * 256 + sl * (16 * NDT) + 16 * ((w >> 2) * NT2) + fr;
#pragma unroll
      for (int j = 0; j < NT2; ++j) { hpp[16 * j] = (bf16)(hpk[j][0] & 0xffffu); hpp[(size_t)D + 16 * j] = (bf16)(hpk[j][0] >> 16); hpp[(size_t)2 * D + 16 * j] = (bf16)(hpk[j][1] & 0xffffu); hpp[(size_t)3 * D + 16 * j] = (bf16)(hpk[j][1] >> 16); } }
    __syncthreads();
}

constexpr int CQ_TS = 144, CQ_SCR = 2 * 32 * CQ_TS;
struct CqItem { const float* W; unsigned char* WT; int Nsrc, c0, k0, row0, row1, rstep; };
__device__ __forceinline__ CqItem cq_decode(Frame& F, int r) {
    constexpr int I_GU1 = (D / 128) * (2048 / 64), I_DN1 = (D / 128) * (D / 64);
    CqItem it;
    if (r < NE * I_GU1) { const int e = r / I_GU1, q = r % I_GU1, kb = q / 32, cb = q % 32, j0 = 32 * cb;
        it.W = F.w_gate_up + (size_t)e * D * 2048; it.WT = (unsigned char*)F.WguT + (size_t)e * 2048 * D; it.Nsrc = 2048; it.c0 = 2 * j0; it.k0 = 128 * kb;
        it.row0 = (j0 >> 7) * 256 + (j0 & 127); it.row1 = it.row0 + 128; it.rstep = 1; }
    else { r -= NE * I_GU1; const int e = r / I_DN1, q = r % I_DN1, kb = q / 16, cb = q % 16;
        it.W = F.w_down + (size_t)e * D * D; it.WT = (unsigned char*)F.WdnT + (size_t)e * D * D; it.Nsrc = D; it.c0 = 64 * cb; it.k0 = 128 * kb;
        it.row0 = 64 * cb; it.row1 = 64 * cb + 1; it.rstep = 2; }
    return it;
}
__device__ __forceinline__ void cq_load(const CqItem& it, int half, int lane, f32x4 (&v)[16]) {
    const float* p = it.W + (size_t)(it.k0 + 64 * half + 4 * (lane >> 4)) * it.Nsrc + it.c0 + 4 * (lane & 15);
#pragma unroll
    for (int pp = 0; pp < 4; ++pp)
#pragma unroll
        for (int i = 0; i < 4; ++i) v[4 * pp + i] = *(const f32x4*)(p + (size_t)(16 * pp + i) * it.Nsrc);
}
__device__ __forceinline__ void cq_pack(const f32x4 (&v)[16], int half, int lane, LAS unsigned char* scr, float sc) {
    LAS unsigned char* t0 = scr + (2 * (lane & 15)) * CQ_TS + 4 * (16 * half + (lane >> 4));
#pragma unroll
    for (int pp = 0; pp < 4; ++pp)
#pragma unroll
        for (int c = 0; c < 4; ++c)
            *(LAS unsigned*)(t0 + (c & 1) * 32 * CQ_TS + (c >> 1) * CQ_TS + 16 * pp) = pk4_fp8(v[4 * pp][c] * sc, v[4 * pp + 1][c] * sc, v[4 * pp + 2][c] * sc, v[4 * pp + 3][c] * sc);
}
__device__ __forceinline__ void cq_store(const CqItem& it, int lane, LAS unsigned char* scr) {
    asm volatile("s_waitcnt lgkmcnt(0)" ::: "memory");
    const int r = lane >> 1, hf = lane & 1;
#pragma unroll
    for (int t = 0; t < 2; ++t) { const LAS unsigned char* s = scr + t * 32 * CQ_TS + r * CQ_TS + 64 * hf;
        unsigned char* d = it.WT + (size_t)((t ? it.row1 : it.row0) + r * it.rstep) * D + it.k0 + 64 * hf;
#pragma unroll
        for (int j = 0; j < 4; ++j) *(u32x4*)(d + 16 * j) = *(const LAS u32x4*)(s + 16 * j); }
    asm volatile("s_waitcnt lgkmcnt(0)" ::: "memory");
}
constexpr int CS_GRAB = 8;
__device__ __forceinline__ void convert_steal(Frame& F) {
    constexpr int I_GU1 = (D / 128) * (2048 / 64), I_DN1 = (D / 128) * (D / 64), NIT = NE * (I_GU1 + I_DN1);
    static_assert(NIT % CS_GRAB == 0, "conversion items per grab");
    LAS unsigned char* scr = F.lds + F.wave * CQ_SCR; LAS int* slot = (LAS int*)(F.lds + 8 * CQ_SCR);
    int nxt = 0;
    __syncthreads();
    if (F.tid == 0) nxt = (int)atomicAdd(F.ctl + CW_QCTR, (unsigned)CS_GRAB);
    for (;;) {
        if (F.tid == 0) slot[0] = nxt;
        __syncthreads();
        const int base = slot[0]; if (base >= NIT) break;
        if (F.tid == 0) nxt = (int)atomicAdd(F.ctl + CW_QCTR, (unsigned)CS_GRAB);
        const CqItem it = cq_decode(F, base + F.wave);
        f32x4 va[16], vb[16];
        cq_load(it, 0, F.lane, va);
        cq_load(it, 1, F.lane, vb);
        cq_pack(va, 0, F.lane, scr, 32.0f);
        cq_pack(vb, 1, F.lane, scr, 32.0f);
        cq_store(it, F.lane, scr);
        __syncthreads();
    }
}

#ifndef ML_NDT
#define ML_NDT 4
#endif
__device__ __forceinline__ void mlstm_phase(Frame& F) {
    constexpr int SLICES = 16 / ML_NDT, NITEMS = NB * 4 * SLICES;
    for (int item = F.vcu; item < NITEMS; item += F.G) mlstm_item<ML_NDT>(F, item / (4 * SLICES), (item / SLICES) & 3, item % SLICES);
#if FAST_ATTN && ATT_QUEUE
    attn_phase(F);
#endif
#if MOE_FP8 && STEAL
#if defined(PROBE_NOSTEAL)
    if (F.vcu >= NITEMS)
#endif
#if defined(PROBE_CONV64)
    if (F.vcu < NITEMS || F.vcu >= 192)
#endif
    convert_steal(F);
#endif
}

constexpr int N_PHASES = 13;
struct Args { const void* in[18]; float* out; unsigned char* ws; int ph_lo, ph_hi; };

__device__ __forceinline__ int opaque_int(int v) { asm volatile("" : "+s"(v)); return v; }
__global__ void __launch_bounds__(NTHREADS, 2) mega_fwd(Args args) {
    extern __shared__ __attribute__((aligned(16))) unsigned char lds[];
    Frame F;
    F.lds = (LAS unsigned char*)lds;
    F.tid = threadIdx.x; F.lane = F.tid & 63; F.wave = __builtin_amdgcn_readfirstlane(F.tid >> 6);
    F.G = gridDim.x; { const int bx = blockIdx.x; F.vcu = (F.G % 8 == 0) ? (bx % 8) * (F.G / 8) + bx / 8 : bx; }
    F.gw = F.vcu * NWAVES + F.wave; F.NGW = F.G * NWAVES;
    unsigned char* ws = args.ws;
    F.ctl = (unsigned*)(ws + WS_CTL);
    F.x = (const float*)args.in[0]; F.positions = (const int*)args.in[1]; F.g_mix = (const float*)args.in[2]; F.w_in = (const float*)args.in[3]; F.conv_qk = (const float*)args.in[4];
    F.b_if = (const float*)args.in[5]; F.g_mnorm = (const float*)args.in[6]; F.w_attn_out = (const float*)args.in[7]; F.w_mlstm_out = (const float*)args.in[8]; F.w_mix_out = (const float*)args.in[9];
    F.g_ffn = (const float*)args.in[10]; F.w_router = (const float*)args.in[11]; F.b_router = (const float*)args.in[12]; F.w_gate_up = (const float*)args.in[13]; F.b_gate_up = (const float*)args.in[14];
    F.w_down = (const float*)args.in[15]; F.b_down = (const float*)args.in[16]; F.g_final = (const float*)args.in[17]; F.out = args.out;
    F.WinT = (bf16*)(ws + WS_WIN); F.WamT = (bf16*)(ws + WS_WAM); F.WoT = (bf16*)(ws + WS_WO); F.WguT = (bf16*)(ws + WS_WGU); F.WdnT = (bf16*)(ws + WS_WDN);
    F.XN = (bf16*)(ws + WS_XN); F.PROJ = (bf16*)(ws + WS_PROJ); F.OG = (bf16*)(ws + WS_OG); F.AM = (bf16*)(ws + WS_AM); F.MERGED = (bf16*)(ws + WS_MERGED);
    F.XS = (bf16*)(ws + WS_XS); F.ACT = (bf16*)(ws + WS_ACT); F.YBUF = (bf16*)(ws + WS_YBUF);
    F.GATES = (float*)(ws + WS_GATES); F.ROPE = (float*)(ws + WS_ROPE); F.LSE = (float*)(ws + WS_LSE); F.HT = (float*)(ws + WS_HT); F.H = (float*)(ws + WS_H);
    F.QC = (float*)(ws + WS_QC); F.KC = (float*)(ws + WS_KC);
    F.TOK_E = (int*)(ws + WS_ROUTE); F.TOK_SLOT = F.TOK_E + NA; F.TOK_W = (float*)(F.TOK_SLOT + NA);
    F.ROW_TOK = (int*)(ws + WS_ROWMETA); F.ROW_W = (float*)(F.ROW_TOK + (RM_FUSED ? NE * ECAP : XS_ROWS));

    const int lo = args.ph_lo, hi = args.ph_hi;
    for (int u = F.tid; u < (LDS_BYTES - LDSCTL_OFF) / 4; u += NTHREADS) ((LAS unsigned*)(F.lds + LDSCTL_OFF))[u] = 0u;
    __syncthreads();
    XcdBarrier bar; bar.bar = F.ctl + CW_BAR; bar.x = 0; bar.st = nullptr;
    if (hi - lo > 1) bar = xcd_barrier_post(F.ctl + CW_BAR, (volatile LAS unsigned*)(F.lds + MISC_OFF) + 8);
#ifndef PH_MASK
#define PH_MASK 0xffffffffu
#endif
#ifndef REP_MASK
#define REP_MASK 0u
#endif
#define IN(k) (((PH_MASK >> (k)) & 1u) && lo <= (k) && (k) < hi)
#define REPS(k) for (int rep_ = 0, nrep_ = ((REP_MASK >> (k)) & 1u) ? opaque_int(2) : 1; rep_ < nrep_; ++rep_)
#define SEAM(k) do { if (IN(k) && IN((k) + 1)) { GRID_BAR(); } } while (0)
#define GRID_BAR() xcd_barrier(bar)

    if (IN(0)) REPS(0) { p0_weights(F); p0_rows(F); }
    SEAM(0);
    if (IN(1)) REPS(1) {
#if FAST_P1
#if P1_FP8
        constexpr int NF8 = 64 * (18 + 42 - P1_HI), NBF = 64 * (P1_HI - 18);
        constexpr bool SPLIT = (NF8 == 128 * 15 && NBF == 128 * 6);
        { pg8::Gemm g{(const bf16*)((const unsigned char*)F.ctl + WS_XN8), F.WinT, T, (18 + 42 - P1_HI) * 256, D / 2}; pg8::SplitOrder S; S.base.init(T, (18 + 42 - P1_HI) * 256, F.G, (int)blockIdx.x);
          S.nA = SPLIT ? 9 : -1; S.nB = SPLIT ? 6 : -1;
          pg8::EpiProj<1> E{F.PROJ, F.ROPE};
          pg8::gemm_phase<pg8::EpiProj<1>, pg8::SplitOrder, true, true, true>(F.lds, g, S, E); }
        { pg8::Gemm g{F.XN, F.WinT + (size_t)18 * 256 * D, T, (P1_HI - 18) * 256, D}; pg8::SplitOrder S; S.base.init(T, (P1_HI - 18) * 256, F.G, (int)blockIdx.x);
          S.nA = SPLIT ? 2 : -1; S.nB = SPLIT ? 4 : -1;
          pg8::EpiProj<2> E{F.PROJ, F.ROPE};
          pg8::gemm_phase<pg8::EpiProj<2>, pg8::SplitOrder, true, true>(F.lds, g, S, E); }
#else
        pg8::Gemm g{F.XN, F.WinT, T, NP, D}; pg8::StaticOrder S; S.init(T, NP, F.G, (int)blockIdx.x);
        pg8::EpiProj<0> E{F.PROJ, F.ROPE};
        pg8::gemm_phase<pg8::EpiProj<0>, pg8::StaticOrder, true, true>(F.lds, g, S, E);
#endif
#else
        naive_p1(F);
#endif
    }
    SEAM(1);
    if (IN(2)) REPS(2) {
#if !FAST_P1
        naive_p1_rope(F);
#endif
    }
#if !FAST_P1
    SEAM(2);
#endif
    if (IN(3)) REPS(3) {
#if !FAST_MLSTM
        naive_conv(F);
#endif
#if FAST_MLSTM
        mlstm_prepass(F);
#endif
#if FAST_ATTN && !(ATT_QUEUE && FAST_MLSTM)
        attn_phase(F);
#elif !FAST_ATTN
        naive_attn(F);
#endif
    }
    SEAM(3);
    if (IN(4)) REPS(4) {
#if FAST_MLSTM
        mlstm_phase(F);
#else
        naive_mlstm(F);
#endif
    }
    SEAM(4);
    if (IN(5)) REPS(5) p3_post_mixer(F);
    SEAM(5);
    if (IN(6)) REPS(6) {
#if FAST_P4
        constexpr bool STREAM = (MIX_STREAM && FAST_P5);
        pg8::Gemm g{F.AM, F.WamT, T, D, MERGE_FP8 ? AMLD / 2 : AMLD};
        { pg8::MergedOrder S; S.base.init(T, D, F.G, (int)blockIdx.x); S.nparts = 2; S.pub = STREAM; S.ready = F.ctl + CW_READY2; S.tmo = F.ctl + CW_TMO;
          pg8::EpiMerged E{MERGE_FP8 ? (bf16*)((unsigned char*)F.AM + 1536) : F.AM + 1536, F.PROJ, F.x, F.H, false};
          pg8::gemm_phase<pg8::EpiMerged, pg8::MergedOrder, false, true, (MERGE_FP8 != 0)>(F.lds, g, S, E); }
        if (STREAM) {
          pg8::MergedOrder S; S.base.init(T, D, F.G, (int)blockIdx.x); S.nparts = 1; S.pub = true; S.ready = F.ctl + CW_READY2; S.tmo = F.ctl + CW_TMO;
          pg8::EpiMerged E{MERGE_FP8 ? (bf16*)((unsigned char*)F.AM + 1536) : F.AM + 1536, F.PROJ, F.x, F.H, false};
          pg8::gemm_phase<pg8::EpiMerged, pg8::MergedOrder, false, true, (MERGE_FP8 != 0)>(F.lds, g, S, E); }
#else
        naive_p4(F);
#endif
    }
#if !(MIX_STREAM && FAST_P4 && FAST_P5)
    SEAM(6);
#endif
    if (IN(7)) REPS(7) {
#if FAST_P5
#if !(MIX_STREAM && FAST_P4)
        { pg8::Gemm g{F.AM, F.WamT, T, D, MERGE_FP8 ? AMLD / 2 : AMLD}; pg8::MergedOrder S; S.base.init(T, D, F.G, (int)blockIdx.x); S.nparts = 1; S.pub = false; S.ready = F.ctl + CW_READY2; S.tmo = F.ctl + CW_TMO;
          pg8::EpiMerged E{MERGE_FP8 ? (bf16*)((unsigned char*)F.AM + 1536) : F.AM + 1536, F.PROJ, F.x, F.H, false};
          pg8::gemm_phase<pg8::EpiMerged, pg8::MergedOrder, false, true, (MERGE_FP8 != 0)>(F.lds, g, S, E); }
#endif
#else
        naive_p5(F);
#endif
    }
    SEAM(7);
#if MOE_FP8 && ROUTER_MFMA
    if (IN(8)) REPS(8) p6_router_mfma(F);
#else
    if (IN(8)) REPS(8) p6_router(F);
#endif
    SEAM(8);
#if !RM_FUSED
    if (IN(9)) REPS(9) p7_gather(F);
    SEAM(9);
#endif
#if MOE_FP8 && MOE_STREAM && FAST_MOE
    if (IN(10)) REPS(10) {
        LAS int* tl_e = (LAS int*)(F.lds + RING_BYTES); LAS int* tl_base = tl_e + 320; LAS int* tl_nv = tl_base + 320; LAS int* tl_n = tl_nv + 320;
        __syncthreads();
        if (F.tid < 64) { const int e = F.lane & 31, cnt = (int)__hip_atomic_load(F.ctl + CW_CNT + 64 * e, __ATOMIC_RELAXED, __HIP_MEMORY_SCOPE_AGENT), nt = (cnt + 255) >> 8;
            int incl = nt;
#pragma unroll
            for (int o = 1; o < 32; o <<= 1) { const int v = __shfl_up(incl, o, 32); if ((F.lane & 31) >= o) incl += v; }
            if (F.tid < 32) { const int t0 = incl - nt; for (int j = 0; j < nt; ++j) { tl_e[t0 + j] = e; tl_base[t0 + j] = e * ECAP + 256 * j; tl_nv[t0 + j] = min(256, cnt - 256 * j); } if (e == 31) tl_n[0] = incl; } }
        __syncthreads();
        const int ntiles = __builtin_amdgcn_readfirstlane(tl_n[0]);
        pg8::MoeOrder S{(const LAS unsigned*)tl_e, ntiles, F.G, (int)blockIdx.x, F.ROW_TOK, F.XN, F.ACT, F.WguT, F.WdnT, F.ctl + CW_READY, F.ctl + CW_TMO, tl_base, tl_nv};
        pg8::Gemm g{F.XN, F.WguT, ntiles * 256, NE * 2048, D / 2};
        pg8::EpiMoe E{{F.ACT, F.b_gate_up, 1.0f / 32.0f}, {F.YBUF, F.b_down, F.ROW_TOK, F.ROW_W, 1.0f / 32.0f, tl_base, tl_nv}};
        pg8::gemm_phase<pg8::EpiMoe, pg8::MoeOrder, true, true, true, true, true>(F.lds, g, S, E);
    }
#else
    if (IN(10)) REPS(10) {
        const int ntiles = (int)F.ctl[CW_NTILES];
#if FAST_MOE
        pg8::GroupedOrder S{F.ctl + CW_TILEE, ntiles, 8, F.G, (int)blockIdx.x, F.ROW_TOK};
#if MOE_FP8
        pg8::Gemm g{F.XN, F.WguT, ntiles * 256, NE * 2048, D / 2}; pg8::EpiSwiGLU<true> E{F.ACT, F.b_gate_up, 1.0f / 32.0f};
        pg8::gemm_phase<pg8::EpiSwiGLU<true>, pg8::GroupedOrder, true, true, true, true>(F.lds, g, S, E);
#else
        pg8::Gemm g{F.XS, F.WguT, ntiles * 256, NE * 2048, D}; pg8::EpiSwiGLU<false> E{F.ACT, F.b_gate_up, 1.0f};
        pg8::gemm_phase<pg8::EpiSwiGLU<false>, pg8::GroupedOrder, true, true, false>(F.lds, g, S, E);
#endif
#else
        naive_p8(F, ntiles);
#endif
    }
    SEAM(10);
    if (IN(11)) REPS(11) {
        const int ntiles = (int)F.ctl[CW_NTILES];
#if FAST_MOE
        pg8::GroupedOrder S{F.ctl + CW_TILEE, ntiles, 4, F.G, (int)blockIdx.x, F.ROW_TOK};
#if MOE_FP8
        pg8::Gemm g{F.ACT, F.WdnT, ntiles * 256, NE * D, D / 2}; pg8::EpiDown E{F.YBUF, F.b_down, F.ROW_TOK, F.ROW_W, 1.0f / 32.0f};
        pg8::gemm_phase<pg8::EpiDown, pg8::GroupedOrder, true, true, true>(F.lds, g, S, E);
#else
        pg8::Gemm g{F.ACT, F.WdnT, ntiles * 256, NE * D, D}; pg8::EpiDown E{F.YBUF, F.b_down, F.ROW_TOK, F.ROW_W, 1.0f};
        pg8::gemm_phase<pg8::EpiDown, pg8::GroupedOrder, true, true, false>(F.lds, g, S, E);
#endif
#else
        naive_p9(F, ntiles);
#endif
    }
#endif
    SEAM(11);
    if (IN(12)) REPS(12) p10_final(F);
#undef IN
#undef SEAM
}

extern "C" void kernel_launch(void* const* d_in, const int* in_sizes, int n_in, void* d_out, int out_size, void* d_ws, size_t ws_size, hipStream_t stream) {
    static int grid = 0;
    if (grid == 0) {
        if (n_in != 18 || out_size != T * D || ws_size < WS_END) { fprintf(stderr, "kernel_launch: unexpected shapes (n_in %d, out %d, ws %zu)\n", n_in, out_size, ws_size); grid = -1; return; }
        int dev = 0, cus = 0;
        if (hipGetDevice(&dev) != hipSuccess || hipDeviceGetAttribute(&cus, hipDeviceAttributeMultiprocessorCount, dev) != hipSuccess) { grid = -1; return; }
        if (hipFuncSetAttribute((const void*)mega_fwd, hipFuncAttributeMaxDynamicSharedMemorySize, LDS_BYTES) != hipSuccess) { fprintf(stderr, "kernel_launch: hipFuncSetAttribute failed\n"); grid = -1; return; }
        int per_cu = 0;
        if (hipOccupancyMaxActiveBlocksPerMultiprocessor(&per_cu, (const void*)mega_fwd, NTHREADS, LDS_BYTES) != hipSuccess || per_cu < 1) { fprintf(stderr, "kernel_launch: occupancy query says %d blocks per CU\n", per_cu); (void)hipGetLastError(); grid = -1; return; }
        grid = cus;
    }
    if (grid < 0) return;
    (void)hipMemsetAsync((char*)d_ws + WS_CTL, 0, CTL_ZERO_BYTES, stream);
    Args a{};
    for (int i = 0; i < 18; ++i) a.in[i] = d_in[i];
    a.out = (float*)d_out; a.ws = (unsigned char*)d_ws;
#if defined(MK_MULTI)
    for (int p = 0; p < N_PHASES; ++p) {
        a.ph_lo = p; a.ph_hi = p + 1;
        hipLaunchKernelGGL(mega_fwd, dim3(grid), dim3(NTHREADS), LDS_BYTES, stream, a);
    }
#else
#if defined(PROBE_HI)
    a.ph_lo = 0; a.ph_hi = PROBE_HI;
    hipLaunchKernelGGL(mega_fwd, dim3(grid), dim3(NTHREADS), LDS_BYTES, stream, a);
    (void)hipMemsetAsync((char*)d_ws + WS_CTL, 0, CTL_ZERO_BYTES, stream);
#endif
    a.ph_lo = 0; a.ph_hi = N_PHASES;
    hipLaunchKernelGGL(mega_fwd, dim3(grid), dim3(NTHREADS), LDS_BYTES, stream, a);
#endif
}
```
